# Optimizing an MI355X kernel written in HIP

```python
import jax, jax.numpy as jnp
from jax import lax
import numpy as np

D_MODEL = 2048
BATCH = 4
SEQ = 2048
DEPTH = 2

GRID_W = 64
CTX_LEN = 256
EPS = 1e-6
NEG_INF = -1e30
ROPE_THETA = 10000.0
BLOCK = 128
N_MOD = 6

MLA_HEADS = 8
MLA_Q_RANK = 512
MLA_KV_RANK = 256
MLA_NOPE = 128
MLA_ROPE = 64
MLA_V = 128

LRU_WIDTH = 1024
LRU_BLOCKS = 8
LRU_CONV = 4
LRU_CONV_LEFT = 2
LRU_C = 8.0

HEAD_DIM = 128
WIN_HEADS = 8
WIN_KV_HEADS = 2
WINDOW = 128
NA_HEADS = 8
NA_ROWS = 8
NA_COLS = 16

N_EXPERTS = 32
N_GROUPS = 8
EXPERTS_PER_GROUP = N_EXPERTS // N_GROUPS
TOP_K = 2
EXPERT_FF = 512

L0_SPLITS = (MLA_Q_RANK, MLA_Q_RANK + MLA_KV_RANK, MLA_Q_RANK + MLA_KV_RANK + MLA_ROPE,
             MLA_Q_RANK + MLA_KV_RANK + MLA_ROPE + LRU_WIDTH)
L0_IN = L0_SPLITS[-1] + LRU_WIDTH
L0_OUT = MLA_HEADS * MLA_V + LRU_WIDTH
WQ_COLS = WIN_HEADS * HEAD_DIM
WKV_COLS = WIN_KV_HEADS * HEAD_DIM
NA_COLS_W = NA_HEADS * HEAD_DIM
L1_SPLITS = (WQ_COLS, WQ_COLS + WKV_COLS, WQ_COLS + 2 * WKV_COLS, WQ_COLS + 2 * WKV_COLS + NA_COLS_W,
             WQ_COLS + 2 * WKV_COLS + 2 * NA_COLS_W)
L1_IN = L1_SPLITS[-1] + NA_COLS_W
L1_OUT = (WIN_HEADS + NA_HEADS) * HEAD_DIM

kernel_name = 'hybrid_dit_mla_rglru_swa_natten_moe'


def rmsnorm(x, g):
    xf = x.astype(jnp.float32)
    y = xf * lax.rsqrt(jnp.mean(xf * xf, axis=-1, keepdims=True) + EPS)
    return (y * g.astype(jnp.float32)).astype(x.dtype)


def modulate(h, shift, scale):
    return h * (1.0 + scale) + shift


def axial_rope(x):
    T, d = x.shape[1], x.shape[-1]
    half, quarter = d // 2, d // 4
    t = jnp.arange(T)
    pos = jnp.stack([t // GRID_W, t % GRID_W], axis=-1).astype(jnp.float32)
    inv_freq = ROPE_THETA ** (-jnp.arange(0, half, 2, dtype=jnp.float32) / half)
    ang = pos[:, :, None] * inv_freq
    cos = jnp.cos(ang)[None, :, None]
    sin = jnp.sin(ang)[None, :, None]
    xs = x.astype(jnp.float32).reshape(x.shape[:-1] + (2, 2, quarter))
    x1, x2 = xs[..., 0, :], xs[..., 1, :]
    out = jnp.stack([x1 * cos - x2 * sin, x2 * cos + x1 * sin], axis=-2)
    return out.reshape(x.shape).astype(x.dtype)


def softmax_sink(s, sink_b):
    if sink_b is None:
        return jax.nn.softmax(s, axis=-1)
    sink_col = jnp.broadcast_to(sink_b.astype(jnp.float32), s.shape[:-1] + (1,))
    return jax.nn.softmax(jnp.concatenate([s, sink_col], axis=-1), axis=-1)[..., :-1]


def full_attention(q, k, v, sink=None):
    scale = q.shape[-1] ** -0.5
    s = jnp.einsum('bqhd,bkhd->bhqk', q, k, preferred_element_type=jnp.float32) * scale
    p = softmax_sink(s, None if sink is None else sink[:, None, None])
    return jnp.einsum('bhqk,bkhd->bqhd', p.astype(v.dtype), v)


def dense_block_attention(q, k, v, k_ctx, v_ctx):
    B, S, H, dq = q.shape
    scale = dq ** -0.5
    keys = jnp.concatenate([k_ctx, k], axis=1)
    vals = jnp.concatenate([v_ctx, v], axis=1)
    qb = jnp.moveaxis(q.reshape(B, S // BLOCK, BLOCK, H, dq), 1, 0)

    def block(qblk):
        s = jnp.einsum('bqhd,bkhd->bhqk', qblk, keys, preferred_element_type=jnp.float32) * scale
        p = jax.nn.softmax(s, axis=-1)
        return jnp.einsum('bhqk,bkhd->bqhd', p.astype(vals.dtype), vals)

    out = lax.map(block, qb)
    return jnp.moveaxis(out, 0, 1).reshape(B, S, H * vals.shape[-1])


def mla_queries(cq, p, rotate):
    B, T, _ = cq.shape
    q = (rmsnorm(cq, p['q_norm']) @ p['w_uq']).reshape(B, T, MLA_HEADS, MLA_NOPE + MLA_ROPE)
    q_nope, q_rope = q[..., :MLA_NOPE], q[..., MLA_NOPE:]
    if rotate:
        q_rope = axial_rope(q_rope)
    return jnp.concatenate([q_nope, q_rope], axis=-1)


def mla_keys_values(ckv, k_rope, p, rotate):
    B, T, _ = ckv.shape
    kv = (rmsnorm(ckv, p['kv_norm']) @ p['w_ukv']).reshape(B, T, MLA_HEADS, MLA_NOPE + MLA_V)
    k_nope, v = kv[..., :MLA_NOPE], kv[..., MLA_NOPE:]
    k_rope = k_rope[:, :, None, :]
    if rotate:
        k_rope = axial_rope(k_rope)
    k = jnp.concatenate([k_nope, jnp.broadcast_to(k_rope, (B, T, MLA_HEADS, MLA_ROPE))], axis=-1)
    return k, v


def centred_conv(x, w, b):
    T = x.shape[1]
    xp = jnp.pad(x, ((0, 0), (LRU_CONV_LEFT, LRU_CONV - 1 - LRU_CONV_LEFT), (0, 0)))
    out = b
    for tap in range(LRU_CONV):
        out = out + xp[:, tap:tap + T] * w[tap]
    return out


def rglru_coeffs(u, p, d):
    B, T, W = u.shape
    ub = u.reshape(B, T, LRU_BLOCKS, W // LRU_BLOCKS)
    gate_a = jnp.einsum('btnk,nkj->btnj', ub, p['gate_a_w'][d].astype(jnp.float32)).reshape(B, T, W) + p['gate_a_b'][d]
    gate_x = jnp.einsum('btnk,nkj->btnj', ub, p['gate_x_w'][d].astype(jnp.float32)).reshape(B, T, W) + p['gate_x_b'][d]
    r = jax.nn.sigmoid(gate_a)
    i = jax.nn.sigmoid(gate_x)
    log_a = -LRU_C * r * jax.nn.softplus(-p['lru_lambda'][d].astype(jnp.float32))
    a = jnp.exp(log_a)
    b = jnp.sqrt(-jnp.expm1(2.0 * log_a)) * (i * u)
    return a, b


def _affine_combine(first, second):
    a1, b1 = first
    a2, b2 = second
    return a1 * a2, a2 * b1 + b2


def linear_scan(a, b, h0, reverse):
    acc_a, acc_b = lax.associative_scan(_affine_combine, (a, b), reverse=reverse, axis=1)
    if h0 is None:
        return acc_b
    return acc_a * h0[:, None, :] + acc_b


def rglru_mixer(xr_l, gr_l, xr_c, gr_c, p, ctx_out):
    u_l = centred_conv(xr_l, p['conv_w'], p['conv_b']).astype(jnp.float32)
    u_c = centred_conv(xr_c, p['conv_w'], p['conv_b']).astype(jnp.float32)
    a, b = rglru_coeffs(u_c, p, 0)
    hc_f = linear_scan(a, b, None, False)
    a, b = rglru_coeffs(u_l, p, 0)
    hl_f = linear_scan(a, b, hc_f[:, -1], False)
    a, b = rglru_coeffs(u_c, p, 1)
    hc_b = linear_scan(a, b, None, True)
    a, b = rglru_coeffs(u_l, p, 1)
    hl_b = linear_scan(a, b, hc_b[:, 0], True)
    y_l = (hl_f + hl_b).astype(xr_l.dtype) * jax.nn.gelu(gr_l)
    y_c = (hc_f + hc_b).astype(xr_c.dtype) * jax.nn.gelu(gr_c) if ctx_out else None
    return y_l, y_c


def mla_rglru_mixer(hl, hc, p, ctx_out):
    cq_l, ckv_l, kr_l, xr_l, gr_l = jnp.split(hl @ p['w_in'], L0_SPLITS, axis=-1)
    cq_c, ckv_c, kr_c, xr_c, gr_c = jnp.split(hc @ p['w_in'], L0_SPLITS, axis=-1)
    q_l = mla_queries(cq_l, p, True)
    k_l, v_l = mla_keys_values(ckv_l, kr_l, p, True)
    k_c, v_c = mla_keys_values(ckv_c, kr_c, p, False)
    att_l = dense_block_attention(q_l, k_l, v_l, k_c, v_c)
    rnn_l, rnn_c = rglru_mixer(xr_l, gr_l, xr_c, gr_c, p, ctx_out)
    y_l = jnp.concatenate([att_l, rnn_l], axis=-1)
    y_c = None
    if ctx_out:
        B, L = hc.shape[:2]
        q_c = mla_queries(cq_c, p, False)
        att_c = full_attention(q_c, k_c, v_c).reshape(B, L, MLA_HEADS * MLA_V)
        y_c = jnp.concatenate([att_c, rnn_c], axis=-1)
    return y_l, y_c


def window_attention(q, k, v, k_ctx, v_ctx, sink):
    B, S, H, d = q.shape
    Hk = k.shape[2]
    G = H // Hk
    nb = S // BLOCK
    span = BLOCK + 2 * WINDOW
    scale = d ** -0.5
    kp = jnp.pad(k, ((0, 0), (WINDOW, WINDOW), (0, 0), (0, 0)))
    vp = jnp.pad(v, ((0, 0), (WINDOW, WINDOW), (0, 0), (0, 0)))
    idx = jnp.arange(nb)[:, None] * BLOCK + jnp.arange(span)[None, :]
    kb = kp[:, idx]
    vb = vp[:, idx]
    qb = q.reshape(B, nb, BLOCK, Hk, G, d)
    s_loc = jnp.einsum('bnqkgd,bnjkd->bnkgqj', qb, kb, preferred_element_type=jnp.float32) * scale
    qpos = jnp.arange(nb)[:, None] * BLOCK + jnp.arange(BLOCK)[None, :]
    kpos = idx - WINDOW
    valid = ((kpos[:, None, :] >= 0) & (kpos[:, None, :] < S)
             & (jnp.abs(qpos[:, :, None] - kpos[:, None, :]) <= WINDOW))
    s_loc = jnp.where(valid[None, :, None, None], s_loc, NEG_INF)
    s_ctx = jnp.einsum('bnqkgd,bckd->bnkgqc', qb, k_ctx, preferred_element_type=jnp.float32) * scale
    p = softmax_sink(jnp.concatenate([s_loc, s_ctx], axis=-1), sink.reshape(Hk, G, 1, 1))
    p_loc, p_ctx = p[..., :span], p[..., span:]
    out = (jnp.einsum('bnkgqj,bnjkd->bnqkgd', p_loc.astype(v.dtype), vb)
           + jnp.einsum('bnkgqc,bckd->bnqkgd', p_ctx.astype(v.dtype), v_ctx))
    return out.reshape(B, S, H * d)


def neighbourhood_attention(q, k, v, k_ctx, v_ctx, rpb):
    B, S, H, d = q.shape
    rows = S // GRID_W
    kr = min(NA_ROWS, rows)
    kc = NA_COLS
    scale = d ** -0.5
    qg = q.reshape(B, rows, GRID_W, H, d)
    kg = k.reshape(B, rows, GRID_W, H, d)
    vg = v.reshape(B, rows, GRID_W, H, d)
    cols = jnp.arange(GRID_W)
    col_idx = jnp.clip(cols - kc // 2, 0, GRID_W - kc)[:, None] + jnp.arange(kc)[None, :]
    coff = col_idx - cols[:, None] + (NA_COLS - 1)
    n_win = kr * kc

    def row_block(r):
        r0 = jnp.clip(r - kr // 2, 0, rows - kr)
        kwin = lax.dynamic_slice_in_dim(kg, r0, kr, axis=1)[:, :, col_idx]
        vwin = lax.dynamic_slice_in_dim(vg, r0, kr, axis=1)[:, :, col_idx]
        qrow = lax.dynamic_index_in_dim(qg, r, axis=1, keepdims=False)
        roff = r0 + jnp.arange(kr) - r + (NA_ROWS - 1)
        bias = rpb[:, roff][:, :, coff]
        s = jnp.einsum('bqhd,brqjhd->bhqrj', qrow, kwin, preferred_element_type=jnp.float32) * scale
        s = s + jnp.transpose(bias, (0, 2, 1, 3))[None].astype(jnp.float32)
        s_ctx = jnp.einsum('bqhd,bchd->bhqc', qrow, k_ctx, preferred_element_type=jnp.float32) * scale
        p = jax.nn.softmax(jnp.concatenate([s.reshape(B, H, GRID_W, n_win), s_ctx], axis=-1), axis=-1)
        p_win = p[..., :n_win].reshape(B, H, GRID_W, kr, kc).astype(v.dtype)
        return (jnp.einsum('bhqrj,brqjhd->bqhd', p_win, vwin)
                + jnp.einsum('bhqc,bchd->bqhd', p[..., n_win:].astype(v.dtype), v_ctx))

    out = lax.map(row_block, jnp.arange(rows))
    return jnp.moveaxis(out, 0, 1).reshape(B, S, H * d)


def window_na_mixer(hl, hc, p, ctx_out):
    B, S, _ = hl.shape
    L = hc.shape[1]

    def heads(z, n):
        return z.reshape(z.shape[:2] + (n, HEAD_DIM))

    qw_l, kw_l, vw_l, qn_l, kn_l, vn_l = jnp.split(hl @ p['w_in'], L1_SPLITS, axis=-1)
    qw_c, kw_c, vw_c, qn_c, kn_c, vn_c = jnp.split(hc @ p['w_in'], L1_SPLITS, axis=-1)
    kw_c, vw_c = heads(kw_c, WIN_KV_HEADS), heads(vw_c, WIN_KV_HEADS)
    kn_c, vn_c = heads(kn_c, NA_HEADS), heads(vn_c, NA_HEADS)
    win_l = window_attention(axial_rope(heads(qw_l, WIN_HEADS)), axial_rope(heads(kw_l, WIN_KV_HEADS)),
                             heads(vw_l, WIN_KV_HEADS), kw_c, vw_c, p['sink'])
    na_l = neighbourhood_attention(heads(qn_l, NA_HEADS), heads(kn_l, NA_HEADS), heads(vn_l, NA_HEADS),
                                   kn_c, vn_c, p['rpb'])
    y_l = jnp.concatenate([win_l, na_l], axis=-1)
    y_c = None
    if ctx_out:
        rep = WIN_HEADS // WIN_KV_HEADS
        win_c = full_attention(heads(qw_c, WIN_HEADS), jnp.repeat(kw_c, rep, axis=2),
                               jnp.repeat(vw_c, rep, axis=2), p['sink']).reshape(B, L, WQ_COLS)
        na_c = full_attention(heads(qn_c, NA_HEADS), kn_c, vn_c).reshape(B, L, NA_COLS_W)
        y_c = jnp.concatenate([win_c, na_c], axis=-1)
    return y_l, y_c


def grouped_moe(h, router_w, router_b, w_gate, w_up, w_down):
    shp = h.shape
    t = h.reshape(-1, shp[-1])
    n = t.shape[0]
    scores = jax.nn.sigmoid(jnp.dot(t, router_w, preferred_element_type=jnp.float32))
    grouped = (scores + router_b.astype(jnp.float32)).reshape(n, N_GROUPS, EXPERTS_PER_GROUP)
    group_score = lax.top_k(grouped, TOP_K)[0].sum(axis=-1)
    g_sel = jnp.argmax(group_score, axis=-1)
    in_group = grouped[jnp.arange(n), g_sel]
    _, e_local = lax.top_k(in_group, TOP_K)
    e_sel = g_sel[:, None] * EXPERTS_PER_GROUP + e_local
    w_sel = jnp.take_along_axis(scores, e_sel, axis=1)
    w_sel = w_sel / jnp.sum(w_sel, axis=-1, keepdims=True)
    gates = jnp.sum(jax.nn.one_hot(e_sel, N_EXPERTS, dtype=jnp.float32) * w_sel[..., None], axis=1).astype(h.dtype)
    out = jnp.zeros_like(t)
    for e in range(N_EXPERTS):
        he = jax.nn.silu(t @ w_gate[e]) * (t @ w_up[e])
        out = out + gates[:, e:e + 1] * (he @ w_down[e])
    return out.reshape(shp)


def setup_inputs(seed: int = 0) -> dict:
    key = jax.random.key(seed)
    keys = iter(list(jax.random.split(key, 64)))

    def nrm(shape, scale):
        return jax.random.normal(next(keys), shape, jnp.float32) * scale

    def gain(n):
        return 1.0 + nrm((n,), 0.01)

    D = D_MODEL
    bw = LRU_WIDTH // LRU_BLOCKS
    inp = {}
    inp['x'] = nrm((BATCH, SEQ, D), 1.0)
    inp['c'] = nrm((BATCH, D), 1.0)
    inp['ctx'] = nrm((BATCH, CTX_LEN, D), 1.0)
    inp['c_ctx'] = nrm((D,), 1.0)
    inp['router_w'] = nrm((D, N_EXPERTS), D ** -0.5)
    inp['router_b'] = nrm((N_EXPERTS,), 0.01)
    inp['final_norm'] = gain(D)
    inp['l0_mod_w'] = nrm((D, N_MOD * D), 0.5 * D ** -0.5)
    inp['l0_mod_b'] = nrm((N_MOD * D,), 0.02)
    inp['l0_norm_mix'] = gain(D)
    inp['l0_norm_ffn'] = gain(D)
    inp['l0_w_in'] = nrm((D, L0_IN), D ** -0.5)
    inp['l0_q_norm'] = gain(MLA_Q_RANK)
    inp['l0_w_uq'] = nrm((MLA_Q_RANK, MLA_HEADS * (MLA_NOPE + MLA_ROPE)), MLA_Q_RANK ** -0.5)
    inp['l0_kv_norm'] = gain(MLA_KV_RANK)
    inp['l0_w_ukv'] = nrm((MLA_KV_RANK, MLA_HEADS * (MLA_NOPE + MLA_V)), MLA_KV_RANK ** -0.5)
    inp['l0_conv_w'] = nrm((LRU_CONV, LRU_WIDTH), 0.5)
    inp['l0_conv_b'] = nrm((LRU_WIDTH,), 0.02)
    inp['l0_gate_a_w'] = nrm((2, LRU_BLOCKS, bw, bw), bw ** -0.5)
    inp['l0_gate_a_b'] = nrm((2, LRU_WIDTH), 0.1)
    inp['l0_gate_x_w'] = nrm((2, LRU_BLOCKS, bw, bw), bw ** -0.5)
    inp['l0_gate_x_b'] = nrm((2, LRU_WIDTH), 0.1)
    u = jax.random.uniform(next(keys), (2, LRU_WIDTH), jnp.float32, 0.9, 0.999)
    a0 = u ** (1.0 / LRU_C)
    inp['l0_lru_lambda'] = jnp.log(a0) - jnp.log1p(-a0)
    inp['l0_w_out'] = nrm((L0_OUT, D), L0_OUT ** -0.5)
    inp['l0_exp_gate'] = nrm((N_EXPERTS, D, EXPERT_FF), D ** -0.5)
    inp['l0_exp_up'] = nrm((N_EXPERTS, D, EXPERT_FF), D ** -0.5)
    inp['l0_exp_down'] = nrm((N_EXPERTS, EXPERT_FF, D), EXPERT_FF ** -0.5)
    inp['l1_mod_w'] = nrm((D, N_MOD * D), 0.5 * D ** -0.5)
    inp['l1_mod_b'] = nrm((N_MOD * D,), 0.02)
    inp['l1_norm_mix'] = gain(D)
    inp['l1_norm_ffn'] = gain(D)
    inp['l1_w_in'] = nrm((D, L1_IN), D ** -0.5)
    inp['l1_sink'] = nrm((WIN_HEADS,), 1.0)
    inp['l1_rpb'] = nrm((NA_HEADS, 2 * NA_ROWS - 1, 2 * NA_COLS - 1), 0.5)
    inp['l1_w_out'] = nrm((L1_OUT, D), L1_OUT ** -0.5)
    inp['l1_exp_gate'] = nrm((N_EXPERTS, D, EXPERT_FF), D ** -0.5)
    inp['l1_exp_up'] = nrm((N_EXPERTS, D, EXPERT_FF), D ** -0.5)
    inp['l1_exp_down'] = nrm((N_EXPERTS, EXPERT_FF, D), EXPERT_FF ** -0.5)
    return inp


def reference(x, c, ctx, c_ctx, router_w, router_b, final_norm,
              l0_mod_w, l0_mod_b, l0_norm_mix, l0_norm_ffn, l0_w_in, l0_q_norm, l0_w_uq, l0_kv_norm, l0_w_ukv,
              l0_conv_w, l0_conv_b, l0_gate_a_w, l0_gate_a_b, l0_gate_x_w, l0_gate_x_b, l0_lru_lambda, l0_w_out,
              l0_exp_gate, l0_exp_up, l0_exp_down,
              l1_mod_w, l1_mod_b, l1_norm_mix, l1_norm_ffn, l1_w_in, l1_sink, l1_rpb, l1_w_out,
              l1_exp_gate, l1_exp_up, l1_exp_down):
    layer_params = (
        dict(mod_w=l0_mod_w, mod_b=l0_mod_b, norm_mix=l0_norm_mix, norm_ffn=l0_norm_ffn, w_in=l0_w_in,
             q_norm=l0_q_norm, w_uq=l0_w_uq, kv_norm=l0_kv_norm, w_ukv=l0_w_ukv, conv_w=l0_conv_w,
             conv_b=l0_conv_b, gate_a_w=l0_gate_a_w, gate_a_b=l0_gate_a_b, gate_x_w=l0_gate_x_w,
             gate_x_b=l0_gate_x_b, lru_lambda=l0_lru_lambda, w_out=l0_w_out,
             exp_gate=l0_exp_gate, exp_up=l0_exp_up, exp_down=l0_exp_down),
        dict(mod_w=l1_mod_w, mod_b=l1_mod_b, norm_mix=l1_norm_mix, norm_ffn=l1_norm_ffn, w_in=l1_w_in,
             sink=l1_sink, rpb=l1_rpb, w_out=l1_w_out,
             exp_gate=l1_exp_gate, exp_up=l1_exp_up, exp_down=l1_exp_down),
    )
    mixers = (mla_rglru_mixer, window_na_mixer)
    xl, xc = x, ctx
    L = ctx.shape[1]
    for layer in range(DEPTH):
        p = layer_params[layer]
        mixer = mixers[layer % 2]
        ctx_out = layer < DEPTH - 1
        ml = (jax.nn.silu(c) @ p['mod_w'] + p['mod_b'])[:, None, :]
        mc = (jax.nn.silu(c_ctx) @ p['mod_w'] + p['mod_b'])[None, None, :]
        sh1, sc1, g1, sh2, sc2, g2 = jnp.split(ml, N_MOD, axis=-1)
        csh1, csc1, cg1, csh2, csc2, cg2 = jnp.split(mc, N_MOD, axis=-1)
        hl = modulate(rmsnorm(xl, p['norm_mix']), sh1, sc1)
        hc = modulate(rmsnorm(xc, p['norm_mix']), csh1, csc1)
        yl, yc = mixer(hl, hc, p, ctx_out)
        xl = xl + g1 * (yl @ p['w_out'])
        hl = modulate(rmsnorm(xl, p['norm_ffn']), sh2, sc2)
        if ctx_out:
            xc = xc + cg1 * (yc @ p['w_out'])
            hc = modulate(rmsnorm(xc, p['norm_ffn']), csh2, csc2)
            f = grouped_moe(jnp.concatenate([hc, hl], axis=1), router_w, router_b,
                            p['exp_gate'], p['exp_up'], p['exp_down'])
            xc = xc + cg2 * f[:, :L]
            xl = xl + g2 * f[:, L:]
        else:
            xl = xl + g2 * grouped_moe(hl, router_w, router_b, p['exp_gate'], p['exp_up'], p['exp_down'])
    return rmsnorm(xl, final_norm)
```

```cpp
#define N_LAUNCH_MODE 0
#include <hip/hip_runtime.h>
#include <stdint.h>
#include <stdio.h>

#define LAS __attribute__((address_space(3)))
#define DI __device__ __forceinline__
typedef unsigned short bf16_t;
typedef short bf16x8 __attribute__((ext_vector_type(8)));
typedef short s16x4 __attribute__((ext_vector_type(4)));
typedef float f32x2 __attribute__((ext_vector_type(2)));
typedef float f32x4 __attribute__((ext_vector_type(4)));
typedef float f32x16 __attribute__((ext_vector_type(16)));
typedef unsigned u32x2 __attribute__((ext_vector_type(2)));
typedef unsigned u32x4 __attribute__((ext_vector_type(4)));
typedef __bf16 hbf16x2 __attribute__((ext_vector_type(2)));

constexpr int DM = 2048, NB = 4, SEQ = 2048, CTX = 256, GRIDW = 64;
constexpr int NCTX = NB * CTX;
constexpr int NLAT = NB * SEQ;
constexpr int NTOK = NCTX + NLAT;
constexpr float EPS = 1e-6f;
constexpr int NEXP = 32, EFF = 512;
constexpr int L0IN = 2880, L0INP = 3072, L1IN = 4608;
constexpr int MODN = 6 * DM;
constexpr int NTHREADS = 512;
constexpr float LOG2E = 1.4426950408889634f;

DI unsigned pk_bf16(float lo, float hi) { f32x2 v = {lo, hi}; hbf16x2 r = __builtin_convertvector(v, hbf16x2); return __builtin_bit_cast(unsigned, r); }
DI float bflo(unsigned w) { return __uint_as_float(w << 16); }
DI float bfhi(unsigned w) { return __uint_as_float(w & 0xffff0000u); }
DI float bf2f(bf16_t b) { return __uint_as_float(((unsigned)b) << 16); }
DI bf16_t f2bf(float f) { return (bf16_t)(pk_bf16(f, 0.f) & 0xffffu); }
DI float wave_sum(float v) {
#pragma unroll
    for (int o = 32; o > 0; o >>= 1) v += __shfl_xor(v, o);
    return v;
}
DI float sigmoidf_(float x) { return 1.0f / (1.0f + __expf(-x)); }
DI int row_mod(int row) { return row < NCTX ? 4 : ((row - NCTX) >> 11); }
#define XB_TMO      128
#define XB_XCNT(j)  (256  + 64 * (j))
#define XB_XSUB(j)  (1280 + 64 * (j))
#define XB_XGEN(j)  (2304 + 64 * (j))
#define XB_TOP      3328
#define XB_TOPGEN   3392
#define XCD_BAR_WORDS 3456
#define XB_SPIN_CAP (1u << 18)

__device__ __forceinline__ unsigned xb_ld(unsigned* p)              { return __hip_atomic_load(p, __ATOMIC_RELAXED, __HIP_MEMORY_SCOPE_AGENT); }
__device__ __forceinline__ unsigned xb_add(unsigned* p, unsigned v) { return __hip_atomic_fetch_add(p, v, __ATOMIC_RELAXED, __HIP_MEMORY_SCOPE_AGENT); }
__device__ __forceinline__ unsigned xb_xcc_id() { return (unsigned)__builtin_amdgcn_s_getreg((3 << 11) | 20) & 0xFu; }
#define XB_SPIN(cond, bar) do { unsigned _sp = 0; while (cond) { __builtin_amdgcn_s_sleep(1); \
    if ((++_sp & 255u) == 0u) { if (xb_ld(&(bar)[XB_TMO])) break; if (_sp > XB_SPIN_CAP) { atomicAdd(&(bar)[XB_TMO], 1u); break; } } } } while (0)

struct XcdBarrier {
    unsigned* bar; unsigned x;
    volatile LAS unsigned* st;
};

__device__ __forceinline__ XcdBarrier xcd_barrier_post(unsigned* bar, volatile LAS unsigned* st) {
    XcdBarrier b; b.bar = bar; b.x = xb_xcc_id(); b.st = st;
    if (threadIdx.x == 0) (void)xb_add(&bar[XB_XCNT(b.x)], 1u);
    return b;
}
__device__ __forceinline__ void xcd_barrier_complete(unsigned* bar, unsigned x, unsigned& nloc, unsigned& nx) {
    const unsigned G = gridDim.x * gridDim.y * gridDim.z;
    unsigned sum, cnt, mine, sp = 0u;
    for (;;) {
        sum = 0u; cnt = 0u; mine = 0u;
#pragma unroll
        for (unsigned j = 0; j < 16; ++j) { const unsigned c = xb_ld(&bar[XB_XCNT(j)]); sum += c; cnt += (c > 0u) ? 1u : 0u; mine = (j == x) ? c : mine; }
        if (sum == G) break;
        __builtin_amdgcn_s_sleep(1);
        if ((++sp & 255u) == 0u) { if (xb_ld(&bar[XB_TMO])) break; if (sp > XB_SPIN_CAP) { atomicAdd(&bar[XB_TMO], 1u); break; } }
    }
    nloc = mine > 0u ? mine : 1u; nx = cnt > 0u ? cnt : 1u;
}

__device__ __forceinline__ void xcd_barrier(const XcdBarrier& b) {
    asm volatile("s_waitcnt vmcnt(0)" ::: "memory");
    __syncthreads();
    if (threadIdx.x == 0) {
        unsigned* bar = b.bar;
        __builtin_amdgcn_s_waitcnt(0);
        unsigned nloc = b.st[0], nx = b.st[1];
        if (nloc == 0u) { xcd_barrier_complete(bar, b.x, nloc, nx); b.st[0] = nloc; b.st[1] = nx; }
        const unsigned old = xb_add(&bar[XB_XSUB(b.x)], 1u);
        const unsigned gen = old / nloc;
        if (old + 1u == (gen + 1u) * nloc) {
            __builtin_amdgcn_fence(__ATOMIC_RELEASE, "agent");
            asm volatile("s_waitcnt vmcnt(0)" ::: "memory");
            const unsigned og = xb_add(&bar[XB_TOP], 1u);
            const unsigned tg = og / nx;
            if (og + 1u == (tg + 1u) * nx) xb_add(&bar[XB_TOPGEN], 1u);
            else XB_SPIN(xb_ld(&bar[XB_TOPGEN]) == tg, bar);
            __builtin_amdgcn_fence(__ATOMIC_ACQUIRE, "agent");
            xb_add(&bar[XB_XGEN(b.x)], 1u);
            asm volatile("s_waitcnt vmcnt(0)" ::: "memory");
        } else {
            XB_SPIN(xb_ld(&bar[XB_XGEN(b.x)]) == gen, bar);
            __builtin_amdgcn_fence(__ATOMIC_ACQUIRE, "agent");
            asm volatile("s_waitcnt vmcnt(0)" ::: "memory");
        }
    }
    __syncthreads();
}

namespace pg8 {
constexpr int BM = 256, BK = 64, HALF = 128, HTB = HALF * BK * 2, STAGE_BYTES = 8 * HTB, NXCD = 8, WGM = 8;
DI int lds_byte(int r, int c) { const int st = (r >> 4) * 2 + (c >> 5), rr = r & 15, cc = c & 31, ob = rr * 64 + cc * 2; return st * 1024 + (ob ^ (((ob >> 9) & 1) << 5)); }
DI void stage_rc(int b, int& R, int& C) { const int st = b / 1024, sb = b % 1024, swz = sb ^ (((sb >> 9) & 1) << 5); R = (st >> 1) * 16 + swz / 64; C = (st & 1) * 32 + (swz % 64) / 2; }
DI int perm32(int rho) { const int n = rho >> 4, i = rho & 15; return 8 * (i >> 2) + 4 * n + (i & 3); }

struct GU { const char* a; const char* b; int pm, pn, e, aux; };

template <class Epi, class Sched>
DI void gemm_phase(LAS unsigned char* lds, const Sched& S, const Epi& E) {
    const int tid = threadIdx.x, wid = __builtin_amdgcn_readfirstlane(tid >> 6), lane = tid & 63, wr = wid >> 2, wc = wid & 3, fr = lane & 15, fq = lane >> 4;
    const int K = S.K, nt = K / BK;
    int RR[2], CC[2];
    unsigned voffA[2], voffB[2];
#pragma unroll
    for (int i = 0; i < 2; ++i) { int R, C; stage_rc(tid * 16 + i * 8192, R, C); RR[i] = R; CC[i] = C; const int Rb = Epi::PERM ? ((R & ~31) + perm32(R & 31)) : R;
        voffA[i] = (unsigned)(R * (int)S.lda + C * 2); voffB[i] = (unsigned)(Rb * (int)S.ldb + C * 2); }
    const size_t kstep = (size_t)(BK * 2);
    const size_t ahs = S.a_h, bhs = S.b_h;
    const unsigned ldsw = (unsigned)wid * 1024u;
    const int aoff = lds_byte(wr * 64 + fr, fq * 8), boff = lds_byte(wc * 32 + fr, fq * 8);
#define PG8_SA(b, h) (((b) * 2 + (h)) * HTB)
#define PG8_SB(b, h) ((4 + (b) * 2 + (h)) * HTB)
#define PG8_STAGE(bufoff, gbase, voff) do { _Pragma("unroll") for (int _i = 0; _i < 2; ++_i) \
        __builtin_amdgcn_global_load_lds((const unsigned*)((const char*)(gbase) + (voff)[_i]), (LAS unsigned*)(lds + (bufoff) + ldsw + _i * 8192), 16, 0, 0); } while (0)
#define PG8_STAGE_A(bufoff, gbase, h, VG) do { if constexpr (Sched::GATHER) { PG8_STAGE(bufoff, gbase, VG[h]); } else { PG8_STAGE(bufoff, (gbase) + (h) * ahs, voffA); } } while (0)
#define PG8_STAGE_B(bufoff, gbase, h) PG8_STAGE(bufoff, (gbase) + (h) * bhs, voffB)
#define PG8_LDA(dst, b, h) do { _Pragma("unroll") for (int m = 0; m < 4; ++m) _Pragma("unroll") for (int k = 0; k < 2; ++k) dst[m][k] = *(const LAS bf16x8*)(lds + PG8_SA(b, h) + aoff + m * 2048 + k * 1024); } while (0)
#define PG8_LDB(dst, b, h) do { _Pragma("unroll") for (int n = 0; n < 2; ++n) _Pragma("unroll") for (int k = 0; k < 2; ++k) dst[n][k] = *(const LAS bf16x8*)(lds + PG8_SB(b, h) + boff + n * 2048 + k * 1024); } while (0)
#define PG8_MMA(ai, bj, At, Bt) do { __builtin_amdgcn_s_setprio(1); _Pragma("unroll") for (int m = 0; m < 4; ++m) _Pragma("unroll") for (int n = 0; n < 2; ++n) _Pragma("unroll") for (int k = 0; k < 2; ++k) \
        acc[ai][bj][m][n] = __builtin_amdgcn_mfma_f32_16x16x32_bf16(Bt[n][k], At[m][k], acc[ai][bj][m][n], 0, 0, 0); __builtin_amdgcn_s_setprio(0); } while (0)
#define PG8_WAIT_V(n) asm volatile("s_waitcnt vmcnt(" #n ")" ::: "memory")
#define PG8_WAIT_L(n) asm volatile("s_waitcnt lgkmcnt(" #n ")" ::: "memory")
#define PG8_BAR __builtin_amdgcn_s_barrier()
#define PG8_SCHED __builtin_amdgcn_sched_barrier(0)
    GU cur, nxt; int ui = 0;
    if (!S.next(0, cur)) return;
    f32x4 acc[2][2][4][2];
#pragma unroll
    for (int a = 0; a < 2; ++a)
#pragma unroll
        for (int b = 0; b < 2; ++b)
#pragma unroll
            for (int m = 0; m < 4; ++m)
#pragma unroll
                for (int n = 0; n < 2; ++n) acc[a][b][m][n] = (f32x4){0.f, 0.f, 0.f, 0.f};
    bf16x8 At[4][2], B0[2][2], B1[2][2];
    unsigned vc[2][2], vn[2][2];
    if constexpr (Sched::GATHER) {
#pragma unroll
        for (int h = 0; h < 2; ++h)
#pragma unroll
            for (int i = 0; i < 2; ++i) { vc[h][i] = S.rowoff(cur, RR[i] + 128 * h) + (unsigned)(CC[i] * 2); vn[h][i] = vc[h][i]; }
    } else {
#pragma unroll
        for (int h = 0; h < 2; ++h)
#pragma unroll
            for (int i = 0; i < 2; ++i) { vc[h][i] = 0u; vn[h][i] = 0u; }
    }
    const char* cA = cur.a; const char* cB = cur.b;
    PG8_STAGE_B(PG8_SB(0, 0), cB, 0); PG8_STAGE_A(PG8_SA(0, 0), cA, 0, vc); PG8_STAGE_B(PG8_SB(0, 1), cB, 1); PG8_STAGE_A(PG8_SA(0, 1), cA, 1, vc);
    if (wr == 1) PG8_BAR;
    PG8_WAIT_V(4); PG8_BAR;
    PG8_STAGE_B(PG8_SB(1, 0), cB + kstep, 0); PG8_STAGE_A(PG8_SA(1, 0), cA + kstep, 0, vc); PG8_STAGE_B(PG8_SB(1, 1), cB + kstep, 1);
    PG8_WAIT_V(6); PG8_BAR;
    for (;;) {
        const bool has_next = S.next(ui + 1, nxt);
        const char* nA = has_next ? nxt.a : cA; const char* nB = has_next ? nxt.b : cB;
        if constexpr (Sched::GATHER) {
            if (has_next) {
#pragma unroll
                for (int h = 0; h < 2; ++h)
#pragma unroll
                    for (int i = 0; i < 2; ++i) vn[h][i] = S.rowoff(nxt, RR[i] + 128 * h) + (unsigned)(CC[i] * 2);
            } else {
#pragma unroll
                for (int h = 0; h < 2; ++h)
#pragma unroll
                    for (int i = 0; i < 2; ++i) vn[h][i] = vc[h][i];
            }
        }
        for (int t = 0; t < nt; t += 2) {
            const bool last = (t == nt - 2);
            const char* a1 = cA + (size_t)(t + 1) * kstep;
            const char* a2 = last ? nA : cA + (size_t)(t + 2) * kstep; const char* b2 = last ? nB : cB + (size_t)(t + 2) * kstep;
            const char* a3 = a2 + kstep; const char* b3 = b2 + kstep;
            unsigned v2[2][2];
#pragma unroll
            for (int h = 0; h < 2; ++h)
#pragma unroll
                for (int i = 0; i < 2; ++i) v2[h][i] = last ? vn[h][i] : vc[h][i];
            PG8_LDB(B0, 0, 0); PG8_SCHED; PG8_LDA(At, 0, 0); PG8_STAGE_A(PG8_SA(1, 1), a1, 1, vc);
            PG8_WAIT_L(8); PG8_BAR; PG8_WAIT_L(0); PG8_MMA(0, 0, At, B0); PG8_BAR; PG8_SCHED;
            PG8_LDB(B1, 0, 1); PG8_STAGE_B(PG8_SB(0, 0), b2, 0);
            PG8_BAR; PG8_WAIT_L(0); PG8_MMA(0, 1, At, B1); PG8_BAR;
            PG8_LDA(At, 0, 1); PG8_STAGE_A(PG8_SA(0, 0), a2, 0, v2);
            PG8_BAR; PG8_WAIT_L(0); PG8_MMA(1, 0, At, B0); PG8_BAR; PG8_SCHED;
            PG8_STAGE_B(PG8_SB(0, 1), b2, 1);
            PG8_WAIT_V(6); PG8_BAR; PG8_MMA(1, 1, At, B1); PG8_BAR;
            PG8_LDB(B0, 1, 0); PG8_SCHED; PG8_LDA(At, 1, 0); PG8_STAGE_A(PG8_SA(0, 1), a2, 1, v2);
            PG8_WAIT_L(8); PG8_BAR; PG8_WAIT_L(0); PG8_MMA(0, 0, At, B0); PG8_BAR; PG8_SCHED;
            PG8_LDB(B1, 1, 1); PG8_STAGE_B(PG8_SB(1, 0), b3, 0);
            PG8_BAR; PG8_WAIT_L(0); PG8_MMA(0, 1, At, B1); PG8_BAR;
            PG8_LDA(At, 1, 1); PG8_STAGE_A(PG8_SA(1, 0), a3, 0, v2);
            PG8_BAR; PG8_WAIT_L(0); PG8_MMA(1, 0, At, B0); PG8_BAR; PG8_SCHED;
            PG8_STAGE_B(PG8_SB(1, 1), b3, 1);
            PG8_WAIT_V(6); PG8_BAR; PG8_MMA(1, 1, At, B1); PG8_BAR;
        }
        E(acc, cur, wr, wc, fr, fq);
        if (!has_next) break;
#pragma unroll
        for (int a = 0; a < 2; ++a)
#pragma unroll
            for (int b = 0; b < 2; ++b)
#pragma unroll
                for (int m = 0; m < 4; ++m)
#pragma unroll
                    for (int n = 0; n < 2; ++n) acc[a][b][m][n] = (f32x4){0.f, 0.f, 0.f, 0.f};
        cur = nxt; cA = nA; cB = nB; ++ui;
        if constexpr (Sched::GATHER) {
#pragma unroll
            for (int h = 0; h < 2; ++h)
#pragma unroll
                for (int i = 0; i < 2; ++i) vc[h][i] = vn[h][i];
        }
    }
    PG8_WAIT_V(0);
    if (wr == 0) PG8_BAR;
    PG8_BAR;
#undef PG8_SA
#undef PG8_SB
#undef PG8_STAGE
#undef PG8_STAGE_A
#undef PG8_STAGE_B
#undef PG8_LDA
#undef PG8_LDB
#undef PG8_MMA
#undef PG8_WAIT_V
#undef PG8_WAIT_L
#undef PG8_BAR
#undef PG8_SCHED
}

struct TileOrder {
    int nM, nN, nwg, G, c;
    DI void init(int nM_, int nN_, int G_, int c_) { nM = nM_; nN = nN_; nwg = nM * nN; G = G_; c = c_; }
    DI bool tile(int i, int& pm, int& pn) const {
        const long L = (long)i * G + c; if (L >= nwg) return false;
        int wgid = (int)L; { const int q = nwg / NXCD, r = nwg % NXCD, xcd = wgid % NXCD, off = wgid / NXCD; wgid = (xcd < r ? xcd * (q + 1) : r * (q + 1) + (xcd - r) * q) + off; }
        const int nig = WGM * nN, gid = wgid / nig, fm = gid * WGM, gsz = (nM - fm) < WGM ? (nM - fm) : WGM;
        pm = fm + ((wgid % nig) % gsz); pn = (wgid % nig) / gsz; return true;
    }
};
}
constexpr size_t AL(size_t x) { return (x + 255) & ~(size_t)255; }
constexpr int MOE_CAP = NTOK;
constexpr int SLOT_ROWS = 2 * NTOK + NEXP * 256;
constexpr int NCHUNK = (CTX + SEQ) / 64;
constexpr size_t WS_CTL    = 0;
constexpr size_t CTL_BYTES = 65536;
constexpr size_t CW_BAR    = 0;
constexpr size_t CW_CNT    = 16384;
constexpr size_t WS_MOD    = AL(WS_CTL + CTL_BYTES);
constexpr size_t WS_ROPE0  = AL(WS_MOD + (size_t)2 * 5 * MODN * 4);
constexpr size_t WS_ROPE1  = AL(WS_ROPE0 + 64 * 16 * 8);
constexpr size_t WS_W0IN   = AL(WS_ROPE1 + 64 * 32 * 8);
constexpr size_t WS_WUQ    = AL(WS_W0IN + (size_t)L0INP * DM * 2);
constexpr size_t WS_WUKV   = AL(WS_WUQ + (size_t)1536 * 512 * 2);
constexpr size_t WS_W0OUT  = AL(WS_WUKV + (size_t)2048 * 256 * 2);
constexpr size_t WS_W1IN   = AL(WS_W0OUT + (size_t)DM * DM * 2);
constexpr size_t WS_W1OUT  = AL(WS_W1IN + (size_t)L1IN * DM * 2);
constexpr size_t EXPW      = (size_t)NEXP * EFF * DM * 2;
constexpr size_t WS_EG     = AL(WS_W1OUT + (size_t)DM * DM * 2);
constexpr size_t WS_EU     = AL(WS_EG + 2 * EXPW);
constexpr size_t WS_ED     = AL(WS_EU + 2 * EXPW);
constexpr size_t WS_GW     = AL(WS_ED + 2 * EXPW);
constexpr size_t WS_XA     = AL(WS_GW + (size_t)2 * 16 * 128 * 128 * 2);
constexpr size_t WS_XB     = AL(WS_XA + (size_t)NTOK * DM * 4);
constexpr size_t WS_H      = AL(WS_XB + (size_t)NTOK * DM * 4);
constexpr size_t WS_Z      = AL(WS_H + (size_t)NTOK * DM * 2);
constexpr size_t WS_CQN    = AL(WS_Z + (size_t)NTOK * L1IN * 2);
constexpr size_t WS_CKVN   = AL(WS_CQN + (size_t)NTOK * 512 * 2);
constexpr size_t WS_KR     = AL(WS_CKVN + (size_t)NTOK * 256 * 2);
constexpr size_t WS_Q0     = AL(WS_KR + (size_t)NTOK * 64 * 2);
constexpr size_t WS_KV0    = AL(WS_Q0 + (size_t)NTOK * 1536 * 2);
constexpr size_t WS_Y      = AL(WS_KV0 + (size_t)NTOK * 2048 * 2);
constexpr size_t WS_SUMM   = AL(WS_Y + (size_t)NTOK * DM * 2);
constexpr size_t WS_CARRY  = AL(WS_SUMM + (size_t)2 * NB * NCHUNK * 1024 * 8);
constexpr size_t WS_LIST   = AL(WS_CARRY + (size_t)2 * NB * NCHUNK * 1024 * 4);
constexpr size_t WS_TOK    = AL(WS_LIST + (size_t)NEXP * MOE_CAP * 4);
constexpr size_t WS_ACT    = AL(WS_TOK + (size_t)NTOK * 32);
constexpr size_t WS_OUT2   = AL(WS_ACT + (size_t)SLOT_ROWS * EFF * 2);
constexpr size_t WS_D      = AL(WS_OUT2 + (size_t)SLOT_ROWS * DM * 2);
constexpr size_t WS_END    = AL(WS_D + (size_t)NTOK * DM * 2);

struct TokInfo { int e0, p0, e1, p1; float w0, w1; int pad0, pad1; };

constexpr int LDS_STAGE = 0;
constexpr int LDS_MISC  = 135168;
constexpr int LDS_BYTES = 135168 + 4096;

struct Params { const float* in[38]; float* out; unsigned char* ws; int ph_lo, ph_hi, flags, pad; };

struct Frame {
    const float* const* in; float* out; unsigned char* ws; LAS unsigned char* lds;
    int tid, lane, wave, G, bid;
};
struct CvtJob { const float* src; bf16_t* dst; int K, N, ldo, perm, tiles_per_b, tile0; size_t sstride, dstride; };

DI int l1_permrow(int n) {
    if (n >= 1280) return n;
    const int hb = n & ~127, d = n & 127, a = d >> 6, part = (d >> 5) & 1, i = d & 31;
    return hb + 64 * a + 32 * (i >> 4) + 16 * part + (i & 15);
}

DI void set_job(LAS CvtJob* J, int j, const float* src, bf16_t* dst, int K, int N, int ldo, int perm, int nb, size_t ss, size_t ds, int& t0) {
    J[j].src = src; J[j].dst = dst; J[j].K = K; J[j].N = N; J[j].ldo = ldo; J[j].perm = perm; J[j].tiles_per_b = (K / 64) * ((N + 255) / 256); J[j].tile0 = t0;
    J[j].sstride = ss; J[j].dstride = ds; t0 += nb * J[j].tiles_per_b;
}

struct CvtTile { const float* src; bf16_t* dst; int N, ldo, k0, n0, nw, perm; };
DI void cvt_decode(LAS CvtJob* J, int nj, int gt, CvtTile& t) {
    int j = 0;
#pragma unroll 1
    for (int q = 1; q < nj; ++q) if (gt >= J[q].tile0) j = q;
    const int rem = gt - J[j].tile0, tpb = J[j].tiles_per_b, b = rem / tpb, r2 = rem % tpb;
    t.N = J[j].N; t.ldo = J[j].ldo; const int nst = (t.N + 255) / 256, kt = r2 / nst, st = r2 % nst; t.perm = J[j].perm;
    t.src = J[j].src + (size_t)b * J[j].sstride; t.dst = J[j].dst + (size_t)b * J[j].dstride;
    t.k0 = kt * 64; t.n0 = st * 256; t.nw = min(256, t.N - t.n0);
}
constexpr int MOE_CVT_TILES = 3 * NEXP * 64;
#ifndef BG_L0_P2
#define BG_L0_P2 960
#endif
#ifndef BG_L0_P6
#define BG_L0_P6 3960
#endif
#define BG_L1_DOWN0 4096
#ifndef BG_L1_P8
#define BG_L1_P8 2400
#endif
#ifndef BG_L1_P11
#define BG_L1_P11 4096
#endif
DI void cvt_group(const Params& p, LAS unsigned char* lds, int group, int t_lo, int t_hi, int r, int I) {
    const int tid = threadIdx.x;
    unsigned char* ws = p.ws;
    __syncthreads();
    LAS CvtJob* J = (LAS CvtJob*)(lds + 72 * 1024);
    LAS float* tile = (LAS float*)lds;
    if (tid == 0) {
        int t0 = 0, nj = 0;
        if (group == 0) {
            set_job(J, 0, p.in[11], (bf16_t*)(ws + WS_W0IN), DM, L0IN, DM, 0, 1, 0, 0, t0);
            set_job(J, 1, p.in[13], (bf16_t*)(ws + WS_WUQ), 512, 1536, 512, 0, 1, 0, 0, t0);
            set_job(J, 2, p.in[15], (bf16_t*)(ws + WS_WUKV), 256, 2048, 256, 0, 1, 0, 0, t0);
            set_job(J, 3, p.in[23], (bf16_t*)(ws + WS_W0OUT), DM, DM, DM, 0, 1, 0, 0, t0);
            set_job(J, 4, p.in[31], (bf16_t*)(ws + WS_W1IN), DM, L1IN, DM, 1, 1, 0, 0, t0);
            set_job(J, 5, p.in[34], (bf16_t*)(ws + WS_W1OUT), DM, DM, DM, 0, 1, 0, 0, t0);
            set_job(J, 6, p.in[18], (bf16_t*)(ws + WS_GW), 128, 128, 128, 0, 16, 128 * 128, 128 * 128, t0);
            set_job(J, 7, p.in[20], (bf16_t*)(ws + WS_GW + (size_t)16 * 128 * 128 * 2), 128, 128, 128, 0, 16, 128 * 128, 128 * 128, t0);
            nj = 8;
        } else if (group == 1) {
            set_job(J, 0, p.in[24], (bf16_t*)(ws + WS_EG), DM, EFF, DM, 0, NEXP, (size_t)DM * EFF, (size_t)EFF * DM, t0);
            set_job(J, 1, p.in[25], (bf16_t*)(ws + WS_EU), DM, EFF, DM, 0, NEXP, (size_t)DM * EFF, (size_t)EFF * DM, t0);
            set_job(J, 2, p.in[26], (bf16_t*)(ws + WS_ED), EFF, DM, EFF, 0, NEXP, (size_t)DM * EFF, (size_t)EFF * DM, t0);
            nj = 3;
        } else {
            set_job(J, 0, p.in[35], (bf16_t*)(ws + WS_EG + EXPW), DM, EFF, DM, 0, NEXP, (size_t)DM * EFF, (size_t)EFF * DM, t0);
            set_job(J, 1, p.in[36], (bf16_t*)(ws + WS_EU + EXPW), DM, EFF, DM, 0, NEXP, (size_t)DM * EFF, (size_t)EFF * DM, t0);
            set_job(J, 2, p.in[37], (bf16_t*)(ws + WS_ED + EXPW), EFF, DM, EFF, 0, NEXP, (size_t)DM * EFF, (size_t)EFF * DM, t0);
            nj = 3;
        }
        J[nj].tile0 = t0; J[15].tile0 = nj;
    }
    __syncthreads();
    const int nj = J[15].tile0, total = J[nj].tile0;
    const int hi = min(t_hi, total);
    const int row = tid >> 6, c4 = (tid & 63) * 4;
    for (int gt = t_lo + r; gt < hi; gt += I) {
        CvtTile cur; cvt_decode(J, nj, gt, cur);
        if (c4 < cur.nw) {
            f32x4 v[8];
#pragma unroll
            for (int i = 0; i < 8; ++i) v[i] = *(const f32x4*)(cur.src + (size_t)(cur.k0 + row + 8 * i) * cur.N + cur.n0 + c4);
#pragma unroll
            for (int i = 0; i < 8; ++i) *(LAS f32x4*)(tile + (row + 8 * i) * 260 + c4) = v[i];
        }
        __syncthreads();
        { const int n = tid & 255, kh = tid >> 8;
          if (n < cur.nw) {
              const int orow = cur.perm ? l1_permrow(cur.n0 + n) : (cur.n0 + n);
#pragma unroll
              for (int q8 = 0; q8 < 4; ++q8) {
                  float w8[8];
#pragma unroll
                  for (int q = 0; q < 8; ++q) w8[q] = tile[(32 * kh + 8 * q8 + q) * 260 + n];
                  u32x4 w; w.x = pk_bf16(w8[0], w8[1]); w.y = pk_bf16(w8[2], w8[3]); w.z = pk_bf16(w8[4], w8[5]); w.w = pk_bf16(w8[6], w8[7]);
                  *(u32x4*)(cur.dst + (size_t)orow * cur.ldo + cur.k0 + 32 * kh + 8 * q8) = w;
              }
          } }
        __syncthreads();
    }
}
DI void bg_range(const Params& p, LAS unsigned char* lds, int group, int t_lo, int t_hi, int nunits, int G, int bid) {
    const int rem = nunits % G;
    if (rem == 0) cvt_group(p, lds, group, t_lo, t_hi, bid, G);
    else if (bid >= rem) cvt_group(p, lds, group, t_lo, t_hi, bid - rem, G - rem);
}
DI int bg_end(int t_lo, int nunits, int per_wg, int G) { const int rem = nunits % G; if (rem == 0) return t_lo; return min(t_lo + (G - rem) * per_wg, MOE_CVT_TILES); }
DI int bg_convert(const Params& p, LAS unsigned char* lds, int group, int t_lo, int nunits, int per_wg, int G, int bid) {
    const int rem = nunits % G;
    if (rem == 0) return t_lo;
    const int idle = G - rem, t_hi = min(t_lo + idle * per_wg, MOE_CVT_TILES);
    if (bid >= rem && t_hi > t_lo) cvt_group(p, lds, group, t_lo, t_hi, bid - rem, idle);
    return t_hi;
}

DI void phase_prologue(const Params& p, LAS unsigned char* lds, int G, int bid) {
    const int tid = threadIdx.x;
    unsigned char* ws = p.ws;
    {
        LAS float* s = (LAS float*)lds;
        LAS float* part = (LAS float*)(lds + 40960);
        for (int i = tid; i < 5 * DM; i += NTHREADS) { const int r = i / DM, k = i % DM; const float c = r < 4 ? p.in[1][r * DM + k] : p.in[3][k]; s[i] = c / (1.0f + __expf(-c)); }
        __syncthreads();
        float* MOD = (float*)(ws + WS_MOD);
        for (int chunk = bid; chunk < 256; chunk += G) {
            const int layer = chunk >> 7, n0 = (chunk & 127) * 96;
            const float* W = layer ? p.in[27] : p.in[7]; const float* bias = layer ? p.in[28] : p.in[8];
            const int cg = tid % 24, ks = tid / 24;
            if (ks < 16) {
                f32x4 acc[5];
#pragma unroll
                for (int r = 0; r < 5; ++r) acc[r] = (f32x4){0.f, 0.f, 0.f, 0.f};
                const float* wp = W + (size_t)(ks * 128) * MODN + n0 + 4 * cg;
                for (int k = 0; k < 128; k += 8) {
                    f32x4 w[8];
#pragma unroll
                    for (int j = 0; j < 8; ++j) w[j] = *(const f32x4*)(wp + (size_t)(k + j) * MODN);
#pragma unroll
                    for (int j = 0; j < 8; ++j)
#pragma unroll
                        for (int r = 0; r < 5; ++r) acc[r] += s[r * DM + ks * 128 + k + j] * w[j];
                }
#pragma unroll
                for (int r = 0; r < 5; ++r)
#pragma unroll
                    for (int j = 0; j < 4; ++j) part[(ks * 5 + r) * 96 + cg * 4 + j] = acc[r][j];
            }
            __syncthreads();
            if (tid < 480) {
                const int r = tid / 96, col = tid % 96; float a = bias[n0 + col];
#pragma unroll
                for (int k2 = 0; k2 < 16; ++k2) a += part[(k2 * 5 + r) * 96 + col];
                MOD[((size_t)layer * 5 + r) * MODN + n0 + col] = a;
            }
            __syncthreads();
        }
    }
    {
        f32x2* R0 = (f32x2*)(ws + WS_ROPE0); f32x2* R1 = (f32x2*)(ws + WS_ROPE1);
        for (int i = bid * NTHREADS + tid; i < 64 * 16 + 64 * 32; i += G * NTHREADS) {
            if (i < 64 * 16) { const int pos = i >> 4, k = i & 15; const float ang = (float)pos * exp2f(-(float)k * (13.287712379549449f / 16.0f)); R0[i] = (f32x2){cosf(ang), sinf(ang)}; }
            else { const int j = i - 64 * 16, pos = j >> 5, k = j & 31; const float ang = (float)pos * exp2f(-(float)k * (13.287712379549449f / 32.0f)); R1[j] = (f32x2){cosf(ang), sinf(ang)}; }
        }
        u32x4* z = (u32x4*)(ws + WS_W0IN + (size_t)L0IN * DM * 2);
        for (int i = bid * NTHREADS + tid; i < (L0INP - L0IN) * DM * 2 / 16; i += G * NTHREADS) z[i] = (u32x4){0u, 0u, 0u, 0u};
    }
    cvt_group(p, lds, 0, 0, 1 << 30, bid, G);
    cvt_group(p, lds, 1, BG_L0_P6, MOE_CVT_TILES, bid, G);
    cvt_group(p, lds, 2, BG_L1_P11, BG_L1_DOWN0, bid, G);
}

DI void norm_mod_store(const f32x4 (&v)[8], const float* gain, const float* shift, const float* scale, bf16_t* hrow, int lane) {
    float ss = 0.f;
#pragma unroll
    for (int i = 0; i < 8; ++i) ss += v[i][0] * v[i][0] + v[i][1] * v[i][1] + v[i][2] * v[i][2] + v[i][3] * v[i][3];
    ss = wave_sum(ss);
    const float r = rsqrtf(ss * (1.0f / DM) + EPS);
#pragma unroll
    for (int i = 0; i < 8; ++i) {
        const int col = 4 * lane + 256 * i;
        const f32x4 g = *(const f32x4*)(gain + col), sh = *(const f32x4*)(shift + col), sc = *(const f32x4*)(scale + col);
        const f32x4 h = (v[i] * r * g) * (1.0f + sc) + sh;
        u32x2 w; w.x = pk_bf16(h[0], h[1]); w.y = pk_bf16(h[2], h[3]);
        *(u32x2*)(hrow + col) = w;
    }
}

DI void phase_norm0(const Params& p, int G, int bid) {
    const int lane = threadIdx.x & 63, wave = threadIdx.x >> 6;
    const float* MOD = (const float*)(p.ws + WS_MOD);
    bf16_t* H = (bf16_t*)(p.ws + WS_H);
    for (int row = bid * 8 + wave; row < NTOK; row += G * 8) {
        const float* xr = row < NCTX ? p.in[2] + (size_t)row * DM : p.in[0] + (size_t)(row - NCTX) * DM;
        f32x4 v[8];
#pragma unroll
        for (int i = 0; i < 8; ++i) v[i] = *(const f32x4*)(xr + 4 * lane + 256 * i);
        const float* md = MOD + (size_t)row_mod(row) * MODN;
        norm_mod_store(v, p.in[9], md, md + DM, H + (size_t)row * DM, lane);
    }
}
DI void phase_l0_rows(const Params& p, int G, int bid) {
    const int lane = threadIdx.x & 63, wave = threadIdx.x >> 6;
    const bf16_t* Z = (const bf16_t*)(p.ws + WS_Z);
    bf16_t* CQN = (bf16_t*)(p.ws + WS_CQN); bf16_t* CKVN = (bf16_t*)(p.ws + WS_CKVN); bf16_t* KR = (bf16_t*)(p.ws + WS_KR);
    const f32x2* R0 = (const f32x2*)(p.ws + WS_ROPE0);
    for (int row = bid * 8 + wave; row < NTOK; row += G * 8) {
        const bf16_t* z = Z + (size_t)row * L0INP;
        {
            const u32x4 w = *(const u32x4*)(z + 8 * lane);
            float v[8] = {bflo(w.x), bfhi(w.x), bflo(w.y), bfhi(w.y), bflo(w.z), bfhi(w.z), bflo(w.w), bfhi(w.w)};
            float ss = 0.f;
#pragma unroll
            for (int j = 0; j < 8; ++j) ss += v[j] * v[j];
            ss = wave_sum(ss);
            const float r = rsqrtf(ss * (1.0f / 512.0f) + EPS);
            const f32x4 g0 = *(const f32x4*)(p.in[12] + 8 * lane), g1 = *(const f32x4*)(p.in[12] + 8 * lane + 4);
            u32x4 o; o.x = pk_bf16(v[0] * r * g0[0], v[1] * r * g0[1]); o.y = pk_bf16(v[2] * r * g0[2], v[3] * r * g0[3]);
            o.z = pk_bf16(v[4] * r * g1[0], v[5] * r * g1[1]); o.w = pk_bf16(v[6] * r * g1[2], v[7] * r * g1[3]);
            *(u32x4*)(CQN + (size_t)row * 512 + 8 * lane) = o;
        }
        {
            const u32x2 w = *(const u32x2*)(z + 512 + 4 * lane);
            float v[4] = {bflo(w.x), bfhi(w.x), bflo(w.y), bfhi(w.y)};
            float ss = v[0] * v[0] + v[1] * v[1] + v[2] * v[2] + v[3] * v[3];
            ss = wave_sum(ss);
            const float r = rsqrtf(ss * (1.0f / 256.0f) + EPS);
            const f32x4 g = *(const f32x4*)(p.in[14] + 4 * lane);
            u32x2 o; o.x = pk_bf16(v[0] * r * g[0], v[1] * r * g[1]); o.y = pk_bf16(v[2] * r * g[2], v[3] * r * g[3]);
            *(u32x2*)(CKVN + (size_t)row * 256 + 4 * lane) = o;
        }
        {
            const float x = bf2f(z[768 + lane]);
            const float xp = __shfl_xor(x, 16);
            float o = x;
            if (row >= NCTX) {
                const int t = (row - NCTX) & (SEQ - 1), axis = lane >> 5, part = (lane >> 4) & 1, i = lane & 15;
                const int pos = axis ? (t & 63) : (t >> 6);
                const f32x2 cs = R0[pos * 16 + i];
                o = part ? (x * cs[0] + xp * cs[1]) : (x * cs[0] - xp * cs[1]);
            }
            KR[(size_t)row * 64 + lane] = f2bf(o);
        }
    }
}

DI float gelu_tanh(float x) { const float u = 0.7978845608028654f * (x + 0.044715f * x * x * x); const float e = __expf(2.0f * u); const float th = 1.0f - 2.0f / (e + 1.0f); return 0.5f * x * (1.0f + th); }

template <int PASS>
DI void lru_units(const Params& p, LAS unsigned char* lds, int G, int bid) {
    const int tid = threadIdx.x, lane = tid & 63, wave = tid >> 6;
    const bf16_t* Z = (const bf16_t*)(p.ws + WS_Z);
    const bf16_t* GWA = (const bf16_t*)(p.ws + WS_GW); const bf16_t* GWX = GWA + 16 * 128 * 128;
    f32x2* SUMM = (f32x2*)(p.ws + WS_SUMM); const float* CARRY = (const float*)(p.ws + WS_CARRY);
    bf16_t* Y = (bf16_t*)(p.ws + WS_Y);
    LAS float* U32 = (LAS float*)lds;
    LAS unsigned char* UBF = lds + 32768;
    LAS f32x2* AB = (LAS f32x2*)lds;
    const bool by_n = (G % 8) == 0;
    const int n_fix = bid & 7, nW = by_n ? G / 8 : G, q0 = by_n ? bid >> 3 : bid, nunits = by_n ? NCHUNK * NB : NCHUNK * NB * 8;
    const int d = wave >> 2, nt = wave & 3, jl = lane & 31, h = lane >> 5, ch = 32 * nt + jl;
    bf16x8 wa[8], wx[8];
    if (by_n) {
        const bf16_t* pa = GWA + ((size_t)(d * 8 + n_fix) * 128 + ch) * 128 + 8 * h;
        const bf16_t* px = GWX + ((size_t)(d * 8 + n_fix) * 128 + ch) * 128 + 8 * h;
#pragma unroll
        for (int ks = 0; ks < 8; ++ks) { wa[ks] = *(const bf16x8*)(pa + 16 * ks); wx[ks] = *(const bf16x8*)(px + 16 * ks); }
    }
    for (int v = q0; v < nunits; v += nW) {
        const int n = by_n ? n_fix : (v & 7), bc = by_n ? v : (v >> 3), b = bc & 3, ci = bc >> 2;
        const int seg_len = ci < 4 ? CTX : SEQ, t0 = ci < 4 ? 64 * ci : 64 * (ci - 4);
        const int row0 = ci < 4 ? b * CTX + t0 : NCTX + b * SEQ + t0;
        const int chg = 128 * n + ch;
        if (!by_n) {
            const bf16_t* pa = GWA + ((size_t)(d * 8 + n) * 128 + ch) * 128 + 8 * h;
            const bf16_t* px = GWX + ((size_t)(d * 8 + n) * 128 + ch) * 128 + 8 * h;
#pragma unroll
            for (int ks = 0; ks < 8; ++ks) { wa[ks] = *(const bf16x8*)(pa + 16 * ks); wx[ks] = *(const bf16x8*)(px + 16 * ks); }
        }
        u32x2 grw[4];
        {
            const int c4 = (tid & 31) * 4, tb = 4 * (tid >> 5), cg = 128 * n + c4;
            f32x4 xv[7];
#pragma unroll
            for (int q = 0; q < 7; ++q) { const int tt = t0 + tb + q - 2; u32x2 w = (u32x2){0u, 0u};
                if (tt >= 0 && tt < seg_len) w = *(const u32x2*)(Z + (size_t)(row0 + tb + q - 2) * L0INP + 832 + cg);
                xv[q] = (f32x4){bflo(w.x), bfhi(w.x), bflo(w.y), bfhi(w.y)}; }
            if (PASS == 2) {
#pragma unroll
                for (int j = 0; j < 4; ++j) grw[j] = *(const u32x2*)(Z + (size_t)(row0 + tb + j) * L0INP + 1856 + cg);
            }
            const f32x4 cb = *(const f32x4*)(p.in[17] + cg);
            f32x4 cw[4];
#pragma unroll
            for (int tap = 0; tap < 4; ++tap) cw[tap] = *(const f32x4*)(p.in[16] + tap * 1024 + cg);
#pragma unroll
            for (int j = 0; j < 4; ++j) {
                const f32x4 acc = cb + xv[j] * cw[0] + xv[j + 1] * cw[1] + xv[j + 2] * cw[2] + xv[j + 3] * cw[3];
                *(LAS f32x4*)(U32 + (tb + j) * 128 + c4) = acc;
                u32x2 o; o.x = pk_bf16(acc[0], acc[1]); o.y = pk_bf16(acc[2], acc[3]);
                *(LAS u32x2*)(UBF + (tb + j) * 272 + c4 * 2) = o;
            }
        }
        __syncthreads();
        f32x16 acc[2][2];
#pragma unroll
        for (int g = 0; g < 2; ++g)
#pragma unroll
            for (int mt = 0; mt < 2; ++mt)
#pragma unroll
                for (int i = 0; i < 16; ++i) acc[g][mt][i] = 0.f;
#pragma unroll
        for (int ks = 0; ks < 8; ++ks) {
            const bf16x8 a0 = *(const LAS bf16x8*)(UBF + jl * 272 + (16 * ks + 8 * h) * 2);
            const bf16x8 a1 = *(const LAS bf16x8*)(UBF + (32 + jl) * 272 + (16 * ks + 8 * h) * 2);
            acc[0][0] = __builtin_amdgcn_mfma_f32_32x32x16_bf16(a0, wa[ks], acc[0][0], 0, 0, 0);
            acc[0][1] = __builtin_amdgcn_mfma_f32_32x32x16_bf16(a1, wa[ks], acc[0][1], 0, 0, 0);
            acc[1][0] = __builtin_amdgcn_mfma_f32_32x32x16_bf16(a0, wx[ks], acc[1][0], 0, 0, 0);
            acc[1][1] = __builtin_amdgcn_mfma_f32_32x32x16_bf16(a1, wx[ks], acc[1][1], 0, 0, 0);
        }
        {
            const float ga_b = p.in[19][d * 1024 + chg], gx_b = p.in[21][d * 1024 + chg], lam = p.in[22][d * 1024 + chg];
            const float sp8l2 = 8.0f * LOG2E * log1pf(expf(-lam));
#pragma unroll
            for (int mt = 0; mt < 2; ++mt)
#pragma unroll
                for (int i = 0; i < 16; ++i) {
                    const int t = 32 * mt + (i & 3) + 8 * (i >> 2) + 4 * h;
                    const float r = __builtin_amdgcn_rcpf(1.0f + __builtin_amdgcn_exp2f(-LOG2E * (acc[0][mt][i] + ga_b)));
                    const float ig = __builtin_amdgcn_rcpf(1.0f + __builtin_amdgcn_exp2f(-LOG2E * (acc[1][mt][i] + gx_b)));
                    const float a = __builtin_amdgcn_exp2f(-sp8l2 * r);
                    const float bb = __builtin_amdgcn_sqrtf((1.0f - a) * (1.0f + a)) * (ig * U32[t * 128 + ch]);
                    acc[0][mt][i] = a; acc[1][mt][i] = bb;
                }
        }
        __syncthreads();
#pragma unroll
        for (int mt = 0; mt < 2; ++mt)
#pragma unroll
            for (int i = 0; i < 16; ++i) { const int t = 32 * mt + (i & 3) + 8 * (i >> 2) + 4 * h; AB[(d * 64 + t) * 128 + ch] = (f32x2){acc[0][mt][i], acc[1][mt][i]}; }
        __syncthreads();
        if (tid < 256) {
            const int sd = tid >> 7, sc = tid & 127;
            const size_t sidx = ((size_t)(sd * NB + b) * NCHUNK + ci) * 1024 + 128 * n + sc;
            if (PASS == 1) {
                float hh = 0.f, ap = 1.f;
#pragma unroll 16
                for (int s2 = 0; s2 < 64; ++s2) { const int t = sd ? 63 - s2 : s2; const f32x2 ab = AB[(sd * 64 + t) * 128 + sc]; hh = ab[0] * hh + ab[1]; ap *= ab[0]; }
                SUMM[sidx] = (f32x2){ap, hh};
            } else {
                float hh = CARRY[sidx];
#pragma unroll 16
                for (int s2 = 0; s2 < 64; ++s2) { const int t = sd ? 63 - s2 : s2; const f32x2 ab = AB[(sd * 64 + t) * 128 + sc]; hh = ab[0] * hh + ab[1]; AB[(sd * 64 + t) * 128 + sc] = (f32x2){ab[0], hh}; }
            }
        }
        __syncthreads();
        if (PASS == 2) {
            const int c4 = (tid & 31) * 4, tb = 4 * (tid >> 5);
#pragma unroll
            for (int j = 0; j < 4; ++j) {
                const int t = tb + j; const size_t row = (size_t)(row0 + t);
                const float gr[4] = {bflo(grw[j].x), bfhi(grw[j].x), bflo(grw[j].y), bfhi(grw[j].y)};
                float y[4];
#pragma unroll
                for (int k = 0; k < 4; ++k) y[k] = (AB[(t) * 128 + c4 + k][1] + AB[(64 + t) * 128 + c4 + k][1]) * gelu_tanh(gr[k]);
                u32x2 o; o.x = pk_bf16(y[0], y[1]); o.y = pk_bf16(y[2], y[3]);
                *(u32x2*)(Y + row * DM + 1024 + 128 * n + c4) = o;
            }
            __syncthreads();
        }
    }
}

DI void lru_carry(const Params& p, int G, int bid) {
    const f32x2* SUMM = (const f32x2*)(p.ws + WS_SUMM); float* CARRY = (float*)(p.ws + WS_CARRY);
    for (int gid = bid * NTHREADS + threadIdx.x; gid < 2 * NB * 1024; gid += G * NTHREADS) {
        const int d = gid >> 12, b = (gid >> 10) & 3, ch = gid & 1023;
        const size_t base = ((size_t)(d * NB + b) * NCHUNK) * 1024 + ch;
        float hh = 0.f;
#pragma unroll
        for (int pos = 0; pos < NCHUNK; ++pos) {
            const int ci = d == 0 ? pos : (pos < 4 ? 3 - pos : 39 - pos);
            CARRY[base + (size_t)ci * 1024] = hh;
            const f32x2 s = SUMM[base + (size_t)ci * 1024];
            hh = s[0] * hh + s[1];
        }
    }
}
#define MFMA32(a, b, c) __builtin_amdgcn_mfma_f32_32x32x16_bf16((a), (b), (c), 0, 0, 0)
constexpr int AT_KSLOT = 24576, AT_VSLOT = 16384, AT_K0 = 0, AT_V0 = 2 * AT_KSLOT, AT_XOFF = AT_V0 + 2 * AT_VSLOT;

#ifndef AT_PIPE_MLA
#define AT_PIPE_MLA false
#endif
#ifndef AT_PIPE_WIN
#define AT_PIPE_WIN false
#endif
#ifndef AT_PIPE_NA
#define AT_PIPE_NA false
#endif
#ifndef AT_SKEW_MLA
#define AT_SKEW_MLA 0
#endif
#ifndef AT_SKEW_WIN
#define AT_SKEW_WIN 0
#endif
#ifndef AT_SKEW_NA
#define AT_SKEW_NA 0
#endif
struct NoBias { DI float operator()(int) const { return 0.f; } };

struct AtRd { int kbase, kbase1, ko[4], vbase, vo[4]; };
template <int DQ> DI int at_kf(int r) { return DQ == 128 ? (r & 15) : ((r >> 1) & 7); }
template <int DQ>
DI AtRd at_rd_init(int lane) {
    AtRd r; const int kr = lane & 31, h = lane >> 5, i16 = lane & 15, q = i16 >> 2, pp = i16 & 3, blk = (lane >> 4) & 1;
    const int f = at_kf<DQ>(kr);
    r.kbase = kr * (DQ * 2) + ((f >> 3) << 7); r.kbase1 = kr * (DQ * 2) + (((f >> 3) ^ 1) << 7);
#pragma unroll
    for (int i = 0; i < 4; ++i) r.ko[i] = ((2 * i + h) ^ (f & 7)) << 4;
    r.vbase = (4 * h + q) * 256 + 8 * pp;
#pragma unroll
    for (int t = 0; t < 4; ++t) r.vo[t] = ((2 * t + blk) ^ ((4 * h + q) & 7)) << 5;
    return r;
}
template <int DQ>
DI void at_qk(const LAS unsigned char* ks, const AtRd& rd, const bf16x8 (&qf)[DQ / 16], f32x16& s0, f32x16& s1) {
#pragma unroll
    for (int i = 0; i < 16; ++i) { s0[i] = 0.f; s1[i] = 0.f; }
    const LAS unsigned char* kp0 = ks + rd.kbase; const LAS unsigned char* kp1 = ks + rd.kbase1;
#pragma unroll
    for (int s = 0; s < DQ / 16; ++s) {
        const LAS unsigned char* kp = (DQ == 128) ? ((s >> 2) ? kp1 : kp0) : kp0 + ((s >> 2) << 7);
        const bf16x8 a0 = *(const LAS bf16x8*)(kp + rd.ko[s & 3]);
        const bf16x8 a1 = *(const LAS bf16x8*)(kp + 32 * (DQ * 2) + rd.ko[s & 3]);
        s0 = MFMA32(a0, qf[s], s0); s1 = MFMA32(a1, qf[s], s1);
    }
}
template <class BiasFn>
DI void at_sm(f32x16& s0, f32x16& s1, f32x16 (&o)[4], float& m, float& l, const float c2, const BiasFn& bias, const int lane, bf16x8 (&pf)[4]) {
    const int h = lane >> 5;
    float mx = -INFINITY;
#pragma unroll
    for (int i = 0; i < 16; ++i) {
        const int key = (i & 3) + 8 * (i >> 2) + 4 * h;
        s0[i] = s0[i] * c2 + bias(key); s1[i] = s1[i] * c2 + bias(32 + key);
        mx = fmaxf(mx, fmaxf(s0[i], s1[i]));
    }
    mx = fmaxf(mx, __shfl_xor(mx, 32));
    if (__any(mx > m + 8.0f)) {
        const float mn = fmaxf(m, mx), alpha = __builtin_amdgcn_exp2f(m - mn);
        m = mn; l *= alpha;
#pragma unroll
        for (int t = 0; t < 4; ++t)
#pragma unroll
            for (int i = 0; i < 16; ++i) o[t][i] *= alpha;
    }
    float rs = 0.f;
#pragma unroll
    for (int i = 0; i < 16; ++i) { s0[i] = __builtin_amdgcn_exp2f(s0[i] - m); s1[i] = __builtin_amdgcn_exp2f(s1[i] - m); rs += s0[i] + s1[i]; }
    l += rs;
    u32x4 w;
    w.x = pk_bf16(s0[0], s0[1]); w.y = pk_bf16(s0[2], s0[3]); w.z = pk_bf16(s0[4], s0[5]); w.w = pk_bf16(s0[6], s0[7]); pf[0] = __builtin_bit_cast(bf16x8, w);
    w.x = pk_bf16(s0[8], s0[9]); w.y = pk_bf16(s0[10], s0[11]); w.z = pk_bf16(s0[12], s0[13]); w.w = pk_bf16(s0[14], s0[15]); pf[1] = __builtin_bit_cast(bf16x8, w);
    w.x = pk_bf16(s1[0], s1[1]); w.y = pk_bf16(s1[2], s1[3]); w.z = pk_bf16(s1[4], s1[5]); w.w = pk_bf16(s1[6], s1[7]); pf[2] = __builtin_bit_cast(bf16x8, w);
    w.x = pk_bf16(s1[8], s1[9]); w.y = pk_bf16(s1[10], s1[11]); w.z = pk_bf16(s1[12], s1[13]); w.w = pk_bf16(s1[14], s1[15]); pf[3] = __builtin_bit_cast(bf16x8, w);
}
DI void at_pv(const LAS unsigned char* vs, const AtRd& rd, const bf16x8 (&pf)[4], f32x16 (&o)[4]) {
    const LAS unsigned char* vb = vs + rd.vbase;
#pragma unroll
    for (int ks = 0; ks < 4; ++ks)
#pragma unroll
        for (int t = 0; t < 4; ++t) {
            const s16x4 lo = __builtin_amdgcn_ds_read_tr16_b64_v4i16((LAS s16x4*)(vb + (16 * ks) * 256 + rd.vo[t]));
            const s16x4 hi = __builtin_amdgcn_ds_read_tr16_b64_v4i16((LAS s16x4*)(vb + (16 * ks + 8) * 256 + rd.vo[t]));
            const bf16x8 vf = __builtin_shufflevector(lo, hi, 0, 1, 2, 3, 4, 5, 6, 7);
            o[t] = MFMA32(vf, pf[ks], o[t]);
        }
}
template <class BiasFn>
DI void at_sm_pv(const LAS unsigned char* vs, const AtRd& rd, f32x16& s0, f32x16& s1, f32x16 (&o)[4], float& m, float& l, const float c2, const BiasFn& bias, const int lane) {
    bf16x8 pf[4];
    at_sm(s0, s1, o, m, l, c2, bias, lane, pf);
    at_pv(vs, rd, pf, o);
}

struct AtDma { unsigned ko[3], vo[2]; unsigned rope; };
template <int DQ>
DI AtDma at_dma_init(int ld_bytes, int wave, int lane) {
    AtDma d; d.rope = 0u;
    constexpr int PPR = DQ / 8;
#pragma unroll
    for (int k = 0; k < DQ / 64; ++k) { const int L = (wave + 8 * k) * 64 + lane, r = L / PPR, pc = (L % PPR) ^ at_kf<DQ>(r);
        if (DQ == 192 && pc >= 16) { d.ko[k] = (unsigned)(r * 128 + (pc - 16) * 16); d.rope |= 1u << k; } else d.ko[k] = (unsigned)(r * ld_bytes + pc * 16); }
    if (DQ == 128) d.ko[2] = 0u;
#pragma unroll
    for (int k = 0; k < 2; ++k) { const int L = (wave + 8 * k) * 64 + lane, r = L >> 4, pc = (L & 15) ^ (2 * (r & 7)); d.vo[k] = (unsigned)(r * ld_bytes + pc * 16); }
    return d;
}
template <int DQ>
DI void at_dma_k(LAS unsigned char* kslot, const char* kb, const char* rb, const AtDma& d, int wave) {
#pragma unroll
    for (int k = 0; k < DQ / 64; ++k) {
        const char* src = (DQ == 192 && ((d.rope >> k) & 1u)) ? rb + d.ko[k] : kb + d.ko[k];
        __builtin_amdgcn_global_load_lds((const unsigned*)src, (LAS unsigned*)(kslot + (wave + 8 * k) * 1024), 16, 0, 0);
    }
}
DI void at_dma_v(LAS unsigned char* vslot, const char* vb, const AtDma& d, int wave) {
#pragma unroll
    for (int k = 0; k < 2; ++k) __builtin_amdgcn_global_load_lds((const unsigned*)(vb + d.vo[k]), (LAS unsigned*)(vslot + (wave + 8 * k) * 1024), 16, 0, 0);
}
#define AT_DRAIN_SYNC() do { asm volatile("s_waitcnt vmcnt(0)" ::: "memory"); __syncthreads(); } while (0)

template <int DQ, bool PIPE, class Drv>
DI void at_run(LAS unsigned char* lds, const Drv& D, const int n, const AtRd& rd, const AtDma& dm, const bf16x8 (&qf)[DQ / 16], f32x16 (&o)[4], float& m, float& l, const float c2, const int lane, const int wave) {
    f32x16 a0, a1;
    __syncthreads();
    at_dma_k<DQ>(lds + AT_K0, D.kb(0), D.rb(0), dm, wave); at_dma_v(lds + AT_V0, D.vb(0), dm, wave);
    if constexpr (PIPE) {
        f32x16 b0, b1;
        if (n > 1) at_dma_k<DQ>(lds + AT_K0 + AT_KSLOT, D.kb(1), D.rb(1), dm, wave);
        AT_DRAIN_SYNC();
        if (D.act(0)) at_qk<DQ>(lds + AT_K0, rd, qf, a0, a1);
#define AT_STEP(J, PAR, C0, C1, N0, N1) do { const int j_ = (J); \
        if (j_ + 2 < n) at_dma_k<DQ>(lds + AT_K0 + (PAR) * AT_KSLOT, D.kb(j_ + 2), D.rb(j_ + 2), dm, wave); \
        if (j_ + 1 < n) at_dma_v(lds + AT_V0 + (1 - (PAR)) * AT_VSLOT, D.vb(j_ + 1), dm, wave); \
        if (j_ + 1 < n && D.act(j_ + 1)) at_qk<DQ>(lds + AT_K0 + (1 - (PAR)) * AT_KSLOT, rd, qf, N0, N1); \
        if (D.act(j_)) at_sm_pv(lds + AT_V0 + (PAR) * AT_VSLOT, rd, C0, C1, o, m, l, c2, D.bias(j_), lane); \
        AT_DRAIN_SYNC(); } while (0)
        for (int j = 0; j < n; j += 2) {
            AT_STEP(j, 0, a0, a1, b0, b1);
            if (j + 1 < n) AT_STEP(j + 1, 1, b0, b1, a0, a1);
        }
#undef AT_STEP
    } else {
        AT_DRAIN_SYNC();
        for (int j = 0; j < n; ++j) {
            const int par = j & 1;
            if (j + 1 < n) { at_dma_k<DQ>(lds + AT_K0 + (1 - par) * AT_KSLOT, D.kb(j + 1), D.rb(j + 1), dm, wave); at_dma_v(lds + AT_V0 + (1 - par) * AT_VSLOT, D.vb(j + 1), dm, wave); }
            if (D.act(j)) { at_qk<DQ>(lds + AT_K0 + par * AT_KSLOT, rd, qf, a0, a1); at_sm_pv(lds + AT_V0 + par * AT_VSLOT, rd, a0, a1, o, m, l, c2, D.bias(j), lane); }
            AT_DRAIN_SYNC();
        }
    }
}

constexpr int AT3_V0 = 2 * AT_KSLOT, AT3_XOFF = AT3_V0 + 3 * AT_VSLOT;
template <int DQ, class Drv>
DI void at_run_skew(LAS unsigned char* lds, const Drv& D, const int n, const AtRd& rd, const AtDma& dm, const bf16x8 (&qf)[DQ / 16], f32x16 (&o)[4], float& m, float& l, const float c2, const int lane, const int wave) {
    const bool late = wave >= 4;
    bf16x8 pf[4];
    __syncthreads();
    at_dma_k<DQ>(lds + AT_K0, D.kb(0), D.rb(0), dm, wave); at_dma_v(lds + AT3_V0, D.vb(0), dm, wave);
    AT_DRAIN_SYNC();
    int vcur = 0;
    for (int j = 0; j < n; ++j) {
        const int vnext = vcur == 2 ? 0 : vcur + 1, vprev = vcur == 0 ? 2 : vcur - 1;
        if (j + 1 < n) { at_dma_k<DQ>(lds + AT_K0 + ((j + 1) & 1) * AT_KSLOT, D.kb(j + 1), D.rb(j + 1), dm, wave); at_dma_v(lds + AT3_V0 + vnext * AT_VSLOT, D.vb(j + 1), dm, wave); }
        if (late && j > 0 && D.act(j - 1)) at_pv(lds + AT3_V0 + vprev * AT_VSLOT, rd, pf, o);
        if (D.act(j)) {
            f32x16 a0, a1;
            at_qk<DQ>(lds + AT_K0 + (j & 1) * AT_KSLOT, rd, qf, a0, a1);
            at_sm(a0, a1, o, m, l, c2, D.bias(j), lane, pf);
            if (!late) at_pv(lds + AT3_V0 + vcur * AT_VSLOT, rd, pf, o);
        }
        AT_DRAIN_SYNC();
        vcur = vnext;
    }
    if (late && D.act(n - 1)) at_pv(lds + AT3_V0 + (vcur == 0 ? 2 : vcur - 1) * AT_VSLOT, rd, pf, o);
}

constexpr int AT4_SLOT = AT_KSLOT + AT_VSLOT, AT4_XOFF = 3 * AT4_SLOT;
template <int DQ, class Drv>
DI void at_run3(LAS unsigned char* lds, const Drv& D, const int n, const AtRd& rd, const AtDma& dm, const bf16x8 (&qf)[DQ / 16], f32x16 (&o)[4], float& m, float& l, const float c2, const int lane, const int wave) {
    __syncthreads();
    at_dma_k<DQ>(lds, D.kb(0), D.rb(0), dm, wave); at_dma_v(lds + AT_KSLOT, D.vb(0), dm, wave);
    if (n > 1) { at_dma_k<DQ>(lds + AT4_SLOT, D.kb(1), D.rb(1), dm, wave); at_dma_v(lds + AT4_SLOT + AT_KSLOT, D.vb(1), dm, wave);
        if (DQ == 192) asm volatile("s_waitcnt vmcnt(5)" ::: "memory"); else asm volatile("s_waitcnt vmcnt(4)" ::: "memory"); }
    else asm volatile("s_waitcnt vmcnt(0)" ::: "memory");
    __syncthreads();
    int cur = 0;
    for (int j = 0; j < n; ++j) {
        const int nx2 = cur == 0 ? 2 : cur - 1;
        if (j + 2 < n) { at_dma_k<DQ>(lds + nx2 * AT4_SLOT, D.kb(j + 2), D.rb(j + 2), dm, wave); at_dma_v(lds + nx2 * AT4_SLOT + AT_KSLOT, D.vb(j + 2), dm, wave); }
        if (D.act(j)) {
            f32x16 a0, a1;
            at_qk<DQ>(lds + cur * AT4_SLOT, rd, qf, a0, a1);
            at_sm_pv(lds + cur * AT4_SLOT + AT_KSLOT, rd, a0, a1, o, m, l, c2, D.bias(j), lane);
        }
        if (j + 2 < n) { if (DQ == 192) asm volatile("s_waitcnt vmcnt(5)" ::: "memory"); else asm volatile("s_waitcnt vmcnt(4)" ::: "memory"); }
        else asm volatile("s_waitcnt vmcnt(0)" ::: "memory");
        __syncthreads();
        cur = cur == 2 ? 0 : cur + 1;
    }
}

DI void attn_store(const f32x16 (&o)[4], float l, float extra, bf16_t* orow, int lane) {
    const int h = lane >> 5;
    const float lt = l + __shfl_xor(l, 32) + extra;
    const float inv = 1.0f / lt;
#pragma unroll
    for (int t = 0; t < 4; ++t)
#pragma unroll
        for (int g4 = 0; g4 < 4; ++g4) {
            u32x2 w; w.x = pk_bf16(o[t][4 * g4] * inv, o[t][4 * g4 + 1] * inv); w.y = pk_bf16(o[t][4 * g4 + 2] * inv, o[t][4 * g4 + 3] * inv);
            *(u32x2*)(orow + 32 * t + 8 * g4 + 4 * h) = w;
        }
}

struct MlaDrv {
    const char* KV; const char* KR; int b, head;
    DI int keyrow0(int j) const { return j < 4 ? b * CTX + 64 * j : NCTX + b * SEQ + 64 * (j - 4); }
    DI const char* kb(int j) const { return KV + (size_t)keyrow0(j) * 4096 + head * 512; }
    DI const char* vb(int j) const { return KV + (size_t)keyrow0(j) * 4096 + head * 512 + 256; }
    DI const char* rb(int j) const { return KR + (size_t)keyrow0(j) * 128; }
    DI bool act(int) const { return true; }
    DI NoBias bias(int) const { return NoBias(); }
};

DI void phase_attn0(const Params& p, LAS unsigned char* lds, int G, int bid) {
    const int tid = threadIdx.x, lane = tid & 63, wave = __builtin_amdgcn_readfirstlane(tid >> 6), h = lane >> 5;
    const bf16_t* Q0 = (const bf16_t*)(p.ws + WS_Q0);
    bf16_t* Y = (bf16_t*)(p.ws + WS_Y);
    const float c2 = 0.07216878364870322f * LOG2E;
    const AtRd rd = at_rd_init<192>(lane);
    const AtDma dm = at_dma_init<192>(4096, wave, lane);
    for (int u = bid; u < 256 + 32; u += G) {
        MlaDrv T; T.KV = (const char*)(p.ws + WS_KV0); T.KR = (const char*)(p.ws + WS_KR);
        int qrow, nt;
        if (u < 256) { T.b = u >> 6; T.head = (u >> 3) & 7; nt = 36; qrow = NCTX + T.b * SEQ + (u & 7) * 256 + wave * 32 + (lane & 31); }
        else { const int v = u - 256; T.b = v >> 3; T.head = v & 7; nt = 4; qrow = T.b * CTX + wave * 32 + (lane & 31); }
        bf16x8 qf[12];
#pragma unroll
        for (int s = 0; s < 12; ++s) qf[s] = *(const bf16x8*)(Q0 + (size_t)qrow * 1536 + T.head * 192 + 16 * s + 8 * h);
        f32x16 o[4];
#pragma unroll
        for (int t = 0; t < 4; ++t)
#pragma unroll
            for (int i = 0; i < 16; ++i) o[t][i] = 0.f;
        float m = -INFINITY, l = 0.f;
        if (AT_SKEW_MLA == 2) at_run3<192>(lds, T, nt, rd, dm, qf, o, m, l, c2, lane, wave); else if (AT_SKEW_MLA) at_run_skew<192>(lds, T, nt, rd, dm, qf, o, m, l, c2, lane, wave); else at_run<192, AT_PIPE_MLA>(lds, T, nt, rd, dm, qf, o, m, l, c2, lane, wave);
        attn_store(o, l, 0.f, Y + (size_t)qrow * DM + T.head * 128, lane);
    }
}

struct WinBias { int base; DI float operator()(int key) const { return ((unsigned)(base - key) <= 256u) ? 0.f : -1e30f; } };
struct WinDrv {
    const char* Z; int b, kvh, k0base, jlo, qpos;
    DI int tid_(int q) const { return q < 4 ? q : jlo + q - 4; }
    DI int keyrow0(int q) const { const int j = tid_(q); return j < 4 ? b * CTX + 64 * j : NCTX + b * SEQ + k0base + 64 * (j - 4); }
    DI const char* kb(int q) const { return Z + (size_t)keyrow0(q) * (L1IN * 2) + (1024 + kvh * 128) * 2; }
    DI const char* vb(int q) const { return Z + (size_t)keyrow0(q) * (L1IN * 2) + (1280 + kvh * 128) * 2; }
    DI const char* rb(int) const { return nullptr; }
    DI bool act(int) const { return true; }
    DI WinBias bias(int q) const { const int j = tid_(q); WinBias B; B.base = j < 4 ? 100 : qpos - (k0base + 64 * (j - 4)) + 128; return B; }
};

DI void phase_attn_win(const Params& p, LAS unsigned char* lds, int G, int bid) {
    const int tid = threadIdx.x, lane = tid & 63, wave = __builtin_amdgcn_readfirstlane(tid >> 6), h = lane >> 5;
    const bf16_t* Z = (const bf16_t*)(p.ws + WS_Z);
    bf16_t* Y = (bf16_t*)(p.ws + WS_Y);
    const float c2 = 0.08838834764831845f * LOG2E;
    const AtRd rd = at_rd_init<128>(lane);
    const AtDma dm = at_dma_init<128>(L1IN * 2, wave, lane);
    for (int u = bid; u < 256; u += G) {
        WinDrv T; T.Z = (const char*)Z; T.b = u >> 6; T.kvh = (u >> 5) & 1; const int blk = u & 31; T.k0base = 64 * blk - 128;
        const int head = T.kvh * 4 + (wave >> 1), qpos = 64 * blk + 32 * (wave & 1) + (lane & 31), qrow = NCTX + T.b * SEQ + qpos;
        T.qpos = qpos;
        bf16x8 qf[8];
#pragma unroll
        for (int s = 0; s < 8; ++s) qf[s] = *(const bf16x8*)(Z + (size_t)qrow * L1IN + head * 128 + 16 * s + 8 * h);
        f32x16 o[4];
#pragma unroll
        for (int t = 0; t < 4; ++t)
#pragma unroll
            for (int i = 0; i < 16; ++i) o[t][i] = 0.f;
        float m = -INFINITY, l = 0.f;
        T.jlo = (T.k0base < 0) ? 4 + ((-T.k0base) >> 6) : 4;
        const int jhi = (T.k0base + 320 > SEQ) ? 9 - ((T.k0base + 320 - SEQ) >> 6) : 9;
        if (AT_SKEW_WIN == 2) at_run3<128>(lds, T, 4 + (jhi - T.jlo), rd, dm, qf, o, m, l, c2, lane, wave); else if (AT_SKEW_WIN) at_run_skew<128>(lds, T, 4 + (jhi - T.jlo), rd, dm, qf, o, m, l, c2, lane, wave); else at_run<128, AT_PIPE_WIN>(lds, T, 4 + (jhi - T.jlo), rd, dm, qf, o, m, l, c2, lane, wave);
        const float sink = p.in[32][head];
        attn_store(o, l, __builtin_amdgcn_exp2f(sink * LOG2E - m), Y + (size_t)qrow * DM + head * 128, lane);
    }
}

struct NaBias { const LAS float* rp; int c0; bool all; DI float operator()(int key) const { return all ? 0.f : ((key >= c0 && key < c0 + 16) ? rp[key] * LOG2E : -1e30f); } };
struct NaDrv {
    const char* Z; const LAS float* RPB; int b, head, rlo, r, c, r0, c0;
    DI int keyrow0(int j) const { return j < 4 ? b * CTX + 64 * j : NCTX + b * SEQ + 64 * (rlo + j - 4); }
    DI const char* kb(int j) const { return Z + (size_t)keyrow0(j) * (L1IN * 2) + (2560 + head * 128) * 2; }
    DI const char* vb(int j) const { return Z + (size_t)keyrow0(j) * (L1IN * 2) + (3584 + head * 128) * 2; }
    DI const char* rb(int) const { return nullptr; }
    DI bool act(int j) const { const int rr = rlo + j - 4; return j < 4 || (rr >= r0 && rr <= r0 + 7); }
    DI NaBias bias(int j) const { const int rr = rlo + j - 4; NaBias B; B.rp = RPB + (j < 4 ? 0 : (rr - r + 7) * 31 + (15 - c)); B.c0 = c0; B.all = j < 4; return B; }
};

DI void phase_attn_na(const Params& p, LAS unsigned char* lds, int G, int bid) {
    const int tid = threadIdx.x, lane = tid & 63, wave = __builtin_amdgcn_readfirstlane(tid >> 6), h = lane >> 5;
    const bf16_t* Z = (const bf16_t*)(p.ws + WS_Z);
    bf16_t* Y = (bf16_t*)(p.ws + WS_Y);
    LAS float* RPB = (LAS float*)(lds + AT4_XOFF);
    const float c2 = 0.08838834764831845f * LOG2E;
    const AtRd rd = at_rd_init<128>(lane);
    const AtDma dm = at_dma_init<128>(L1IN * 2, wave, lane);
    for (int u = bid; u < 256; u += G) {
        NaDrv T; T.Z = (const char*)Z; T.RPB = RPB; T.b = u >> 6; T.head = (u >> 3) & 7; const int R = u & 7;
        T.r = 4 * R + (wave >> 1); T.c = 32 * (wave & 1) + (lane & 31); const int qrow = NCTX + T.b * SEQ + 64 * T.r + T.c;
        T.r0 = min(max(T.r - 4, 0), 24); T.c0 = min(max(T.c - 8, 0), 48);
        T.rlo = min(max(4 * R - 4, 0), 24);
        const int rhi = min(max(4 * R + 3 - 4, 0), 24) + 7;
        const int ntl = 4 + (rhi - T.rlo + 1);
        __syncthreads();
        for (int i = tid; i < 15 * 31; i += NTHREADS) RPB[i] = p.in[33][T.head * 465 + i];
        bf16x8 qf[8];
#pragma unroll
        for (int s = 0; s < 8; ++s) qf[s] = *(const bf16x8*)(Z + (size_t)qrow * L1IN + 1536 + T.head * 128 + 16 * s + 8 * h);
        f32x16 o[4];
#pragma unroll
        for (int t = 0; t < 4; ++t)
#pragma unroll
            for (int i = 0; i < 16; ++i) o[t][i] = 0.f;
        float m = -INFINITY, l = 0.f;
        if (AT_SKEW_NA == 2) at_run3<128>(lds, T, ntl, rd, dm, qf, o, m, l, c2, lane, wave); else if (AT_SKEW_NA) at_run_skew<128>(lds, T, ntl, rd, dm, qf, o, m, l, c2, lane, wave); else at_run<128, AT_PIPE_NA>(lds, T, ntl, rd, dm, qf, o, m, l, c2, lane, wave);
        attn_store(o, l, 0.f, Y + (size_t)qrow * DM + 1024 + T.head * 128, lane);
    }
}
constexpr int RT_HS = 2052;
typedef float f32x4r __attribute__((ext_vector_type(4)));
DI void phase_router(const Params& p, LAS unsigned char* lds, int G, int bid, const int layer, const float* xin_ctx, const float* xin_lat, const int row_lo, const int row_hi) {
    const int tid = threadIdx.x, lane = tid & 63, wave = tid >> 6;
    const float* MOD = (const float*)(p.ws + WS_MOD) + (size_t)layer * 5 * MODN;
    const float* gain = layer ? p.in[30] : p.in[10];
    const float* rw = p.in[4]; const float* rb = p.in[5];
    bf16_t* H = (bf16_t*)(p.ws + WS_H);
    int* cnt = (int*)(p.ws + WS_CTL + CW_CNT) + layer * NEXP;
    int* LIST = (int*)(p.ws + WS_LIST); TokInfo* TOK = (TokInfo*)(p.ws + WS_TOK);
    LAS float* hs = (LAS float*)lds;
    LAS float* sc = (LAS float*)(lds + 16 * RT_HS * 4);
    const int nb = (row_hi - row_lo) / 16;
    float wb0[64], wb1[64];
    {
        const float* bp = rw + (size_t)(256 * wave + (lane >> 4)) * 32 + (lane & 15);
#pragma unroll
        for (int s2 = 0; s2 < 64; ++s2) { wb0[s2] = bp[4 * s2 * 32]; wb1[s2] = bp[4 * s2 * 32 + 16]; }
    }
    for (int bt = bid; bt < nb; bt += G) {
        __syncthreads();
#pragma unroll 1
        for (int rr = 0; rr < 2; ++rr) {
            const int lr = 2 * wave + rr, row = row_lo + bt * 16 + lr;
            const float* xr = row < NCTX ? xin_ctx + (size_t)row * DM : xin_lat + (size_t)(row - NCTX) * DM;
            const bf16_t* dr = (const bf16_t*)(p.ws + WS_D) + (size_t)row * DM;
            const float* md = MOD + (size_t)row_mod(row) * MODN;
            f32x4 v[8]; float ss = 0.f;
#pragma unroll
            for (int i = 0; i < 8; ++i) {
                const int col = 4 * lane + 256 * i;
                const u32x2 dw = *(const u32x2*)(dr + col);
                v[i] = *(const f32x4*)(xr + col) + *(const f32x4*)(md + 2 * DM + col) * (f32x4){bflo(dw.x), bfhi(dw.x), bflo(dw.y), bfhi(dw.y)};
                ss += v[i][0] * v[i][0] + v[i][1] * v[i][1] + v[i][2] * v[i][2] + v[i][3] * v[i][3];
            }
            ss = wave_sum(ss);
            const float r = rsqrtf(ss * (1.0f / DM) + EPS);
#pragma unroll
            for (int i = 0; i < 8; ++i) {
                const int col = 4 * lane + 256 * i;
                const f32x4 g = *(const f32x4*)(gain + col), sh = *(const f32x4*)(md + 3 * DM + col), scl = *(const f32x4*)(md + 4 * DM + col);
                const f32x4 hv = (v[i] * r * g) * (1.0f + scl) + sh;
                u32x2 w; w.x = pk_bf16(hv[0], hv[1]); w.y = pk_bf16(hv[2], hv[3]);
                *(u32x2*)(H + (size_t)row * DM + col) = w;
                *(LAS f32x4*)(hs + lr * RT_HS + col) = hv;
            }
        }
        __syncthreads();
        f32x4r c0 = {0.f, 0.f, 0.f, 0.f}, c1 = {0.f, 0.f, 0.f, 0.f};
        {
            const int ar = lane & 15, kq = lane >> 4;
            const LAS float* ap = hs + ar * RT_HS + 256 * wave + kq;
#pragma unroll
            for (int s2 = 0; s2 < 64; ++s2) {
                const float a = ap[4 * s2];
                c0 = __builtin_amdgcn_mfma_f32_16x16x4f32(a, wb0[s2], c0, 0, 0, 0);
                c1 = __builtin_amdgcn_mfma_f32_16x16x4f32(a, wb1[s2], c1, 0, 0, 0);
            }
        }
        __syncthreads();
        {
            LAS float* part = hs;
            const int e = lane & 15, r4 = 4 * (lane >> 4);
#pragma unroll
            for (int j = 0; j < 4; ++j) { part[(wave * 16 + r4 + j) * 32 + e] = c0[j]; part[(wave * 16 + r4 + j) * 32 + 16 + e] = c1[j]; }
        }
        __syncthreads();
        {
            const int r = tid >> 5, e = tid & 31; float a = 0.f;
#pragma unroll
            for (int w2 = 0; w2 < 8; ++w2) a += hs[(w2 * 16 + r) * 32 + e];
            sc[r * 32 + e] = 1.0f / (1.0f + expf(-a));
        }
        __syncthreads();
        if (tid < 16) {
            const LAS float* s = sc + tid * 32;
            int bg = 0; float bgs = -INFINITY;
#pragma unroll
            for (int g = 0; g < 8; ++g) {
                const float v0 = s[4 * g] + rb[4 * g], v1 = s[4 * g + 1] + rb[4 * g + 1], v2 = s[4 * g + 2] + rb[4 * g + 2], v3 = s[4 * g + 3] + rb[4 * g + 3];
                const float hi01 = fmaxf(v0, v1), lo01 = fminf(v0, v1), hi23 = fmaxf(v2, v3), lo23 = fminf(v2, v3);
                const float m1 = fmaxf(hi01, hi23), m2 = fmaxf(fminf(hi01, hi23), fmaxf(lo01, lo23));
                const float gs = m1 + m2;
                if (gs > bgs) { bgs = gs; bg = g; }
            }
            float bv[4];
#pragma unroll
            for (int j = 0; j < 4; ++j) bv[j] = s[4 * bg + j] + rb[4 * bg + j];
            int i0 = 0; float b0 = bv[0];
#pragma unroll
            for (int j = 1; j < 4; ++j) if (bv[j] > b0) { b0 = bv[j]; i0 = j; }
            int i1 = -1; float b1 = -INFINITY;
#pragma unroll
            for (int j = 0; j < 4; ++j) if (j != i0 && bv[j] > b1) { b1 = bv[j]; i1 = j; }
            const int e0 = 4 * bg + i0, e1 = 4 * bg + i1;
            const float w0 = s[e0], w1 = s[e1], ws = w0 + w1;
            const int trow = row_lo + bt * 16 + tid;
            const int p0 = atomicAdd(cnt + e0, 1), p1 = atomicAdd(cnt + e1, 1);
            LIST[(size_t)e0 * MOE_CAP + p0] = trow; LIST[(size_t)e1 * MOE_CAP + p1] = trow;
            TokInfo ti; ti.e0 = e0; ti.p0 = p0; ti.e1 = e1; ti.p1 = p1; ti.w0 = w0 / ws; ti.w1 = w1 / ws; ti.pad0 = 0; ti.pad1 = 0;
            TOK[trow] = ti;
        }
    }
}

DI void moe_tables(const Params& p, LAS int* MT, int layer) {
    __syncthreads();
    if (threadIdx.x == 0) {
        const int* cnt = (const int*)(p.ws + WS_CTL + CW_CNT) + layer * NEXP;
        int seg = 0, tp = 0;
        for (int e = 0; e < NEXP; ++e) { const int c = cnt[e]; const int t = (c + 255) >> 8; MT[e] = seg; MT[64 + e] = tp; MT[128 + e] = c; seg += t * 256; tp += t; }
        MT[32] = seg; MT[64 + 32] = tp;
    }
    __syncthreads();
}

struct MoeSchedUp {
    static constexpr bool GATHER = true;
    const char* Hb; const char* EG; const int* LIST; const LAS int* MT; int K; size_t lda, ldb, a_h, b_h; int G, c;
    DI bool next(int i, pg8::GU& u) const {
        const int L = i * G + c, T = MT[64 + 32]; if (L >= T * 4) return false;
        const int rt = L >> 2, ct = L & 3; int e = 0;
#pragma unroll 1
        for (int q = 1; q < NEXP; ++q) if (rt >= MT[64 + q]) e = q;
        const int lt = rt - MT[64 + e];
        u.e = e; u.pm = lt; u.pn = ct; u.aux = MT[e] + 256 * lt; u.a = Hb; u.b = EG + (size_t)e * (EFF * DM * 2) + (size_t)ct * 128 * ldb; return true;
    }
    DI unsigned rowoff(const pg8::GU& u, int r) const { const int gr = 256 * u.pm + r; const int tok = gr < MT[128 + u.e] ? LIST[(size_t)u.e * MOE_CAP + gr] : 0; return (unsigned)tok * (unsigned)lda; }
};
struct MoeSchedDown {
    static constexpr bool GATHER = false;
    const char* ACT; const char* ED; const LAS int* MT; int K; size_t lda, ldb, a_h, b_h; int G, c;
    DI bool next(int i, pg8::GU& u) const {
        const int L = i * G + c, T = MT[64 + 32]; if (L >= T * 8) return false;
        const int rt = L >> 3, ct = L & 7; int e = 0;
#pragma unroll 1
        for (int q = 1; q < NEXP; ++q) if (rt >= MT[64 + q]) e = q;
        const int lt = rt - MT[64 + e];
        u.e = e; u.pm = lt; u.pn = ct; u.aux = MT[e] + 256 * lt; u.a = ACT + (size_t)u.aux * lda; u.b = ED + (size_t)e * (DM * EFF * 2) + (size_t)ct * 256 * ldb; return true;
    }
    DI unsigned rowoff(const pg8::GU&, int) const { return 0u; }
};
struct EpiSwiGLU {
    static constexpr bool PERM = true;
    bf16_t* ACT;
    DI void operator()(const f32x4 (&acc)[2][2][4][2], const pg8::GU& u, int wr, int wc, int fr, int fq) const {
        const int row0 = u.aux + wr * 64 + fr, col0 = u.pn * 128 + wc * 32 + 8 * fq;
#pragma unroll
        for (int ai = 0; ai < 2; ++ai)
#pragma unroll
            for (int m = 0; m < 4; ++m) {
                float a[8];
#pragma unroll
                for (int n = 0; n < 2; ++n)
#pragma unroll
                    for (int j = 0; j < 4; ++j) { const float g = acc[ai][0][m][n][j], up = acc[ai][1][m][n][j]; a[4 * n + j] = g / (1.0f + __expf(-g)) * up; }
                u32x4 w; w.x = pk_bf16(a[0], a[1]); w.y = pk_bf16(a[2], a[3]); w.z = pk_bf16(a[4], a[5]); w.w = pk_bf16(a[6], a[7]);
                *(u32x4*)(ACT + (size_t)(row0 + ai * 128 + m * 16) * EFF + col0) = w;
            }
    }
};
struct EpiBf16Rows {
    static constexpr bool PERM = true;
    bf16_t* O; int ldc; int use_aux; int skip = 0;
    DI void operator()(const f32x4 (&acc)[2][2][4][2], const pg8::GU& u, int wr, int wc, int fr, int fq) const {
        if (skip) return;
        const int row0 = (use_aux ? u.aux : u.pm * 256) + wr * 64 + fr, col0 = u.pn * 256 + wc * 32 + 8 * fq;
#pragma unroll
        for (int ai = 0; ai < 2; ++ai)
#pragma unroll
            for (int m = 0; m < 4; ++m) {
                bf16_t* rowp = O + (size_t)(row0 + ai * 128 + m * 16) * ldc + col0;
#pragma unroll
                for (int bj = 0; bj < 2; ++bj) {
                    const f32x4 v0 = acc[ai][bj][m][0], v1 = acc[ai][bj][m][1];
                    u32x4 w; w.x = pk_bf16(v0[0], v0[1]); w.y = pk_bf16(v0[2], v0[3]); w.z = pk_bf16(v1[0], v1[1]); w.w = pk_bf16(v1[2], v1[3]);
                    *(u32x4*)(rowp + bj * 128) = w;
                }
            }
    }
};

template <bool FINAL>
DI void phase_combine(const Params& p, LAS unsigned char* lds, int G, int bid, const int layer, const float* xin_ctx, const float* xin_lat, const int row_lo, const int row_hi) {
    const int lane = threadIdx.x & 63, wave = threadIdx.x >> 6;
    LAS int* MT = (LAS int*)(lds + LDS_MISC + 64);
    moe_tables(p, MT, layer);
    const float* MOD = (const float*)(p.ws + WS_MOD);
    const bf16_t* OUT2 = (const bf16_t*)(p.ws + WS_OUT2);
    const TokInfo* TOK = (const TokInfo*)(p.ws + WS_TOK);
    float* XB = (float*)(p.ws + WS_XB); bf16_t* H = (bf16_t*)(p.ws + WS_H);
    for (int row = row_lo + bid * 8 + wave; row < row_hi; row += G * 8) {
        const TokInfo ti = TOK[row];
        const bf16_t* o0 = OUT2 + (size_t)(MT[ti.e0] + ti.p0) * DM; const bf16_t* o1 = OUT2 + (size_t)(MT[ti.e1] + ti.p1) * DM;
        const float* xr = row < NCTX ? xin_ctx + (size_t)row * DM : xin_lat + (size_t)(row - NCTX) * DM;
        const bf16_t* dr = (const bf16_t*)(p.ws + WS_D) + (size_t)row * DM;
        const int mi = row_mod(row);
        const float* g1 = MOD + ((size_t)layer * 5 + mi) * MODN + 2 * DM;
        const float* g2 = MOD + ((size_t)layer * 5 + mi) * MODN + 5 * DM;
        f32x4 v[8];
#pragma unroll
        for (int i = 0; i < 8; ++i) {
            const int col = 4 * lane + 256 * i;
            const u32x2 dw = *(const u32x2*)(dr + col);
            const f32x4 x = *(const f32x4*)(xr + col) + *(const f32x4*)(g1 + col) * (f32x4){bflo(dw.x), bfhi(dw.x), bflo(dw.y), bfhi(dw.y)}, g = *(const f32x4*)(g2 + col);
            const u32x2 a = *(const u32x2*)(o0 + col), b = *(const u32x2*)(o1 + col);
            const f32x4 fa = {bflo(a.x), bfhi(a.x), bflo(a.y), bfhi(a.y)}, fb = {bflo(b.x), bfhi(b.x), bflo(b.y), bfhi(b.y)};
            v[i] = x + g * (fa * ti.w0 + fb * ti.w1);
        }
        if (!FINAL) {
#pragma unroll
            for (int i = 0; i < 8; ++i) *(f32x4*)(XB + (size_t)row * DM + 4 * lane + 256 * i) = v[i];
            const float* md = MOD + ((size_t)5 + mi) * MODN;
            norm_mod_store(v, p.in[29], md, md + DM, H + (size_t)row * DM, lane);
        } else {
            float ss = 0.f;
#pragma unroll
            for (int i = 0; i < 8; ++i) ss += v[i][0] * v[i][0] + v[i][1] * v[i][1] + v[i][2] * v[i][2] + v[i][3] * v[i][3];
            ss = wave_sum(ss);
            const float r = rsqrtf(ss * (1.0f / DM) + EPS);
#pragma unroll
            for (int i = 0; i < 8; ++i) { const int col = 4 * lane + 256 * i; const f32x4 g = *(const f32x4*)(p.in[6] + col); *(f32x4*)(p.out + (size_t)(row - NCTX) * DM + col) = v[i] * r * g; }
        }
    }
}
struct PlainSched {
    static constexpr bool GATHER = false;
    const char* A; const char* Bt; int K; size_t lda, ldb, a_h, b_h; pg8::TileOrder T;
    DI void init(const void* A_, const void* Bt_, int M, int N, int K_, int lda_e, int ldb_e, int G, int c) {
        A = (const char*)A_; Bt = (const char*)Bt_; K = K_; lda = (size_t)lda_e * 2; ldb = (size_t)ldb_e * 2; a_h = 128 * lda; b_h = 128 * ldb; T.init(M / 256, N / 256, G, c); }
    DI bool next(int i, pg8::GU& u) const { int pm, pn; if (!T.tile(i, pm, pn)) return false; u.pm = pm; u.pn = pn; u.e = 0; u.aux = 0; u.a = A + (size_t)pm * 256 * lda; u.b = Bt + (size_t)pn * 256 * ldb; return true; }
    DI unsigned rowoff(const pg8::GU&, int) const { return 0u; }
};

template <int MODE>
struct EpiRope {
    static constexpr bool PERM = false;
    bf16_t* O; int ldc; const f32x2* R;
    DI void operator()(const f32x4 (&acc)[2][2][4][2], const pg8::GU& u, int wr, int wc, int fr, int fq) const {
        const int row0 = u.pm * 256 + wr * 64 + fr;
#pragma unroll
        for (int bj = 0; bj < 2; ++bj) {
            const int g32 = 8 * u.pn + 4 * bj + wc;
            int axis, ibase; bool rot;
            if (MODE == 0) { const int hg = g32 % 6; rot = hg >= 4; axis = hg - 4; ibase = 4 * fq; }
            else { rot = u.pn < 5; axis = (g32 & 3) >> 1; ibase = 16 * (g32 & 1) + 4 * fq; }
            const int col0 = 32 * g32 + 4 * fq;
#pragma unroll
            for (int ai = 0; ai < 2; ++ai)
#pragma unroll
                for (int m = 0; m < 4; ++m) {
                    const int row = row0 + ai * 128 + m * 16;
                    f32x4 x1 = acc[ai][bj][m][0], x2 = acc[ai][bj][m][1];
                    if (rot && row >= NCTX) {
                        const int t = (row - NCTX) & (SEQ - 1), pos = axis ? (t & 63) : (t >> 6);
                        const f32x2* cs = R + pos * (MODE == 0 ? 16 : 32) + ibase;
                        f32x4 o1, o2;
#pragma unroll
                        for (int j = 0; j < 4; ++j) { const f32x2 c = cs[j]; o1[j] = x1[j] * c[0] - x2[j] * c[1]; o2[j] = x2[j] * c[0] + x1[j] * c[1]; }
                        x1 = o1; x2 = o2;
                    }
                    bf16_t* rowp = O + (size_t)row * ldc + col0;
                    u32x2 w1, w2; w1.x = pk_bf16(x1[0], x1[1]); w1.y = pk_bf16(x1[2], x1[3]); w2.x = pk_bf16(x2[0], x2[1]); w2.y = pk_bf16(x2[2], x2[3]);
                    *(u32x2*)(rowp) = w1; *(u32x2*)(rowp + 16) = w2;
                }
        }
    }
};

struct EpiResid {
    static constexpr bool PERM = true;
    const float* xin_ctx; const float* xin_lat; float* XO; const float* MODL; int rowbase;
    DI void operator()(const f32x4 (&acc)[2][2][4][2], const pg8::GU& u, int wr, int wc, int fr, int fq) const {
        const int row0 = rowbase + u.pm * 256 + wr * 64 + fr, col0 = u.pn * 256 + wc * 32 + 8 * fq;
        const float* g1 = MODL + (size_t)row_mod(rowbase + u.pm * 256) * MODN + 2 * DM;
        f32x4 gv[2][2];
#pragma unroll
        for (int bj = 0; bj < 2; ++bj)
#pragma unroll
            for (int n = 0; n < 2; ++n) gv[bj][n] = *(const f32x4*)(g1 + col0 + bj * 128 + n * 4);
#pragma unroll
        for (int ai = 0; ai < 2; ++ai)
#pragma unroll
            for (int m = 0; m < 4; ++m) {
                const int row = row0 + ai * 128 + m * 16;
                const float* xr = (row < NCTX ? xin_ctx + (size_t)row * DM : xin_lat + (size_t)(row - NCTX) * DM) + col0;
                float* xo = XO + (size_t)row * DM + col0;
#pragma unroll
                for (int bj = 0; bj < 2; ++bj)
#pragma unroll
                    for (int n = 0; n < 2; ++n) *(f32x4*)(xo + bj * 128 + n * 4) = *(const f32x4*)(xr + bj * 128 + n * 4) + gv[bj][n] * acc[ai][bj][m][n];
            }
    }
};

constexpr int NPHASE = 18;
constexpr int BG_U2 = (NTOK / 256) * (L0INP / 256), BG_U6 = (NTOK / 256) * (DM / 256), BG_U11 = (NTOK / 256) * (L1IN / 256);
#ifndef BG_Q2
#define BG_Q2 12
#endif
#ifndef BG_Q6
#define BG_Q6 10
#endif
#ifndef BG_Q8
#define BG_Q8 12
#endif
#ifndef BG_Q11
#define BG_Q11 12
#endif
__global__ void __launch_bounds__(NTHREADS, 2) fwd_kernel(Params p) {
    extern __shared__ __attribute__((aligned(16))) unsigned char lds_raw[];
    LAS unsigned char* lds = (LAS unsigned char*)lds_raw;
    const int tid = threadIdx.x, G = gridDim.x, bid = blockIdx.x;
    unsigned char* ws = p.ws;
    if (tid < 64) ((LAS unsigned*)(lds + LDS_MISC))[tid] = 0u;
    __syncthreads();
    const int lo = p.ph_lo, hi = p.ph_hi;
    const bool use_bar = (hi - lo) > 1;
    XcdBarrier bar; bar.bar = (unsigned*)(ws + WS_CTL + CW_BAR); bar.x = 0; bar.st = (volatile LAS unsigned*)(lds + LDS_MISC);
    if (use_bar) bar = xcd_barrier_post((unsigned*)(ws + WS_CTL + CW_BAR), (volatile LAS unsigned*)(lds + LDS_MISC));
#ifndef PH_MASK
#define PH_MASK 0x3ffff
#endif
#define IN(k) (((PH_MASK >> (k)) & 1) && lo <= (k) && (k) < hi)
#ifndef REPEAT_MASK
#define REPEAT_MASK 0
#endif
#define REP(k) 0
#define SEAM(k) do { if (rep_ == REP(k) && IN((k) + 1)) xcd_barrier(bar); } while (0)
    const float* MOD = (const float*)(ws + WS_MOD);
    LAS int* MT = (LAS int*)(lds + LDS_MISC + 64);
    const int vc = (G % 8 == 0) ? (bid % 8) * (G / 8) + bid / 8 : bid;
    (void)vc;

    if (IN(0)) for (int rep_ = 0; rep_ <= REP(0); ++rep_) { if (rep_) __syncthreads(); phase_prologue(p, lds, G, bid); SEAM(0); }
    if (IN(1)) for (int rep_ = 0; rep_ <= REP(1); ++rep_) { if (rep_) __syncthreads(); phase_norm0(p, G, bid); SEAM(1); }
    if (IN(2)) for (int rep_ = 0; rep_ <= REP(2); ++rep_) { if (rep_) __syncthreads();
        PlainSched S; S.init(ws + WS_H, ws + WS_W0IN, NTOK, L0INP, DM, DM, DM, G, bid);
        EpiBf16Rows E{(bf16_t*)(ws + WS_Z), L0INP, 0, p.flags & 1};
        pg8::gemm_phase(lds, S, E);
        bg_range(p, lds, 1, 0, BG_L0_P2, BG_U2, G, bid);
        SEAM(2);
    }
    if (IN(3)) for (int rep_ = 0; rep_ <= REP(3); ++rep_) { if (rep_) __syncthreads(); phase_l0_rows(p, G, bid); __syncthreads(); lru_units<1>(p, lds, G, bid); SEAM(3); }
    if (IN(4)) for (int rep_ = 0; rep_ <= REP(4); ++rep_) { if (rep_) __syncthreads();
        { PlainSched S; S.init(ws + WS_CQN, ws + WS_WUQ, NTOK, 1536, 512, 512, 512, G, bid);
          EpiRope<0> E{(bf16_t*)(ws + WS_Q0), 1536, (const f32x2*)(ws + WS_ROPE0)};
          pg8::gemm_phase(lds, S, E); }
        { PlainSched S; S.init(ws + WS_CKVN, ws + WS_WUKV, NTOK, 2048, 256, 256, 256, G, bid);
          EpiBf16Rows E{(bf16_t*)(ws + WS_KV0), 2048, 0};
          pg8::gemm_phase(lds, S, E); }
        lru_carry(p, G, bid);
        SEAM(4);
    }
    if (IN(5)) for (int rep_ = 0; rep_ <= REP(5); ++rep_) { if (rep_) __syncthreads(); if (!(p.flags & 2)) phase_attn0(p, lds, G, bid); __syncthreads(); if (!(p.flags & 4)) lru_units<2>(p, lds, G, bid); SEAM(5); }
    if (IN(6)) for (int rep_ = 0; rep_ <= REP(6); ++rep_) { if (rep_) __syncthreads();
        PlainSched S; S.init(ws + WS_Y, ws + WS_W0OUT, NTOK, DM, DM, DM, DM, G, bid);
        EpiBf16Rows E{(bf16_t*)(ws + WS_D), DM, 0};
        pg8::gemm_phase(lds, S, E);
        bg_range(p, lds, 1, BG_L0_P2, BG_L0_P6, BG_U6, G, bid);
        SEAM(6);
    }
    if (IN(7)) for (int rep_ = 0; rep_ <= REP(7); ++rep_) { if (rep_) __syncthreads(); phase_router(p, lds, G, bid, 0, p.in[2], p.in[0], 0, NTOK); SEAM(7); }
    if (IN(8)) for (int rep_ = 0; rep_ <= REP(8); ++rep_) { if (rep_) __syncthreads();
        moe_tables(p, MT, 0);
        MoeSchedUp S; S.Hb = (const char*)(ws + WS_H); S.EG = (const char*)(ws + WS_EG); S.LIST = (const int*)(ws + WS_LIST); S.MT = MT; S.K = DM;
        S.lda = DM * 2; S.ldb = DM * 2; S.a_h = 0; S.b_h = WS_EU - WS_EG; S.G = G; S.c = bid;
        EpiSwiGLU E{(bf16_t*)(ws + WS_ACT)};
        pg8::gemm_phase(lds, S, E);
        bg_range(p, lds, 2, 0, BG_L1_P8, 4 * MT[64 + 32], G, bid);
        SEAM(8);
    }
    if (IN(9)) for (int rep_ = 0; rep_ <= REP(9); ++rep_) { if (rep_) __syncthreads();
        moe_tables(p, MT, 0);
        MoeSchedDown S; S.ACT = (const char*)(ws + WS_ACT); S.ED = (const char*)(ws + WS_ED); S.MT = MT; S.K = EFF;
        S.lda = EFF * 2; S.ldb = EFF * 2; S.a_h = 128 * EFF * 2; S.b_h = 128 * EFF * 2; S.G = G; S.c = bid;
        EpiBf16Rows E{(bf16_t*)(ws + WS_OUT2), DM, 1};
        pg8::gemm_phase(lds, S, E); SEAM(9);
    }
    if (IN(10)) for (int rep_ = 0; rep_ <= REP(10); ++rep_) { if (rep_) __syncthreads(); phase_combine<false>(p, lds, G, bid, 0, p.in[2], p.in[0], 0, NTOK); SEAM(10); }
    if (IN(11)) for (int rep_ = 0; rep_ <= REP(11); ++rep_) { if (rep_) __syncthreads();
        PlainSched S; S.init(ws + WS_H, ws + WS_W1IN, NTOK, L1IN, DM, DM, DM, G, bid);
        EpiRope<1> E{(bf16_t*)(ws + WS_Z), L1IN, (const f32x2*)(ws + WS_ROPE1)};
        pg8::gemm_phase(lds, S, E);
        bg_range(p, lds, 2, BG_L1_P8, BG_L1_P11, BG_U11, G, bid);
        SEAM(11);
    }
    if (IN(12)) for (int rep_ = 0; rep_ <= REP(12); ++rep_) { if (rep_) __syncthreads(); if (!(p.flags & 2)) phase_attn_win(p, lds, G, bid); __syncthreads(); if (!(p.flags & 4)) phase_attn_na(p, lds, G, bid); SEAM(12); }
    if (IN(13)) for (int rep_ = 0; rep_ <= REP(13); ++rep_) { if (rep_) __syncthreads();
        PlainSched S; S.init(ws + WS_Y + (size_t)NCTX * DM * 2, ws + WS_W1OUT, NLAT, DM, DM, DM, DM, G, bid);
        EpiBf16Rows E{(bf16_t*)(ws + WS_D) + (size_t)NCTX * DM, DM, 0};
        pg8::gemm_phase(lds, S, E); SEAM(13);
    }
    if (IN(14)) for (int rep_ = 0; rep_ <= REP(14); ++rep_) { if (rep_) __syncthreads(); phase_router(p, lds, G, bid, 1, (const float*)(ws + WS_XB), (const float*)(ws + WS_XB) + (size_t)NCTX * DM, NCTX, NTOK); SEAM(14); }
    if (IN(15)) for (int rep_ = 0; rep_ <= REP(15); ++rep_) { if (rep_) __syncthreads();
        moe_tables(p, MT, 1);
        MoeSchedUp S; S.Hb = (const char*)(ws + WS_H); S.EG = (const char*)(ws + WS_EG + EXPW); S.LIST = (const int*)(ws + WS_LIST); S.MT = MT; S.K = DM;
        S.lda = DM * 2; S.ldb = DM * 2; S.a_h = 0; S.b_h = WS_EU - WS_EG; S.G = G; S.c = bid;
        EpiSwiGLU E{(bf16_t*)(ws + WS_ACT)};
        pg8::gemm_phase(lds, S, E);
        bg_range(p, lds, 2, BG_L1_DOWN0, MOE_CVT_TILES, 4 * MT[64 + 32], G, bid);
        SEAM(15);
    }
    if (IN(16)) for (int rep_ = 0; rep_ <= REP(16); ++rep_) { if (rep_) __syncthreads();
        moe_tables(p, MT, 1);
        MoeSchedDown S; S.ACT = (const char*)(ws + WS_ACT); S.ED = (const char*)(ws + WS_ED + EXPW); S.MT = MT; S.K = EFF;
        S.lda = EFF * 2; S.ldb = EFF * 2; S.a_h = 128 * EFF * 2; S.b_h = 128 * EFF * 2; S.G = G; S.c = bid;
        EpiBf16Rows E{(bf16_t*)(ws + WS_OUT2), DM, 1};
        pg8::gemm_phase(lds, S, E); SEAM(16);
    }
    if (IN(17)) for (int rep_ = 0; rep_ <= REP(17); ++rep_) { if (rep_) __syncthreads(); phase_combine<true>(p, lds, G, bid, 1, (const float*)(ws + WS_XB), (const float*)(ws + WS_XB) + (size_t)NCTX * DM, NCTX, NTOK); }
#undef IN
#undef SEAM
}

#ifndef REPEAT_FLAGS
#define REPEAT_FLAGS 0
#endif
#ifndef N_LAUNCH_MODE
#define N_LAUNCH_MODE 0
#endif
extern "C" void kernel_launch(void* const* d_in, const int* in_sizes, int n_in, void* d_out, int out_size, void* d_ws, size_t ws_size, hipStream_t stream) {
    static int grid = 0;
    if (grid == 0) {
        if (n_in != 38 || out_size != NLAT * DM || ws_size < WS_END) { fprintf(stderr, "kernel_launch: unexpected problem shape (n_in %d out %d ws %zu need %zu)\n", n_in, out_size, ws_size, (size_t)WS_END); grid = -1; return; }
        int dev = 0, cus = 0, per_cu = 0;
        if (hipGetDevice(&dev) != hipSuccess || hipDeviceGetAttribute(&cus, hipDeviceAttributeMultiprocessorCount, dev) != hipSuccess) { grid = -1; return; }
        if (hipFuncSetAttribute((const void*)fwd_kernel, hipFuncAttributeMaxDynamicSharedMemorySize, LDS_BYTES) != hipSuccess) { fprintf(stderr, "kernel_launch: hipFuncSetAttribute failed\n"); grid = -1; return; }
        if (hipOccupancyMaxActiveBlocksPerMultiprocessor(&per_cu, (const void*)fwd_kernel, NTHREADS, LDS_BYTES) != hipSuccess || per_cu < 1) { fprintf(stderr, "kernel_launch: occupancy query reports %d\n", per_cu); (void)hipGetLastError(); }
        grid = cus;
    }
    if (grid < 0) return;
    (void)hipMemsetAsync((char*)d_ws + WS_CTL, 0, CTL_BYTES, stream);
    Params prm{};
    for (int i = 0; i < 38; ++i) prm.in[i] = (const float*)d_in[i];
    prm.out = (float*)d_out; prm.ws = (unsigned char*)d_ws; prm.flags = 0; prm.pad = 0;
#if N_LAUNCH_MODE == 0
    prm.ph_lo = 0; prm.ph_hi = NPHASE;
    hipLaunchKernelGGL(fwd_kernel, dim3(grid), dim3(NTHREADS), LDS_BYTES, stream, prm);
#else
    for (int k = 0; k < NPHASE; ++k) { prm.ph_lo = k; prm.ph_hi = k + 1; const int reps = 1 + ((REPEAT_MASK >> k) & 1);
        for (int r = 0; r < reps; ++r) { prm.flags = r ? (REPEAT_FLAGS) : 0; if (r && (k == 7 || k == 14)) (void)hipMemsetAsync((char*)d_ws + WS_CTL + CW_CNT + (k == 14 ? NEXP * 4 : 0), 0, NEXP * 4, stream);
            hipLaunchKernelGGL(fwd_kernel, dim3(grid), dim3(NTHREADS), LDS_BYTES, stream, prm); } }
#endif
}
```

```cpp
#define N_LAUNCH_MODE 0
#include <hip/hip_runtime.h>
#include <stdint.h>
#include <stdio.h>

#define LAS __attribute__((address_space(3)))
#define DI __device__ __forceinline__
typedef unsigned short bf16_t;
typedef short bf16x8 __attribute__((ext_vector_type(8)));
typedef short s16x4 __attribute__((ext_vector_type(4)));
typedef float f32x2 __attribute__((ext_vector_type(2)));
typedef float f32x4 __attribute__((ext_vector_type(4)));
typedef float f32x16 __attribute__((ext_vector_type(16)));
typedef unsigned u32x2 __attribute__((ext_vector_type(2)));
typedef unsigned u32x4 __attribute__((ext_vector_type(4)));
typedef __bf16 hbf16x2 __attribute__((ext_vector_type(2)));

constexpr int DM = 2048, NB = 4, SEQ = 2048, CTX = 256, GRIDW = 64;
constexpr int NCTX = NB * CTX;
constexpr int NLAT = NB * SEQ;
constexpr int NTOK = NCTX + NLAT;
constexpr float EPS = 1e-6f;
constexpr int NEXP = 32, EFF = 512;
constexpr int L0IN = 2880, L0INP = 3072, L1IN = 4608;
constexpr int MODN = 6 * DM;
constexpr int NTHREADS = 512;
constexpr float LOG2E = 1.4426950408889634f;

DI unsigned pk_bf16(float lo, float hi) { f32x2 v = {lo, hi}; hbf16x2 r = __builtin_convertvector(v, hbf16x2); return __builtin_bit_cast(unsigned, r); }
DI float bflo(unsigned w) { return __uint_as_float(w << 16); }
DI float bfhi(unsigned w) { return __uint_as_float(w & 0xffff0000u); }
DI float bf2f(bf16_t b) { return __uint_as_float(((unsigned)b) << 16); }
DI bf16_t f2bf(float f) { return (bf16_t)(pk_bf16(f, 0.f) & 0xffffu); }
DI float wave_sum(float v) {
#pragma unroll
    for (int o = 32; o > 0; o >>= 1) v += __shfl_xor(v, o);
    return v;
}
DI float sigmoidf_(float x) { return 1.0f / (1.0f + __expf(-x)); }
DI int row_mod(int row) { return row < NCTX ? 4 : ((row - NCTX) >> 11); }
#define XB_TMO      128
#define XB_XCNT(j)  (256  + 64 * (j))
#define XB_XSUB(j)  (1280 + 64 * (j))
#define XB_XGEN(j)  (2304 + 64 * (j))
#define XB_TOP      3328
#define XB_TOPGEN   3392
#define XCD_BAR_WORDS 3456
#define XB_SPIN_CAP (1u << 18)

__device__ __forceinline__ unsigned xb_ld(unsigned* p)              { return __hip_atomic_load(p, __ATOMIC_RELAXED, __HIP_MEMORY_SCOPE_AGENT); }
__device__ __forceinline__ unsigned xb_add(unsigned* p, unsigned v) { return __hip_atomic_fetch_add(p, v, __ATOMIC_RELAXED, __HIP_MEMORY_SCOPE_AGENT); }
__device__ __forceinline__ unsigned xb_xcc_id() { return (unsigned)__builtin_amdgcn_s_getreg((3 << 11) | 20) & 0xFu; }
#define XB_SPIN(cond, bar) do { unsigned _sp = 0; while (cond) { __builtin_amdgcn_s_sleep(1); \
    if ((++_sp & 255u) == 0u) { if (xb_ld(&(bar)[XB_TMO])) break; if (_sp > XB_SPIN_CAP) { atomicAdd(&(bar)[XB_TMO], 1u); break; } } } } while (0)

struct XcdBarrier {
    unsigned* bar; unsigned x;
    volatile LAS unsigned* st;
};

__device__ __forceinline__ XcdBarrier xcd_barrier_post(unsigned* bar, volatile LAS unsigned* st) {
    XcdBarrier b; b.bar = bar; b.x = xb_xcc_id(); b.st = st;
    if (threadIdx.x == 0) (void)xb_add(&bar[XB_XCNT(b.x)], 1u);
    return b;
}
__device__ __forceinline__ void xcd_barrier_complete(unsigned* bar, unsigned x, unsigned& nloc, unsigned& nx) {
    const unsigned G = gridDim.x * gridDim.y * gridDim.z;
    unsigned sum, cnt, mine, sp = 0u;
    for (;;) {
        sum = 0u; cnt = 0u; mine = 0u;
#pragma unroll
        for (unsigned j = 0; j < 16; ++j) { const unsigned c = xb_ld(&bar[XB_XCNT(j)]); sum += c; cnt += (c > 0u) ? 1u : 0u; mine = (j == x) ? c : mine; }
        if (sum == G) break;
        __builtin_amdgcn_s_sleep(1);
        if ((++sp & 255u) == 0u) { if (xb_ld(&bar[XB_TMO])) break; if (sp > XB_SPIN_CAP) { atomicAdd(&bar[XB_TMO], 1u); break; } }
    }
    nloc = mine > 0u ? mine : 1u; nx = cnt > 0u ? cnt : 1u;
}

__device__ __forceinline__ void xcd_barrier(const XcdBarrier& b) {
    asm volatile("s_waitcnt vmcnt(0)" ::: "memory");
    __syncthreads();
    if (threadIdx.x == 0) {
        unsigned* bar = b.bar;
        __builtin_amdgcn_s_waitcnt(0);
        unsigned nloc = b.st[0], nx = b.st[1];
        if (nloc == 0u) { xcd_barrier_complete(bar, b.x, nloc, nx); b.st[0] = nloc; b.st[1] = nx; }
        const unsigned old = xb_add(&bar[XB_XSUB(b.x)], 1u);
        const unsigned gen = old / nloc;
        if (old + 1u == (gen + 1u) * nloc) {
            __builtin_amdgcn_fence(__ATOMIC_RELEASE, "agent");
            asm volatile("s_waitcnt vmcnt(0)" ::: "memory");
            const unsigned og = xb_add(&bar[XB_TOP], 1u);
            const unsigned tg = og / nx;
            if (og + 1u == (tg + 1u) * nx) xb_add(&bar[XB_TOPGEN], 1u);
            else XB_SPIN(xb_ld(&bar[XB_TOPGEN]) == tg, bar);
            __builtin_amdgcn_fence(__ATOMIC_ACQUIRE, "agent");
            xb_add(&bar[XB_XGEN(b.x)], 1u);
            asm volatile("s_waitcnt vmcnt(0)" ::: "memory");
        } else {
            XB_SPIN(xb_ld(&bar[XB_XGEN(b.x)]) == gen, bar);
            __builtin_amdgcn_fence(__ATOMIC_ACQUIRE, "agent");
            asm volatile("s_waitcnt vmcnt(0)" ::: "memory");
        }
    }
    __syncthreads();
}

#ifndef PG8_SP2
#define PG8_SP2 true
#endif
#ifndef PG8_ALIGN_EPI
#define PG8_ALIGN_EPI true
#endif
namespace pg8 {
constexpr int BM = 256, BK = 64, HALF = 128, HTB = HALF * BK * 2, STAGE_BYTES = 8 * HTB, NXCD = 8, WGM = 8;
DI int lds_byte(int r, int c) { const int st = (r >> 4) * 2 + (c >> 5), rr = r & 15, cc = c & 31, ob = rr * 64 + cc * 2; return st * 1024 + (ob ^ (((ob >> 9) & 1) << 5)); }
DI void stage_rc(int b, int& R, int& C) { const int st = b / 1024, sb = b % 1024, swz = sb ^ (((sb >> 9) & 1) << 5); R = (st >> 1) * 16 + swz / 64; C = (st & 1) * 32 + (swz % 64) / 2; }
DI int perm32(int rho) { const int n = rho >> 4, i = rho & 15; return 8 * (i >> 2) + 4 * n + (i & 3); }

struct GU { const char* a; const char* b; int pm, pn, e, aux; };

template <class Epi, class Sched>
DI void gemm_phase(LAS unsigned char* lds, const Sched& S, const Epi& E) {
    const int tid = threadIdx.x, wid = __builtin_amdgcn_readfirstlane(tid >> 6), lane = tid & 63, wr = wid >> 2, wc = wid & 3, fr = lane & 15, fq = lane >> 4;
    const int K = S.K, nt = K / BK;
    int RR[2], CC[2];
    unsigned voffA[2], voffB[2];
#pragma unroll
    for (int i = 0; i < 2; ++i) { int R, C; stage_rc(tid * 16 + i * 8192, R, C); RR[i] = R; CC[i] = C; const int Rb = Epi::PERM ? ((R & ~31) + perm32(R & 31)) : R;
        voffA[i] = (unsigned)(R * (int)S.lda + C * 2); voffB[i] = (unsigned)(Rb * (int)S.ldb + C * 2); }
    const size_t kstep = (size_t)(BK * 2);
    const size_t ahs = S.a_h, bhs = S.b_h;
    const unsigned ldsw = (unsigned)wid * 1024u;
    const int aoff = lds_byte(wr * 64 + fr, fq * 8), boff = lds_byte(wc * 32 + fr, fq * 8);
#define PG8_SA(b, h) (((b) * 2 + (h)) * HTB)
#define PG8_SB(b, h) ((4 + (b) * 2 + (h)) * HTB)
#define PG8_STAGE(bufoff, gbase, voff) do { _Pragma("unroll") for (int _i = 0; _i < 2; ++_i) \
        __builtin_amdgcn_global_load_lds((const unsigned*)((const char*)(gbase) + (voff)[_i]), (LAS unsigned*)(lds + (bufoff) + ldsw + _i * 8192), 16, 0, 0); } while (0)
#define PG8_STAGE_A(bufoff, gbase, h, VG) do { if constexpr (Sched::GATHER) { PG8_STAGE(bufoff, gbase, VG[h]); } else { PG8_STAGE(bufoff, (gbase) + (h) * ahs, voffA); } } while (0)
#define PG8_STAGE_B(bufoff, gbase, h) PG8_STAGE(bufoff, (gbase) + (h) * bhs, voffB)
#define PG8_LDA(dst, b, h) do { _Pragma("unroll") for (int m = 0; m < 4; ++m) _Pragma("unroll") for (int k = 0; k < 2; ++k) dst[m][k] = *(const LAS bf16x8*)(lds + PG8_SA(b, h) + aoff + m * 2048 + k * 1024); } while (0)
#define PG8_LDB(dst, b, h) do { _Pragma("unroll") for (int n = 0; n < 2; ++n) _Pragma("unroll") for (int k = 0; k < 2; ++k) dst[n][k] = *(const LAS bf16x8*)(lds + PG8_SB(b, h) + boff + n * 2048 + k * 1024); } while (0)
#define PG8_MMA(ai, bj, At, Bt) do { __builtin_amdgcn_s_setprio(1); _Pragma("unroll") for (int m = 0; m < 4; ++m) _Pragma("unroll") for (int n = 0; n < 2; ++n) _Pragma("unroll") for (int k = 0; k < 2; ++k) \
        acc[ai][bj][m][n] = __builtin_amdgcn_mfma_f32_16x16x32_bf16(Bt[n][k], At[m][k], acc[ai][bj][m][n], 0, 0, 0); __builtin_amdgcn_s_setprio(0); } while (0)
#define PG8_WAIT_V(n) asm volatile("s_waitcnt vmcnt(" #n ")" ::: "memory")
#define PG8_WAIT_L(n) asm volatile("s_waitcnt lgkmcnt(" #n ")" ::: "memory")
#define PG8_BAR __builtin_amdgcn_s_barrier()
#define PG8_SCHED __builtin_amdgcn_sched_barrier(0)
    GU cur, nxt; int ui = 0;
    if (!S.next(0, cur)) return;
    f32x4 acc[2][2][4][2];
#pragma unroll
    for (int a = 0; a < 2; ++a)
#pragma unroll
        for (int b = 0; b < 2; ++b)
#pragma unroll
            for (int m = 0; m < 4; ++m)
#pragma unroll
                for (int n = 0; n < 2; ++n) acc[a][b][m][n] = (f32x4){0.f, 0.f, 0.f, 0.f};
    bf16x8 At[4][2], B0[2][2], B1[2][2];
    unsigned vc[2][2], vn[2][2];
    if constexpr (Sched::GATHER) {
#pragma unroll
        for (int h = 0; h < 2; ++h)
#pragma unroll
            for (int i = 0; i < 2; ++i) { vc[h][i] = S.rowoff(cur, RR[i] + 128 * h) + (unsigned)(CC[i] * 2); vn[h][i] = vc[h][i]; }
    } else {
#pragma unroll
        for (int h = 0; h < 2; ++h)
#pragma unroll
            for (int i = 0; i < 2; ++i) { vc[h][i] = 0u; vn[h][i] = 0u; }
    }
    const char* cA = cur.a; const char* cB = cur.b;
    if constexpr (PG8_SP2) {
        PG8_STAGE_B(PG8_SB(0, 0), cB, 0); PG8_STAGE_B(PG8_SB(0, 1), cB, 1); PG8_STAGE_A(PG8_SA(0, 0), cA, 0, vc); PG8_STAGE_A(PG8_SA(0, 1), cA, 1, vc);
        if (wr == 1) PG8_BAR;
        PG8_WAIT_V(2); PG8_BAR;
        PG8_STAGE_B(PG8_SB(1, 0), cB + kstep, 0); PG8_STAGE_A(PG8_SA(1, 0), cA + kstep, 0, vc); PG8_STAGE_B(PG8_SB(1, 1), cB + kstep, 1);
        PG8_WAIT_V(6); PG8_BAR;
    } else {
        PG8_STAGE_B(PG8_SB(0, 0), cB, 0); PG8_STAGE_A(PG8_SA(0, 0), cA, 0, vc); PG8_STAGE_B(PG8_SB(0, 1), cB, 1); PG8_STAGE_A(PG8_SA(0, 1), cA, 1, vc);
        if (wr == 1) PG8_BAR;
        PG8_WAIT_V(4); PG8_BAR;
        PG8_STAGE_B(PG8_SB(1, 0), cB + kstep, 0); PG8_STAGE_A(PG8_SA(1, 0), cA + kstep, 0, vc); PG8_STAGE_B(PG8_SB(1, 1), cB + kstep, 1);
        PG8_WAIT_V(6); PG8_BAR;
    }
    for (;;) {
        const bool has_next = S.next(ui + 1, nxt);
        const char* nA = has_next ? nxt.a : cA; const char* nB = has_next ? nxt.b : cB;
        if constexpr (Sched::GATHER) {
            if (has_next) {
#pragma unroll
                for (int h = 0; h < 2; ++h)
#pragma unroll
                    for (int i = 0; i < 2; ++i) vn[h][i] = S.rowoff(nxt, RR[i] + 128 * h) + (unsigned)(CC[i] * 2);
            } else {
#pragma unroll
                for (int h = 0; h < 2; ++h)
#pragma unroll
                    for (int i = 0; i < 2; ++i) vn[h][i] = vc[h][i];
            }
        }
        for (int t = 0; t < nt; t += 2) {
            const bool last = (t == nt - 2);
            const char* a1 = cA + (size_t)(t + 1) * kstep;
            const char* a2 = last ? nA : cA + (size_t)(t + 2) * kstep; const char* b2 = last ? nB : cB + (size_t)(t + 2) * kstep;
            const char* a3 = a2 + kstep; const char* b3 = b2 + kstep;
            unsigned v2[2][2];
#pragma unroll
            for (int h = 0; h < 2; ++h)
#pragma unroll
                for (int i = 0; i < 2; ++i) v2[h][i] = last ? vn[h][i] : vc[h][i];
            if constexpr (PG8_SP2) {
            PG8_LDB(B0, 0, 0); PG8_LDB(B1, 0, 1); PG8_SCHED; PG8_LDA(At, 0, 0); PG8_STAGE_A(PG8_SA(1, 1), a1, 1, vc);
            PG8_WAIT_V(8); PG8_WAIT_L(0); PG8_BAR; PG8_MMA(0, 0, At, B0); PG8_MMA(0, 1, At, B1); PG8_BAR; PG8_SCHED;
            PG8_LDA(At, 0, 1); PG8_STAGE_B(PG8_SB(0, 0), b2, 0); PG8_STAGE_B(PG8_SB(0, 1), b2, 1); PG8_STAGE_A(PG8_SA(0, 0), a2, 0, v2);
            PG8_WAIT_V(8); PG8_WAIT_L(0); PG8_BAR; PG8_MMA(1, 0, At, B0); PG8_MMA(1, 1, At, B1); PG8_BAR; PG8_SCHED;
            PG8_LDB(B0, 1, 0); PG8_LDB(B1, 1, 1); PG8_SCHED; PG8_LDA(At, 1, 0); PG8_STAGE_A(PG8_SA(0, 1), a2, 1, v2);
            PG8_WAIT_V(8); PG8_WAIT_L(0); PG8_BAR; PG8_MMA(0, 0, At, B0); PG8_MMA(0, 1, At, B1); PG8_BAR; PG8_SCHED;
            PG8_LDA(At, 1, 1); PG8_STAGE_B(PG8_SB(1, 0), b3, 0); PG8_STAGE_B(PG8_SB(1, 1), b3, 1); PG8_STAGE_A(PG8_SA(1, 0), a3, 0, v2);
            PG8_WAIT_V(8); PG8_WAIT_L(0); PG8_BAR; PG8_MMA(1, 0, At, B0); PG8_MMA(1, 1, At, B1); PG8_BAR; PG8_SCHED;
            } else {
            PG8_LDB(B0, 0, 0); PG8_SCHED; PG8_LDA(At, 0, 0); PG8_STAGE_A(PG8_SA(1, 1), a1, 1, vc);
            PG8_WAIT_L(8); PG8_BAR; PG8_WAIT_L(0); PG8_MMA(0, 0, At, B0); PG8_BAR; PG8_SCHED;
            PG8_LDB(B1, 0, 1); PG8_STAGE_B(PG8_SB(0, 0), b2, 0);
            PG8_BAR; PG8_WAIT_L(0); PG8_MMA(0, 1, At, B1); PG8_BAR;
            PG8_LDA(At, 0, 1); PG8_STAGE_A(PG8_SA(0, 0), a2, 0, v2);
            PG8_BAR; PG8_WAIT_L(0); PG8_MMA(1, 0, At, B0); PG8_BAR; PG8_SCHED;
            PG8_STAGE_B(PG8_SB(0, 1), b2, 1);
            PG8_WAIT_V(6); PG8_BAR; PG8_MMA(1, 1, At, B1); PG8_BAR;
            PG8_LDB(B0, 1, 0); PG8_SCHED; PG8_LDA(At, 1, 0); PG8_STAGE_A(PG8_SA(0, 1), a2, 1, v2);
            PG8_WAIT_L(8); PG8_BAR; PG8_WAIT_L(0); PG8_MMA(0, 0, At, B0); PG8_BAR; PG8_SCHED;
            PG8_LDB(B1, 1, 1); PG8_STAGE_B(PG8_SB(1, 0), b3, 0);
            PG8_BAR; PG8_WAIT_L(0); PG8_MMA(0, 1, At, B1); PG8_BAR;
            PG8_LDA(At, 1, 1); PG8_STAGE_A(PG8_SA(1, 0), a3, 0, v2);
            PG8_BAR; PG8_WAIT_L(0); PG8_MMA(1, 0, At, B0); PG8_BAR; PG8_SCHED;
            PG8_STAGE_B(PG8_SB(1, 1), b3, 1);
            PG8_WAIT_V(6); PG8_BAR; PG8_MMA(1, 1, At, B1); PG8_BAR;
            }
        }
        if constexpr (PG8_ALIGN_EPI) { if (wr == 0) PG8_BAR; }
        E(acc, cur, wr, wc, fr, fq);
        if (!has_next) break;
#pragma unroll
        for (int a = 0; a < 2; ++a)
#pragma unroll
            for (int b = 0; b < 2; ++b)
#pragma unroll
                for (int m = 0; m < 4; ++m)
#pragma unroll
                    for (int n = 0; n < 2; ++n) acc[a][b][m][n] = (f32x4){0.f, 0.f, 0.f, 0.f};
        cur = nxt; cA = nA; cB = nB; ++ui;
        if constexpr (Sched::GATHER) {
#pragma unroll
            for (int h = 0; h < 2; ++h)
#pragma unroll
                for (int i = 0; i < 2; ++i) vc[h][i] = vn[h][i];
        }
        if constexpr (PG8_ALIGN_EPI) { if (wr == 1) PG8_BAR; }
    }
    PG8_WAIT_V(0);
    if constexpr (!PG8_ALIGN_EPI) { if (wr == 0) PG8_BAR; }
    PG8_BAR;
#undef PG8_SA
#undef PG8_SB
#undef PG8_STAGE
#undef PG8_STAGE_A
#undef PG8_STAGE_B
#undef PG8_LDA
#undef PG8_LDB
#undef PG8_MMA
#undef PG8_WAIT_V
#undef PG8_WAIT_L
#undef PG8_BAR
#undef PG8_SCHED
}

struct TileOrder {
    int nM, nN, nwg, G, c;
    DI void init(int nM_, int nN_, int G_, int c_) { nM = nM_; nN = nN_; nwg = nM * nN; G = G_; c = c_; }
    DI bool tile(int i, int& pm, int& pn) const {
        const long L = (long)i * G + c; if (L >= nwg) return false;
        int wgid = (int)L; { const int q = nwg / NXCD, r = nwg % NXCD, xcd = wgid % NXCD, off = wgid / NXCD; wgid = (xcd < r ? xcd * (q + 1) : r * (q + 1) + (xcd - r) * q) + off; }
        const int nig = WGM * nN, gid = wgid / nig, fm = gid * WGM, gsz = (nM - fm) < WGM ? (nM - fm) : WGM;
        pm = fm + ((wgid % nig) % gsz); pn = (wgid % nig) / gsz; return true;
    }
};
}
constexpr size_t AL(size_t x) { return (x + 255) & ~(size_t)255; }
constexpr int MOE_CAP = NTOK;
constexpr int SLOT_ROWS = 2 * NTOK + NEXP * 256;
constexpr int NCHUNK = (CTX + SEQ) / 64;
constexpr size_t WS_CTL    = 0;
constexpr size_t CTL_BYTES = 65536;
constexpr size_t CW_BAR    = 0;
constexpr size_t CW_CNT    = 16384;
constexpr size_t WS_MOD    = AL(WS_CTL + CTL_BYTES);
constexpr size_t WS_ROPE0  = AL(WS_MOD + (size_t)2 * 5 * MODN * 4);
constexpr size_t WS_ROPE1  = AL(WS_ROPE0 + 64 * 16 * 8);
constexpr size_t WS_W0IN   = AL(WS_ROPE1 + 64 * 32 * 8);
constexpr size_t WS_WUQ    = AL(WS_W0IN + (size_t)L0INP * DM * 2);
constexpr size_t WS_WUKV   = AL(WS_WUQ + (size_t)1536 * 512 * 2);
constexpr size_t WS_W0OUT  = AL(WS_WUKV + (size_t)2048 * 256 * 2);
constexpr size_t WS_W1IN   = AL(WS_W0OUT + (size_t)DM * DM * 2);
constexpr size_t WS_W1OUT  = AL(WS_W1IN + (size_t)L1IN * DM * 2);
constexpr size_t EXPW      = (size_t)NEXP * EFF * DM * 2;
constexpr size_t WS_EG     = AL(WS_W1OUT + (size_t)DM * DM * 2);
constexpr size_t WS_EU     = AL(WS_EG + 2 * EXPW);
constexpr size_t WS_ED     = AL(WS_EU + 2 * EXPW);
constexpr size_t WS_GW     = AL(WS_ED + 2 * EXPW);
constexpr size_t WS_XA     = AL(WS_GW + (size_t)2 * 16 * 128 * 128 * 2);
constexpr size_t WS_XB     = AL(WS_XA + (size_t)NTOK * DM * 4);
constexpr size_t WS_H      = AL(WS_XB + (size_t)NTOK * DM * 4);
constexpr size_t WS_Z      = AL(WS_H + (size_t)NTOK * DM * 2);
constexpr size_t WS_CQN    = AL(WS_Z + (size_t)NTOK * L1IN * 2);
constexpr size_t WS_CKVN   = AL(WS_CQN + (size_t)NTOK * 512 * 2);
constexpr size_t WS_KR     = AL(WS_CKVN + (size_t)NTOK * 256 * 2);
constexpr size_t WS_Q0     = AL(WS_KR + (size_t)NTOK * 64 * 2);
constexpr size_t WS_KV0    = AL(WS_Q0 + (size_t)NTOK * 1536 * 2);
constexpr size_t WS_Y      = AL(WS_KV0 + (size_t)NTOK * 2048 * 2);
constexpr size_t WS_SUMM   = AL(WS_Y + (size_t)NTOK * DM * 2);
constexpr size_t WS_CARRY  = AL(WS_SUMM + (size_t)2 * NB * NCHUNK * 1024 * 8);
constexpr size_t WS_LIST   = AL(WS_CARRY + (size_t)2 * NB * NCHUNK * 1024 * 4);
constexpr size_t WS_TOK    = AL(WS_LIST + (size_t)NEXP * MOE_CAP * 4);
constexpr size_t WS_ACT    = AL(WS_TOK + (size_t)NTOK * 32);
constexpr size_t WS_OUT2   = AL(WS_ACT + (size_t)SLOT_ROWS * EFF * 2);
constexpr size_t WS_D      = AL(WS_OUT2 + (size_t)SLOT_ROWS * DM * 2);
constexpr size_t WS_ABG    = AL(WS_D + (size_t)NTOK * DM * 2);
constexpr size_t WS_END    = AL(WS_ABG + (size_t)NB * NCHUNK * 8 * 2 * 64 * 128 * 4);

struct TokInfo { int e0, p0, e1, p1; float w0, w1; int pad0, pad1; };

constexpr int LDS_STAGE = 0;
constexpr int LDS_MISC  = 135168;
constexpr int LDS_BYTES = 135168 + 4096;

struct Params { const float* in[38]; float* out; unsigned char* ws; int ph_lo, ph_hi, flags, pad; };

struct Frame {
    const float* const* in; float* out; unsigned char* ws; LAS unsigned char* lds;
    int tid, lane, wave, G, bid;
};
struct CvtJob { const float* src; bf16_t* dst; int K, N, ldo, perm, tiles_per_b, tile0; size_t sstride, dstride; };

DI int l1_permrow(int n) {
    if (n >= 1280) return n;
    const int hb = n & ~127, d = n & 127, a = d >> 6, part = (d >> 5) & 1, i = d & 31;
    return hb + 64 * a + 32 * (i >> 4) + 16 * part + (i & 15);
}

DI void set_job(LAS CvtJob* J, int j, const float* src, bf16_t* dst, int K, int N, int ldo, int perm, int nb, size_t ss, size_t ds, int& t0) {
    J[j].src = src; J[j].dst = dst; J[j].K = K; J[j].N = N; J[j].ldo = ldo; J[j].perm = perm; J[j].tiles_per_b = (K / 64) * ((N + 255) / 256); J[j].tile0 = t0;
    J[j].sstride = ss; J[j].dstride = ds; t0 += nb * J[j].tiles_per_b;
}

struct CvtTile { const float* src; bf16_t* dst; int N, ldo, k0, n0, nw, perm; };
DI void cvt_decode(LAS CvtJob* J, int nj, int gt, CvtTile& t) {
    int j = 0;
#pragma unroll 1
    for (int q = 1; q < nj; ++q) if (gt >= J[q].tile0) j = q;
    const int rem = gt - J[j].tile0, tpb = J[j].tiles_per_b, b = rem / tpb, r2 = rem % tpb;
    t.N = J[j].N; t.ldo = J[j].ldo; const int nst = (t.N + 255) / 256, kt = r2 / nst, st = r2 % nst; t.perm = J[j].perm;
    t.src = J[j].src + (size_t)b * J[j].sstride; t.dst = J[j].dst + (size_t)b * J[j].dstride;
    t.k0 = kt * 64; t.n0 = st * 256; t.nw = min(256, t.N - t.n0);
}
constexpr int MOE_CVT_TILES = 3 * NEXP * 64;
#ifndef BG_L0_P2
#define BG_L0_P2 960
#endif
#ifndef BG_L0_P6
#define BG_L0_P6 3960
#endif
#define BG_L1_DOWN0 4096
#ifndef BG_L1_P8
#define BG_L1_P8 2400
#endif
#ifndef BG_L1_P11
#define BG_L1_P11 4096
#endif
DI void cvt_group(const Params& p, LAS unsigned char* lds, int group, int t_lo, int t_hi, int r, int I) {
    const int tid = threadIdx.x;
    unsigned char* ws = p.ws;
    __syncthreads();
    LAS CvtJob* J = (LAS CvtJob*)(lds + 72 * 1024);
    LAS float* tile = (LAS float*)lds;
    if (tid == 0) {
        int t0 = 0, nj = 0;
        if (group == 0) {
            set_job(J, 0, p.in[11], (bf16_t*)(ws + WS_W0IN), DM, L0IN, DM, 0, 1, 0, 0, t0);
            set_job(J, 1, p.in[13], (bf16_t*)(ws + WS_WUQ), 512, 1536, 512, 0, 1, 0, 0, t0);
            set_job(J, 2, p.in[15], (bf16_t*)(ws + WS_WUKV), 256, 2048, 256, 0, 1, 0, 0, t0);
            set_job(J, 3, p.in[23], (bf16_t*)(ws + WS_W0OUT), DM, DM, DM, 0, 1, 0, 0, t0);
            set_job(J, 4, p.in[31], (bf16_t*)(ws + WS_W1IN), DM, L1IN, DM, 1, 1, 0, 0, t0);
            set_job(J, 5, p.in[34], (bf16_t*)(ws + WS_W1OUT), DM, DM, DM, 0, 1, 0, 0, t0);
            set_job(J, 6, p.in[18], (bf16_t*)(ws + WS_GW), 128, 128, 128, 0, 16, 128 * 128, 128 * 128, t0);
            set_job(J, 7, p.in[20], (bf16_t*)(ws + WS_GW + (size_t)16 * 128 * 128 * 2), 128, 128, 128, 0, 16, 128 * 128, 128 * 128, t0);
            nj = 8;
        } else if (group == 1) {
            set_job(J, 0, p.in[24], (bf16_t*)(ws + WS_EG), DM, EFF, DM, 0, NEXP, (size_t)DM * EFF, (size_t)EFF * DM, t0);
            set_job(J, 1, p.in[25], (bf16_t*)(ws + WS_EU), DM, EFF, DM, 0, NEXP, (size_t)DM * EFF, (size_t)EFF * DM, t0);
            set_job(J, 2, p.in[26], (bf16_t*)(ws + WS_ED), EFF, DM, EFF, 0, NEXP, (size_t)DM * EFF, (size_t)EFF * DM, t0);
            nj = 3;
        } else {
            set_job(J, 0, p.in[35], (bf16_t*)(ws + WS_EG + EXPW), DM, EFF, DM, 0, NEXP, (size_t)DM * EFF, (size_t)EFF * DM, t0);
            set_job(J, 1, p.in[36], (bf16_t*)(ws + WS_EU + EXPW), DM, EFF, DM, 0, NEXP, (size_t)DM * EFF, (size_t)EFF * DM, t0);
            set_job(J, 2, p.in[37], (bf16_t*)(ws + WS_ED + EXPW), EFF, DM, EFF, 0, NEXP, (size_t)DM * EFF, (size_t)EFF * DM, t0);
            nj = 3;
        }
        J[nj].tile0 = t0; J[15].tile0 = nj;
    }
    __syncthreads();
    const int nj = J[15].tile0, total = J[nj].tile0;
    const int hi = min(t_hi, total);
    const int row = tid >> 6, c4 = (tid & 63) * 4;
    for (int gt = t_lo + r; gt < hi; gt += I) {
        CvtTile cur; cvt_decode(J, nj, gt, cur);
        if (c4 < cur.nw) {
            f32x4 v[8];
#pragma unroll
            for (int i = 0; i < 8; ++i) v[i] = *(const f32x4*)(cur.src + (size_t)(cur.k0 + row + 8 * i) * cur.N + cur.n0 + c4);
#pragma unroll
            for (int i = 0; i < 8; ++i) *(LAS f32x4*)(tile + (row + 8 * i) * 260 + c4) = v[i];
        }
        __syncthreads();
        { const int n = tid & 255, kh = tid >> 8;
          if (n < cur.nw) {
              const int orow = cur.perm ? l1_permrow(cur.n0 + n) : (cur.n0 + n);
#pragma unroll
              for (int q8 = 0; q8 < 4; ++q8) {
                  float w8[8];
#pragma unroll
                  for (int q = 0; q < 8; ++q) w8[q] = tile[(32 * kh + 8 * q8 + q) * 260 + n];
                  u32x4 w; w.x = pk_bf16(w8[0], w8[1]); w.y = pk_bf16(w8[2], w8[3]); w.z = pk_bf16(w8[4], w8[5]); w.w = pk_bf16(w8[6], w8[7]);
                  *(u32x4*)(cur.dst + (size_t)orow * cur.ldo + cur.k0 + 32 * kh + 8 * q8) = w;
              }
          } }
        __syncthreads();
    }
}
DI void bg_range(const Params& p, LAS unsigned char* lds, int group, int t_lo, int t_hi, int nunits, int G, int bid) {
    const int rem = nunits % G;
    if (rem == 0) cvt_group(p, lds, group, t_lo, t_hi, bid, G);
    else if (bid >= rem) cvt_group(p, lds, group, t_lo, t_hi, bid - rem, G - rem);
}
DI int bg_end(int t_lo, int nunits, int per_wg, int G) { const int rem = nunits % G; if (rem == 0) return t_lo; return min(t_lo + (G - rem) * per_wg, MOE_CVT_TILES); }
DI int bg_convert(const Params& p, LAS unsigned char* lds, int group, int t_lo, int nunits, int per_wg, int G, int bid) {
    const int rem = nunits % G;
    if (rem == 0) return t_lo;
    const int idle = G - rem, t_hi = min(t_lo + idle * per_wg, MOE_CVT_TILES);
    if (bid >= rem && t_hi > t_lo) cvt_group(p, lds, group, t_lo, t_hi, bid - rem, idle);
    return t_hi;
}

DI void phase_prologue(const Params& p, LAS unsigned char* lds, int G, int bid) {
    const int tid = threadIdx.x;
    unsigned char* ws = p.ws;
    {
        LAS float* s = (LAS float*)lds;
        LAS float* part = (LAS float*)(lds + 40960);
        for (int i = tid; i < 5 * DM; i += NTHREADS) { const int r = i / DM, k = i % DM; const float c = r < 4 ? p.in[1][r * DM + k] : p.in[3][k]; s[i] = c / (1.0f + __expf(-c)); }
        __syncthreads();
        float* MOD = (float*)(ws + WS_MOD);
        for (int chunk = bid; chunk < 256; chunk += G) {
            const int layer = chunk >> 7, n0 = (chunk & 127) * 96;
            const float* W = layer ? p.in[27] : p.in[7]; const float* bias = layer ? p.in[28] : p.in[8];
            const int cg = tid % 24, ks = tid / 24;
            if (ks < 16) {
                f32x4 acc[5];
#pragma unroll
                for (int r = 0; r < 5; ++r) acc[r] = (f32x4){0.f, 0.f, 0.f, 0.f};
                const float* wp = W + (size_t)(ks * 128) * MODN + n0 + 4 * cg;
                for (int k = 0; k < 128; k += 8) {
                    f32x4 w[8];
#pragma unroll
                    for (int j = 0; j < 8; ++j) w[j] = *(const f32x4*)(wp + (size_t)(k + j) * MODN);
#pragma unroll
                    for (int j = 0; j < 8; ++j)
#pragma unroll
                        for (int r = 0; r < 5; ++r) acc[r] += s[r * DM + ks * 128 + k + j] * w[j];
                }
#pragma unroll
                for (int r = 0; r < 5; ++r)
#pragma unroll
                    for (int j = 0; j < 4; ++j) part[(ks * 5 + r) * 96 + cg * 4 + j] = acc[r][j];
            }
            __syncthreads();
            if (tid < 480) {
                const int r = tid / 96, col = tid % 96; float a = bias[n0 + col];
#pragma unroll
                for (int k2 = 0; k2 < 16; ++k2) a += part[(k2 * 5 + r) * 96 + col];
                MOD[((size_t)layer * 5 + r) * MODN + n0 + col] = a;
            }
            __syncthreads();
        }
    }
    {
        f32x2* R0 = (f32x2*)(ws + WS_ROPE0); f32x2* R1 = (f32x2*)(ws + WS_ROPE1);
        for (int i = bid * NTHREADS + tid; i < 64 * 16 + 64 * 32; i += G * NTHREADS) {
            if (i < 64 * 16) { const int pos = i >> 4, k = i & 15; const float ang = (float)pos * exp2f(-(float)k * (13.287712379549449f / 16.0f)); R0[i] = (f32x2){cosf(ang), sinf(ang)}; }
            else { const int j = i - 64 * 16, pos = j >> 5, k = j & 31; const float ang = (float)pos * exp2f(-(float)k * (13.287712379549449f / 32.0f)); R1[j] = (f32x2){cosf(ang), sinf(ang)}; }
        }
        u32x4* z = (u32x4*)(ws + WS_W0IN + (size_t)L0IN * DM * 2);
        for (int i = bid * NTHREADS + tid; i < (L0INP - L0IN) * DM * 2 / 16; i += G * NTHREADS) z[i] = (u32x4){0u, 0u, 0u, 0u};
    }
    cvt_group(p, lds, 0, 0, 1 << 30, bid, G);
    cvt_group(p, lds, 1, BG_L0_P6, MOE_CVT_TILES, bid, G);
    cvt_group(p, lds, 2, BG_L1_P11, BG_L1_DOWN0, bid, G);
}

DI void norm_mod_store(const f32x4 (&v)[8], const float* gain, const float* shift, const float* scale, bf16_t* hrow, int lane) {
    float ss = 0.f;
#pragma unroll
    for (int i = 0; i < 8; ++i) ss += v[i][0] * v[i][0] + v[i][1] * v[i][1] + v[i][2] * v[i][2] + v[i][3] * v[i][3];
    ss = wave_sum(ss);
    const float r = rsqrtf(ss * (1.0f / DM) + EPS);
#pragma unroll
    for (int i = 0; i < 8; ++i) {
        const int col = 4 * lane + 256 * i;
        const f32x4 g = *(const f32x4*)(gain + col), sh = *(const f32x4*)(shift + col), sc = *(const f32x4*)(scale + col);
        const f32x4 h = (v[i] * r * g) * (1.0f + sc) + sh;
        u32x2 w; w.x = pk_bf16(h[0], h[1]); w.y = pk_bf16(h[2], h[3]);
        *(u32x2*)(hrow + col) = w;
    }
}

DI void phase_norm0(const Params& p, int G, int bid) {
    const int lane = threadIdx.x & 63, wave = threadIdx.x >> 6;
    const float* MOD = (const float*)(p.ws + WS_MOD);
    bf16_t* H = (bf16_t*)(p.ws + WS_H);
    for (int row = bid * 8 + wave; row < NTOK; row += G * 8) {
        const float* xr = row < NCTX ? p.in[2] + (size_t)row * DM : p.in[0] + (size_t)(row - NCTX) * DM;
        f32x4 v[8];
#pragma unroll
        for (int i = 0; i < 8; ++i) v[i] = *(const f32x4*)(xr + 4 * lane + 256 * i);
        const float* md = MOD + (size_t)row_mod(row) * MODN;
        norm_mod_store(v, p.in[9], md, md + DM, H + (size_t)row * DM, lane);
    }
}
DI void phase_l0_rows(const Params& p, int G, int bid) {
    const int lane = threadIdx.x & 63, wave = threadIdx.x >> 6;
    const bf16_t* Z = (const bf16_t*)(p.ws + WS_Z);
    bf16_t* CQN = (bf16_t*)(p.ws + WS_CQN); bf16_t* CKVN = (bf16_t*)(p.ws + WS_CKVN); bf16_t* KR = (bf16_t*)(p.ws + WS_KR);
    const f32x2* R0 = (const f32x2*)(p.ws + WS_ROPE0);
    for (int row = bid * 8 + wave; row < NTOK; row += G * 8) {
        const bf16_t* z = Z + (size_t)row * L0INP;
        {
            const u32x4 w = *(const u32x4*)(z + 8 * lane);
            float v[8] = {bflo(w.x), bfhi(w.x), bflo(w.y), bfhi(w.y), bflo(w.z), bfhi(w.z), bflo(w.w), bfhi(w.w)};
            float ss = 0.f;
#pragma unroll
            for (int j = 0; j < 8; ++j) ss += v[j] * v[j];
            ss = wave_sum(ss);
            const float r = rsqrtf(ss * (1.0f / 512.0f) + EPS);
            const f32x4 g0 = *(const f32x4*)(p.in[12] + 8 * lane), g1 = *(const f32x4*)(p.in[12] + 8 * lane + 4);
            u32x4 o; o.x = pk_bf16(v[0] * r * g0[0], v[1] * r * g0[1]); o.y = pk_bf16(v[2] * r * g0[2], v[3] * r * g0[3]);
            o.z = pk_bf16(v[4] * r * g1[0], v[5] * r * g1[1]); o.w = pk_bf16(v[6] * r * g1[2], v[7] * r * g1[3]);
            *(u32x4*)(CQN + (size_t)row * 512 + 8 * lane) = o;
        }
        {
            const u32x2 w = *(const u32x2*)(z + 512 + 4 * lane);
            float v[4] = {bflo(w.x), bfhi(w.x), bflo(w.y), bfhi(w.y)};
            float ss = v[0] * v[0] + v[1] * v[1] + v[2] * v[2] + v[3] * v[3];
            ss = wave_sum(ss);
            const float r = rsqrtf(ss * (1.0f / 256.0f) + EPS);
            const f32x4 g = *(const f32x4*)(p.in[14] + 4 * lane);
            u32x2 o; o.x = pk_bf16(v[0] * r * g[0], v[1] * r * g[1]); o.y = pk_bf16(v[2] * r * g[2], v[3] * r * g[3]);
            *(u32x2*)(CKVN + (size_t)row * 256 + 4 * lane) = o;
        }
        {
            const float x = bf2f(z[768 + lane]);
            const float xp = __shfl_xor(x, 16);
            float o = x;
            if (row >= NCTX) {
                const int t = (row - NCTX) & (SEQ - 1), axis = lane >> 5, part = (lane >> 4) & 1, i = lane & 15;
                const int pos = axis ? (t & 63) : (t >> 6);
                const f32x2 cs = R0[pos * 16 + i];
                o = part ? (x * cs[0] + xp * cs[1]) : (x * cs[0] - xp * cs[1]);
            }
            KR[(size_t)row * 64 + lane] = f2bf(o);
        }
    }
}

DI float gelu_tanh(float x) { const float u = 0.7978845608028654f * (x + 0.044715f * x * x * x); const float e = __expf(2.0f * u); const float th = 1.0f - 2.0f / (e + 1.0f); return 0.5f * x * (1.0f + th); }

template <int PASS>
DI void lru_units(const Params& p, LAS unsigned char* lds, int G, int bid) {
    const int tid = threadIdx.x, lane = tid & 63, wave = tid >> 6;
    const bf16_t* Z = (const bf16_t*)(p.ws + WS_Z);
    const bf16_t* GWA = (const bf16_t*)(p.ws + WS_GW); const bf16_t* GWX = GWA + 16 * 128 * 128;
    f32x2* SUMM = (f32x2*)(p.ws + WS_SUMM); const float* CARRY = (const float*)(p.ws + WS_CARRY);
    bf16_t* Y = (bf16_t*)(p.ws + WS_Y);
    unsigned* ABG = (unsigned*)(p.ws + WS_ABG);
    LAS float* U32 = (LAS float*)lds;
    LAS unsigned char* UBF = lds + 32768;
    LAS f32x2* AB = (LAS f32x2*)lds;
    const bool by_n = (G % 8) == 0;
    const int n_fix = bid & 7, nW = by_n ? G / 8 : G, q0 = by_n ? bid >> 3 : bid, nunits = by_n ? NCHUNK * NB : NCHUNK * NB * 8;
    const int d = wave >> 2, nt = wave & 3, jl = lane & 31, h = lane >> 5, ch = 32 * nt + jl;
    bf16x8 wa[8], wx[8];
    if (by_n) {
        const bf16_t* pa = GWA + ((size_t)(d * 8 + n_fix) * 128 + ch) * 128 + 8 * h;
        const bf16_t* px = GWX + ((size_t)(d * 8 + n_fix) * 128 + ch) * 128 + 8 * h;
#pragma unroll
        for (int ks = 0; ks < 8; ++ks) { wa[ks] = *(const bf16x8*)(pa + 16 * ks); wx[ks] = *(const bf16x8*)(px + 16 * ks); }
    }
    for (int v = q0; v < nunits; v += nW) {
        const int n = by_n ? n_fix : (v & 7), bc = by_n ? v : (v >> 3), b = bc & 3, ci = bc >> 2;
        const int seg_len = ci < 4 ? CTX : SEQ, t0 = ci < 4 ? 64 * ci : 64 * (ci - 4);
        const int row0 = ci < 4 ? b * CTX + t0 : NCTX + b * SEQ + t0;
        const int chg = 128 * n + ch;
        if (!by_n) {
            const bf16_t* pa = GWA + ((size_t)(d * 8 + n) * 128 + ch) * 128 + 8 * h;
            const bf16_t* px = GWX + ((size_t)(d * 8 + n) * 128 + ch) * 128 + 8 * h;
#pragma unroll
            for (int ks = 0; ks < 8; ++ks) { wa[ks] = *(const bf16x8*)(pa + 16 * ks); wx[ks] = *(const bf16x8*)(px + 16 * ks); }
        }
        u32x2 grw[4];
        {
            const int c4 = (tid & 31) * 4, tb = 4 * (tid >> 5), cg = 128 * n + c4;
            f32x4 xv[7];
#pragma unroll
            for (int q = 0; q < 7; ++q) { const int tt = t0 + tb + q - 2; u32x2 w = (u32x2){0u, 0u};
                if (tt >= 0 && tt < seg_len) w = *(const u32x2*)(Z + (size_t)(row0 + tb + q - 2) * L0INP + 832 + cg);
                xv[q] = (f32x4){bflo(w.x), bfhi(w.x), bflo(w.y), bfhi(w.y)}; }
            if (PASS == 2) {
#pragma unroll
                for (int j = 0; j < 4; ++j) grw[j] = *(const u32x2*)(Z + (size_t)(row0 + tb + j) * L0INP + 1856 + cg);
            }
            const f32x4 cb = *(const f32x4*)(p.in[17] + cg);
            f32x4 cw[4];
#pragma unroll
            for (int tap = 0; tap < 4; ++tap) cw[tap] = *(const f32x4*)(p.in[16] + tap * 1024 + cg);
#pragma unroll
            for (int j = 0; j < 4; ++j) {
                const f32x4 acc = cb + xv[j] * cw[0] + xv[j + 1] * cw[1] + xv[j + 2] * cw[2] + xv[j + 3] * cw[3];
                *(LAS f32x4*)(U32 + (tb + j) * 128 + c4) = acc;
                u32x2 o; o.x = pk_bf16(acc[0], acc[1]); o.y = pk_bf16(acc[2], acc[3]);
                *(LAS u32x2*)(UBF + (tb + j) * 272 + c4 * 2) = o;
            }
        }
        __syncthreads();
        f32x16 acc[2][2];
#pragma unroll
        for (int g = 0; g < 2; ++g)
#pragma unroll
            for (int mt = 0; mt < 2; ++mt)
#pragma unroll
                for (int i = 0; i < 16; ++i) acc[g][mt][i] = 0.f;
#pragma unroll
        for (int ks = 0; ks < 8; ++ks) {
            const bf16x8 a0 = *(const LAS bf16x8*)(UBF + jl * 272 + (16 * ks + 8 * h) * 2);
            const bf16x8 a1 = *(const LAS bf16x8*)(UBF + (32 + jl) * 272 + (16 * ks + 8 * h) * 2);
            acc[0][0] = __builtin_amdgcn_mfma_f32_32x32x16_bf16(a0, wa[ks], acc[0][0], 0, 0, 0);
            acc[0][1] = __builtin_amdgcn_mfma_f32_32x32x16_bf16(a1, wa[ks], acc[0][1], 0, 0, 0);
            acc[1][0] = __builtin_amdgcn_mfma_f32_32x32x16_bf16(a0, wx[ks], acc[1][0], 0, 0, 0);
            acc[1][1] = __builtin_amdgcn_mfma_f32_32x32x16_bf16(a1, wx[ks], acc[1][1], 0, 0, 0);
        }
        {
            const float ga_b = p.in[19][d * 1024 + chg], gx_b = p.in[21][d * 1024 + chg], lam = p.in[22][d * 1024 + chg];
            const float sp8l2 = 8.0f * LOG2E * log1pf(expf(-lam));
#pragma unroll
            for (int mt = 0; mt < 2; ++mt)
#pragma unroll
                for (int i = 0; i < 16; ++i) {
                    const int t = 32 * mt + (i & 3) + 8 * (i >> 2) + 4 * h;
                    const float r = __builtin_amdgcn_rcpf(1.0f + __builtin_amdgcn_exp2f(-LOG2E * (acc[0][mt][i] + ga_b)));
                    const float ig = __builtin_amdgcn_rcpf(1.0f + __builtin_amdgcn_exp2f(-LOG2E * (acc[1][mt][i] + gx_b)));
                    const float a = __builtin_amdgcn_exp2f(-sp8l2 * r);
                    const float bb = __builtin_amdgcn_sqrtf((1.0f - a) * (1.0f + a)) * (ig * U32[t * 128 + ch]);
                    acc[0][mt][i] = a; acc[1][mt][i] = bb;
                }
        }
        __syncthreads();
#pragma unroll
        for (int mt = 0; mt < 2; ++mt)
#pragma unroll
            for (int i = 0; i < 16; ++i) { const int t = 32 * mt + (i & 3) + 8 * (i >> 2) + 4 * h; AB[(d * 64 + t) * 128 + ch] = (f32x2){acc[0][mt][i], acc[1][mt][i]};
                if (PASS == 1) ABG[((((size_t)(b * NCHUNK + ci) * 8 + n) * 2 + d) * 64 + t) * 128 + ch] = pk_bf16(1.0f - acc[0][mt][i], acc[1][mt][i]); }
        __syncthreads();
        if (tid < 256) {
            const int sd = tid >> 7, sc = tid & 127;
            const size_t sidx = ((size_t)(sd * NB + b) * NCHUNK + ci) * 1024 + 128 * n + sc;
            if (PASS == 1) {
                float hh = 0.f, ap = 1.f;
#pragma unroll 16
                for (int s2 = 0; s2 < 64; ++s2) { const int t = sd ? 63 - s2 : s2; const f32x2 ab = AB[(sd * 64 + t) * 128 + sc]; hh = ab[0] * hh + ab[1]; ap *= ab[0]; }
                SUMM[sidx] = (f32x2){ap, hh};
            } else {
                float hh = CARRY[sidx];
#pragma unroll 16
                for (int s2 = 0; s2 < 64; ++s2) { const int t = sd ? 63 - s2 : s2; const f32x2 ab = AB[(sd * 64 + t) * 128 + sc]; hh = ab[0] * hh + ab[1]; AB[(sd * 64 + t) * 128 + sc] = (f32x2){ab[0], hh}; }
            }
        }
        __syncthreads();
        if (PASS == 2) {
            const int c4 = (tid & 31) * 4, tb = 4 * (tid >> 5);
#pragma unroll
            for (int j = 0; j < 4; ++j) {
                const int t = tb + j; const size_t row = (size_t)(row0 + t);
                const float gr[4] = {bflo(grw[j].x), bfhi(grw[j].x), bflo(grw[j].y), bfhi(grw[j].y)};
                float y[4];
#pragma unroll
                for (int k = 0; k < 4; ++k) y[k] = (AB[(t) * 128 + c4 + k][1] + AB[(64 + t) * 128 + c4 + k][1]) * gelu_tanh(gr[k]);
                u32x2 o; o.x = pk_bf16(y[0], y[1]); o.y = pk_bf16(y[2], y[3]);
                *(u32x2*)(Y + row * DM + 1024 + 128 * n + c4) = o;
            }
            __syncthreads();
        }
    }
}

DI void lru_pass2(const Params& p, LAS unsigned char* lds, int G, int bid) {
    const int tid = threadIdx.x;
    const bf16_t* Z = (const bf16_t*)(p.ws + WS_Z);
    const unsigned* ABG = (const unsigned*)(p.ws + WS_ABG); const float* CARRY = (const float*)(p.ws + WS_CARRY);
    bf16_t* Y = (bf16_t*)(p.ws + WS_Y);
    LAS float* HB = (LAS float*)lds;
    for (int u = bid; u < NCHUNK * NB * 8; u += G) {
        const int n = u & 7, bc = u >> 3, b = bc & 3, ci = bc >> 2;
        const int t0 = ci < 4 ? 64 * ci : 64 * (ci - 4);
        const int row0 = ci < 4 ? b * CTX + t0 : NCTX + b * SEQ + t0;
        const int c4 = (tid & 31) * 4, tb = 4 * (tid >> 5), cg = 128 * n + c4;
        u32x2 grw[4];
#pragma unroll
        for (int j = 0; j < 4; ++j) grw[j] = *(const u32x2*)(Z + (size_t)(row0 + tb + j) * L0INP + 1856 + cg);
        if (tid < 256) {
            const int sd = tid >> 7, sc = tid & 127;
            const unsigned* ab = ABG + ((((size_t)(b * NCHUNK + ci) * 8 + n) * 2 + sd) * 64) * 128 + sc;
            unsigned w[64];
#pragma unroll
            for (int t = 0; t < 64; ++t) w[t] = ab[t * 128];
            float hh = CARRY[((size_t)(sd * NB + b) * NCHUNK + ci) * 1024 + 128 * n + sc];
            if (sd == 0) {
#pragma unroll
                for (int t = 0; t < 64; ++t) { hh = fmaf(1.0f - bflo(w[t]), hh, bfhi(w[t])); HB[t * 128 + sc] = hh; }
            } else {
#pragma unroll
                for (int t = 63; t >= 0; --t) { hh = fmaf(1.0f - bflo(w[t]), hh, bfhi(w[t])); HB[(64 + t) * 128 + sc] = hh; }
            }
        }
        __syncthreads();
#pragma unroll
        for (int j = 0; j < 4; ++j) {
            const int t = tb + j; const size_t row = (size_t)(row0 + t);
            const float gr[4] = {bflo(grw[j].x), bfhi(grw[j].x), bflo(grw[j].y), bfhi(grw[j].y)};
            const f32x4 hf = *(const LAS f32x4*)(HB + t * 128 + c4), hb = *(const LAS f32x4*)(HB + (64 + t) * 128 + c4);
            float y[4];
#pragma unroll
            for (int k = 0; k < 4; ++k) y[k] = (hf[k] + hb[k]) * gelu_tanh(gr[k]);
            u32x2 o; o.x = pk_bf16(y[0], y[1]); o.y = pk_bf16(y[2], y[3]);
            *(u32x2*)(Y + row * DM + 1024 + 128 * n + c4) = o;
        }
        __syncthreads();
    }
}

DI void lru_carry(const Params& p, int G, int bid) {
    const f32x2* SUMM = (const f32x2*)(p.ws + WS_SUMM); float* CARRY = (float*)(p.ws + WS_CARRY);
    for (int gid = bid * NTHREADS + threadIdx.x; gid < 2 * NB * 1024; gid += G * NTHREADS) {
        const int d = gid >> 12, b = (gid >> 10) & 3, ch = gid & 1023;
        const size_t base = ((size_t)(d * NB + b) * NCHUNK) * 1024 + ch;
        float hh = 0.f;
#pragma unroll
        for (int pos = 0; pos < NCHUNK; ++pos) {
            const int ci = d == 0 ? pos : (pos < 4 ? 3 - pos : 39 - pos);
            CARRY[base + (size_t)ci * 1024] = hh;
            const f32x2 s = SUMM[base + (size_t)ci * 1024];
            hh = s[0] * hh + s[1];
        }
    }
}
#define MFMA32(a, b, c) __builtin_amdgcn_mfma_f32_32x32x16_bf16((a), (b), (c), 0, 0, 0)
constexpr int AT_KSLOT = 24576, AT_VSLOT = 16384, AT_K0 = 0, AT_V0 = 2 * AT_KSLOT, AT_XOFF = AT_V0 + 2 * AT_VSLOT;

#ifndef AT_PIPE_MLA
#define AT_PIPE_MLA false
#endif
#ifndef AT_PIPE_WIN
#define AT_PIPE_WIN false
#endif
#ifndef AT_PIPE_NA
#define AT_PIPE_NA false
#endif
#ifndef AT_SKEW_MLA
#define AT_SKEW_MLA 0
#endif
#ifndef AT_SKEW_WIN
#define AT_SKEW_WIN 0
#endif
#ifndef AT_SKEW_NA
#define AT_SKEW_NA 0
#endif
constexpr float AT_M0 = -30.0f;
struct NoBias { DI float operator()(int, float nm) const { return nm; } };

struct AtRd { int kbase, kbase1, ko[4], vbase, vo[4]; };
template <int DQ> DI int at_kf(int r) { return DQ == 128 ? (r & 15) : ((r >> 1) & 7); }
template <int DQ>
DI AtRd at_rd_init(int lane) {
    AtRd r; const int kr = lane & 31, h = lane >> 5, i16 = lane & 15, q = i16 >> 2, pp = i16 & 3, blk = (lane >> 4) & 1;
    const int f = at_kf<DQ>(kr);
    r.kbase = kr * (DQ * 2) + ((f >> 3) << 7); r.kbase1 = kr * (DQ * 2) + (((f >> 3) ^ 1) << 7);
#pragma unroll
    for (int i = 0; i < 4; ++i) r.ko[i] = ((2 * i + h) ^ (f & 7)) << 4;
    r.vbase = (4 * h + q) * 256 + 8 * pp;
#pragma unroll
    for (int t = 0; t < 4; ++t) r.vo[t] = ((2 * t + blk) ^ ((4 * h + q) & 7)) << 5;
    return r;
}
template <int DQ>
DI void at_qk(const LAS unsigned char* ks, const AtRd& rd, const bf16x8 (&qf)[DQ / 16], f32x16& s0, f32x16& s1) {
#pragma unroll
    for (int i = 0; i < 16; ++i) { s0[i] = 0.f; s1[i] = 0.f; }
    const LAS unsigned char* kp0 = ks + rd.kbase; const LAS unsigned char* kp1 = ks + rd.kbase1;
#pragma unroll
    for (int s = 0; s < DQ / 16; ++s) {
        const LAS unsigned char* kp = (DQ == 128) ? ((s >> 2) ? kp1 : kp0) : kp0 + ((s >> 2) << 7);
        const bf16x8 a0 = *(const LAS bf16x8*)(kp + rd.ko[s & 3]);
        const bf16x8 a1 = *(const LAS bf16x8*)(kp + 32 * (DQ * 2) + rd.ko[s & 3]);
        s0 = MFMA32(a0, qf[s], s0); s1 = MFMA32(a1, qf[s], s1);
    }
}
template <class BiasFn>
DI void at_sm(f32x16& s0, f32x16& s1, f32x16 (&o)[4], float& m, float& l, const float c2, const BiasFn& bias, const int lane, bf16x8 (&pf)[4]) {
    const int h = lane >> 5;
    const float nm = -m;
    float mx = -INFINITY;
#pragma unroll
    for (int i = 0; i < 16; ++i) {
        const int key = (i & 3) + 8 * (i >> 2) + 4 * h;
        s0[i] = fmaf(s0[i], c2, bias(key, nm)); s1[i] = fmaf(s1[i], c2, bias(32 + key, nm));
        mx = fmaxf(mx, fmaxf(s0[i], s1[i]));
    }
    { const auto sw = __builtin_amdgcn_permlane32_swap(__float_as_uint(mx), __float_as_uint(mx), false, false); mx = fmaxf(__uint_as_float(sw[0]), __uint_as_float(sw[1])); }
    if (__any(mx > 8.0f)) {
        const float d = fmaxf(mx, 0.f), alpha = __builtin_amdgcn_exp2f(-d);
        m += d; l *= alpha;
#pragma unroll
        for (int t = 0; t < 4; ++t)
#pragma unroll
            for (int i = 0; i < 16; ++i) o[t][i] *= alpha;
#pragma unroll
        for (int i = 0; i < 16; ++i) { s0[i] -= d; s1[i] -= d; }
    }
    float rs = 0.f;
#pragma unroll
    for (int i = 0; i < 16; ++i) { s0[i] = __builtin_amdgcn_exp2f(s0[i]); s1[i] = __builtin_amdgcn_exp2f(s1[i]); rs += s0[i] + s1[i]; }
    l += rs;
    u32x4 w;
    w.x = pk_bf16(s0[0], s0[1]); w.y = pk_bf16(s0[2], s0[3]); w.z = pk_bf16(s0[4], s0[5]); w.w = pk_bf16(s0[6], s0[7]); pf[0] = __builtin_bit_cast(bf16x8, w);
    w.x = pk_bf16(s0[8], s0[9]); w.y = pk_bf16(s0[10], s0[11]); w.z = pk_bf16(s0[12], s0[13]); w.w = pk_bf16(s0[14], s0[15]); pf[1] = __builtin_bit_cast(bf16x8, w);
    w.x = pk_bf16(s1[0], s1[1]); w.y = pk_bf16(s1[2], s1[3]); w.z = pk_bf16(s1[4], s1[5]); w.w = pk_bf16(s1[6], s1[7]); pf[2] = __builtin_bit_cast(bf16x8, w);
    w.x = pk_bf16(s1[8], s1[9]); w.y = pk_bf16(s1[10], s1[11]); w.z = pk_bf16(s1[12], s1[13]); w.w = pk_bf16(s1[14], s1[15]); pf[3] = __builtin_bit_cast(bf16x8, w);
}
DI void at_pv(const LAS unsigned char* vs, const AtRd& rd, const bf16x8 (&pf)[4], f32x16 (&o)[4]) {
    const LAS unsigned char* vb = vs + rd.vbase;
#pragma unroll
    for (int ks = 0; ks < 4; ++ks)
#pragma unroll
        for (int t = 0; t < 4; ++t) {
            const s16x4 lo = __builtin_amdgcn_ds_read_tr16_b64_v4i16((LAS s16x4*)(vb + (16 * ks) * 256 + rd.vo[t]));
            const s16x4 hi = __builtin_amdgcn_ds_read_tr16_b64_v4i16((LAS s16x4*)(vb + (16 * ks + 8) * 256 + rd.vo[t]));
            const bf16x8 vf = __builtin_shufflevector(lo, hi, 0, 1, 2, 3, 4, 5, 6, 7);
            o[t] = MFMA32(vf, pf[ks], o[t]);
        }
}
template <class BiasFn>
DI void at_sm_pv(const LAS unsigned char* vs, const AtRd& rd, f32x16& s0, f32x16& s1, f32x16 (&o)[4], float& m, float& l, const float c2, const BiasFn& bias, const int lane) {
    bf16x8 pf[4];
    at_sm(s0, s1, o, m, l, c2, bias, lane, pf);
    at_pv(vs, rd, pf, o);
}

struct AtDma { unsigned ko[3], vo[2]; unsigned rope; };
template <int DQ>
DI AtDma at_dma_init(int ld_bytes, int wave, int lane) {
    AtDma d; d.rope = 0u;
    constexpr int PPR = DQ / 8;
#pragma unroll
    for (int k = 0; k < DQ / 64; ++k) { const int L = (wave + 8 * k) * 64 + lane, r = L / PPR, pc = (L % PPR) ^ at_kf<DQ>(r);
        if (DQ == 192 && pc >= 16) { d.ko[k] = (unsigned)(r * 128 + (pc - 16) * 16); d.rope |= 1u << k; } else d.ko[k] = (unsigned)(r * ld_bytes + pc * 16); }
    if (DQ == 128) d.ko[2] = 0u;
#pragma unroll
    for (int k = 0; k < 2; ++k) { const int L = (wave + 8 * k) * 64 + lane, r = L >> 4, pc = (L & 15) ^ (2 * (r & 7)); d.vo[k] = (unsigned)(r * ld_bytes + pc * 16); }
    return d;
}
template <int DQ>
DI void at_dma_k(LAS unsigned char* kslot, const char* kb, const char* rb, const AtDma& d, int wave) {
#pragma unroll
    for (int k = 0; k < DQ / 64; ++k) {
        const char* src = (DQ == 192 && ((d.rope >> k) & 1u)) ? rb + d.ko[k] : kb + d.ko[k];
        __builtin_amdgcn_global_load_lds((const unsigned*)src, (LAS unsigned*)(kslot + (wave + 8 * k) * 1024), 16, 0, 0);
    }
}
DI void at_dma_v(LAS unsigned char* vslot, const char* vb, const AtDma& d, int wave) {
#pragma unroll
    for (int k = 0; k < 2; ++k) __builtin_amdgcn_global_load_lds((const unsigned*)(vb + d.vo[k]), (LAS unsigned*)(vslot + (wave + 8 * k) * 1024), 16, 0, 0);
}
#define AT_DRAIN_SYNC() do { asm volatile("s_waitcnt vmcnt(0)" ::: "memory"); __syncthreads(); } while (0)

template <int DQ, bool PIPE, class Drv>
DI void at_run(LAS unsigned char* lds, const Drv& D, const int n, const AtRd& rd, const AtDma& dm, const bf16x8 (&qf)[DQ / 16], f32x16 (&o)[4], float& m, float& l, const float c2, const int lane, const int wave) {
    f32x16 a0, a1;
    __syncthreads();
    at_dma_k<DQ>(lds + AT_K0, D.kb(0), D.rb(0), dm, wave); at_dma_v(lds + AT_V0, D.vb(0), dm, wave);
    if constexpr (PIPE) {
        f32x16 b0, b1;
        if (n > 1) at_dma_k<DQ>(lds + AT_K0 + AT_KSLOT, D.kb(1), D.rb(1), dm, wave);
        AT_DRAIN_SYNC();
        if (D.act(0)) at_qk<DQ>(lds + AT_K0, rd, qf, a0, a1);
#define AT_STEP(J, PAR, C0, C1, N0, N1) do { const int j_ = (J); \
        if (j_ + 2 < n) at_dma_k<DQ>(lds + AT_K0 + (PAR) * AT_KSLOT, D.kb(j_ + 2), D.rb(j_ + 2), dm, wave); \
        if (j_ + 1 < n) at_dma_v(lds + AT_V0 + (1 - (PAR)) * AT_VSLOT, D.vb(j_ + 1), dm, wave); \
        if (j_ + 1 < n && D.act(j_ + 1)) at_qk<DQ>(lds + AT_K0 + (1 - (PAR)) * AT_KSLOT, rd, qf, N0, N1); \
        if (D.act(j_)) at_sm_pv(lds + AT_V0 + (PAR) * AT_VSLOT, rd, C0, C1, o, m, l, c2, D.bias(j_), lane); \
        AT_DRAIN_SYNC(); } while (0)
        for (int j = 0; j < n; j += 2) {
            AT_STEP(j, 0, a0, a1, b0, b1);
            if (j + 1 < n) AT_STEP(j + 1, 1, b0, b1, a0, a1);
        }
#undef AT_STEP
    } else {
        AT_DRAIN_SYNC();
        for (int j = 0; j < n; ++j) {
            const int par = j & 1;
            if (j + 1 < n) { at_dma_k<DQ>(lds + AT_K0 + (1 - par) * AT_KSLOT, D.kb(j + 1), D.rb(j + 1), dm, wave); at_dma_v(lds + AT_V0 + (1 - par) * AT_VSLOT, D.vb(j + 1), dm, wave); }
            if (D.act(j)) { at_qk<DQ>(lds + AT_K0 + par * AT_KSLOT, rd, qf, a0, a1); at_sm_pv(lds + AT_V0 + par * AT_VSLOT, rd, a0, a1, o, m, l, c2, D.bias(j), lane); }
            AT_DRAIN_SYNC();
        }
    }
}

constexpr int AT3_V0 = 2 * AT_KSLOT, AT3_XOFF = AT3_V0 + 3 * AT_VSLOT;
template <int DQ, class Drv>
DI void at_run_skew(LAS unsigned char* lds, const Drv& D, const int n, const AtRd& rd, const AtDma& dm, const bf16x8 (&qf)[DQ / 16], f32x16 (&o)[4], float& m, float& l, const float c2, const int lane, const int wave) {
    const bool late = wave >= 4;
    bf16x8 pf[4];
    __syncthreads();
    at_dma_k<DQ>(lds + AT_K0, D.kb(0), D.rb(0), dm, wave); at_dma_v(lds + AT3_V0, D.vb(0), dm, wave);
    AT_DRAIN_SYNC();
    int vcur = 0;
    for (int j = 0; j < n; ++j) {
        const int vnext = vcur == 2 ? 0 : vcur + 1, vprev = vcur == 0 ? 2 : vcur - 1;
        if (j + 1 < n) { at_dma_k<DQ>(lds + AT_K0 + ((j + 1) & 1) * AT_KSLOT, D.kb(j + 1), D.rb(j + 1), dm, wave); at_dma_v(lds + AT3_V0 + vnext * AT_VSLOT, D.vb(j + 1), dm, wave); }
        if (late && j > 0 && D.act(j - 1)) at_pv(lds + AT3_V0 + vprev * AT_VSLOT, rd, pf, o);
        if (D.act(j)) {
            f32x16 a0, a1;
            at_qk<DQ>(lds + AT_K0 + (j & 1) * AT_KSLOT, rd, qf, a0, a1);
            at_sm(a0, a1, o, m, l, c2, D.bias(j), lane, pf);
            if (!late) at_pv(lds + AT3_V0 + vcur * AT_VSLOT, rd, pf, o);
        }
        AT_DRAIN_SYNC();
        vcur = vnext;
    }
    if (late && D.act(n - 1)) at_pv(lds + AT3_V0 + (vcur == 0 ? 2 : vcur - 1) * AT_VSLOT, rd, pf, o);
}

constexpr int AT4_SLOT = AT_KSLOT + AT_VSLOT, AT4_XOFF = 3 * AT4_SLOT;
template <int DQ, class Drv>
DI void at_run3(LAS unsigned char* lds, const Drv& D, const int n, const AtRd& rd, const AtDma& dm, const bf16x8 (&qf)[DQ / 16], f32x16 (&o)[4], float& m, float& l, const float c2, const int lane, const int wave) {
    __syncthreads();
    at_dma_k<DQ>(lds, D.kb(0), D.rb(0), dm, wave); at_dma_v(lds + AT_KSLOT, D.vb(0), dm, wave);
    if (n > 1) { at_dma_k<DQ>(lds + AT4_SLOT, D.kb(1), D.rb(1), dm, wave); at_dma_v(lds + AT4_SLOT + AT_KSLOT, D.vb(1), dm, wave);
        if (DQ == 192) asm volatile("s_waitcnt vmcnt(5)" ::: "memory"); else asm volatile("s_waitcnt vmcnt(4)" ::: "memory"); }
    else asm volatile("s_waitcnt vmcnt(0)" ::: "memory");
    __syncthreads();
    int cur = 0;
    for (int j = 0; j < n; ++j) {
        const int nx2 = cur == 0 ? 2 : cur - 1;
        if (j + 2 < n) { at_dma_k<DQ>(lds + nx2 * AT4_SLOT, D.kb(j + 2), D.rb(j + 2), dm, wave); at_dma_v(lds + nx2 * AT4_SLOT + AT_KSLOT, D.vb(j + 2), dm, wave); }
        if (D.act(j)) {
            f32x16 a0, a1;
            at_qk<DQ>(lds + cur * AT4_SLOT, rd, qf, a0, a1);
            at_sm_pv(lds + cur * AT4_SLOT + AT_KSLOT, rd, a0, a1, o, m, l, c2, D.bias(j), lane);
        }
        if (j + 2 < n) { if (DQ == 192) asm volatile("s_waitcnt vmcnt(5)" ::: "memory"); else asm volatile("s_waitcnt vmcnt(4)" ::: "memory"); }
        else asm volatile("s_waitcnt vmcnt(0)" ::: "memory");
        __syncthreads();
        cur = cur == 2 ? 0 : cur + 1;
    }
}

DI void attn_store(const f32x16 (&o)[4], float l, float extra, bf16_t* orow, int lane) {
    const int h = lane >> 5;
    const float lt = l + __shfl_xor(l, 32) + extra;
    const float inv = 1.0f / lt;
#pragma unroll
    for (int t = 0; t < 4; ++t)
#pragma unroll
        for (int g4 = 0; g4 < 4; ++g4) {
            u32x2 w; w.x = pk_bf16(o[t][4 * g4] * inv, o[t][4 * g4 + 1] * inv); w.y = pk_bf16(o[t][4 * g4 + 2] * inv, o[t][4 * g4 + 3] * inv);
            *(u32x2*)(orow + 32 * t + 8 * g4 + 4 * h) = w;
        }
}

struct MlaDrv {
    const char* KV; const char* KR; int b, head;
    DI int keyrow0(int j) const { return j < 4 ? b * CTX + 64 * j : NCTX + b * SEQ + 64 * (j - 4); }
    DI const char* kb(int j) const { return KV + (size_t)keyrow0(j) * 4096 + head * 512; }
    DI const char* vb(int j) const { return KV + (size_t)keyrow0(j) * 4096 + head * 512 + 256; }
    DI const char* rb(int j) const { return KR + (size_t)keyrow0(j) * 128; }
    DI bool act(int) const { return true; }
    DI NoBias bias(int) const { return NoBias(); }
};

DI void phase_attn0(const Params& p, LAS unsigned char* lds, int G, int bid) {
    const int tid = threadIdx.x, lane = tid & 63, wave = __builtin_amdgcn_readfirstlane(tid >> 6), h = lane >> 5;
    const bf16_t* Q0 = (const bf16_t*)(p.ws + WS_Q0);
    bf16_t* Y = (bf16_t*)(p.ws + WS_Y);
    const float c2 = 0.07216878364870322f * LOG2E;
    const AtRd rd = at_rd_init<192>(lane);
    const AtDma dm = at_dma_init<192>(4096, wave, lane);
    for (int u = bid; u < 256 + 32; u += G) {
        MlaDrv T; T.KV = (const char*)(p.ws + WS_KV0); T.KR = (const char*)(p.ws + WS_KR);
        int qrow, nt;
        if (u < 256) { T.b = u >> 6; T.head = (u >> 3) & 7; nt = 36; qrow = NCTX + T.b * SEQ + (u & 7) * 256 + wave * 32 + (lane & 31); }
        else { const int v = u - 256; T.b = v >> 3; T.head = v & 7; nt = 4; qrow = T.b * CTX + wave * 32 + (lane & 31); }
        bf16x8 qf[12];
#pragma unroll
        for (int s = 0; s < 12; ++s) qf[s] = *(const bf16x8*)(Q0 + (size_t)qrow * 1536 + T.head * 192 + 16 * s + 8 * h);
        f32x16 o[4];
#pragma unroll
        for (int t = 0; t < 4; ++t)
#pragma unroll
            for (int i = 0; i < 16; ++i) o[t][i] = 0.f;
        float m = AT_M0, l = 0.f;
        if (AT_SKEW_MLA == 2) at_run3<192>(lds, T, nt, rd, dm, qf, o, m, l, c2, lane, wave); else if (AT_SKEW_MLA) at_run_skew<192>(lds, T, nt, rd, dm, qf, o, m, l, c2, lane, wave); else at_run<192, AT_PIPE_MLA>(lds, T, nt, rd, dm, qf, o, m, l, c2, lane, wave);
        attn_store(o, l, 0.f, Y + (size_t)qrow * DM + T.head * 128, lane);
    }
}

struct WinBias { int base; DI float operator()(int key, float nm) const { return ((unsigned)(base - key) <= 256u) ? nm : -1e30f; } };
struct WinDrv {
    const char* Z; int b, kvh, k0base, jlo, qpos;
    DI int tid_(int q) const { return q < 4 ? q : jlo + q - 4; }
    DI int keyrow0(int q) const { const int j = tid_(q); return j < 4 ? b * CTX + 64 * j : NCTX + b * SEQ + k0base + 64 * (j - 4); }
    DI const char* kb(int q) const { return Z + (size_t)keyrow0(q) * (L1IN * 2) + (1024 + kvh * 128) * 2; }
    DI const char* vb(int q) const { return Z + (size_t)keyrow0(q) * (L1IN * 2) + (1280 + kvh * 128) * 2; }
    DI const char* rb(int) const { return nullptr; }
    DI bool act(int) const { return true; }
    DI WinBias bias(int q) const { const int j = tid_(q); WinBias B; B.base = j < 4 ? 100 : qpos - (k0base + 64 * (j - 4)) + 128; return B; }
};

DI void phase_attn_win(const Params& p, LAS unsigned char* lds, int G, int bid) {
    const int tid = threadIdx.x, lane = tid & 63, wave = __builtin_amdgcn_readfirstlane(tid >> 6), h = lane >> 5;
    const bf16_t* Z = (const bf16_t*)(p.ws + WS_Z);
    bf16_t* Y = (bf16_t*)(p.ws + WS_Y);
    const float c2 = 0.08838834764831845f * LOG2E;
    const AtRd rd = at_rd_init<128>(lane);
    const AtDma dm = at_dma_init<128>(L1IN * 2, wave, lane);
    for (int u = bid; u < 256; u += G) {
        WinDrv T; T.Z = (const char*)Z; T.b = u >> 6; T.kvh = (u >> 5) & 1; const int blk = u & 31; T.k0base = 64 * blk - 128;
        const int head = T.kvh * 4 + (wave >> 1), qpos = 64 * blk + 32 * (wave & 1) + (lane & 31), qrow = NCTX + T.b * SEQ + qpos;
        T.qpos = qpos;
        bf16x8 qf[8];
#pragma unroll
        for (int s = 0; s < 8; ++s) qf[s] = *(const bf16x8*)(Z + (size_t)qrow * L1IN + head * 128 + 16 * s + 8 * h);
        f32x16 o[4];
#pragma unroll
        for (int t = 0; t < 4; ++t)
#pragma unroll
            for (int i = 0; i < 16; ++i) o[t][i] = 0.f;
        float m = AT_M0, l = 0.f;
        T.jlo = (T.k0base < 0) ? 4 + ((-T.k0base) >> 6) : 4;
        const int jhi = (T.k0base + 320 > SEQ) ? 9 - ((T.k0base + 320 - SEQ) >> 6) : 9;
        if (AT_SKEW_WIN == 2) at_run3<128>(lds, T, 4 + (jhi - T.jlo), rd, dm, qf, o, m, l, c2, lane, wave); else if (AT_SKEW_WIN) at_run_skew<128>(lds, T, 4 + (jhi - T.jlo), rd, dm, qf, o, m, l, c2, lane, wave); else at_run<128, AT_PIPE_WIN>(lds, T, 4 + (jhi - T.jlo), rd, dm, qf, o, m, l, c2, lane, wave);
        const float sink = p.in[32][head];
        attn_store(o, l, __builtin_amdgcn_exp2f(sink * LOG2E - m), Y + (size_t)qrow * DM + head * 128, lane);
    }
}

struct NaBias { const LAS float* rp; int c0; bool all; DI float operator()(int key, float nm) const { return all ? nm : ((key >= c0 && key < c0 + 16) ? fmaf(rp[key], LOG2E, nm) : -1e30f); } };
struct NaDrv {
    const char* Z; const LAS float* RPB; int b, head, rlo, r, c, r0, c0;
    DI int keyrow0(int j) const { return j < 4 ? b * CTX + 64 * j : NCTX + b * SEQ + 64 * (rlo + j - 4); }
    DI const char* kb(int j) const { return Z + (size_t)keyrow0(j) * (L1IN * 2) + (2560 + head * 128) * 2; }
    DI const char* vb(int j) const { return Z + (size_t)keyrow0(j) * (L1IN * 2) + (3584 + head * 128) * 2; }
    DI const char* rb(int) const { return nullptr; }
    DI bool act(int j) const { const int rr = rlo + j - 4; return j < 4 || (rr >= r0 && rr <= r0 + 7); }
    DI NaBias bias(int j) const { const int rr = rlo + j - 4; NaBias B; B.rp = RPB + (j < 4 ? 0 : (rr - r + 7) * 31 + (15 - c)); B.c0 = c0; B.all = j < 4; return B; }
};

DI void phase_attn_na(const Params& p, LAS unsigned char* lds, int G, int bid) {
    const int tid = threadIdx.x, lane = tid & 63, wave = __builtin_amdgcn_readfirstlane(tid >> 6), h = lane >> 5;
    const bf16_t* Z = (const bf16_t*)(p.ws + WS_Z);
    bf16_t* Y = (bf16_t*)(p.ws + WS_Y);
    LAS float* RPB = (LAS float*)(lds + AT4_XOFF);
    const float c2 = 0.08838834764831845f * LOG2E;
    const AtRd rd = at_rd_init<128>(lane);
    const AtDma dm = at_dma_init<128>(L1IN * 2, wave, lane);
    for (int u = bid; u < 256; u += G) {
        NaDrv T; T.Z = (const char*)Z; T.RPB = RPB; T.b = u >> 6; T.head = (u >> 3) & 7; const int R = u & 7;
        T.r = 4 * R + (wave >> 1); T.c = 32 * (wave & 1) + (lane & 31); const int qrow = NCTX + T.b * SEQ + 64 * T.r + T.c;
        T.r0 = min(max(T.r - 4, 0), 24); T.c0 = min(max(T.c - 8, 0), 48);
        T.rlo = min(max(4 * R - 4, 0), 24);
        const int rhi = min(max(4 * R + 3 - 4, 0), 24) + 7;
        const int ntl = 4 + (rhi - T.rlo + 1);
        __syncthreads();
        for (int i = tid; i < 15 * 31; i += NTHREADS) RPB[i] = p.in[33][T.head * 465 + i];
        bf16x8 qf[8];
#pragma unroll
        for (int s = 0; s < 8; ++s) qf[s] = *(const bf16x8*)(Z + (size_t)qrow * L1IN + 1536 + T.head * 128 + 16 * s + 8 * h);
        f32x16 o[4];
#pragma unroll
        for (int t = 0; t < 4; ++t)
#pragma unroll
            for (int i = 0; i < 16; ++i) o[t][i] = 0.f;
        float m = AT_M0, l = 0.f;
        if (AT_SKEW_NA == 2) at_run3<128>(lds, T, ntl, rd, dm, qf, o, m, l, c2, lane, wave); else if (AT_SKEW_NA) at_run_skew<128>(lds, T, ntl, rd, dm, qf, o, m, l, c2, lane, wave); else at_run<128, AT_PIPE_NA>(lds, T, ntl, rd, dm, qf, o, m, l, c2, lane, wave);
        attn_store(o, l, 0.f, Y + (size_t)qrow * DM + 1024 + T.head * 128, lane);
    }
}
constexpr int RT_HS = 2052;
typedef float f32x4r __attribute__((ext_vector_type(4)));
DI void phase_router(const Params& p, LAS unsigned char* lds, int G, int bid, const int layer, const float* xin_ctx, const float* xin_lat, const int row_lo, const int row_hi) {
    const int tid = threadIdx.x, lane = tid & 63, wave = tid >> 6;
    const float* MOD = (const float*)(p.ws + WS_MOD) + (size_t)layer * 5 * MODN;
    const float* gain = layer ? p.in[30] : p.in[10];
    const float* rw = p.in[4]; const float* rb = p.in[5];
    bf16_t* H = (bf16_t*)(p.ws + WS_H);
    int* cnt = (int*)(p.ws + WS_CTL + CW_CNT) + layer * NEXP;
    int* LIST = (int*)(p.ws + WS_LIST); TokInfo* TOK = (TokInfo*)(p.ws + WS_TOK);
    LAS float* hs = (LAS float*)lds;
    LAS float* sc = (LAS float*)(lds + 16 * RT_HS * 4);
    const int nb = (row_hi - row_lo) / 16;
    float wb0[64], wb1[64];
    {
        const float* bp = rw + (size_t)(256 * wave + (lane >> 4)) * 32 + (lane & 15);
#pragma unroll
        for (int s2 = 0; s2 < 64; ++s2) { wb0[s2] = bp[4 * s2 * 32]; wb1[s2] = bp[4 * s2 * 32 + 16]; }
    }
    for (int bt = bid; bt < nb; bt += G) {
        __syncthreads();
#pragma unroll 1
        for (int rr = 0; rr < 2; ++rr) {
            const int lr = 2 * wave + rr, row = row_lo + bt * 16 + lr;
            const float* xr = row < NCTX ? xin_ctx + (size_t)row * DM : xin_lat + (size_t)(row - NCTX) * DM;
            const bf16_t* dr = (const bf16_t*)(p.ws + WS_D) + (size_t)row * DM;
            const float* md = MOD + (size_t)row_mod(row) * MODN;
            f32x4 v[8]; float ss = 0.f;
#pragma unroll
            for (int i = 0; i < 8; ++i) {
                const int col = 4 * lane + 256 * i;
                const u32x2 dw = *(const u32x2*)(dr + col);
                v[i] = *(const f32x4*)(xr + col) + *(const f32x4*)(md + 2 * DM + col) * (f32x4){bflo(dw.x), bfhi(dw.x), bflo(dw.y), bfhi(dw.y)};
                ss += v[i][0] * v[i][0] + v[i][1] * v[i][1] + v[i][2] * v[i][2] + v[i][3] * v[i][3];
            }
            ss = wave_sum(ss);
            const float r = rsqrtf(ss * (1.0f / DM) + EPS);
#pragma unroll
            for (int i = 0; i < 8; ++i) {
                const int col = 4 * lane + 256 * i;
                const f32x4 g = *(const f32x4*)(gain + col), sh = *(const f32x4*)(md + 3 * DM + col), scl = *(const f32x4*)(md + 4 * DM + col);
                const f32x4 hv = (v[i] * r * g) * (1.0f + scl) + sh;
                u32x2 w; w.x = pk_bf16(hv[0], hv[1]); w.y = pk_bf16(hv[2], hv[3]);
                *(u32x2*)(H + (size_t)row * DM + col) = w;
                *(LAS f32x4*)(hs + lr * RT_HS + col) = hv;
            }
        }
        __syncthreads();
        f32x4r c0 = {0.f, 0.f, 0.f, 0.f}, c1 = {0.f, 0.f, 0.f, 0.f};
        {
            const int ar = lane & 15, kq = lane >> 4;
            const LAS float* ap = hs + ar * RT_HS + 256 * wave + kq;
#pragma unroll
            for (int s2 = 0; s2 < 64; ++s2) {
                const float a = ap[4 * s2];
                c0 = __builtin_amdgcn_mfma_f32_16x16x4f32(a, wb0[s2], c0, 0, 0, 0);
                c1 = __builtin_amdgcn_mfma_f32_16x16x4f32(a, wb1[s2], c1, 0, 0, 0);
            }
        }
        __syncthreads();
        {
            LAS float* part = hs;
            const int e = lane & 15, r4 = 4 * (lane >> 4);
#pragma unroll
            for (int j = 0; j < 4; ++j) { part[(wave * 16 + r4 + j) * 32 + e] = c0[j]; part[(wave * 16 + r4 + j) * 32 + 16 + e] = c1[j]; }
        }
        __syncthreads();
        {
            const int r = tid >> 5, e = tid & 31; float a = 0.f;
#pragma unroll
            for (int w2 = 0; w2 < 8; ++w2) a += hs[(w2 * 16 + r) * 32 + e];
            sc[r * 32 + e] = 1.0f / (1.0f + expf(-a));
        }
        __syncthreads();
        if (tid < 16) {
            const LAS float* s = sc + tid * 32;
            int bg = 0; float bgs = -INFINITY;
#pragma unroll
            for (int g = 0; g < 8; ++g) {
                const float v0 = s[4 * g] + rb[4 * g], v1 = s[4 * g + 1] + rb[4 * g + 1], v2 = s[4 * g + 2] + rb[4 * g + 2], v3 = s[4 * g + 3] + rb[4 * g + 3];
                const float hi01 = fmaxf(v0, v1), lo01 = fminf(v0, v1), hi23 = fmaxf(v2, v3), lo23 = fminf(v2, v3);
                const float m1 = fmaxf(hi01, hi23), m2 = fmaxf(fminf(hi01, hi23), fmaxf(lo01, lo23));
                const float gs = m1 + m2;
                if (gs > bgs) { bgs = gs; bg = g; }
            }
            float bv[4];
#pragma unroll
            for (int j = 0; j < 4; ++j) bv[j] = s[4 * bg + j] + rb[4 * bg + j];
            int i0 = 0; float b0 = bv[0];
#pragma unroll
            for (int j = 1; j < 4; ++j) if (bv[j] > b0) { b0 = bv[j]; i0 = j; }
            int i1 = -1; float b1 = -INFINITY;
#pragma unroll
            for (int j = 0; j < 4; ++j) if (j != i0 && bv[j] > b1) { b1 = bv[j]; i1 = j; }
            const int e0 = 4 * bg + i0, e1 = 4 * bg + i1;
            const float w0 = s[e0], w1 = s[e1], ws = w0 + w1;
            const int trow = row_lo + bt * 16 + tid;
            const int p0 = atomicAdd(cnt + e0, 1), p1 = atomicAdd(cnt + e1, 1);
            LIST[(size_t)e0 * MOE_CAP + p0] = trow; LIST[(size_t)e1 * MOE_CAP + p1] = trow;
            TokInfo ti; ti.e0 = e0; ti.p0 = p0; ti.e1 = e1; ti.p1 = p1; ti.w0 = w0 / ws; ti.w1 = w1 / ws; ti.pad0 = 0; ti.pad1 = 0;
            TOK[trow] = ti;
        }
    }
}

DI void moe_tables(const Params& p, LAS int* MT, int layer) {
    __syncthreads();
    if (threadIdx.x == 0) {
        const int* cnt = (const int*)(p.ws + WS_CTL + CW_CNT) + layer * NEXP;
        int seg = 0, tp = 0;
        for (int e = 0; e < NEXP; ++e) { const int c = cnt[e]; const int t = (c + 255) >> 8; MT[e] = seg; MT[64 + e] = tp; MT[128 + e] = c; seg += t * 256; tp += t; }
        MT[32] = seg; MT[64 + 32] = tp;
    }
    __syncthreads();
}

struct MoeSchedUp {
    static constexpr bool GATHER = true;
    const char* Hb; const char* EG; const int* LIST; const LAS int* MT; int K; size_t lda, ldb, a_h, b_h; int G, c;
    DI bool next(int i, pg8::GU& u) const {
        const int L = i * G + c, T = MT[64 + 32]; if (L >= T * 4) return false;
        const int rt = L >> 2, ct = L & 3; int e = 0;
#pragma unroll 1
        for (int q = 1; q < NEXP; ++q) if (rt >= MT[64 + q]) e = q;
        const int lt = rt - MT[64 + e];
        u.e = e; u.pm = lt; u.pn = ct; u.aux = MT[e] + 256 * lt; u.a = Hb; u.b = EG + (size_t)e * (EFF * DM * 2) + (size_t)ct * 128 * ldb; return true;
    }
    DI unsigned rowoff(const pg8::GU& u, int r) const { const int gr = 256 * u.pm + r; const int tok = gr < MT[128 + u.e] ? LIST[(size_t)u.e * MOE_CAP + gr] : 0; return (unsigned)tok * (unsigned)lda; }
};
struct MoeSchedDown {
    static constexpr bool GATHER = false;
    const char* ACT; const char* ED; const LAS int* MT; int K; size_t lda, ldb, a_h, b_h; int G, c;
    DI bool next(int i, pg8::GU& u) const {
        const int L = i * G + c, T = MT[64 + 32]; if (L >= T * 8) return false;
        const int rt = L >> 3, ct = L & 7; int e = 0;
#pragma unroll 1
        for (int q = 1; q < NEXP; ++q) if (rt >= MT[64 + q]) e = q;
        const int lt = rt - MT[64 + e];
        u.e = e; u.pm = lt; u.pn = ct; u.aux = MT[e] + 256 * lt; u.a = ACT + (size_t)u.aux * lda; u.b = ED + (size_t)e * (DM * EFF * 2) + (size_t)ct * 256 * ldb; return true;
    }
    DI unsigned rowoff(const pg8::GU&, int) const { return 0u; }
};
struct EpiSwiGLU {
    static constexpr bool PERM = true;
    bf16_t* ACT;
    DI void operator()(const f32x4 (&acc)[2][2][4][2], const pg8::GU& u, int wr, int wc, int fr, int fq) const {
        const int row0 = u.aux + wr * 64 + fr, col0 = u.pn * 128 + wc * 32 + 8 * fq;
#pragma unroll
        for (int ai = 0; ai < 2; ++ai)
#pragma unroll
            for (int m = 0; m < 4; ++m) {
                float a[8];
#pragma unroll
                for (int n = 0; n < 2; ++n)
#pragma unroll
                    for (int j = 0; j < 4; ++j) { const float g = acc[ai][0][m][n][j], up = acc[ai][1][m][n][j]; a[4 * n + j] = g / (1.0f + __expf(-g)) * up; }
                u32x4 w; w.x = pk_bf16(a[0], a[1]); w.y = pk_bf16(a[2], a[3]); w.z = pk_bf16(a[4], a[5]); w.w = pk_bf16(a[6], a[7]);
                *(u32x4*)(ACT + (size_t)(row0 + ai * 128 + m * 16) * EFF + col0) = w;
            }
    }
};
struct EpiBf16Rows {
    static constexpr bool PERM = true;
    bf16_t* O; int ldc; int use_aux; int skip = 0;
    DI void operator()(const f32x4 (&acc)[2][2][4][2], const pg8::GU& u, int wr, int wc, int fr, int fq) const {
        if (skip) return;
        const int row0 = (use_aux ? u.aux : u.pm * 256) + wr * 64 + fr, col0 = u.pn * 256 + wc * 32 + 8 * fq;
#pragma unroll
        for (int ai = 0; ai < 2; ++ai)
#pragma unroll
            for (int m = 0; m < 4; ++m) {
                bf16_t* rowp = O + (size_t)(row0 + ai * 128 + m * 16) * ldc + col0;
#pragma unroll
                for (int bj = 0; bj < 2; ++bj) {
                    const f32x4 v0 = acc[ai][bj][m][0], v1 = acc[ai][bj][m][1];
                    u32x4 w; w.x = pk_bf16(v0[0], v0[1]); w.y = pk_bf16(v0[2], v0[3]); w.z = pk_bf16(v1[0], v1[1]); w.w = pk_bf16(v1[2], v1[3]);
                    *(u32x4*)(rowp + bj * 128) = w;
                }
            }
    }
};

template <bool FINAL>
DI void phase_combine(const Params& p, LAS unsigned char* lds, int G, int bid, const int layer, const float* xin_ctx, const float* xin_lat, const int row_lo, const int row_hi) {
    const int lane = threadIdx.x & 63, wave = threadIdx.x >> 6;
    LAS int* MT = (LAS int*)(lds + LDS_MISC + 64);
    moe_tables(p, MT, layer);
    const float* MOD = (const float*)(p.ws + WS_MOD);
    const bf16_t* OUT2 = (const bf16_t*)(p.ws + WS_OUT2);
    const TokInfo* TOK = (const TokInfo*)(p.ws + WS_TOK);
    float* XB = (float*)(p.ws + WS_XB); bf16_t* H = (bf16_t*)(p.ws + WS_H);
    for (int row = row_lo + bid * 8 + wave; row < row_hi; row += G * 8) {
        const TokInfo ti = TOK[row];
        const bf16_t* o0 = OUT2 + (size_t)(MT[ti.e0] + ti.p0) * DM; const bf16_t* o1 = OUT2 + (size_t)(MT[ti.e1] + ti.p1) * DM;
        const float* xr = row < NCTX ? xin_ctx + (size_t)row * DM : xin_lat + (size_t)(row - NCTX) * DM;
        const bf16_t* dr = (const bf16_t*)(p.ws + WS_D) + (size_t)row * DM;
        const int mi = row_mod(row);
        const float* g1 = MOD + ((size_t)layer * 5 + mi) * MODN + 2 * DM;
        const float* g2 = MOD + ((size_t)layer * 5 + mi) * MODN + 5 * DM;
        f32x4 v[8];
#pragma unroll
        for (int i = 0; i < 8; ++i) {
            const int col = 4 * lane + 256 * i;
            const u32x2 dw = *(const u32x2*)(dr + col);
            const f32x4 x = *(const f32x4*)(xr + col) + *(const f32x4*)(g1 + col) * (f32x4){bflo(dw.x), bfhi(dw.x), bflo(dw.y), bfhi(dw.y)}, g = *(const f32x4*)(g2 + col);
            const u32x2 a = *(const u32x2*)(o0 + col), b = *(const u32x2*)(o1 + col);
            const f32x4 fa = {bflo(a.x), bfhi(a.x), bflo(a.y), bfhi(a.y)}, fb = {bflo(b.x), bfhi(b.x), bflo(b.y), bfhi(b.y)};
            v[i] = x + g * (fa * ti.w0 + fb * ti.w1);
        }
        if (!FINAL) {
#pragma unroll
            for (int i = 0; i < 8; ++i) *(f32x4*)(XB + (size_t)row * DM + 4 * lane + 256 * i) = v[i];
            const float* md = MOD + ((size_t)5 + mi) * MODN;
            norm_mod_store(v, p.in[29], md, md + DM, H + (size_t)row * DM, lane);
        } else {
            float ss = 0.f;
#pragma unroll
            for (int i = 0; i < 8; ++i) ss += v[i][0] * v[i][0] + v[i][1] * v[i][1] + v[i][2] * v[i][2] + v[i][3] * v[i][3];
            ss = wave_sum(ss);
            const float r = rsqrtf(ss * (1.0f / DM) + EPS);
#pragma unroll
            for (int i = 0; i < 8; ++i) { const int col = 4 * lane + 256 * i; const f32x4 g = *(const f32x4*)(p.in[6] + col); *(f32x4*)(p.out + (size_t)(row - NCTX) * DM + col) = v[i] * r * g; }
        }
    }
}
struct PlainSched {
    static constexpr bool GATHER = false;
    const char* A; const char* Bt; int K; size_t lda, ldb, a_h, b_h; pg8::TileOrder T;
    DI void init(const void* A_, const void* Bt_, int M, int N, int K_, int lda_e, int ldb_e, int G, int c) {
        A = (const char*)A_; Bt = (const char*)Bt_; K = K_; lda = (size_t)lda_e * 2; ldb = (size_t)ldb_e * 2; a_h = 128 * lda; b_h = 128 * ldb; T.init(M / 256, N / 256, G, c); }
    DI bool next(int i, pg8::GU& u) const { int pm, pn; if (!T.tile(i, pm, pn)) return false; u.pm = pm; u.pn = pn; u.e = 0; u.aux = 0; u.a = A + (size_t)pm * 256 * lda; u.b = Bt + (size_t)pn * 256 * ldb; return true; }
    DI unsigned rowoff(const pg8::GU&, int) const { return 0u; }
};

template <int MODE>
struct EpiRope {
    static constexpr bool PERM = false;
    bf16_t* O; int ldc; const f32x2* R;
    DI void operator()(const f32x4 (&acc)[2][2][4][2], const pg8::GU& u, int wr, int wc, int fr, int fq) const {
        const int row0 = u.pm * 256 + wr * 64 + fr;
#pragma unroll
        for (int bj = 0; bj < 2; ++bj) {
            const int g32 = 8 * u.pn + 4 * bj + wc;
            int axis, ibase; bool rot;
            if (MODE == 0) { const int hg = g32 % 6; rot = hg >= 4; axis = hg - 4; ibase = 4 * fq; }
            else { rot = u.pn < 5; axis = (g32 & 3) >> 1; ibase = 16 * (g32 & 1) + 4 * fq; }
            const int col0 = 32 * g32 + 4 * fq;
#pragma unroll
            for (int ai = 0; ai < 2; ++ai)
#pragma unroll
                for (int m = 0; m < 4; ++m) {
                    const int row = row0 + ai * 128 + m * 16;
                    f32x4 x1 = acc[ai][bj][m][0], x2 = acc[ai][bj][m][1];
                    if (rot && row >= NCTX) {
                        const int t = (row - NCTX) & (SEQ - 1), pos = axis ? (t & 63) : (t >> 6);
                        const f32x2* cs = R + pos * (MODE == 0 ? 16 : 32) + ibase;
                        f32x4 o1, o2;
#pragma unroll
                        for (int j = 0; j < 4; ++j) { const f32x2 c = cs[j]; o1[j] = x1[j] * c[0] - x2[j] * c[1]; o2[j] = x2[j] * c[0] + x1[j] * c[1]; }
                        x1 = o1; x2 = o2;
                    }
                    bf16_t* rowp = O + (size_t)row * ldc + col0;
                    u32x2 w1, w2; w1.x = pk_bf16(x1[0], x1[1]); w1.y = pk_bf16(x1[2], x1[3]); w2.x = pk_bf16(x2[0], x2[1]); w2.y = pk_bf16(x2[2], x2[3]);
                    *(u32x2*)(rowp) = w1; *(u32x2*)(rowp + 16) = w2;
                }
        }
    }
};

struct EpiResid {
    static constexpr bool PERM = true;
    const float* xin_ctx; const float* xin_lat; float* XO; const float* MODL; int rowbase;
    DI void operator()(const f32x4 (&acc)[2][2][4][2], const pg8::GU& u, int wr, int wc, int fr, int fq) const {
        const int row0 = rowbase + u.pm * 256 + wr * 64 + fr, col0 = u.pn * 256 + wc * 32 + 8 * fq;
        const float* g1 = MODL + (size_t)row_mod(rowbase + u.pm * 256) * MODN + 2 * DM;
        f32x4 gv[2][2];
#pragma unroll
        for (int bj = 0; bj < 2; ++bj)
#pragma unroll
            for (int n = 0; n < 2; ++n) gv[bj][n] = *(const f32x4*)(g1 + col0 + bj * 128 + n * 4);
#pragma unroll
        for (int ai = 0; ai < 2; ++ai)
#pragma unroll
            for (int m = 0; m < 4; ++m) {
                const int row = row0 + ai * 128 + m * 16;
                const float* xr = (row < NCTX ? xin_ctx + (size_t)row * DM : xin_lat + (size_t)(row - NCTX) * DM) + col0;
                float* xo = XO + (size_t)row * DM + col0;
#pragma unroll
                for (int bj = 0; bj < 2; ++bj)
#pragma unroll
                    for (int n = 0; n < 2; ++n) *(f32x4*)(xo + bj * 128 + n * 4) = *(const f32x4*)(xr + bj * 128 + n * 4) + gv[bj][n] * acc[ai][bj][m][n];
            }
    }
};

constexpr int NPHASE = 18;
constexpr int BG_U2 = (NTOK / 256) * (L0INP / 256), BG_U6 = (NTOK / 256) * (DM / 256), BG_U11 = (NTOK / 256) * (L1IN / 256);
#ifndef BG_Q2
#define BG_Q2 12
#endif
#ifndef BG_Q6
#define BG_Q6 10
#endif
#ifndef BG_Q8
#define BG_Q8 12
#endif
#ifndef BG_Q11
#define BG_Q11 12
#endif
__global__ void __launch_bounds__(NTHREADS, 2) fwd_kernel(Params p) {
    extern __shared__ __attribute__((aligned(16))) unsigned char lds_raw[];
    LAS unsigned char* lds = (LAS unsigned char*)lds_raw;
    const int tid = threadIdx.x, G = gridDim.x, bid = blockIdx.x;
    unsigned char* ws = p.ws;
    if (tid < 64) ((LAS unsigned*)(lds + LDS_MISC))[tid] = 0u;
    __syncthreads();
    const int lo = p.ph_lo, hi = p.ph_hi;
    const bool use_bar = (hi - lo) > 1;
    XcdBarrier bar; bar.bar = (unsigned*)(ws + WS_CTL + CW_BAR); bar.x = 0; bar.st = (volatile LAS unsigned*)(lds + LDS_MISC);
    if (use_bar) bar = xcd_barrier_post((unsigned*)(ws + WS_CTL + CW_BAR), (volatile LAS unsigned*)(lds + LDS_MISC));
#ifndef PH_MASK
#define PH_MASK 0x3ffff
#endif
#define IN(k) (((PH_MASK >> (k)) & 1) && lo <= (k) && (k) < hi)
#ifndef REPEAT_MASK
#define REPEAT_MASK 0
#endif
#define REP(k) 0
#define SEAM(k) do { if (rep_ == REP(k) && IN((k) + 1)) xcd_barrier(bar); } while (0)
    const float* MOD = (const float*)(ws + WS_MOD);
    LAS int* MT = (LAS int*)(lds + LDS_MISC + 64);
    const int vc = (G % 8 == 0) ? (bid % 8) * (G / 8) + bid / 8 : bid;
    (void)vc;

    if (IN(0)) for (int rep_ = 0; rep_ <= REP(0); ++rep_) { if (rep_) __syncthreads(); phase_prologue(p, lds, G, bid); SEAM(0); }
    if (IN(1)) for (int rep_ = 0; rep_ <= REP(1); ++rep_) { if (rep_) __syncthreads(); phase_norm0(p, G, bid); SEAM(1); }
    if (IN(2)) for (int rep_ = 0; rep_ <= REP(2); ++rep_) { if (rep_) __syncthreads();
        PlainSched S; S.init(ws + WS_H, ws + WS_W0IN, NTOK, L0INP, DM, DM, DM, G, bid);
        EpiBf16Rows E{(bf16_t*)(ws + WS_Z), L0INP, 0, p.flags & 1};
        pg8::gemm_phase(lds, S, E);
        bg_range(p, lds, 1, 0, BG_L0_P2, BG_U2, G, bid);
        SEAM(2);
    }
    if (IN(3)) for (int rep_ = 0; rep_ <= REP(3); ++rep_) { if (rep_) __syncthreads(); phase_l0_rows(p, G, bid); __syncthreads(); lru_units<1>(p, lds, G, bid); SEAM(3); }
    if (IN(4)) for (int rep_ = 0; rep_ <= REP(4); ++rep_) { if (rep_) __syncthreads();
        { PlainSched S; S.init(ws + WS_CQN, ws + WS_WUQ, NTOK, 1536, 512, 512, 512, G, bid);
          EpiRope<0> E{(bf16_t*)(ws + WS_Q0), 1536, (const f32x2*)(ws + WS_ROPE0)};
          pg8::gemm_phase(lds, S, E); }
        { PlainSched S; S.init(ws + WS_CKVN, ws + WS_WUKV, NTOK, 2048, 256, 256, 256, G, bid);
          EpiBf16Rows E{(bf16_t*)(ws + WS_KV0), 2048, 0};
          pg8::gemm_phase(lds, S, E); }
        lru_carry(p, G, bid);
        SEAM(4);
    }
    if (IN(5)) for (int rep_ = 0; rep_ <= REP(5); ++rep_) { if (rep_) __syncthreads(); if (!(p.flags & 2)) phase_attn0(p, lds, G, bid); __syncthreads(); if (!(p.flags & 4)) lru_pass2(p, lds, G, bid); SEAM(5); }
    if (IN(6)) for (int rep_ = 0; rep_ <= REP(6); ++rep_) { if (rep_) __syncthreads();
        PlainSched S; S.init(ws + WS_Y, ws + WS_W0OUT, NTOK, DM, DM, DM, DM, G, bid);
        EpiBf16Rows E{(bf16_t*)(ws + WS_D), DM, 0};
        pg8::gemm_phase(lds, S, E);
        bg_range(p, lds, 1, BG_L0_P2, BG_L0_P6, BG_U6, G, bid);
        SEAM(6);
    }
    if (IN(7)) for (int rep_ = 0; rep_ <= REP(7); ++rep_) { if (rep_) __syncthreads(); phase_router(p, lds, G, bid, 0, p.in[2], p.in[0], 0, NTOK); SEAM(7); }
    if (IN(8)) for (int rep_ = 0; rep_ <= REP(8); ++rep_) { if (rep_) __syncthreads();
        moe_tables(p, MT, 0);
        MoeSchedUp S; S.Hb = (const char*)(ws + WS_H); S.EG = (const char*)(ws + WS_EG); S.LIST = (const int*)(ws + WS_LIST); S.MT = MT; S.K = DM;
        S.lda = DM * 2; S.ldb = DM * 2; S.a_h = 0; S.b_h = WS_EU - WS_EG; S.G = G; S.c = bid;
        EpiSwiGLU E{(bf16_t*)(ws + WS_ACT)};
        pg8::gemm_phase(lds, S, E);
        bg_range(p, lds, 2, 0, BG_L1_P8, 4 * MT[64 + 32], G, bid);
        SEAM(8);
    }
    if (IN(9)) for (int rep_ = 0; rep_ <= REP(9); ++rep_) { if (rep_) __syncthreads();
        moe_tables(p, MT, 0);
        MoeSchedDown S; S.ACT = (const char*)(ws + WS_ACT); S.ED = (const char*)(ws + WS_ED); S.MT = MT; S.K = EFF;
        S.lda = EFF * 2; S.ldb = EFF * 2; S.a_h = 128 * EFF * 2; S.b_h = 128 * EFF * 2; S.G = G; S.c = bid;
        EpiBf16Rows E{(bf16_t*)(ws + WS_OUT2), DM, 1};
        pg8::gemm_phase(lds, S, E); SEAM(9);
    }
    if (IN(10)) for (int rep_ = 0; rep_ <= REP(10); ++rep_) { if (rep_) __syncthreads(); phase_combine<false>(p, lds, G, bid, 0, p.in[2], p.in[0], 0, NTOK); SEAM(10); }
    if (IN(11)) for (int rep_ = 0; rep_ <= REP(11); ++rep_) { if (rep_) __syncthreads();
        PlainSched S; S.init(ws + WS_H, ws + WS_W1IN, NTOK, L1IN, DM, DM, DM, G, bid);
        EpiRope<1> E{(bf16_t*)(ws + WS_Z), L1IN, (const f32x2*)(ws + WS_ROPE1)};
        pg8::gemm_phase(lds, S, E);
        bg_range(p, lds, 2, BG_L1_P8, BG_L1_P11, BG_U11, G, bid);
        SEAM(11);
    }
    if (IN(12)) for (int rep_ = 0; rep_ <= REP(12); ++rep_) { if (rep_) __syncthreads(); if (!(p.flags & 2)) phase_attn_win(p, lds, G, bid); __syncthreads(); if (!(p.flags & 4)) phase_attn_na(p, lds, G, bid); SEAM(12); }
    if (IN(13)) for (int rep_ = 0; rep_ <= REP(13); ++rep_) { if (rep_) __syncthreads();
        PlainSched S; S.init(ws + WS_Y + (size_t)NCTX * DM * 2, ws + WS_W1OUT, NLAT, DM, DM, DM, DM, G, bid);
        EpiBf16Rows E{(bf16_t*)(ws + WS_D) + (size_t)NCTX * DM, DM, 0};
        pg8::gemm_phase(lds, S, E); SEAM(13);
    }
    if (IN(14)) for (int rep_ = 0; rep_ <= REP(14); ++rep_) { if (rep_) __syncthreads(); phase_router(p, lds, G, bid, 1, (const float*)(ws + WS_XB), (const float*)(ws + WS_XB) + (size_t)NCTX * DM, NCTX, NTOK); SEAM(14); }
    if (IN(15)) for (int rep_ = 0; rep_ <= REP(15); ++rep_) { if (rep_) __syncthreads();
        moe_tables(p, MT, 1);
        MoeSchedUp S; S.Hb = (const char*)(ws + WS_H); S.EG = (const char*)(ws + WS_EG + EXPW); S.LIST = (const int*)(ws + WS_LIST); S.MT = MT; S.K = DM;
        S.lda = DM * 2; S.ldb = DM * 2; S.a_h = 0; S.b_h = WS_EU - WS_EG; S.G = G; S.c = bid;
        EpiSwiGLU E{(bf16_t*)(ws + WS_ACT)};
        pg8::gemm_phase(lds, S, E);
        bg_range(p, lds, 2, BG_L1_DOWN0, MOE_CVT_TILES, 4 * MT[64 + 32], G, bid);
        SEAM(15);
    }
    if (IN(16)) for (int rep_ = 0; rep_ <= REP(16); ++rep_) { if (rep_) __syncthreads();
        moe_tables(p, MT, 1);
        MoeSchedDown S; S.ACT = (const char*)(ws + WS_ACT); S.ED = (const char*)(ws + WS_ED + EXPW); S.MT = MT; S.K = EFF;
        S.lda = EFF * 2; S.ldb = EFF * 2; S.a_h = 128 * EFF * 2; S.b_h = 128 * EFF * 2; S.G = G; S.c = bid;
        EpiBf16Rows E{(bf16_t*)(ws + WS_OUT2), DM, 1};
        pg8::gemm_phase(lds, S, E); SEAM(16);
    }
    if (IN(17)) for (int rep_ = 0; rep_ <= REP(17); ++rep_) { if (rep_) __syncthreads(); phase_combine<true>(p, lds, G, bid, 1, (const float*)(ws + WS_XB), (const float*)(ws + WS_XB) + (size_t)NCTX * DM, NCTX, NTOK); }
#undef IN
#undef SEAM
}

#ifndef REPEAT_FLAGS
#define REPEAT_FLAGS 0
#endif
#ifndef N_LAUNCH_MODE
#define N_LAUNCH_MODE 0
#endif
extern "C" void kernel_launch(void* const* d_in, const int* in_sizes, int n_in, void* d_out, int out_size, void* d_ws, size_t ws_size, hipStream_t stream) {
    static int grid = 0;
    if (grid == 0) {
        if (n_in != 38 || out_size != NLAT * DM || ws_size < WS_END) { fprintf(stderr, "kernel_launch: unexpected problem shape (n_in %d out %d ws %zu need %zu)\n", n_in, out_size, ws_size, (size_t)WS_END); grid = -1; return; }
        int dev = 0, cus = 0, per_cu = 0;
        if (hipGetDevice(&dev) != hipSuccess || hipDeviceGetAttribute(&cus, hipDeviceAttributeMultiprocessorCount, dev) != hipSuccess) { grid = -1; return; }
        if (hipFuncSetAttribute((const void*)fwd_kernel, hipFuncAttributeMaxDynamicSharedMemorySize, LDS_BYTES) != hipSuccess) { fprintf(stderr, "kernel_launch: hipFuncSetAttribute failed\n"); grid = -1; return; }
        if (hipOccupancyMaxActiveBlocksPerMultiprocessor(&per_cu, (const void*)fwd_kernel, NTHREADS, LDS_BYTES) != hipSuccess || per_cu < 1) { fprintf(stderr, "kernel_launch: occupancy query reports %d\n", per_cu); (void)hipGetLastError(); }
        grid = cus;
    }
    if (grid < 0) return;
    (void)hipMemsetAsync((char*)d_ws + WS_CTL, 0, CTL_BYTES, stream);
    Params prm{};
    for (int i = 0; i < 38; ++i) prm.in[i] = (const float*)d_in[i];
    prm.out = (float*)d_out; prm.ws = (unsigned char*)d_ws; prm.flags = 0; prm.pad = 0;
#if N_LAUNCH_MODE == 0
    prm.ph_lo = 0; prm.ph_hi = NPHASE;
    hipLaunchKernelGGL(fwd_kernel, dim3(grid), dim3(NTHREADS), LDS_BYTES, stream, prm);
#else
    for (int k = 0; k < NPHASE; ++k) { prm.ph_lo = k; prm.ph_hi = k + 1; const int reps = 1 + ((REPEAT_MASK >> k) & 1);
        for (int r = 0; r < reps; ++r) { prm.flags = r ? (REPEAT_FLAGS) : 0; if (r && (k == 7 || k == 14)) (void)hipMemsetAsync((char*)d_ws + WS_CTL + CW_CNT + (k == 14 ? NEXP * 4 : 0), 0, NEXP * 4, stream);
            hipLaunchKernelGGL(fwd_kernel, dim3(grid), dim3(NTHREADS), LDS_BYTES, stream, prm); } }
#endif
}
```

```cpp
#define N_LAUNCH_MODE 0
#include <hip/hip_runtime.h>
#include <stdint.h>
#include <stdio.h>

#define LAS __attribute__((address_space(3)))
#define DI __device__ __forceinline__
typedef unsigned short bf16_t;
typedef short bf16x8 __attribute__((ext_vector_type(8)));
typedef short s16x4 __attribute__((ext_vector_type(4)));
typedef float f32x2 __attribute__((ext_vector_type(2)));
typedef float f32x4 __attribute__((ext_vector_type(4)));
typedef float f32x16 __attribute__((ext_vector_type(16)));
typedef unsigned u32x2 __attribute__((ext_vector_type(2)));
typedef unsigned u32x4 __attribute__((ext_vector_type(4)));
typedef __bf16 hbf16x2 __attribute__((ext_vector_type(2)));

constexpr int DM = 2048, NB = 4, SEQ = 2048, CTX = 256, GRIDW = 64;
constexpr int NCTX = NB * CTX;
constexpr int NLAT = NB * SEQ;
constexpr int NTOK = NCTX + NLAT;
constexpr float EPS = 1e-6f;
constexpr int NEXP = 32, EFF = 512;
constexpr int L0IN = 2880, L0INP = 3072, L1IN = 4608;
constexpr int MODN = 6 * DM;
constexpr int NTHREADS = 512;
constexpr float LOG2E = 1.4426950408889634f;

DI unsigned pk_bf16(float lo, float hi) { f32x2 v = {lo, hi}; hbf16x2 r = __builtin_convertvector(v, hbf16x2); return __builtin_bit_cast(unsigned, r); }
DI float bflo(unsigned w) { return __uint_as_float(w << 16); }
DI float bfhi(unsigned w) { return __uint_as_float(w & 0xffff0000u); }
DI float bf2f(bf16_t b) { return __uint_as_float(((unsigned)b) << 16); }
DI bf16_t f2bf(float f) { return (bf16_t)(pk_bf16(f, 0.f) & 0xffffu); }
DI float wave_sum(float v) {
#pragma unroll
    for (int o = 32; o > 0; o >>= 1) v += __shfl_xor(v, o);
    return v;
}
DI float sigmoidf_(float x) { return 1.0f / (1.0f + __expf(-x)); }
DI int row_mod(int row) { return row < NCTX ? 4 : ((row - NCTX) >> 11); }
#define XB_TMO      128
#define XB_XCNT(j)  (256  + 64 * (j))
#define XB_XSUB(j)  (1280 + 64 * (j))
#define XB_XGEN(j)  (2304 + 64 * (j))
#define XB_TOP      3328
#define XB_TOPGEN   3392
#define XCD_BAR_WORDS 3456
#define XB_SPIN_CAP (1u << 18)

__device__ __forceinline__ unsigned xb_ld(unsigned* p)              { return __hip_atomic_load(p, __ATOMIC_RELAXED, __HIP_MEMORY_SCOPE_AGENT); }
__device__ __forceinline__ unsigned xb_add(unsigned* p, unsigned v) { return __hip_atomic_fetch_add(p, v, __ATOMIC_RELAXED, __HIP_MEMORY_SCOPE_AGENT); }
__device__ __forceinline__ unsigned xb_xcc_id() { return (unsigned)__builtin_amdgcn_s_getreg((3 << 11) | 20) & 0xFu; }
#define XB_SPIN(cond, bar) do { unsigned _sp = 0; while (cond) { __builtin_amdgcn_s_sleep(1); \
    if ((++_sp & 255u) == 0u) { if (xb_ld(&(bar)[XB_TMO])) break; if (_sp > XB_SPIN_CAP) { atomicAdd(&(bar)[XB_TMO], 1u); break; } } } } while (0)

struct XcdBarrier {
    unsigned* bar; unsigned x;
    volatile LAS unsigned* st;
};

__device__ __forceinline__ XcdBarrier xcd_barrier_post(unsigned* bar, volatile LAS unsigned* st) {
    XcdBarrier b; b.bar = bar; b.x = xb_xcc_id(); b.st = st;
    if (threadIdx.x == 0) (void)xb_add(&bar[XB_XCNT(b.x)], 1u);
    return b;
}
__device__ __forceinline__ void xcd_barrier_complete(unsigned* bar, unsigned x, unsigned& nloc, unsigned& nx) {
    const unsigned G = gridDim.x * gridDim.y * gridDim.z;
    unsigned sum, cnt, mine, sp = 0u;
    for (;;) {
        sum = 0u; cnt = 0u; mine = 0u;
#pragma unroll
        for (unsigned j = 0; j < 16; ++j) { const unsigned c = xb_ld(&bar[XB_XCNT(j)]); sum += c; cnt += (c > 0u) ? 1u : 0u; mine = (j == x) ? c : mine; }
        if (sum == G) break;
        __builtin_amdgcn_s_sleep(1);
        if ((++sp & 255u) == 0u) { if (xb_ld(&bar[XB_TMO])) break; if (sp > XB_SPIN_CAP) { atomicAdd(&bar[XB_TMO], 1u); break; } }
    }
    nloc = mine > 0u ? mine : 1u; nx = cnt > 0u ? cnt : 1u;
}

__device__ __forceinline__ void xcd_barrier(const XcdBarrier& b) {
    asm volatile("s_waitcnt vmcnt(0)" ::: "memory");
    __syncthreads();
    if (threadIdx.x == 0) {
        unsigned* bar = b.bar;
        __builtin_amdgcn_s_waitcnt(0);
        unsigned nloc = b.st[0], nx = b.st[1];
        if (nloc == 0u) { xcd_barrier_complete(bar, b.x, nloc, nx); b.st[0] = nloc; b.st[1] = nx; }
        const unsigned old = xb_add(&bar[XB_XSUB(b.x)], 1u);
        const unsigned gen = old / nloc;
        if (old + 1u == (gen + 1u) * nloc) {
            __builtin_amdgcn_fence(__ATOMIC_RELEASE, "agent");
            asm volatile("s_waitcnt vmcnt(0)" ::: "memory");
            const unsigned og = xb_add(&bar[XB_TOP], 1u);
            const unsigned tg = og / nx;
            if (og + 1u == (tg + 1u) * nx) xb_add(&bar[XB_TOPGEN], 1u);
            else XB_SPIN(xb_ld(&bar[XB_TOPGEN]) == tg, bar);
            __builtin_amdgcn_fence(__ATOMIC_ACQUIRE, "agent");
            xb_add(&bar[XB_XGEN(b.x)], 1u);
            asm volatile("s_waitcnt vmcnt(0)" ::: "memory");
        } else {
            XB_SPIN(xb_ld(&bar[XB_XGEN(b.x)]) == gen, bar);
            __builtin_amdgcn_fence(__ATOMIC_ACQUIRE, "agent");
            asm volatile("s_waitcnt vmcnt(0)" ::: "memory");
        }
    }
    __syncthreads();
}

#ifndef PG8_SP2
#define PG8_SP2 true
#endif
#ifndef PG8_ALIGN_EPI
#define PG8_ALIGN_EPI true
#endif
namespace pg8 {
constexpr int BM = 256, BK = 64, HALF = 128, HTB = HALF * BK * 2, STAGE_BYTES = 8 * HTB, NXCD = 8, WGM = 8;
DI int lds_byte(int r, int c) { const int st = (r >> 4) * 2 + (c >> 5), rr = r & 15, cc = c & 31, ob = rr * 64 + cc * 2; return st * 1024 + (ob ^ (((ob >> 9) & 1) << 5)); }
DI void stage_rc(int b, int& R, int& C) { const int st = b / 1024, sb = b % 1024, swz = sb ^ (((sb >> 9) & 1) << 5); R = (st >> 1) * 16 + swz / 64; C = (st & 1) * 32 + (swz % 64) / 2; }
DI int perm32(int rho) { const int n = rho >> 4, i = rho & 15; return 8 * (i >> 2) + 4 * n + (i & 3); }

struct GU { const char* a; const char* b; int pm, pn, e, aux; };

template <class Epi, class Sched>
DI void gemm_phase(LAS unsigned char* lds, const Sched& S, const Epi& E) {
    const int tid = threadIdx.x, wid = __builtin_amdgcn_readfirstlane(tid >> 6), lane = tid & 63, wr = wid >> 2, wc = wid & 3, fr = lane & 15, fq = lane >> 4;
    const int K = S.K, nt = K / BK;
    int RR[2], CC[2];
    unsigned voffA[2], voffB[2];
#pragma unroll
    for (int i = 0; i < 2; ++i) { int R, C; stage_rc(tid * 16 + i * 8192, R, C); RR[i] = R; CC[i] = C; const int Rb = Epi::PERM ? ((R & ~31) + perm32(R & 31)) : R;
        voffA[i] = (unsigned)(R * (int)S.lda + C * 2); voffB[i] = (unsigned)(Rb * (int)S.ldb + C * 2); }
    const size_t kstep = (size_t)(BK * 2);
    const size_t ahs = S.a_h, bhs = S.b_h;
    const unsigned ldsw = (unsigned)wid * 1024u;
    const int aoff = lds_byte(wr * 64 + fr, fq * 8), boff = lds_byte(wc * 32 + fr, fq * 8);
#define PG8_SA(b, h) (((b) * 2 + (h)) * HTB)
#define PG8_SB(b, h) ((4 + (b) * 2 + (h)) * HTB)
#define PG8_STAGE(bufoff, gbase, voff) do { _Pragma("unroll") for (int _i = 0; _i < 2; ++_i) \
        __builtin_amdgcn_global_load_lds((const unsigned*)((const char*)(gbase) + (voff)[_i]), (LAS unsigned*)(lds + (bufoff) + ldsw + _i * 8192), 16, 0, 0); } while (0)
#define PG8_STAGE_A(bufoff, gbase, h, VG) do { if constexpr (Sched::GATHER) { PG8_STAGE(bufoff, gbase, VG[h]); } else { PG8_STAGE(bufoff, (gbase) + (h) * ahs, voffA); } } while (0)
#define PG8_STAGE_B(bufoff, gbase, h) PG8_STAGE(bufoff, (gbase) + (h) * bhs, voffB)
#define PG8_LDA(dst, b, h) do { _Pragma("unroll") for (int m = 0; m < 4; ++m) _Pragma("unroll") for (int k = 0; k < 2; ++k) dst[m][k] = *(const LAS bf16x8*)(lds + PG8_SA(b, h) + aoff + m * 2048 + k * 1024); } while (0)
#define PG8_LDB(dst, b, h) do { _Pragma("unroll") for (int n = 0; n < 2; ++n) _Pragma("unroll") for (int k = 0; k < 2; ++k) dst[n][k] = *(const LAS bf16x8*)(lds + PG8_SB(b, h) + boff + n * 2048 + k * 1024); } while (0)
#define PG8_MMA(ai, bj, At, Bt) do { __builtin_amdgcn_s_setprio(1); _Pragma("unroll") for (int m = 0; m < 4; ++m) _Pragma("unroll") for (int n = 0; n < 2; ++n) _Pragma("unroll") for (int k = 0; k < 2; ++k) \
        acc[ai][bj][m][n] = __builtin_amdgcn_mfma_f32_16x16x32_bf16(Bt[n][k], At[m][k], acc[ai][bj][m][n], 0, 0, 0); __builtin_amdgcn_s_setprio(0); } while (0)
#define PG8_WAIT_V(n) asm volatile("s_waitcnt vmcnt(" #n ")" ::: "memory")
#define PG8_WAIT_L(n) asm volatile("s_waitcnt lgkmcnt(" #n ")" ::: "memory")
#define PG8_BAR __builtin_amdgcn_s_barrier()
#define PG8_SCHED __builtin_amdgcn_sched_barrier(0)
    GU cur, nxt; int ui = 0;
    if (!S.next(0, cur)) return;
    f32x4 acc[2][2][4][2];
#pragma unroll
    for (int a = 0; a < 2; ++a)
#pragma unroll
        for (int b = 0; b < 2; ++b)
#pragma unroll
            for (int m = 0; m < 4; ++m)
#pragma unroll
                for (int n = 0; n < 2; ++n) acc[a][b][m][n] = (f32x4){0.f, 0.f, 0.f, 0.f};
    bf16x8 At[4][2], B0[2][2], B1[2][2];
    unsigned vc[2][2], vn[2][2];
    if constexpr (Sched::GATHER) {
#pragma unroll
        for (int h = 0; h < 2; ++h)
#pragma unroll
            for (int i = 0; i < 2; ++i) { vc[h][i] = S.rowoff(cur, RR[i] + 128 * h) + (unsigned)(CC[i] * 2); vn[h][i] = vc[h][i]; }
    } else {
#pragma unroll
        for (int h = 0; h < 2; ++h)
#pragma unroll
            for (int i = 0; i < 2; ++i) { vc[h][i] = 0u; vn[h][i] = 0u; }
    }
    const char* cA = cur.a; const char* cB = cur.b;
    if constexpr (PG8_SP2) {
        PG8_STAGE_B(PG8_SB(0, 0), cB, 0); PG8_STAGE_B(PG8_SB(0, 1), cB, 1); PG8_STAGE_A(PG8_SA(0, 0), cA, 0, vc); PG8_STAGE_A(PG8_SA(0, 1), cA, 1, vc);
        if (wr == 1) PG8_BAR;
        PG8_WAIT_V(2); PG8_BAR;
        PG8_STAGE_B(PG8_SB(1, 0), cB + kstep, 0); PG8_STAGE_A(PG8_SA(1, 0), cA + kstep, 0, vc); PG8_STAGE_B(PG8_SB(1, 1), cB + kstep, 1);
        PG8_WAIT_V(6); PG8_BAR;
    } else {
        PG8_STAGE_B(PG8_SB(0, 0), cB, 0); PG8_STAGE_A(PG8_SA(0, 0), cA, 0, vc); PG8_STAGE_B(PG8_SB(0, 1), cB, 1); PG8_STAGE_A(PG8_SA(0, 1), cA, 1, vc);
        if (wr == 1) PG8_BAR;
        PG8_WAIT_V(4); PG8_BAR;
        PG8_STAGE_B(PG8_SB(1, 0), cB + kstep, 0); PG8_STAGE_A(PG8_SA(1, 0), cA + kstep, 0, vc); PG8_STAGE_B(PG8_SB(1, 1), cB + kstep, 1);
        PG8_WAIT_V(6); PG8_BAR;
    }
    for (;;) {
        const bool has_next = S.next(ui + 1, nxt);
        const char* nA = has_next ? nxt.a : cA; const char* nB = has_next ? nxt.b : cB;
        if constexpr (Sched::GATHER) {
            if (has_next) {
#pragma unroll
                for (int h = 0; h < 2; ++h)
#pragma unroll
                    for (int i = 0; i < 2; ++i) vn[h][i] = S.rowoff(nxt, RR[i] + 128 * h) + (unsigned)(CC[i] * 2);
            } else {
#pragma unroll
                for (int h = 0; h < 2; ++h)
#pragma unroll
                    for (int i = 0; i < 2; ++i) vn[h][i] = vc[h][i];
            }
        }
        for (int t = 0; t < nt; t += 2) {
            const bool last = (t == nt - 2);
            const char* a1 = cA + (size_t)(t + 1) * kstep;
            const char* a2 = last ? nA : cA + (size_t)(t + 2) * kstep; const char* b2 = last ? nB : cB + (size_t)(t + 2) * kstep;
            const char* a3 = a2 + kstep; const char* b3 = b2 + kstep;
            unsigned v2[2][2];
#pragma unroll
            for (int h = 0; h < 2; ++h)
#pragma unroll
                for (int i = 0; i < 2; ++i) v2[h][i] = last ? vn[h][i] : vc[h][i];
            if constexpr (PG8_SP2) {
            PG8_LDB(B0, 0, 0); PG8_LDB(B1, 0, 1); PG8_SCHED; PG8_LDA(At, 0, 0); PG8_STAGE_A(PG8_SA(1, 1), a1, 1, vc);
            PG8_WAIT_V(8); PG8_WAIT_L(0); PG8_BAR; PG8_MMA(0, 0, At, B0); PG8_MMA(0, 1, At, B1); PG8_BAR; PG8_SCHED;
            PG8_LDA(At, 0, 1); PG8_STAGE_B(PG8_SB(0, 0), b2, 0); PG8_STAGE_B(PG8_SB(0, 1), b2, 1); PG8_STAGE_A(PG8_SA(0, 0), a2, 0, v2);
            PG8_WAIT_V(8); PG8_WAIT_L(0); PG8_BAR; PG8_MMA(1, 0, At, B0); PG8_MMA(1, 1, At, B1); PG8_BAR; PG8_SCHED;
            PG8_LDB(B0, 1, 0); PG8_LDB(B1, 1, 1); PG8_SCHED; PG8_LDA(At, 1, 0); PG8_STAGE_A(PG8_SA(0, 1), a2, 1, v2);
            PG8_WAIT_V(8); PG8_WAIT_L(0); PG8_BAR; PG8_MMA(0, 0, At, B0); PG8_MMA(0, 1, At, B1); PG8_BAR; PG8_SCHED;
            PG8_LDA(At, 1, 1); PG8_STAGE_B(PG8_SB(1, 0), b3, 0); PG8_STAGE_B(PG8_SB(1, 1), b3, 1); PG8_STAGE_A(PG8_SA(1, 0), a3, 0, v2);
            PG8_WAIT_V(8); PG8_WAIT_L(0); PG8_BAR; PG8_MMA(1, 0, At, B0); PG8_MMA(1, 1, At, B1); PG8_BAR; PG8_SCHED;
            } else {
            PG8_LDB(B0, 0, 0); PG8_SCHED; PG8_LDA(At, 0, 0); PG8_STAGE_A(PG8_SA(1, 1), a1, 1, vc);
            PG8_WAIT_L(8); PG8_BAR; PG8_WAIT_L(0); PG8_MMA(0, 0, At, B0); PG8_BAR; PG8_SCHED;
            PG8_LDB(B1, 0, 1); PG8_STAGE_B(PG8_SB(0, 0), b2, 0);
            PG8_BAR; PG8_WAIT_L(0); PG8_MMA(0, 1, At, B1); PG8_BAR;
            PG8_LDA(At, 0, 1); PG8_STAGE_A(PG8_SA(0, 0), a2, 0, v2);
            PG8_BAR; PG8_WAIT_L(0); PG8_MMA(1, 0, At, B0); PG8_BAR; PG8_SCHED;
            PG8_STAGE_B(PG8_SB(0, 1), b2, 1);
            PG8_WAIT_V(6); PG8_BAR; PG8_MMA(1, 1, At, B1); PG8_BAR;
            PG8_LDB(B0, 1, 0); PG8_SCHED; PG8_LDA(At, 1, 0); PG8_STAGE_A(PG8_SA(0, 1), a2, 1, v2);
            PG8_WAIT_L(8); PG8_BAR; PG8_WAIT_L(0); PG8_MMA(0, 0, At, B0); PG8_BAR; PG8_SCHED;
            PG8_LDB(B1, 1, 1); PG8_STAGE_B(PG8_SB(1, 0), b3, 0);
            PG8_BAR; PG8_WAIT_L(0); PG8_MMA(0, 1, At, B1); PG8_BAR;
            PG8_LDA(At, 1, 1); PG8_STAGE_A(PG8_SA(1, 0), a3, 0, v2);
            PG8_BAR; PG8_WAIT_L(0); PG8_MMA(1, 0, At, B0); PG8_BAR; PG8_SCHED;
            PG8_STAGE_B(PG8_SB(1, 1), b3, 1);
            PG8_WAIT_V(6); PG8_BAR; PG8_MMA(1, 1, At, B1); PG8_BAR;
            }
        }
        if constexpr (PG8_ALIGN_EPI) { if (wr == 0) PG8_BAR; }
        E(acc, cur, wr, wc, fr, fq);
        if (!has_next) break;
#pragma unroll
        for (int a = 0; a < 2; ++a)
#pragma unroll
            for (int b = 0; b < 2; ++b)
#pragma unroll
                for (int m = 0; m < 4; ++m)
#pragma unroll
                    for (int n = 0; n < 2; ++n) acc[a][b][m][n] = (f32x4){0.f, 0.f, 0.f, 0.f};
        cur = nxt; cA = nA; cB = nB; ++ui;
        if constexpr (Sched::GATHER) {
#pragma unroll
            for (int h = 0; h < 2; ++h)
#pragma unroll
                for (int i = 0; i < 2; ++i) vc[h][i] = vn[h][i];
        }
        if constexpr (PG8_ALIGN_EPI) { if (wr == 1) PG8_BAR; }
    }
    PG8_WAIT_V(0);
    if constexpr (!PG8_ALIGN_EPI) { if (wr == 0) PG8_BAR; }
    PG8_BAR;
#undef PG8_SA
#undef PG8_SB
#undef PG8_STAGE
#undef PG8_STAGE_A
#undef PG8_STAGE_B
#undef PG8_LDA
#undef PG8_LDB
#undef PG8_MMA
#undef PG8_WAIT_V
#undef PG8_WAIT_L
#undef PG8_BAR
#undef PG8_SCHED
}

struct TileOrder {
    int nM, nN, nwg, G, c;
    DI void init(int nM_, int nN_, int G_, int c_) { nM = nM_; nN = nN_; nwg = nM * nN; G = G_; c = c_; }
    DI bool tile(int i, int& pm, int& pn) const {
        const long L = (long)i * G + c; if (L >= nwg) return false;
        int wgid = (int)L; { const int q = nwg / NXCD, r = nwg % NXCD, xcd = wgid % NXCD, off = wgid / NXCD; wgid = (xcd < r ? xcd * (q + 1) : r * (q + 1) + (xcd - r) * q) + off; }
        const int nig = WGM * nN, gid = wgid / nig, fm = gid * WGM, gsz = (nM - fm) < WGM ? (nM - fm) : WGM;
        pm = fm + ((wgid % nig) % gsz); pn = (wgid % nig) / gsz; return true;
    }
};
}
constexpr size_t AL(size_t x) { return (x + 255) & ~(size_t)255; }
constexpr int MOE_CAP = NTOK;
constexpr int SLOT_ROWS = 2 * NTOK + NEXP * 256;
constexpr int NCHUNK = (CTX + SEQ) / 64;
constexpr size_t WS_CTL    = 0;
constexpr size_t CTL_BYTES = 65536;
constexpr size_t CW_BAR    = 0;
constexpr size_t CW_CNT    = 16384;
constexpr size_t WS_MOD    = AL(WS_CTL + CTL_BYTES);
constexpr size_t WS_ROPE0  = AL(WS_MOD + (size_t)2 * 5 * MODN * 4);
constexpr size_t WS_ROPE1  = AL(WS_ROPE0 + 64 * 16 * 8);
constexpr size_t WS_W0IN   = AL(WS_ROPE1 + 64 * 32 * 8);
constexpr size_t WS_WUQ    = AL(WS_W0IN + (size_t)L0INP * DM * 2);
constexpr size_t WS_WUKV   = AL(WS_WUQ + (size_t)1536 * 512 * 2);
constexpr size_t WS_W0OUT  = AL(WS_WUKV + (size_t)2048 * 256 * 2);
constexpr size_t WS_W1IN   = AL(WS_W0OUT + (size_t)DM * DM * 2);
constexpr size_t WS_W1OUT  = AL(WS_W1IN + (size_t)L1IN * DM * 2);
constexpr size_t EXPW      = (size_t)NEXP * EFF * DM * 2;
constexpr size_t WS_EG     = AL(WS_W1OUT + (size_t)DM * DM * 2);
constexpr size_t WS_EU     = AL(WS_EG + 2 * EXPW);
constexpr size_t WS_ED     = AL(WS_EU + 2 * EXPW);
constexpr size_t WS_GW     = AL(WS_ED + 2 * EXPW);
constexpr size_t WS_XA     = AL(WS_GW + (size_t)2 * 16 * 128 * 128 * 2);
constexpr size_t WS_XB     = AL(WS_XA + (size_t)NTOK * DM * 4);
constexpr size_t WS_H      = AL(WS_XB + (size_t)NTOK * DM * 4);
constexpr size_t WS_Z      = AL(WS_H + (size_t)NTOK * DM * 2);
constexpr size_t WS_CQN    = AL(WS_Z + (size_t)NTOK * L1IN * 2);
constexpr size_t WS_CKVN   = AL(WS_CQN + (size_t)NTOK * 512 * 2);
constexpr size_t WS_KR     = AL(WS_CKVN + (size_t)NTOK * 256 * 2);
constexpr size_t WS_Q0     = AL(WS_KR + (size_t)NTOK * 64 * 2);
constexpr size_t WS_KV0    = AL(WS_Q0 + (size_t)NTOK * 1536 * 2);
constexpr size_t WS_Y      = AL(WS_KV0 + (size_t)NTOK * 2048 * 2);
constexpr size_t WS_SUMM   = AL(WS_Y + (size_t)NTOK * DM * 2);
constexpr size_t WS_CARRY  = AL(WS_SUMM + (size_t)2 * NB * NCHUNK * 1024 * 8);
constexpr size_t WS_LIST   = AL(WS_CARRY + (size_t)2 * NB * NCHUNK * 1024 * 4);
constexpr size_t WS_TOK    = AL(WS_LIST + (size_t)NEXP * MOE_CAP * 4);
constexpr size_t WS_ACT    = AL(WS_TOK + (size_t)NTOK * 32);
constexpr size_t WS_OUT2   = AL(WS_ACT + (size_t)SLOT_ROWS * EFF * 2);
constexpr size_t WS_D      = AL(WS_OUT2 + (size_t)SLOT_ROWS * DM * 2);
constexpr size_t WS_ABG    = AL(WS_D + (size_t)NTOK * DM * 2);
constexpr size_t WS_END    = AL(WS_ABG + (size_t)NB * NCHUNK * 8 * 2 * 64 * 128 * 4);

struct TokInfo { int e0, p0, e1, p1; float w0, w1; int pad0, pad1; };

constexpr int LDS_STAGE = 0;
constexpr int LDS_MISC  = 139264;
constexpr int LDS_BYTES = 139264 + 4096;

struct Params { const float* in[38]; float* out; unsigned char* ws; int ph_lo, ph_hi, flags, pad; };

struct Frame {
    const float* const* in; float* out; unsigned char* ws; LAS unsigned char* lds;
    int tid, lane, wave, G, bid;
};
struct CvtJob { const float* src; bf16_t* dst; int K, N, ldo, perm, tiles_per_b, tile0; size_t sstride, dstride; };

DI int l1_permrow(int n) {
    if (n >= 1280) return n;
    const int hb = n & ~127, d = n & 127, a = d >> 6, part = (d >> 5) & 1, i = d & 31;
    return hb + 64 * a + 32 * (i >> 4) + 16 * part + (i & 15);
}

DI void set_job(LAS CvtJob* J, int j, const float* src, bf16_t* dst, int K, int N, int ldo, int perm, int nb, size_t ss, size_t ds, int& t0) {
    J[j].src = src; J[j].dst = dst; J[j].K = K; J[j].N = N; J[j].ldo = ldo; J[j].perm = perm; J[j].tiles_per_b = (K / 64) * ((N + 255) / 256); J[j].tile0 = t0;
    J[j].sstride = ss; J[j].dstride = ds; t0 += nb * J[j].tiles_per_b;
}

struct CvtTile { const float* src; bf16_t* dst; int N, ldo, k0, n0, nw, perm; };
DI void cvt_decode(LAS CvtJob* J, int nj, int gt, CvtTile& t) {
    int j = 0;
#pragma unroll 1
    for (int q = 1; q < nj; ++q) if (gt >= J[q].tile0) j = q;
    const int rem = gt - J[j].tile0, tpb = J[j].tiles_per_b, b = rem / tpb, r2 = rem % tpb;
    t.N = J[j].N; t.ldo = J[j].ldo; const int nst = (t.N + 255) / 256, kt = r2 / nst, st = r2 % nst; t.perm = J[j].perm;
    t.src = J[j].src + (size_t)b * J[j].sstride; t.dst = J[j].dst + (size_t)b * J[j].dstride;
    t.k0 = kt * 64; t.n0 = st * 256; t.nw = min(256, t.N - t.n0);
}
constexpr int MOE_CVT_TILES = 3 * NEXP * 64;
#ifndef BG_L0_P2
#define BG_L0_P2 960
#endif
#ifndef BG_L0_P6
#define BG_L0_P6 3960
#endif
#define BG_L1_DOWN0 4096
#ifndef BG_L1_P8
#define BG_L1_P8 2400
#endif
#ifndef BG_L1_P11
#define BG_L1_P11 4096
#endif
DI void cvt_group(const Params& p, LAS unsigned char* lds, int group, int t_lo, int t_hi, int r, int I) {
    const int tid = threadIdx.x;
    unsigned char* ws = p.ws;
    __syncthreads();
    LAS CvtJob* J = (LAS CvtJob*)(lds + 72 * 1024);
    LAS float* tile = (LAS float*)lds;
    if (tid == 0) {
        int t0 = 0, nj = 0;
        if (group == 0) {
            set_job(J, 0, p.in[11], (bf16_t*)(ws + WS_W0IN), DM, L0IN, DM, 0, 1, 0, 0, t0);
            set_job(J, 1, p.in[13], (bf16_t*)(ws + WS_WUQ), 512, 1536, 512, 0, 1, 0, 0, t0);
            set_job(J, 2, p.in[15], (bf16_t*)(ws + WS_WUKV), 256, 2048, 256, 0, 1, 0, 0, t0);
            set_job(J, 3, p.in[23], (bf16_t*)(ws + WS_W0OUT), DM, DM, DM, 0, 1, 0, 0, t0);
            set_job(J, 4, p.in[31], (bf16_t*)(ws + WS_W1IN), DM, L1IN, DM, 1, 1, 0, 0, t0);
            set_job(J, 5, p.in[34], (bf16_t*)(ws + WS_W1OUT), DM, DM, DM, 0, 1, 0, 0, t0);
            set_job(J, 6, p.in[18], (bf16_t*)(ws + WS_GW), 128, 128, 128, 0, 16, 128 * 128, 128 * 128, t0);
            set_job(J, 7, p.in[20], (bf16_t*)(ws + WS_GW + (size_t)16 * 128 * 128 * 2), 128, 128, 128, 0, 16, 128 * 128, 128 * 128, t0);
            nj = 8;
        } else if (group == 1) {
            set_job(J, 0, p.in[24], (bf16_t*)(ws + WS_EG), DM, EFF, DM, 0, NEXP, (size_t)DM * EFF, (size_t)EFF * DM, t0);
            set_job(J, 1, p.in[25], (bf16_t*)(ws + WS_EU), DM, EFF, DM, 0, NEXP, (size_t)DM * EFF, (size_t)EFF * DM, t0);
            set_job(J, 2, p.in[26], (bf16_t*)(ws + WS_ED), EFF, DM, EFF, 0, NEXP, (size_t)DM * EFF, (size_t)EFF * DM, t0);
            nj = 3;
        } else {
            set_job(J, 0, p.in[35], (bf16_t*)(ws + WS_EG + EXPW), DM, EFF, DM, 0, NEXP, (size_t)DM * EFF, (size_t)EFF * DM, t0);
            set_job(J, 1, p.in[36], (bf16_t*)(ws + WS_EU + EXPW), DM, EFF, DM, 0, NEXP, (size_t)DM * EFF, (size_t)EFF * DM, t0);
            set_job(J, 2, p.in[37], (bf16_t*)(ws + WS_ED + EXPW), EFF, DM, EFF, 0, NEXP, (size_t)DM * EFF, (size_t)EFF * DM, t0);
            nj = 3;
        }
        J[nj].tile0 = t0; J[15].tile0 = nj;
    }
    __syncthreads();
    const int nj = J[15].tile0, total = J[nj].tile0;
    const int hi = min(t_hi, total);
    const int row = tid >> 6, c4 = (tid & 63) * 4;
    for (int gt = t_lo + r; gt < hi; gt += I) {
        CvtTile cur; cvt_decode(J, nj, gt, cur);
        if (c4 < cur.nw) {
            f32x4 v[8];
#pragma unroll
            for (int i = 0; i < 8; ++i) v[i] = *(const f32x4*)(cur.src + (size_t)(cur.k0 + row + 8 * i) * cur.N + cur.n0 + c4);
#pragma unroll
            for (int i = 0; i < 8; ++i) *(LAS f32x4*)(tile + (row + 8 * i) * 260 + c4) = v[i];
        }
        __syncthreads();
        { const int n = tid & 255, kh = tid >> 8;
          if (n < cur.nw) {
              const int orow = cur.perm ? l1_permrow(cur.n0 + n) : (cur.n0 + n);
#pragma unroll
              for (int q8 = 0; q8 < 4; ++q8) {
                  float w8[8];
#pragma unroll
                  for (int q = 0; q < 8; ++q) w8[q] = tile[(32 * kh + 8 * q8 + q) * 260 + n];
                  u32x4 w; w.x = pk_bf16(w8[0], w8[1]); w.y = pk_bf16(w8[2], w8[3]); w.z = pk_bf16(w8[4], w8[5]); w.w = pk_bf16(w8[6], w8[7]);
                  *(u32x4*)(cur.dst + (size_t)orow * cur.ldo + cur.k0 + 32 * kh + 8 * q8) = w;
              }
          } }
        __syncthreads();
    }
}
DI void bg_range(const Params& p, LAS unsigned char* lds, int group, int t_lo, int t_hi, int nunits, int G, int bid) {
    const int rem = nunits % G;
    if (rem == 0) cvt_group(p, lds, group, t_lo, t_hi, bid, G);
    else if (bid >= rem) cvt_group(p, lds, group, t_lo, t_hi, bid - rem, G - rem);
}
DI int bg_end(int t_lo, int nunits, int per_wg, int G) { const int rem = nunits % G; if (rem == 0) return t_lo; return min(t_lo + (G - rem) * per_wg, MOE_CVT_TILES); }
DI int bg_convert(const Params& p, LAS unsigned char* lds, int group, int t_lo, int nunits, int per_wg, int G, int bid) {
    const int rem = nunits % G;
    if (rem == 0) return t_lo;
    const int idle = G - rem, t_hi = min(t_lo + idle * per_wg, MOE_CVT_TILES);
    if (bid >= rem && t_hi > t_lo) cvt_group(p, lds, group, t_lo, t_hi, bid - rem, idle);
    return t_hi;
}

DI void phase_prologue(const Params& p, LAS unsigned char* lds, int G, int bid) {
    const int tid = threadIdx.x;
    unsigned char* ws = p.ws;
    {
        LAS float* s = (LAS float*)lds;
        LAS float* part = (LAS float*)(lds + 40960);
        for (int i = tid; i < 5 * DM; i += NTHREADS) { const int r = i / DM, k = i % DM; const float c = r < 4 ? p.in[1][r * DM + k] : p.in[3][k]; s[i] = c / (1.0f + __expf(-c)); }
        __syncthreads();
        float* MOD = (float*)(ws + WS_MOD);
        for (int chunk = bid; chunk < 256; chunk += G) {
            const int layer = chunk >> 7, n0 = (chunk & 127) * 96;
            const float* W = layer ? p.in[27] : p.in[7]; const float* bias = layer ? p.in[28] : p.in[8];
            const int cg = tid % 24, ks = tid / 24;
            if (ks < 16) {
                f32x4 acc[5];
#pragma unroll
                for (int r = 0; r < 5; ++r) acc[r] = (f32x4){0.f, 0.f, 0.f, 0.f};
                const float* wp = W + (size_t)(ks * 128) * MODN + n0 + 4 * cg;
                for (int k = 0; k < 128; k += 8) {
                    f32x4 w[8];
#pragma unroll
                    for (int j = 0; j < 8; ++j) w[j] = *(const f32x4*)(wp + (size_t)(k + j) * MODN);
#pragma unroll
                    for (int j = 0; j < 8; ++j)
#pragma unroll
                        for (int r = 0; r < 5; ++r) acc[r] += s[r * DM + ks * 128 + k + j] * w[j];
                }
#pragma unroll
                for (int r = 0; r < 5; ++r)
#pragma unroll
                    for (int j = 0; j < 4; ++j) part[(ks * 5 + r) * 96 + cg * 4 + j] = acc[r][j];
            }
            __syncthreads();
            if (tid < 480) {
                const int r = tid / 96, col = tid % 96; float a = bias[n0 + col];
#pragma unroll
                for (int k2 = 0; k2 < 16; ++k2) a += part[(k2 * 5 + r) * 96 + col];
                MOD[((size_t)layer * 5 + r) * MODN + n0 + col] = a;
            }
            __syncthreads();
        }
    }
    {
        f32x2* R0 = (f32x2*)(ws + WS_ROPE0); f32x2* R1 = (f32x2*)(ws + WS_ROPE1);
        for (int i = bid * NTHREADS + tid; i < 64 * 16 + 64 * 32; i += G * NTHREADS) {
            if (i < 64 * 16) { const int pos = i >> 4, k = i & 15; const float ang = (float)pos * exp2f(-(float)k * (13.287712379549449f / 16.0f)); R0[i] = (f32x2){cosf(ang), sinf(ang)}; }
            else { const int j = i - 64 * 16, pos = j >> 5, k = j & 31; const float ang = (float)pos * exp2f(-(float)k * (13.287712379549449f / 32.0f)); R1[j] = (f32x2){cosf(ang), sinf(ang)}; }
        }
        u32x4* z = (u32x4*)(ws + WS_W0IN + (size_t)L0IN * DM * 2);
        for (int i = bid * NTHREADS + tid; i < (L0INP - L0IN) * DM * 2 / 16; i += G * NTHREADS) z[i] = (u32x4){0u, 0u, 0u, 0u};
    }
    cvt_group(p, lds, 0, 0, 1 << 30, bid, G);
    cvt_group(p, lds, 1, BG_L0_P6, MOE_CVT_TILES, bid, G);
    cvt_group(p, lds, 2, BG_L1_P11, BG_L1_DOWN0, bid, G);
}

DI void norm_mod_store(const f32x4 (&v)[8], const float* gain, const float* shift, const float* scale, bf16_t* hrow, int lane) {
    float ss = 0.f;
#pragma unroll
    for (int i = 0; i < 8; ++i) ss += v[i][0] * v[i][0] + v[i][1] * v[i][1] + v[i][2] * v[i][2] + v[i][3] * v[i][3];
    ss = wave_sum(ss);
    const float r = rsqrtf(ss * (1.0f / DM) + EPS);
#pragma unroll
    for (int i = 0; i < 8; ++i) {
        const int col = 4 * lane + 256 * i;
        const f32x4 g = *(const f32x4*)(gain + col), sh = *(const f32x4*)(shift + col), sc = *(const f32x4*)(scale + col);
        const f32x4 h = (v[i] * r * g) * (1.0f + sc) + sh;
        u32x2 w; w.x = pk_bf16(h[0], h[1]); w.y = pk_bf16(h[2], h[3]);
        *(u32x2*)(hrow + col) = w;
    }
}

DI void phase_norm0(const Params& p, int G, int bid) {
    const int lane = threadIdx.x & 63, wave = threadIdx.x >> 6;
    const float* MOD = (const float*)(p.ws + WS_MOD);
    bf16_t* H = (bf16_t*)(p.ws + WS_H);
    for (int row = bid * 8 + wave; row < NTOK; row += G * 8) {
        const float* xr = row < NCTX ? p.in[2] + (size_t)row * DM : p.in[0] + (size_t)(row - NCTX) * DM;
        f32x4 v[8];
#pragma unroll
        for (int i = 0; i < 8; ++i) v[i] = *(const f32x4*)(xr + 4 * lane + 256 * i);
        const float* md = MOD + (size_t)row_mod(row) * MODN;
        norm_mod_store(v, p.in[9], md, md + DM, H + (size_t)row * DM, lane);
    }
}
DI void phase_l0_rows(const Params& p, int G, int bid) {
    const int lane = threadIdx.x & 63, wave = threadIdx.x >> 6;
    const bf16_t* Z = (const bf16_t*)(p.ws + WS_Z);
    bf16_t* CQN = (bf16_t*)(p.ws + WS_CQN); bf16_t* CKVN = (bf16_t*)(p.ws + WS_CKVN); bf16_t* KR = (bf16_t*)(p.ws + WS_KR);
    const f32x2* R0 = (const f32x2*)(p.ws + WS_ROPE0);
    for (int row = bid * 8 + wave; row < NTOK; row += G * 8) {
        const bf16_t* z = Z + (size_t)row * L0INP;
        {
            const u32x4 w = *(const u32x4*)(z + 8 * lane);
            float v[8] = {bflo(w.x), bfhi(w.x), bflo(w.y), bfhi(w.y), bflo(w.z), bfhi(w.z), bflo(w.w), bfhi(w.w)};
            float ss = 0.f;
#pragma unroll
            for (int j = 0; j < 8; ++j) ss += v[j] * v[j];
            ss = wave_sum(ss);
            const float r = rsqrtf(ss * (1.0f / 512.0f) + EPS);
            const f32x4 g0 = *(const f32x4*)(p.in[12] + 8 * lane), g1 = *(const f32x4*)(p.in[12] + 8 * lane + 4);
            u32x4 o; o.x = pk_bf16(v[0] * r * g0[0], v[1] * r * g0[1]); o.y = pk_bf16(v[2] * r * g0[2], v[3] * r * g0[3]);
            o.z = pk_bf16(v[4] * r * g1[0], v[5] * r * g1[1]); o.w = pk_bf16(v[6] * r * g1[2], v[7] * r * g1[3]);
            *(u32x4*)(CQN + (size_t)row * 512 + 8 * lane) = o;
        }
        {
            const u32x2 w = *(const u32x2*)(z + 512 + 4 * lane);
            float v[4] = {bflo(w.x), bfhi(w.x), bflo(w.y), bfhi(w.y)};
            float ss = v[0] * v[0] + v[1] * v[1] + v[2] * v[2] + v[3] * v[3];
            ss = wave_sum(ss);
            const float r = rsqrtf(ss * (1.0f / 256.0f) + EPS);
            const f32x4 g = *(const f32x4*)(p.in[14] + 4 * lane);
            u32x2 o; o.x = pk_bf16(v[0] * r * g[0], v[1] * r * g[1]); o.y = pk_bf16(v[2] * r * g[2], v[3] * r * g[3]);
            *(u32x2*)(CKVN + (size_t)row * 256 + 4 * lane) = o;
        }
        {
            const float x = bf2f(z[768 + lane]);
            const float xp = __shfl_xor(x, 16);
            float o = x;
            if (row >= NCTX) {
                const int t = (row - NCTX) & (SEQ - 1), axis = lane >> 5, part = (lane >> 4) & 1, i = lane & 15;
                const int pos = axis ? (t & 63) : (t >> 6);
                const f32x2 cs = R0[pos * 16 + i];
                o = part ? (x * cs[0] + xp * cs[1]) : (x * cs[0] - xp * cs[1]);
            }
            KR[(size_t)row * 64 + lane] = f2bf(o);
        }
    }
}

DI float gelu_tanh(float x) { const float u = 0.7978845608028654f * (x + 0.044715f * x * x * x); const float e = __expf(2.0f * u); const float th = 1.0f - 2.0f / (e + 1.0f); return 0.5f * x * (1.0f + th); }

template <int PASS>
DI void lru_units(const Params& p, LAS unsigned char* lds, int G, int bid) {
    const int tid = threadIdx.x, lane = tid & 63, wave = tid >> 6;
    const bf16_t* Z = (const bf16_t*)(p.ws + WS_Z);
    const bf16_t* GWA = (const bf16_t*)(p.ws + WS_GW); const bf16_t* GWX = GWA + 16 * 128 * 128;
    f32x2* SUMM = (f32x2*)(p.ws + WS_SUMM); const float* CARRY = (const float*)(p.ws + WS_CARRY);
    bf16_t* Y = (bf16_t*)(p.ws + WS_Y);
    unsigned* ABG = (unsigned*)(p.ws + WS_ABG);
    LAS float* U32 = (LAS float*)lds;
    LAS unsigned char* UBF = lds + 32768;
    LAS f32x2* AB = (LAS f32x2*)lds;
    const bool by_n = (G % 8) == 0;
    const int n_fix = bid & 7, nW = by_n ? G / 8 : G, q0 = by_n ? bid >> 3 : bid, nunits = by_n ? NCHUNK * NB : NCHUNK * NB * 8;
    const int d = wave >> 2, nt = wave & 3, jl = lane & 31, h = lane >> 5, ch = 32 * nt + jl;
    bf16x8 wa[8], wx[8];
    if (by_n) {
        const bf16_t* pa = GWA + ((size_t)(d * 8 + n_fix) * 128 + ch) * 128 + 8 * h;
        const bf16_t* px = GWX + ((size_t)(d * 8 + n_fix) * 128 + ch) * 128 + 8 * h;
#pragma unroll
        for (int ks = 0; ks < 8; ++ks) { wa[ks] = *(const bf16x8*)(pa + 16 * ks); wx[ks] = *(const bf16x8*)(px + 16 * ks); }
    }
    for (int v = q0; v < nunits; v += nW) {
        const int n = by_n ? n_fix : (v & 7), bc = by_n ? v : (v >> 3), b = bc & 3, ci = bc >> 2;
        const int seg_len = ci < 4 ? CTX : SEQ, t0 = ci < 4 ? 64 * ci : 64 * (ci - 4);
        const int row0 = ci < 4 ? b * CTX + t0 : NCTX + b * SEQ + t0;
        const int chg = 128 * n + ch;
        if (!by_n) {
            const bf16_t* pa = GWA + ((size_t)(d * 8 + n) * 128 + ch) * 128 + 8 * h;
            const bf16_t* px = GWX + ((size_t)(d * 8 + n) * 128 + ch) * 128 + 8 * h;
#pragma unroll
            for (int ks = 0; ks < 8; ++ks) { wa[ks] = *(const bf16x8*)(pa + 16 * ks); wx[ks] = *(const bf16x8*)(px + 16 * ks); }
        }
        u32x2 grw[4];
        {
            const int c4 = (tid & 31) * 4, tb = 4 * (tid >> 5), cg = 128 * n + c4;
            f32x4 xv[7];
#pragma unroll
            for (int q = 0; q < 7; ++q) { const int tt = t0 + tb + q - 2; u32x2 w = (u32x2){0u, 0u};
                if (tt >= 0 && tt < seg_len) w = *(const u32x2*)(Z + (size_t)(row0 + tb + q - 2) * L0INP + 832 + cg);
                xv[q] = (f32x4){bflo(w.x), bfhi(w.x), bflo(w.y), bfhi(w.y)}; }
            if (PASS == 2) {
#pragma unroll
                for (int j = 0; j < 4; ++j) grw[j] = *(const u32x2*)(Z + (size_t)(row0 + tb + j) * L0INP + 1856 + cg);
            }
            const f32x4 cb = *(const f32x4*)(p.in[17] + cg);
            f32x4 cw[4];
#pragma unroll
            for (int tap = 0; tap < 4; ++tap) cw[tap] = *(const f32x4*)(p.in[16] + tap * 1024 + cg);
#pragma unroll
            for (int j = 0; j < 4; ++j) {
                const f32x4 acc = cb + xv[j] * cw[0] + xv[j + 1] * cw[1] + xv[j + 2] * cw[2] + xv[j + 3] * cw[3];
                *(LAS f32x4*)(U32 + (tb + j) * 128 + c4) = acc;
                u32x2 o; o.x = pk_bf16(acc[0], acc[1]); o.y = pk_bf16(acc[2], acc[3]);
                *(LAS u32x2*)(UBF + (tb + j) * 272 + c4 * 2) = o;
            }
        }
        __syncthreads();
        f32x16 acc[2][2];
#pragma unroll
        for (int g = 0; g < 2; ++g)
#pragma unroll
            for (int mt = 0; mt < 2; ++mt)
#pragma unroll
                for (int i = 0; i < 16; ++i) acc[g][mt][i] = 0.f;
#pragma unroll
        for (int ks = 0; ks < 8; ++ks) {
            const bf16x8 a0 = *(const LAS bf16x8*)(UBF + jl * 272 + (16 * ks + 8 * h) * 2);
            const bf16x8 a1 = *(const LAS bf16x8*)(UBF + (32 + jl) * 272 + (16 * ks + 8 * h) * 2);
            acc[0][0] = __builtin_amdgcn_mfma_f32_32x32x16_bf16(a0, wa[ks], acc[0][0], 0, 0, 0);
            acc[0][1] = __builtin_amdgcn_mfma_f32_32x32x16_bf16(a1, wa[ks], acc[0][1], 0, 0, 0);
            acc[1][0] = __builtin_amdgcn_mfma_f32_32x32x16_bf16(a0, wx[ks], acc[1][0], 0, 0, 0);
            acc[1][1] = __builtin_amdgcn_mfma_f32_32x32x16_bf16(a1, wx[ks], acc[1][1], 0, 0, 0);
        }
        {
            const float ga_b = p.in[19][d * 1024 + chg], gx_b = p.in[21][d * 1024 + chg], lam = p.in[22][d * 1024 + chg];
            const float sp8l2 = 8.0f * LOG2E * log1pf(expf(-lam));
#pragma unroll
            for (int mt = 0; mt < 2; ++mt)
#pragma unroll
                for (int i = 0; i < 16; ++i) {
                    const int t = 32 * mt + (i & 3) + 8 * (i >> 2) + 4 * h;
                    const float r = __builtin_amdgcn_rcpf(1.0f + __builtin_amdgcn_exp2f(-LOG2E * (acc[0][mt][i] + ga_b)));
                    const float ig = __builtin_amdgcn_rcpf(1.0f + __builtin_amdgcn_exp2f(-LOG2E * (acc[1][mt][i] + gx_b)));
                    const float a = __builtin_amdgcn_exp2f(-sp8l2 * r);
                    const float bb = __builtin_amdgcn_sqrtf((1.0f - a) * (1.0f + a)) * (ig * U32[t * 128 + ch]);
                    acc[0][mt][i] = a; acc[1][mt][i] = bb;
                }
        }
        __syncthreads();
#pragma unroll
        for (int mt = 0; mt < 2; ++mt)
#pragma unroll
            for (int i = 0; i < 16; ++i) { const int t = 32 * mt + (i & 3) + 8 * (i >> 2) + 4 * h; AB[(d * 64 + t) * 128 + ch] = (f32x2){acc[0][mt][i], acc[1][mt][i]};
                if (PASS == 1) ABG[((((size_t)(b * NCHUNK + ci) * 8 + n) * 2 + d) * 64 + t) * 128 + ch] = pk_bf16(1.0f - acc[0][mt][i], acc[1][mt][i]); }
        __syncthreads();
        if (tid < 256) {
            const int sd = tid >> 7, sc = tid & 127;
            const size_t sidx = ((size_t)(sd * NB + b) * NCHUNK + ci) * 1024 + 128 * n + sc;
            if (PASS == 1) {
                float hh = 0.f, ap = 1.f;
#pragma unroll 16
                for (int s2 = 0; s2 < 64; ++s2) { const int t = sd ? 63 - s2 : s2; const f32x2 ab = AB[(sd * 64 + t) * 128 + sc]; hh = ab[0] * hh + ab[1]; ap *= ab[0]; }
                SUMM[sidx] = (f32x2){ap, hh};
            } else {
                float hh = CARRY[sidx];
#pragma unroll 16
                for (int s2 = 0; s2 < 64; ++s2) { const int t = sd ? 63 - s2 : s2; const f32x2 ab = AB[(sd * 64 + t) * 128 + sc]; hh = ab[0] * hh + ab[1]; AB[(sd * 64 + t) * 128 + sc] = (f32x2){ab[0], hh}; }
            }
        }
        __syncthreads();
        if (PASS == 2) {
            const int c4 = (tid & 31) * 4, tb = 4 * (tid >> 5);
#pragma unroll
            for (int j = 0; j < 4; ++j) {
                const int t = tb + j; const size_t row = (size_t)(row0 + t);
                const float gr[4] = {bflo(grw[j].x), bfhi(grw[j].x), bflo(grw[j].y), bfhi(grw[j].y)};
                float y[4];
#pragma unroll
                for (int k = 0; k < 4; ++k) y[k] = (AB[(t) * 128 + c4 + k][1] + AB[(64 + t) * 128 + c4 + k][1]) * gelu_tanh(gr[k]);
                u32x2 o; o.x = pk_bf16(y[0], y[1]); o.y = pk_bf16(y[2], y[3]);
                *(u32x2*)(Y + row * DM + 1024 + 128 * n + c4) = o;
            }
            __syncthreads();
        }
    }
}

DI void lru_pass2(const Params& p, LAS unsigned char* lds, int G, int bid) {
    const int tid = threadIdx.x;
    const bf16_t* Z = (const bf16_t*)(p.ws + WS_Z);
    const unsigned* ABG = (const unsigned*)(p.ws + WS_ABG); const float* CARRY = (const float*)(p.ws + WS_CARRY);
    bf16_t* Y = (bf16_t*)(p.ws + WS_Y);
    LAS float* HB = (LAS float*)lds;
    for (int u = bid; u < NCHUNK * NB * 8; u += G) {
        const int n = u & 7, bc = u >> 3, b = bc & 3, ci = bc >> 2;
        const int t0 = ci < 4 ? 64 * ci : 64 * (ci - 4);
        const int row0 = ci < 4 ? b * CTX + t0 : NCTX + b * SEQ + t0;
        const int c4 = (tid & 31) * 4, tb = 4 * (tid >> 5), cg = 128 * n + c4;
        u32x2 grw[4];
#pragma unroll
        for (int j = 0; j < 4; ++j) grw[j] = *(const u32x2*)(Z + (size_t)(row0 + tb + j) * L0INP + 1856 + cg);
        if (tid < 256) {
            const int sd = tid >> 7, sc = tid & 127;
            const unsigned* ab = ABG + ((((size_t)(b * NCHUNK + ci) * 8 + n) * 2 + sd) * 64) * 128 + sc;
            unsigned w[64];
#pragma unroll
            for (int t = 0; t < 64; ++t) w[t] = ab[t * 128];
            float hh = CARRY[((size_t)(sd * NB + b) * NCHUNK + ci) * 1024 + 128 * n + sc];
            if (sd == 0) {
#pragma unroll
                for (int t = 0; t < 64; ++t) { hh = fmaf(1.0f - bflo(w[t]), hh, bfhi(w[t])); HB[t * 128 + sc] = hh; }
            } else {
#pragma unroll
                for (int t = 63; t >= 0; --t) { hh = fmaf(1.0f - bflo(w[t]), hh, bfhi(w[t])); HB[(64 + t) * 128 + sc] = hh; }
            }
        }
        __syncthreads();
#pragma unroll
        for (int j = 0; j < 4; ++j) {
            const int t = tb + j; const size_t row = (size_t)(row0 + t);
            const float gr[4] = {bflo(grw[j].x), bfhi(grw[j].x), bflo(grw[j].y), bfhi(grw[j].y)};
            const f32x4 hf = *(const LAS f32x4*)(HB + t * 128 + c4), hb = *(const LAS f32x4*)(HB + (64 + t) * 128 + c4);
            float y[4];
#pragma unroll
            for (int k = 0; k < 4; ++k) y[k] = (hf[k] + hb[k]) * gelu_tanh(gr[k]);
            u32x2 o; o.x = pk_bf16(y[0], y[1]); o.y = pk_bf16(y[2], y[3]);
            *(u32x2*)(Y + row * DM + 1024 + 128 * n + c4) = o;
        }
        __syncthreads();
    }
}

DI void lru_carry(const Params& p, int G, int bid) {
    const f32x2* SUMM = (const f32x2*)(p.ws + WS_SUMM); float* CARRY = (float*)(p.ws + WS_CARRY);
    for (int gid = bid * NTHREADS + threadIdx.x; gid < 2 * NB * 1024; gid += G * NTHREADS) {
        const int d = gid >> 12, b = (gid >> 10) & 3, ch = gid & 1023;
        const size_t base = ((size_t)(d * NB + b) * NCHUNK) * 1024 + ch;
        float hh = 0.f;
#pragma unroll
        for (int pos = 0; pos < NCHUNK; ++pos) {
            const int ci = d == 0 ? pos : (pos < 4 ? 3 - pos : 39 - pos);
            CARRY[base + (size_t)ci * 1024] = hh;
            const f32x2 s = SUMM[base + (size_t)ci * 1024];
            hh = s[0] * hh + s[1];
        }
    }
}
#define MFMA32(a, b, c) __builtin_amdgcn_mfma_f32_32x32x16_bf16((a), (b), (c), 0, 0, 0)
constexpr int AT_KSLOT = 24576, AT_VSLOT = 16384, AT_K0 = 0, AT_V0 = 2 * AT_KSLOT, AT_XOFF = AT_V0 + 2 * AT_VSLOT;

#ifndef AT_PIPE_MLA
#define AT_PIPE_MLA false
#endif
#ifndef AT_PIPE_WIN
#define AT_PIPE_WIN false
#endif
#ifndef AT_PIPE_NA
#define AT_PIPE_NA false
#endif
#ifndef AT_SKEW_MLA
#define AT_SKEW_MLA 0
#endif
#ifndef AT_SKEW_WIN
#define AT_SKEW_WIN 0
#endif
#ifndef AT_SKEW_NA
#define AT_SKEW_NA 0
#endif
constexpr float AT_M0 = -30.0f;
struct NoBias { DI float operator()(int, float nm) const { return nm; } };

struct AtRd { int kbase, kbase1, ko[4], vbase, vo[4]; };
template <int DQ> DI int at_kf(int r) { return DQ == 128 ? (r & 15) : ((r >> 1) & 7); }
template <int DQ>
DI AtRd at_rd_init(int lane) {
    AtRd r; const int kr = lane & 31, h = lane >> 5, i16 = lane & 15, q = i16 >> 2, pp = i16 & 3, blk = (lane >> 4) & 1;
    const int f = at_kf<DQ>(kr);
    r.kbase = kr * (DQ * 2) + ((f >> 3) << 7); r.kbase1 = kr * (DQ * 2) + (((f >> 3) ^ 1) << 7);
#pragma unroll
    for (int i = 0; i < 4; ++i) r.ko[i] = ((2 * i + h) ^ (f & 7)) << 4;
    r.vbase = (4 * h + q) * 256 + 8 * pp;
#pragma unroll
    for (int t = 0; t < 4; ++t) r.vo[t] = ((2 * t + blk) ^ ((4 * h + q) & 7)) << 5;
    return r;
}
template <int DQ>
DI void at_qk(const LAS unsigned char* ks, const AtRd& rd, const bf16x8 (&qf)[DQ / 16], f32x16& s0, f32x16& s1) {
#pragma unroll
    for (int i = 0; i < 16; ++i) { s0[i] = 0.f; s1[i] = 0.f; }
    const LAS unsigned char* kp0 = ks + rd.kbase; const LAS unsigned char* kp1 = ks + rd.kbase1;
#pragma unroll
    for (int s = 0; s < DQ / 16; ++s) {
        const LAS unsigned char* kp = (DQ == 128) ? ((s >> 2) ? kp1 : kp0) : kp0 + ((s >> 2) << 7);
        const bf16x8 a0 = *(const LAS bf16x8*)(kp + rd.ko[s & 3]);
        const bf16x8 a1 = *(const LAS bf16x8*)(kp + 32 * (DQ * 2) + rd.ko[s & 3]);
        s0 = MFMA32(a0, qf[s], s0); s1 = MFMA32(a1, qf[s], s1);
    }
}
template <class BiasFn>
DI void at_sm(f32x16& s0, f32x16& s1, f32x16 (&o)[4], float& m, float& l, const float c2, const BiasFn& bias, const int lane, bf16x8 (&pf)[4]) {
    const int h = lane >> 5;
    const float nm = -m;
    float mx = -INFINITY;
#pragma unroll
    for (int i = 0; i < 16; ++i) {
        const int key = (i & 3) + 8 * (i >> 2) + 4 * h;
        s0[i] = fmaf(s0[i], c2, bias(key, nm)); s1[i] = fmaf(s1[i], c2, bias(32 + key, nm));
        mx = fmaxf(mx, fmaxf(s0[i], s1[i]));
    }
    { const auto sw = __builtin_amdgcn_permlane32_swap(__float_as_uint(mx), __float_as_uint(mx), false, false); mx = fmaxf(__uint_as_float(sw[0]), __uint_as_float(sw[1])); }
    if (__any(mx > 8.0f)) {
        const float d = fmaxf(mx, 0.f), alpha = __builtin_amdgcn_exp2f(-d);
        m += d; l *= alpha;
#pragma unroll
        for (int t = 0; t < 4; ++t)
#pragma unroll
            for (int i = 0; i < 16; ++i) o[t][i] *= alpha;
#pragma unroll
        for (int i = 0; i < 16; ++i) { s0[i] -= d; s1[i] -= d; }
    }
    float rs = 0.f;
#pragma unroll
    for (int i = 0; i < 16; ++i) { s0[i] = __builtin_amdgcn_exp2f(s0[i]); s1[i] = __builtin_amdgcn_exp2f(s1[i]); rs += s0[i] + s1[i]; }
    l += rs;
    u32x4 w;
    w.x = pk_bf16(s0[0], s0[1]); w.y = pk_bf16(s0[2], s0[3]); w.z = pk_bf16(s0[4], s0[5]); w.w = pk_bf16(s0[6], s0[7]); pf[0] = __builtin_bit_cast(bf16x8, w);
    w.x = pk_bf16(s0[8], s0[9]); w.y = pk_bf16(s0[10], s0[11]); w.z = pk_bf16(s0[12], s0[13]); w.w = pk_bf16(s0[14], s0[15]); pf[1] = __builtin_bit_cast(bf16x8, w);
    w.x = pk_bf16(s1[0], s1[1]); w.y = pk_bf16(s1[2], s1[3]); w.z = pk_bf16(s1[4], s1[5]); w.w = pk_bf16(s1[6], s1[7]); pf[2] = __builtin_bit_cast(bf16x8, w);
    w.x = pk_bf16(s1[8], s1[9]); w.y = pk_bf16(s1[10], s1[11]); w.z = pk_bf16(s1[12], s1[13]); w.w = pk_bf16(s1[14], s1[15]); pf[3] = __builtin_bit_cast(bf16x8, w);
}
DI void at_pv(const LAS unsigned char* vs, const AtRd& rd, const bf16x8 (&pf)[4], f32x16 (&o)[4]) {
    const LAS unsigned char* vb = vs + rd.vbase;
#pragma unroll
    for (int ks = 0; ks < 4; ++ks)
#pragma unroll
        for (int t = 0; t < 4; ++t) {
            const s16x4 lo = __builtin_amdgcn_ds_read_tr16_b64_v4i16((LAS s16x4*)(vb + (16 * ks) * 256 + rd.vo[t]));
            const s16x4 hi = __builtin_amdgcn_ds_read_tr16_b64_v4i16((LAS s16x4*)(vb + (16 * ks + 8) * 256 + rd.vo[t]));
            const bf16x8 vf = __builtin_shufflevector(lo, hi, 0, 1, 2, 3, 4, 5, 6, 7);
            o[t] = MFMA32(vf, pf[ks], o[t]);
        }
}
template <class BiasFn>
DI void at_sm_pv(const LAS unsigned char* vs, const AtRd& rd, f32x16& s0, f32x16& s1, f32x16 (&o)[4], float& m, float& l, const float c2, const BiasFn& bias, const int lane) {
    bf16x8 pf[4];
    at_sm(s0, s1, o, m, l, c2, bias, lane, pf);
    at_pv(vs, rd, pf, o);
}

struct AtDma { unsigned ko[3], vo[2]; unsigned rope; };
template <int DQ>
DI AtDma at_dma_init(int ld_bytes, int wave, int lane) {
    AtDma d; d.rope = 0u;
    constexpr int PPR = DQ / 8;
#pragma unroll
    for (int k = 0; k < DQ / 64; ++k) { const int L = (wave + 8 * k) * 64 + lane, r = L / PPR, pc = (L % PPR) ^ at_kf<DQ>(r);
        if (DQ == 192 && pc >= 16) { d.ko[k] = (unsigned)(r * 128 + (pc - 16) * 16); d.rope |= 1u << k; } else d.ko[k] = (unsigned)(r * ld_bytes + pc * 16); }
    if (DQ == 128) d.ko[2] = 0u;
#pragma unroll
    for (int k = 0; k < 2; ++k) { const int L = (wave + 8 * k) * 64 + lane, r = L >> 4, pc = (L & 15) ^ (2 * (r & 7)); d.vo[k] = (unsigned)(r * ld_bytes + pc * 16); }
    return d;
}
template <int DQ>
DI void at_dma_k(LAS unsigned char* kslot, const char* kb, const char* rb, const AtDma& d, int wave) {
#pragma unroll
    for (int k = 0; k < DQ / 64; ++k) {
        const char* src = (DQ == 192 && ((d.rope >> k) & 1u)) ? rb + d.ko[k] : kb + d.ko[k];
        __builtin_amdgcn_global_load_lds((const unsigned*)src, (LAS unsigned*)(kslot + (wave + 8 * k) * 1024), 16, 0, 0);
    }
}
DI void at_dma_v(LAS unsigned char* vslot, const char* vb, const AtDma& d, int wave) {
#pragma unroll
    for (int k = 0; k < 2; ++k) __builtin_amdgcn_global_load_lds((const unsigned*)(vb + d.vo[k]), (LAS unsigned*)(vslot + (wave + 8 * k) * 1024), 16, 0, 0);
}
#define AT_DRAIN_SYNC() do { asm volatile("s_waitcnt vmcnt(0)" ::: "memory"); __syncthreads(); } while (0)

template <int DQ, bool PIPE, class Drv>
DI void at_run(LAS unsigned char* lds, const Drv& D, const int n, const AtRd& rd, const AtDma& dm, const bf16x8 (&qf)[DQ / 16], f32x16 (&o)[4], float& m, float& l, const float c2, const int lane, const int wave) {
    f32x16 a0, a1;
    __syncthreads();
    at_dma_k<DQ>(lds + AT_K0, D.kb(0), D.rb(0), dm, wave); at_dma_v(lds + AT_V0, D.vb(0), dm, wave);
    if constexpr (PIPE) {
        f32x16 b0, b1;
        if (n > 1) at_dma_k<DQ>(lds + AT_K0 + AT_KSLOT, D.kb(1), D.rb(1), dm, wave);
        AT_DRAIN_SYNC();
        if (D.act(0)) at_qk<DQ>(lds + AT_K0, rd, qf, a0, a1);
#define AT_STEP(J, PAR, C0, C1, N0, N1) do { const int j_ = (J); \
        if (j_ + 2 < n) at_dma_k<DQ>(lds + AT_K0 + (PAR) * AT_KSLOT, D.kb(j_ + 2), D.rb(j_ + 2), dm, wave); \
        if (j_ + 1 < n) at_dma_v(lds + AT_V0 + (1 - (PAR)) * AT_VSLOT, D.vb(j_ + 1), dm, wave); \
        if (j_ + 1 < n && D.act(j_ + 1)) at_qk<DQ>(lds + AT_K0 + (1 - (PAR)) * AT_KSLOT, rd, qf, N0, N1); \
        if (D.act(j_)) at_sm_pv(lds + AT_V0 + (PAR) * AT_VSLOT, rd, C0, C1, o, m, l, c2, D.bias(j_), lane); \
        AT_DRAIN_SYNC(); } while (0)
        for (int j = 0; j < n; j += 2) {
            AT_STEP(j, 0, a0, a1, b0, b1);
            if (j + 1 < n) AT_STEP(j + 1, 1, b0, b1, a0, a1);
        }
#undef AT_STEP
    } else {
        AT_DRAIN_SYNC();
        for (int j = 0; j < n; ++j) {
            const int par = j & 1;
            if (j + 1 < n) { at_dma_k<DQ>(lds + AT_K0 + (1 - par) * AT_KSLOT, D.kb(j + 1), D.rb(j + 1), dm, wave); at_dma_v(lds + AT_V0 + (1 - par) * AT_VSLOT, D.vb(j + 1), dm, wave); }
            if (D.act(j)) { at_qk<DQ>(lds + AT_K0 + par * AT_KSLOT, rd, qf, a0, a1); at_sm_pv(lds + AT_V0 + par * AT_VSLOT, rd, a0, a1, o, m, l, c2, D.bias(j), lane); }
            AT_DRAIN_SYNC();
        }
    }
}

constexpr int AT3_V0 = 2 * AT_KSLOT, AT3_XOFF = AT3_V0 + 3 * AT_VSLOT;
template <int DQ, class Drv>
DI void at_run_skew(LAS unsigned char* lds, const Drv& D, const int n, const AtRd& rd, const AtDma& dm, const bf16x8 (&qf)[DQ / 16], f32x16 (&o)[4], float& m, float& l, const float c2, const int lane, const int wave) {
    const bool late = wave >= 4;
    bf16x8 pf[4];
    __syncthreads();
    at_dma_k<DQ>(lds + AT_K0, D.kb(0), D.rb(0), dm, wave); at_dma_v(lds + AT3_V0, D.vb(0), dm, wave);
    AT_DRAIN_SYNC();
    int vcur = 0;
    for (int j = 0; j < n; ++j) {
        const int vnext = vcur == 2 ? 0 : vcur + 1, vprev = vcur == 0 ? 2 : vcur - 1;
        if (j + 1 < n) { at_dma_k<DQ>(lds + AT_K0 + ((j + 1) & 1) * AT_KSLOT, D.kb(j + 1), D.rb(j + 1), dm, wave); at_dma_v(lds + AT3_V0 + vnext * AT_VSLOT, D.vb(j + 1), dm, wave); }
        if (late && j > 0 && D.act(j - 1)) at_pv(lds + AT3_V0 + vprev * AT_VSLOT, rd, pf, o);
        if (D.act(j)) {
            f32x16 a0, a1;
            at_qk<DQ>(lds + AT_K0 + (j & 1) * AT_KSLOT, rd, qf, a0, a1);
            at_sm(a0, a1, o, m, l, c2, D.bias(j), lane, pf);
            if (!late) at_pv(lds + AT3_V0 + vcur * AT_VSLOT, rd, pf, o);
        }
        AT_DRAIN_SYNC();
        vcur = vnext;
    }
    if (late && D.act(n - 1)) at_pv(lds + AT3_V0 + (vcur == 0 ? 2 : vcur - 1) * AT_VSLOT, rd, pf, o);
}

constexpr int AT4_SLOT = AT_KSLOT + AT_VSLOT, AT4_XOFF = 3 * AT4_SLOT;
template <int DQ, class Drv>
DI void at_run3(LAS unsigned char* lds, const Drv& D, const int n, const AtRd& rd, const AtDma& dm, const bf16x8 (&qf)[DQ / 16], f32x16 (&o)[4], float& m, float& l, const float c2, const int lane, const int wave) {
    __syncthreads();
    at_dma_k<DQ>(lds, D.kb(0), D.rb(0), dm, wave); at_dma_v(lds + AT_KSLOT, D.vb(0), dm, wave);
    if (n > 1) { at_dma_k<DQ>(lds + AT4_SLOT, D.kb(1), D.rb(1), dm, wave); at_dma_v(lds + AT4_SLOT + AT_KSLOT, D.vb(1), dm, wave);
        if (DQ == 192) asm volatile("s_waitcnt vmcnt(5)" ::: "memory"); else asm volatile("s_waitcnt vmcnt(4)" ::: "memory"); }
    else asm volatile("s_waitcnt vmcnt(0)" ::: "memory");
    __syncthreads();
    int cur = 0;
    for (int j = 0; j < n; ++j) {
        const int nx2 = cur == 0 ? 2 : cur - 1;
        if (j + 2 < n) { at_dma_k<DQ>(lds + nx2 * AT4_SLOT, D.kb(j + 2), D.rb(j + 2), dm, wave); at_dma_v(lds + nx2 * AT4_SLOT + AT_KSLOT, D.vb(j + 2), dm, wave); }
        if (D.act(j)) {
            f32x16 a0, a1;
            at_qk<DQ>(lds + cur * AT4_SLOT, rd, qf, a0, a1);
            at_sm_pv(lds + cur * AT4_SLOT + AT_KSLOT, rd, a0, a1, o, m, l, c2, D.bias(j), lane);
        }
        if (j + 2 < n) { if (DQ == 192) asm volatile("s_waitcnt vmcnt(5)" ::: "memory"); else asm volatile("s_waitcnt vmcnt(4)" ::: "memory"); }
        else asm volatile("s_waitcnt vmcnt(0)" ::: "memory");
        __syncthreads();
        cur = cur == 2 ? 0 : cur + 1;
    }
}

DI void attn_store(const f32x16 (&o)[4], float l, float extra, bf16_t* orow, int lane) {
    const int h = lane >> 5;
    const float lt = l + __shfl_xor(l, 32) + extra;
    const float inv = 1.0f / lt;
#pragma unroll
    for (int t = 0; t < 4; ++t)
#pragma unroll
        for (int g4 = 0; g4 < 4; ++g4) {
            u32x2 w; w.x = pk_bf16(o[t][4 * g4] * inv, o[t][4 * g4 + 1] * inv); w.y = pk_bf16(o[t][4 * g4 + 2] * inv, o[t][4 * g4 + 3] * inv);
            *(u32x2*)(orow + 32 * t + 8 * g4 + 4 * h) = w;
        }
}

struct MlaDrv {
    const char* KV; const char* KR; int b, head;
    DI int keyrow0(int j) const { return j < 4 ? b * CTX + 64 * j : NCTX + b * SEQ + 64 * (j - 4); }
    DI const char* kb(int j) const { return KV + (size_t)keyrow0(j) * 4096 + head * 512; }
    DI const char* vb(int j) const { return KV + (size_t)keyrow0(j) * 4096 + head * 512 + 256; }
    DI const char* rb(int j) const { return KR + (size_t)keyrow0(j) * 128; }
    DI bool act(int) const { return true; }
    DI NoBias bias(int) const { return NoBias(); }
};

DI void phase_attn0(const Params& p, LAS unsigned char* lds, int G, int bid) {
    const int tid = threadIdx.x, lane = tid & 63, wave = __builtin_amdgcn_readfirstlane(tid >> 6), h = lane >> 5;
    const bf16_t* Q0 = (const bf16_t*)(p.ws + WS_Q0);
    bf16_t* Y = (bf16_t*)(p.ws + WS_Y);
    const float c2 = 0.07216878364870322f * LOG2E;
    const AtRd rd = at_rd_init<192>(lane);
    const AtDma dm = at_dma_init<192>(4096, wave, lane);
    for (int u = bid; u < 256 + 32; u += G) {
        MlaDrv T; T.KV = (const char*)(p.ws + WS_KV0); T.KR = (const char*)(p.ws + WS_KR);
        int qrow, nt;
        if (u < 256) { T.b = u >> 6; T.head = (u >> 3) & 7; nt = 36; qrow = NCTX + T.b * SEQ + (u & 7) * 256 + wave * 32 + (lane & 31); }
        else { const int v = u - 256; T.b = v >> 3; T.head = v & 7; nt = 4; qrow = T.b * CTX + wave * 32 + (lane & 31); }
        bf16x8 qf[12];
#pragma unroll
        for (int s = 0; s < 12; ++s) qf[s] = *(const bf16x8*)(Q0 + (size_t)qrow * 1536 + T.head * 192 + 16 * s + 8 * h);
        f32x16 o[4];
#pragma unroll
        for (int t = 0; t < 4; ++t)
#pragma unroll
            for (int i = 0; i < 16; ++i) o[t][i] = 0.f;
        float m = AT_M0, l = 0.f;
        if (AT_SKEW_MLA == 2) at_run3<192>(lds, T, nt, rd, dm, qf, o, m, l, c2, lane, wave); else if (AT_SKEW_MLA) at_run_skew<192>(lds, T, nt, rd, dm, qf, o, m, l, c2, lane, wave); else at_run<192, AT_PIPE_MLA>(lds, T, nt, rd, dm, qf, o, m, l, c2, lane, wave);
        attn_store(o, l, 0.f, Y + (size_t)qrow * DM + T.head * 128, lane);
    }
}

struct WinBias { int base; DI float operator()(int key, float nm) const { return ((unsigned)(base - key) <= 256u) ? nm : -1e30f; } };
struct WinDrv {
    const char* Z; int b, kvh, k0base, jlo, qpos;
    DI int tid_(int q) const { return q < 4 ? q : jlo + q - 4; }
    DI int keyrow0(int q) const { const int j = tid_(q); return j < 4 ? b * CTX + 64 * j : NCTX + b * SEQ + k0base + 64 * (j - 4); }
    DI const char* kb(int q) const { return Z + (size_t)keyrow0(q) * (L1IN * 2) + (1024 + kvh * 128) * 2; }
    DI const char* vb(int q) const { return Z + (size_t)keyrow0(q) * (L1IN * 2) + (1280 + kvh * 128) * 2; }
    DI const char* rb(int) const { return nullptr; }
    DI bool act(int) const { return true; }
    DI WinBias bias(int q) const { const int j = tid_(q); WinBias B; B.base = j < 4 ? 100 : qpos - (k0base + 64 * (j - 4)) + 128; return B; }
};

DI void phase_attn_win(const Params& p, LAS unsigned char* lds, int G, int bid) {
    const int tid = threadIdx.x, lane = tid & 63, wave = __builtin_amdgcn_readfirstlane(tid >> 6), h = lane >> 5;
    const bf16_t* Z = (const bf16_t*)(p.ws + WS_Z);
    bf16_t* Y = (bf16_t*)(p.ws + WS_Y);
    const float c2 = 0.08838834764831845f * LOG2E;
    const AtRd rd = at_rd_init<128>(lane);
    const AtDma dm = at_dma_init<128>(L1IN * 2, wave, lane);
    for (int u = bid; u < 256; u += G) {
        WinDrv T; T.Z = (const char*)Z; T.b = u >> 6; T.kvh = (u >> 5) & 1; const int blk = u & 31; T.k0base = 64 * blk - 128;
        const int head = T.kvh * 4 + (wave >> 1), qpos = 64 * blk + 32 * (wave & 1) + (lane & 31), qrow = NCTX + T.b * SEQ + qpos;
        T.qpos = qpos;
        bf16x8 qf[8];
#pragma unroll
        for (int s = 0; s < 8; ++s) qf[s] = *(const bf16x8*)(Z + (size_t)qrow * L1IN + head * 128 + 16 * s + 8 * h);
        f32x16 o[4];
#pragma unroll
        for (int t = 0; t < 4; ++t)
#pragma unroll
            for (int i = 0; i < 16; ++i) o[t][i] = 0.f;
        float m = AT_M0, l = 0.f;
        T.jlo = (T.k0base < 0) ? 4 + ((-T.k0base) >> 6) : 4;
        const int jhi = (T.k0base + 320 > SEQ) ? 9 - ((T.k0base + 320 - SEQ) >> 6) : 9;
        if (AT_SKEW_WIN == 2) at_run3<128>(lds, T, 4 + (jhi - T.jlo), rd, dm, qf, o, m, l, c2, lane, wave); else if (AT_SKEW_WIN) at_run_skew<128>(lds, T, 4 + (jhi - T.jlo), rd, dm, qf, o, m, l, c2, lane, wave); else at_run<128, AT_PIPE_WIN>(lds, T, 4 + (jhi - T.jlo), rd, dm, qf, o, m, l, c2, lane, wave);
        const float sink = p.in[32][head];
        attn_store(o, l, __builtin_amdgcn_exp2f(sink * LOG2E - m), Y + (size_t)qrow * DM + head * 128, lane);
    }
}

struct NaBias { const LAS float* rp; int c0; bool all; DI float operator()(int key, float nm) const { return all ? nm : ((key >= c0 && key < c0 + 16) ? fmaf(rp[key], LOG2E, nm) : -1e30f); } };
struct NaDrv {
    const char* Z; const LAS float* RPB; int b, head, rlo, r, c, r0, c0;
    DI int keyrow0(int j) const { return j < 4 ? b * CTX + 64 * j : NCTX + b * SEQ + 64 * (rlo + j - 4); }
    DI const char* kb(int j) const { return Z + (size_t)keyrow0(j) * (L1IN * 2) + (2560 + head * 128) * 2; }
    DI const char* vb(int j) const { return Z + (size_t)keyrow0(j) * (L1IN * 2) + (3584 + head * 128) * 2; }
    DI const char* rb(int) const { return nullptr; }
    DI bool act(int j) const { const int rr = rlo + j - 4; return j < 4 || (rr >= r0 && rr <= r0 + 7); }
    DI NaBias bias(int j) const { const int rr = rlo + j - 4; NaBias B; B.rp = RPB + (j < 4 ? 0 : (rr - r + 7) * 31 + (15 - c)); B.c0 = c0; B.all = j < 4; return B; }
};

DI void phase_attn_na(const Params& p, LAS unsigned char* lds, int G, int bid) {
    const int tid = threadIdx.x, lane = tid & 63, wave = __builtin_amdgcn_readfirstlane(tid >> 6), h = lane >> 5;
    const bf16_t* Z = (const bf16_t*)(p.ws + WS_Z);
    bf16_t* Y = (bf16_t*)(p.ws + WS_Y);
    LAS float* RPB = (LAS float*)(lds + AT4_XOFF);
    const float c2 = 0.08838834764831845f * LOG2E;
    const AtRd rd = at_rd_init<128>(lane);
    const AtDma dm = at_dma_init<128>(L1IN * 2, wave, lane);
    for (int u = bid; u < 256; u += G) {
        NaDrv T; T.Z = (const char*)Z; T.RPB = RPB; T.b = u >> 6; T.head = (u >> 3) & 7; const int R = u & 7;
        T.r = 4 * R + (wave >> 1); T.c = 32 * (wave & 1) + (lane & 31); const int qrow = NCTX + T.b * SEQ + 64 * T.r + T.c;
        T.r0 = min(max(T.r - 4, 0), 24); T.c0 = min(max(T.c - 8, 0), 48);
        T.rlo = min(max(4 * R - 4, 0), 24);
        const int rhi = min(max(4 * R + 3 - 4, 0), 24) + 7;
        const int ntl = 4 + (rhi - T.rlo + 1);
        __syncthreads();
        for (int i = tid; i < 15 * 31; i += NTHREADS) RPB[i] = p.in[33][T.head * 465 + i];
        bf16x8 qf[8];
#pragma unroll
        for (int s = 0; s < 8; ++s) qf[s] = *(const bf16x8*)(Z + (size_t)qrow * L1IN + 1536 + T.head * 128 + 16 * s + 8 * h);
        f32x16 o[4];
#pragma unroll
        for (int t = 0; t < 4; ++t)
#pragma unroll
            for (int i = 0; i < 16; ++i) o[t][i] = 0.f;
        float m = AT_M0, l = 0.f;
        if (AT_SKEW_NA == 2) at_run3<128>(lds, T, ntl, rd, dm, qf, o, m, l, c2, lane, wave); else if (AT_SKEW_NA) at_run_skew<128>(lds, T, ntl, rd, dm, qf, o, m, l, c2, lane, wave); else at_run<128, AT_PIPE_NA>(lds, T, ntl, rd, dm, qf, o, m, l, c2, lane, wave);
        attn_store(o, l, 0.f, Y + (size_t)qrow * DM + 1024 + T.head * 128, lane);
    }
}
constexpr int RT_HS = 2052;
typedef float f32x4r __attribute__((ext_vector_type(4)));
DI void phase_router(const Params& p, LAS unsigned char* lds, int G, int bid, const int layer, const float* xin_ctx, const float* xin_lat, const int row_lo, const int row_hi) {
    const int tid = threadIdx.x, lane = tid & 63, wave = tid >> 6;
    const float* MOD = (const float*)(p.ws + WS_MOD) + (size_t)layer * 5 * MODN;
    const float* gain = layer ? p.in[30] : p.in[10];
    const float* rw = p.in[4]; const float* rb = p.in[5];
    bf16_t* H = (bf16_t*)(p.ws + WS_H);
    int* cnt = (int*)(p.ws + WS_CTL + CW_CNT) + layer * NEXP;
    int* LIST = (int*)(p.ws + WS_LIST); TokInfo* TOK = (TokInfo*)(p.ws + WS_TOK);
    LAS float* hs = (LAS float*)lds;
    LAS float* sc = (LAS float*)(lds + 16 * RT_HS * 4);
    const int nb = (row_hi - row_lo) / 16;
    float wb0[64], wb1[64];
    {
        const float* bp = rw + (size_t)(256 * wave + (lane >> 4)) * 32 + (lane & 15);
#pragma unroll
        for (int s2 = 0; s2 < 64; ++s2) { wb0[s2] = bp[4 * s2 * 32]; wb1[s2] = bp[4 * s2 * 32 + 16]; }
    }
    int lb = 0;
    for (int bt = bid; bt < nb; bt += G, ++lb) {
        __syncthreads();
#pragma unroll 1
        for (int rr = 0; rr < 2; ++rr) {
            const int lr = 2 * wave + rr, row = row_lo + bt * 16 + lr;
            const float* xr = row < NCTX ? xin_ctx + (size_t)row * DM : xin_lat + (size_t)(row - NCTX) * DM;
            const bf16_t* dr = (const bf16_t*)(p.ws + WS_D) + (size_t)row * DM;
            const float* md = MOD + (size_t)row_mod(row) * MODN;
            f32x4 v[8]; float ss = 0.f;
#pragma unroll
            for (int i = 0; i < 8; ++i) {
                const int col = 4 * lane + 256 * i;
                const u32x2 dw = *(const u32x2*)(dr + col);
                v[i] = *(const f32x4*)(xr + col) + *(const f32x4*)(md + 2 * DM + col) * (f32x4){bflo(dw.x), bfhi(dw.x), bflo(dw.y), bfhi(dw.y)};
                ss += v[i][0] * v[i][0] + v[i][1] * v[i][1] + v[i][2] * v[i][2] + v[i][3] * v[i][3];
            }
            ss = wave_sum(ss);
            const float r = rsqrtf(ss * (1.0f / DM) + EPS);
#pragma unroll
            for (int i = 0; i < 8; ++i) {
                const int col = 4 * lane + 256 * i;
                const f32x4 g = *(const f32x4*)(gain + col), sh = *(const f32x4*)(md + 3 * DM + col), scl = *(const f32x4*)(md + 4 * DM + col);
                const f32x4 hv = (v[i] * r * g) * (1.0f + scl) + sh;
                u32x2 w; w.x = pk_bf16(hv[0], hv[1]); w.y = pk_bf16(hv[2], hv[3]);
                *(u32x2*)(H + (size_t)row * DM + col) = w;
                *(LAS f32x4*)(hs + lr * RT_HS + col) = hv;
            }
        }
        __syncthreads();
        f32x4r c0 = {0.f, 0.f, 0.f, 0.f}, c1 = {0.f, 0.f, 0.f, 0.f};
        {
            const int ar = lane & 15, kq = lane >> 4;
            const LAS float* ap = hs + ar * RT_HS + 256 * wave + kq;
            if (!(p.flags & 8))
#pragma unroll
            for (int s2 = 0; s2 < 64; ++s2) {
                const float a = ap[4 * s2];
                c0 = __builtin_amdgcn_mfma_f32_16x16x4f32(a, wb0[s2], c0, 0, 0, 0);
                c1 = __builtin_amdgcn_mfma_f32_16x16x4f32(a, wb1[s2], c1, 0, 0, 0);
            }
        }
        __syncthreads();
        {
            LAS float* part = hs;
            const int e = lane & 15, r4 = 4 * (lane >> 4);
#pragma unroll
            for (int j = 0; j < 4; ++j) { part[(wave * 16 + r4 + j) * 32 + e] = c0[j]; part[(wave * 16 + r4 + j) * 32 + 16 + e] = c1[j]; }
        }
        __syncthreads();
        {
            const int r = tid >> 5, e = tid & 31; float a = 0.f;
#pragma unroll
            for (int w2 = 0; w2 < 8; ++w2) a += hs[(w2 * 16 + r) * 32 + e];
            sc[(lb * 16 + r) * 32 + e] = 1.0f / (1.0f + expf(-a));
        }
    }
    __syncthreads();
    {
        LAS int* lcnt = (LAS int*)(lds + LDS_MISC + 1024);
        if (tid < 64) lcnt[tid] = 0;
        __syncthreads();
        int e0 = 0, e1 = 0, li0 = 0, li1 = 0, trow = 0; float w0 = 0.f, w1 = 0.f;
        const bool has = tid < lb * 16;
        if (has) {
            const LAS float* s = sc + tid * 32;
            int bg = 0; float bgs = -INFINITY;
#pragma unroll
            for (int g = 0; g < 8; ++g) {
                const float v0 = s[4 * g] + rb[4 * g], v1 = s[4 * g + 1] + rb[4 * g + 1], v2 = s[4 * g + 2] + rb[4 * g + 2], v3 = s[4 * g + 3] + rb[4 * g + 3];
                const float hi01 = fmaxf(v0, v1), lo01 = fminf(v0, v1), hi23 = fmaxf(v2, v3), lo23 = fminf(v2, v3);
                const float m1 = fmaxf(hi01, hi23), m2 = fmaxf(fminf(hi01, hi23), fmaxf(lo01, lo23));
                const float gs = m1 + m2;
                if (gs > bgs) { bgs = gs; bg = g; }
            }
            float bv[4];
#pragma unroll
            for (int j = 0; j < 4; ++j) bv[j] = s[4 * bg + j] + rb[4 * bg + j];
            int i0 = 0; float b0 = bv[0];
#pragma unroll
            for (int j = 1; j < 4; ++j) if (bv[j] > b0) { b0 = bv[j]; i0 = j; }
            int i1 = -1; float b1 = -INFINITY;
#pragma unroll
            for (int j = 0; j < 4; ++j) if (j != i0 && bv[j] > b1) { b1 = bv[j]; i1 = j; }
            e0 = 4 * bg + i0; e1 = 4 * bg + i1;
            const float s0 = s[e0], s1 = s[e1], ws = s0 + s1; w0 = s0 / ws; w1 = s1 / ws;
            trow = row_lo + (bid + (tid >> 4) * G) * 16 + (tid & 15);
            li0 = atomicAdd((int*)(lcnt + e0), 1); li1 = atomicAdd((int*)(lcnt + e1), 1);
        }
        __syncthreads();
        if (tid < 32) { const int c = lcnt[tid]; lcnt[32 + tid] = c > 0 ? atomicAdd(cnt + tid, c) : 0; }
        __syncthreads();
        if (has) {
            const int p0 = lcnt[32 + e0] + li0, p1 = lcnt[32 + e1] + li1;
            LIST[(size_t)e0 * MOE_CAP + p0] = trow; LIST[(size_t)e1 * MOE_CAP + p1] = trow;
            TokInfo ti; ti.e0 = e0; ti.p0 = p0; ti.e1 = e1; ti.p1 = p1; ti.w0 = w0; ti.w1 = w1; ti.pad0 = 0; ti.pad1 = 0;
            TOK[trow] = ti;
        }
    }
}

DI void moe_tables(const Params& p, LAS int* MT, int layer) {
    __syncthreads();
    if (threadIdx.x == 0) {
        const int* cnt = (const int*)(p.ws + WS_CTL + CW_CNT) + layer * NEXP;
        int seg = 0, tp = 0;
        for (int e = 0; e < NEXP; ++e) { const int c = cnt[e]; const int t = (c + 255) >> 8; MT[e] = seg; MT[64 + e] = tp; MT[128 + e] = c; seg += t * 256; tp += t; }
        MT[32] = seg; MT[64 + 32] = tp;
    }
    __syncthreads();
}

struct MoeSchedUp {
    static constexpr bool GATHER = true;
    const char* Hb; const char* EG; const int* LIST; const LAS int* MT; int K; size_t lda, ldb, a_h, b_h; int G, c;
    DI bool next(int i, pg8::GU& u) const {
        const int L = i * G + c, T = MT[64 + 32]; if (L >= T * 4) return false;
        const int rt = L >> 2, ct = L & 3; int e = 0;
#pragma unroll 1
        for (int q = 1; q < NEXP; ++q) if (rt >= MT[64 + q]) e = q;
        const int lt = rt - MT[64 + e];
        u.e = e; u.pm = lt; u.pn = ct; u.aux = MT[e] + 256 * lt; u.a = Hb; u.b = EG + (size_t)e * (EFF * DM * 2) + (size_t)ct * 128 * ldb; return true;
    }
    DI unsigned rowoff(const pg8::GU& u, int r) const { const int gr = 256 * u.pm + r; const int tok = gr < MT[128 + u.e] ? LIST[(size_t)u.e * MOE_CAP + gr] : 0; return (unsigned)tok * (unsigned)lda; }
};
struct MoeSchedDown {
    static constexpr bool GATHER = false;
    const char* ACT; const char* ED; const LAS int* MT; int K; size_t lda, ldb, a_h, b_h; int G, c;
    DI bool next(int i, pg8::GU& u) const {
        const int L = i * G + c, T = MT[64 + 32]; if (L >= T * 8) return false;
        const int rt = L >> 3, ct = L & 7; int e = 0;
#pragma unroll 1
        for (int q = 1; q < NEXP; ++q) if (rt >= MT[64 + q]) e = q;
        const int lt = rt - MT[64 + e];
        u.e = e; u.pm = lt; u.pn = ct; u.aux = MT[e] + 256 * lt; u.a = ACT + (size_t)u.aux * lda; u.b = ED + (size_t)e * (DM * EFF * 2) + (size_t)ct * 256 * ldb; return true;
    }
    DI unsigned rowoff(const pg8::GU&, int) const { return 0u; }
};
struct EpiSwiGLU {
    static constexpr bool PERM = true;
    bf16_t* ACT;
    DI void operator()(const f32x4 (&acc)[2][2][4][2], const pg8::GU& u, int wr, int wc, int fr, int fq) const {
        const int row0 = u.aux + wr * 64 + fr, col0 = u.pn * 128 + wc * 32 + 8 * fq;
#pragma unroll
        for (int ai = 0; ai < 2; ++ai)
#pragma unroll
            for (int m = 0; m < 4; ++m) {
                float a[8];
#pragma unroll
                for (int n = 0; n < 2; ++n)
#pragma unroll
                    for (int j = 0; j < 4; ++j) { const float g = acc[ai][0][m][n][j], up = acc[ai][1][m][n][j]; a[4 * n + j] = g / (1.0f + __expf(-g)) * up; }
                u32x4 w; w.x = pk_bf16(a[0], a[1]); w.y = pk_bf16(a[2], a[3]); w.z = pk_bf16(a[4], a[5]); w.w = pk_bf16(a[6], a[7]);
                *(u32x4*)(ACT + (size_t)(row0 + ai * 128 + m * 16) * EFF + col0) = w;
            }
    }
};
struct EpiBf16Rows {
    static constexpr bool PERM = true;
    bf16_t* O; int ldc; int use_aux; int skip = 0;
    DI void operator()(const f32x4 (&acc)[2][2][4][2], const pg8::GU& u, int wr, int wc, int fr, int fq) const {
        if (skip) return;
        const int row0 = (use_aux ? u.aux : u.pm * 256) + wr * 64 + fr, col0 = u.pn * 256 + wc * 32 + 8 * fq;
#pragma unroll
        for (int ai = 0; ai < 2; ++ai)
#pragma unroll
            for (int m = 0; m < 4; ++m) {
                bf16_t* rowp = O + (size_t)(row0 + ai * 128 + m * 16) * ldc + col0;
#pragma unroll
                for (int bj = 0; bj < 2; ++bj) {
                    const f32x4 v0 = acc[ai][bj][m][0], v1 = acc[ai][bj][m][1];
                    u32x4 w; w.x = pk_bf16(v0[0], v0[1]); w.y = pk_bf16(v0[2], v0[3]); w.z = pk_bf16(v1[0], v1[1]); w.w = pk_bf16(v1[2], v1[3]);
                    *(u32x4*)(rowp + bj * 128) = w;
                }
            }
    }
};

template <bool FINAL>
DI void phase_combine(const Params& p, LAS unsigned char* lds, int G, int bid, const int layer, const float* xin_ctx, const float* xin_lat, const int row_lo, const int row_hi) {
    const int lane = threadIdx.x & 63, wave = threadIdx.x >> 6;
    LAS int* MT = (LAS int*)(lds + LDS_MISC + 64);
    moe_tables(p, MT, layer);
    const float* MOD = (const float*)(p.ws + WS_MOD);
    const bf16_t* OUT2 = (const bf16_t*)(p.ws + WS_OUT2);
    const TokInfo* TOK = (const TokInfo*)(p.ws + WS_TOK);
    float* XB = (float*)(p.ws + WS_XB); bf16_t* H = (bf16_t*)(p.ws + WS_H);
    for (int row = row_lo + bid * 8 + wave; row < row_hi; row += G * 8) {
        const TokInfo ti = TOK[row];
        const bf16_t* o0 = OUT2 + (size_t)(MT[ti.e0] + ti.p0) * DM; const bf16_t* o1 = OUT2 + (size_t)(MT[ti.e1] + ti.p1) * DM;
        const float* xr = row < NCTX ? xin_ctx + (size_t)row * DM : xin_lat + (size_t)(row - NCTX) * DM;
        const bf16_t* dr = (const bf16_t*)(p.ws + WS_D) + (size_t)row * DM;
        const int mi = row_mod(row);
        const float* g1 = MOD + ((size_t)layer * 5 + mi) * MODN + 2 * DM;
        const float* g2 = MOD + ((size_t)layer * 5 + mi) * MODN + 5 * DM;
        f32x4 v[8];
#pragma unroll
        for (int i = 0; i < 8; ++i) {
            const int col = 4 * lane + 256 * i;
            const u32x2 dw = *(const u32x2*)(dr + col);
            const f32x4 x = *(const f32x4*)(xr + col) + *(const f32x4*)(g1 + col) * (f32x4){bflo(dw.x), bfhi(dw.x), bflo(dw.y), bfhi(dw.y)}, g = *(const f32x4*)(g2 + col);
            const u32x2 a = *(const u32x2*)(o0 + col), b = *(const u32x2*)(o1 + col);
            const f32x4 fa = {bflo(a.x), bfhi(a.x), bflo(a.y), bfhi(a.y)}, fb = {bflo(b.x), bfhi(b.x), bflo(b.y), bfhi(b.y)};
            v[i] = x + g * (fa * ti.w0 + fb * ti.w1);
        }
        if (!FINAL) {
#pragma unroll
            for (int i = 0; i < 8; ++i) *(f32x4*)(XB + (size_t)row * DM + 4 * lane + 256 * i) = v[i];
            const float* md = MOD + ((size_t)5 + mi) * MODN;
            norm_mod_store(v, p.in[29], md, md + DM, H + (size_t)row * DM, lane);
        } else {
            float ss = 0.f;
#pragma unroll
            for (int i = 0; i < 8; ++i) ss += v[i][0] * v[i][0] + v[i][1] * v[i][1] + v[i][2] * v[i][2] + v[i][3] * v[i][3];
            ss = wave_sum(ss);
            const float r = rsqrtf(ss * (1.0f / DM) + EPS);
#pragma unroll
            for (int i = 0; i < 8; ++i) { const int col = 4 * lane + 256 * i; const f32x4 g = *(const f32x4*)(p.in[6] + col); *(f32x4*)(p.out + (size_t)(row - NCTX) * DM + col) = v[i] * r * g; }
        }
    }
}
struct PlainSched {
    static constexpr bool GATHER = false;
    const char* A; const char* Bt; int K; size_t lda, ldb, a_h, b_h; pg8::TileOrder T;
    DI void init(const void* A_, const void* Bt_, int M, int N, int K_, int lda_e, int ldb_e, int G, int c) {
        A = (const char*)A_; Bt = (const char*)Bt_; K = K_; lda = (size_t)lda_e * 2; ldb = (size_t)ldb_e * 2; a_h = 128 * lda; b_h = 128 * ldb; T.init(M / 256, N / 256, G, c); }
    DI bool next(int i, pg8::GU& u) const { int pm, pn; if (!T.tile(i, pm, pn)) return false; u.pm = pm; u.pn = pn; u.e = 0; u.aux = 0; u.a = A + (size_t)pm * 256 * lda; u.b = Bt + (size_t)pn * 256 * ldb; return true; }
    DI unsigned rowoff(const pg8::GU&, int) const { return 0u; }
};

template <int MODE>
struct EpiRope {
    static constexpr bool PERM = false;
    bf16_t* O; int ldc; const f32x2* R;
    DI void operator()(const f32x4 (&acc)[2][2][4][2], const pg8::GU& u, int wr, int wc, int fr, int fq) const {
        const int row0 = u.pm * 256 + wr * 64 + fr;
#pragma unroll
        for (int bj = 0; bj < 2; ++bj) {
            const int g32 = 8 * u.pn + 4 * bj + wc;
            int axis, ibase; bool rot;
            if (MODE == 0) { const int hg = g32 % 6; rot = hg >= 4; axis = hg - 4; ibase = 4 * fq; }
            else { rot = u.pn < 5; axis = (g32 & 3) >> 1; ibase = 16 * (g32 & 1) + 4 * fq; }
            const int col0 = 32 * g32 + 4 * fq;
#pragma unroll
            for (int ai = 0; ai < 2; ++ai)
#pragma unroll
                for (int m = 0; m < 4; ++m) {
                    const int row = row0 + ai * 128 + m * 16;
                    f32x4 x1 = acc[ai][bj][m][0], x2 = acc[ai][bj][m][1];
                    if (rot && row >= NCTX) {
                        const int t = (row - NCTX) & (SEQ - 1), pos = axis ? (t & 63) : (t >> 6);
                        const f32x2* cs = R + pos * (MODE == 0 ? 16 : 32) + ibase;
                        f32x4 o1, o2;
#pragma unroll
                        for (int j = 0; j < 4; ++j) { const f32x2 c = cs[j]; o1[j] = x1[j] * c[0] - x2[j] * c[1]; o2[j] = x2[j] * c[0] + x1[j] * c[1]; }
                        x1 = o1; x2 = o2;
                    }
                    bf16_t* rowp = O + (size_t)row * ldc + col0;
                    u32x2 w1, w2; w1.x = pk_bf16(x1[0], x1[1]); w1.y = pk_bf16(x1[2], x1[3]); w2.x = pk_bf16(x2[0], x2[1]); w2.y = pk_bf16(x2[2], x2[3]);
                    *(u32x2*)(rowp) = w1; *(u32x2*)(rowp + 16) = w2;
                }
        }
    }
};

struct EpiResid {
    static constexpr bool PERM = true;
    const float* xin_ctx; const float* xin_lat; float* XO; const float* MODL; int rowbase;
    DI void operator()(const f32x4 (&acc)[2][2][4][2], const pg8::GU& u, int wr, int wc, int fr, int fq) const {
        const int row0 = rowbase + u.pm * 256 + wr * 64 + fr, col0 = u.pn * 256 + wc * 32 + 8 * fq;
        const float* g1 = MODL + (size_t)row_mod(rowbase + u.pm * 256) * MODN + 2 * DM;
        f32x4 gv[2][2];
#pragma unroll
        for (int bj = 0; bj < 2; ++bj)
#pragma unroll
            for (int n = 0; n < 2; ++n) gv[bj][n] = *(const f32x4*)(g1 + col0 + bj * 128 + n * 4);
#pragma unroll
        for (int ai = 0; ai < 2; ++ai)
#pragma unroll
            for (int m = 0; m < 4; ++m) {
                const int row = row0 + ai * 128 + m * 16;
                const float* xr = (row < NCTX ? xin_ctx + (size_t)row * DM : xin_lat + (size_t)(row - NCTX) * DM) + col0;
                float* xo = XO + (size_t)row * DM + col0;
#pragma unroll
                for (int bj = 0; bj < 2; ++bj)
#pragma unroll
                    for (int n = 0; n < 2; ++n) *(f32x4*)(xo + bj * 128 + n * 4) = *(const f32x4*)(xr + bj * 128 + n * 4) + gv[bj][n] * acc[ai][bj][m][n];
            }
    }
};

constexpr int NPHASE = 18;
constexpr int BG_U2 = (NTOK / 256) * (L0INP / 256), BG_U6 = (NTOK / 256) * (DM / 256), BG_U11 = (NTOK / 256) * (L1IN / 256);
#ifndef BG_Q2
#define BG_Q2 12
#endif
#ifndef BG_Q6
#define BG_Q6 10
#endif
#ifndef BG_Q8
#define BG_Q8 12
#endif
#ifndef BG_Q11
#define BG_Q11 12
#endif
__global__ void __launch_bounds__(NTHREADS, 2) fwd_kernel(Params p) {
    extern __shared__ __attribute__((aligned(16))) unsigned char lds_raw[];
    LAS unsigned char* lds = (LAS unsigned char*)lds_raw;
    const int tid = threadIdx.x, G = gridDim.x, bid = blockIdx.x;
    unsigned char* ws = p.ws;
    if (tid < 64) ((LAS unsigned*)(lds + LDS_MISC))[tid] = 0u;
    __syncthreads();
    const int lo = p.ph_lo, hi = p.ph_hi;
    const bool use_bar = (hi - lo) > 1;
    XcdBarrier bar; bar.bar = (unsigned*)(ws + WS_CTL + CW_BAR); bar.x = 0; bar.st = (volatile LAS unsigned*)(lds + LDS_MISC);
    if (use_bar) bar = xcd_barrier_post((unsigned*)(ws + WS_CTL + CW_BAR), (volatile LAS unsigned*)(lds + LDS_MISC));
#ifndef PH_MASK
#define PH_MASK 0x3ffff
#endif
#define IN(k) (((PH_MASK >> (k)) & 1) && lo <= (k) && (k) < hi)
#ifndef REPEAT_MASK
#define REPEAT_MASK 0
#endif
#define REP(k) 0
#define SEAM(k) do { if (rep_ == REP(k) && IN((k) + 1)) xcd_barrier(bar); } while (0)
    const float* MOD = (const float*)(ws + WS_MOD);
    LAS int* MT = (LAS int*)(lds + LDS_MISC + 64);
    const int vc = (G % 8 == 0) ? (bid % 8) * (G / 8) + bid / 8 : bid;
    (void)vc;

    if (IN(0)) for (int rep_ = 0; rep_ <= REP(0); ++rep_) { if (rep_) __syncthreads(); phase_prologue(p, lds, G, bid); SEAM(0); }
    if (IN(1)) for (int rep_ = 0; rep_ <= REP(1); ++rep_) { if (rep_) __syncthreads(); phase_norm0(p, G, bid); SEAM(1); }
    if (IN(2)) for (int rep_ = 0; rep_ <= REP(2); ++rep_) { if (rep_) __syncthreads();
        PlainSched S; S.init(ws + WS_H, ws + WS_W0IN, NTOK, L0INP, DM, DM, DM, G, bid);
        EpiBf16Rows E{(bf16_t*)(ws + WS_Z), L0INP, 0, p.flags & 1};
        pg8::gemm_phase(lds, S, E);
        bg_range(p, lds, 1, 0, BG_L0_P2, BG_U2, G, bid);
        SEAM(2);
    }
    if (IN(3)) for (int rep_ = 0; rep_ <= REP(3); ++rep_) { if (rep_) __syncthreads(); phase_l0_rows(p, G, bid); __syncthreads(); lru_units<1>(p, lds, G, bid); SEAM(3); }
    if (IN(4)) for (int rep_ = 0; rep_ <= REP(4); ++rep_) { if (rep_) __syncthreads();
        { PlainSched S; S.init(ws + WS_CQN, ws + WS_WUQ, NTOK, 1536, 512, 512, 512, G, bid);
          EpiRope<0> E{(bf16_t*)(ws + WS_Q0), 1536, (const f32x2*)(ws + WS_ROPE0)};
          pg8::gemm_phase(lds, S, E); }
        { PlainSched S; S.init(ws + WS_CKVN, ws + WS_WUKV, NTOK, 2048, 256, 256, 256, G, bid);
          EpiBf16Rows E{(bf16_t*)(ws + WS_KV0), 2048, 0};
          pg8::gemm_phase(lds, S, E); }
        lru_carry(p, G, bid);
        SEAM(4);
    }
    if (IN(5)) for (int rep_ = 0; rep_ <= REP(5); ++rep_) { if (rep_) __syncthreads(); if (!(p.flags & 2)) phase_attn0(p, lds, G, bid); __syncthreads(); if (!(p.flags & 4)) lru_pass2(p, lds, G, bid); SEAM(5); }
    if (IN(6)) for (int rep_ = 0; rep_ <= REP(6); ++rep_) { if (rep_) __syncthreads();
        PlainSched S; S.init(ws + WS_Y, ws + WS_W0OUT, NTOK, DM, DM, DM, DM, G, bid);
        EpiBf16Rows E{(bf16_t*)(ws + WS_D), DM, 0};
        pg8::gemm_phase(lds, S, E);
        bg_range(p, lds, 1, BG_L0_P2, BG_L0_P6, BG_U6, G, bid);
        SEAM(6);
    }
    if (IN(7)) for (int rep_ = 0; rep_ <= REP(7); ++rep_) { if (rep_) __syncthreads(); phase_router(p, lds, G, bid, 0, p.in[2], p.in[0], 0, NTOK); SEAM(7); }
    if (IN(8)) for (int rep_ = 0; rep_ <= REP(8); ++rep_) { if (rep_) __syncthreads();
        moe_tables(p, MT, 0);
        MoeSchedUp S; S.Hb = (const char*)(ws + WS_H); S.EG = (const char*)(ws + WS_EG); S.LIST = (const int*)(ws + WS_LIST); S.MT = MT; S.K = DM;
        S.lda = DM * 2; S.ldb = DM * 2; S.a_h = 0; S.b_h = WS_EU - WS_EG; S.G = G; S.c = bid;
        EpiSwiGLU E{(bf16_t*)(ws + WS_ACT)};
        pg8::gemm_phase(lds, S, E);
        bg_range(p, lds, 2, 0, BG_L1_P8, 4 * MT[64 + 32], G, bid);
        SEAM(8);
    }
    if (IN(9)) for (int rep_ = 0; rep_ <= REP(9); ++rep_) { if (rep_) __syncthreads();
        moe_tables(p, MT, 0);
        MoeSchedDown S; S.ACT = (const char*)(ws + WS_ACT); S.ED = (const char*)(ws + WS_ED); S.MT = MT; S.K = EFF;
        S.lda = EFF * 2; S.ldb = EFF * 2; S.a_h = 128 * EFF * 2; S.b_h = 128 * EFF * 2; S.G = G; S.c = bid;
        EpiBf16Rows E{(bf16_t*)(ws + WS_OUT2), DM, 1};
        pg8::gemm_phase(lds, S, E); SEAM(9);
    }
    if (IN(10)) for (int rep_ = 0; rep_ <= REP(10); ++rep_) { if (rep_) __syncthreads(); phase_combine<false>(p, lds, G, bid, 0, p.in[2], p.in[0], 0, NTOK); SEAM(10); }
    if (IN(11)) for (int rep_ = 0; rep_ <= REP(11); ++rep_) { if (rep_) __syncthreads();
        PlainSched S; S.init(ws + WS_H, ws + WS_W1IN, NTOK, L1IN, DM, DM, DM, G, bid);
        EpiRope<1> E{(bf16_t*)(ws + WS_Z), L1IN, (const f32x2*)(ws + WS_ROPE1)};
        pg8::gemm_phase(lds, S, E);
        bg_range(p, lds, 2, BG_L1_P8, BG_L1_P11, BG_U11, G, bid);
        SEAM(11);
    }
    if (IN(12)) for (int rep_ = 0; rep_ <= REP(12); ++rep_) { if (rep_) __syncthreads(); if (!(p.flags & 2)) phase_attn_win(p, lds, G, bid); __syncthreads(); if (!(p.flags & 4)) phase_attn_na(p, lds, G, bid); SEAM(12); }
    if (IN(13)) for (int rep_ = 0; rep_ <= REP(13); ++rep_) { if (rep_) __syncthreads();
        PlainSched S; S.init(ws + WS_Y + (size_t)NCTX * DM * 2, ws + WS_W1OUT, NLAT, DM, DM, DM, DM, G, bid);
        EpiBf16Rows E{(bf16_t*)(ws + WS_D) + (size_t)NCTX * DM, DM, 0};
        pg8::gemm_phase(lds, S, E); SEAM(13);
    }
    if (IN(14)) for (int rep_ = 0; rep_ <= REP(14); ++rep_) { if (rep_) __syncthreads(); phase_router(p, lds, G, bid, 1, (const float*)(ws + WS_XB), (const float*)(ws + WS_XB) + (size_t)NCTX * DM, NCTX, NTOK); SEAM(14); }
    if (IN(15)) for (int rep_ = 0; rep_ <= REP(15); ++rep_) { if (rep_) __syncthreads();
        moe_tables(p, MT, 1);
        MoeSchedUp S; S.Hb = (const char*)(ws + WS_H); S.EG = (const char*)(ws + WS_EG + EXPW); S.LIST = (const int*)(ws + WS_LIST); S.MT = MT; S.K = DM;
        S.lda = DM * 2; S.ldb = DM * 2; S.a_h = 0; S.b_h = WS_EU - WS_EG; S.G = G; S.c = bid;
        EpiSwiGLU E{(bf16_t*)(ws + WS_ACT)};
        pg8::gemm_phase(lds, S, E);
        bg_range(p, lds, 2, BG_L1_DOWN0, MOE_CVT_TILES, 4 * MT[64 + 32], G, bid);
        SEAM(15);
    }
    if (IN(16)) for (int rep_ = 0; rep_ <= REP(16); ++rep_) { if (rep_) __syncthreads();
        moe_tables(p, MT, 1);
        MoeSchedDown S; S.ACT = (const char*)(ws + WS_ACT); S.ED = (const char*)(ws + WS_ED + EXPW); S.MT = MT; S.K = EFF;
        S.lda = EFF * 2; S.ldb = EFF * 2; S.a_h = 128 * EFF * 2; S.b_h = 128 * EFF * 2; S.G = G; S.c = bid;
        EpiBf16Rows E{(bf16_t*)(ws + WS_OUT2), DM, 1};
        pg8::gemm_phase(lds, S, E); SEAM(16);
    }
    if (IN(17)) for (int rep_ = 0; rep_ <= REP(17); ++rep_) { if (rep_) __syncthreads(); phase_combine<true>(p, lds, G, bid, 1, (const float*)(ws + WS_XB), (const float*)(ws + WS_XB) + (size_t)NCTX * DM, NCTX, NTOK); }
#undef IN
#undef SEAM
}

#ifndef REPEAT_FLAGS
#define REPEAT_FLAGS 0
#endif
#ifndef N_LAUNCH_MODE
#define N_LAUNCH_MODE 0
#endif
extern "C" void kernel_launch(void* const* d_in, const int* in_sizes, int n_in, void* d_out, int out_size, void* d_ws, size_t ws_size, hipStream_t stream) {
    static int grid = 0;
    if (grid == 0) {
        if (n_in != 38 || out_size != NLAT * DM || ws_size < WS_END) { fprintf(stderr, "kernel_launch: unexpected problem shape (n_in %d out %d ws %zu need %zu)\n", n_in, out_size, ws_size, (size_t)WS_END); grid = -1; return; }
        int dev = 0, cus = 0, per_cu = 0;
        if (hipGetDevice(&dev) != hipSuccess || hipDeviceGetAttribute(&cus, hipDeviceAttributeMultiprocessorCount, dev) != hipSuccess) { grid = -1; return; }
        if (hipFuncSetAttribute((const void*)fwd_kernel, hipFuncAttributeMaxDynamicSharedMemorySize, LDS_BYTES) != hipSuccess) { fprintf(stderr, "kernel_launch: hipFuncSetAttribute failed\n"); grid = -1; return; }
        if (hipOccupancyMaxActiveBlocksPerMultiprocessor(&per_cu, (const void*)fwd_kernel, NTHREADS, LDS_BYTES) != hipSuccess || per_cu < 1) { fprintf(stderr, "kernel_launch: occupancy query reports %d\n", per_cu); (void)hipGetLastError(); }
        if (cus * 48 < NTOK) { fprintf(stderr, "kernel_launch: built for >= 192 CUs (router score table), got %d\n", cus); grid = -1; return; }
        grid = cus;
    }
    if (grid < 0) return;
    (void)hipMemsetAsync((char*)d_ws + WS_CTL, 0, CTL_BYTES, stream);
    Params prm{};
    for (int i = 0; i < 38; ++i) prm.in[i] = (const float*)d_in[i];
    prm.out = (float*)d_out; prm.ws = (unsigned char*)d_ws; prm.flags = 0; prm.pad = 0;
#if N_LAUNCH_MODE == 0
    prm.ph_lo = 0; prm.ph_hi = NPHASE;
    hipLaunchKernelGGL(fwd_kernel, dim3(grid), dim3(NTHREADS), LDS_BYTES, stream, prm);
#else
    for (int k = 0; k < NPHASE; ++k) { prm.ph_lo = k; prm.ph_hi = k + 1; const int reps = 1 + ((REPEAT_MASK >> k) & 1);
        for (int r = 0; r < reps; ++r) { prm.flags = (reps > 1 && r == 0) ? (REPEAT_FLAGS) : 0; if (r && (k == 7 || k == 14)) (void)hipMemsetAsync((char*)d_ws + WS_CTL + CW_CNT + (k == 14 ? NEXP * 4 : 0), 0, NEXP * 4, stream);
            hipLaunchKernelGGL(fwd_kernel, dim3(grid), dim3(NTHREADS), LDS_BYTES, stream, prm); } }
#endif
}
```

```cpp
#define N_LAUNCH_MODE 0
#include <hip/hip_runtime.h>
#include <stdint.h>
#include <stdio.h>

#define LAS __attribute__((address_space(3)))
#define DI __device__ __forceinline__
typedef unsigned short bf16_t;
typedef short bf16x8 __attribute__((ext_vector_type(8)));
typedef short s16x4 __attribute__((ext_vector_type(4)));
typedef float f32x2 __attribute__((ext_vector_type(2)));
typedef float f32x4 __attribute__((ext_vector_type(4)));
typedef float f32x16 __attribute__((ext_vector_type(16)));
typedef unsigned u32x2 __attribute__((ext_vector_type(2)));
typedef unsigned u32x4 __attribute__((ext_vector_type(4)));
typedef __bf16 hbf16x2 __attribute__((ext_vector_type(2)));

constexpr int DM = 2048, NB = 4, SEQ = 2048, CTX = 256, GRIDW = 64;
constexpr int NCTX = NB * CTX;
constexpr int NLAT = NB * SEQ;
constexpr int NTOK = NCTX + NLAT;
constexpr float EPS = 1e-6f;
constexpr int NEXP = 32, EFF = 512;
constexpr int L0IN = 2880, L0INP = 3072, L1IN = 4608;
constexpr int MODN = 6 * DM;
constexpr int NTHREADS = 512;
constexpr float LOG2E = 1.4426950408889634f;

DI unsigned pk_bf16(float lo, float hi) { f32x2 v = {lo, hi}; hbf16x2 r = __builtin_convertvector(v, hbf16x2); return __builtin_bit_cast(unsigned, r); }
DI float bflo(unsigned w) { return __uint_as_float(w << 16); }
DI float bfhi(unsigned w) { return __uint_as_float(w & 0xffff0000u); }
DI float bf2f(bf16_t b) { return __uint_as_float(((unsigned)b) << 16); }
DI bf16_t f2bf(float f) { return (bf16_t)(pk_bf16(f, 0.f) & 0xffffu); }
DI float wave_sum(float v) {
#pragma unroll
    for (int o = 32; o > 0; o >>= 1) v += __shfl_xor(v, o);
    return v;
}
DI float sigmoidf_(float x) { return 1.0f / (1.0f + __expf(-x)); }
DI int row_mod(int row) { return row < NCTX ? 4 : ((row - NCTX) >> 11); }
#define XB_TMO      128
#define XB_XCNT(j)  (256  + 64 * (j))
#define XB_XSUB(j)  (1280 + 64 * (j))
#define XB_XGEN(j)  (2304 + 64 * (j))
#define XB_TOP      3328
#define XB_TOPGEN   3392
#define XCD_BAR_WORDS 3456
#define XB_SPIN_CAP (1u << 18)

__device__ __forceinline__ unsigned xb_ld(unsigned* p)              { return __hip_atomic_load(p, __ATOMIC_RELAXED, __HIP_MEMORY_SCOPE_AGENT); }
__device__ __forceinline__ unsigned xb_add(unsigned* p, unsigned v) { return __hip_atomic_fetch_add(p, v, __ATOMIC_RELAXED, __HIP_MEMORY_SCOPE_AGENT); }
__device__ __forceinline__ unsigned xb_xcc_id() { return (unsigned)__builtin_amdgcn_s_getreg((3 << 11) | 20) & 0xFu; }
#define XB_SPIN(cond, bar) do { unsigned _sp = 0; while (cond) { __builtin_amdgcn_s_sleep(1); \
    if ((++_sp & 255u) == 0u) { if (xb_ld(&(bar)[XB_TMO])) break; if (_sp > XB_SPIN_CAP) { atomicAdd(&(bar)[XB_TMO], 1u); break; } } } } while (0)

struct XcdBarrier {
    unsigned* bar; unsigned x;
    volatile LAS unsigned* st;
};

__device__ __forceinline__ XcdBarrier xcd_barrier_post(unsigned* bar, volatile LAS unsigned* st) {
    XcdBarrier b; b.bar = bar; b.x = xb_xcc_id(); b.st = st;
    if (threadIdx.x == 0) (void)xb_add(&bar[XB_XCNT(b.x)], 1u);
    return b;
}
__device__ __forceinline__ void xcd_barrier_complete(unsigned* bar, unsigned x, unsigned& nloc, unsigned& nx) {
    const unsigned G = gridDim.x * gridDim.y * gridDim.z;
    unsigned sum, cnt, mine, sp = 0u;
    for (;;) {
        sum = 0u; cnt = 0u; mine = 0u;
#pragma unroll
        for (unsigned j = 0; j < 16; ++j) { const unsigned c = xb_ld(&bar[XB_XCNT(j)]); sum += c; cnt += (c > 0u) ? 1u : 0u; mine = (j == x) ? c : mine; }
        if (sum == G) break;
        __builtin_amdgcn_s_sleep(1);
        if ((++sp & 255u) == 0u) { if (xb_ld(&bar[XB_TMO])) break; if (sp > XB_SPIN_CAP) { atomicAdd(&bar[XB_TMO], 1u); break; } }
    }
    nloc = mine > 0u ? mine : 1u; nx = cnt > 0u ? cnt : 1u;
}

__device__ __forceinline__ void xcd_barrier(const XcdBarrier& b) {
    asm volatile("s_waitcnt vmcnt(0)" ::: "memory");
    __syncthreads();
    if (threadIdx.x == 0) {
        unsigned* bar = b.bar;
        __builtin_amdgcn_s_waitcnt(0);
        unsigned nloc = b.st[0], nx = b.st[1];
        if (nloc == 0u) { xcd_barrier_complete(bar, b.x, nloc, nx); b.st[0] = nloc; b.st[1] = nx; }
        const unsigned old = xb_add(&bar[XB_XSUB(b.x)], 1u);
        const unsigned gen = old / nloc;
        if (old + 1u == (gen + 1u) * nloc) {
            __builtin_amdgcn_fence(__ATOMIC_RELEASE, "agent");
            asm volatile("s_waitcnt vmcnt(0)" ::: "memory");
            const unsigned og = xb_add(&bar[XB_TOP], 1u);
            const unsigned tg = og / nx;
            if (og + 1u == (tg + 1u) * nx) xb_add(&bar[XB_TOPGEN], 1u);
            else XB_SPIN(xb_ld(&bar[XB_TOPGEN]) == tg, bar);
            __builtin_amdgcn_fence(__ATOMIC_ACQUIRE, "agent");
            xb_add(&bar[XB_XGEN(b.x)], 1u);
            asm volatile("s_waitcnt vmcnt(0)" ::: "memory");
        } else {
            XB_SPIN(xb_ld(&bar[XB_XGEN(b.x)]) == gen, bar);
            __builtin_amdgcn_fence(__ATOMIC_ACQUIRE, "agent");
            asm volatile("s_waitcnt vmcnt(0)" ::: "memory");
        }
    }
    __syncthreads();
}

#ifndef PG8_SP2
#define PG8_SP2 true
#endif
#ifndef PG8_ALIGN_EPI
#define PG8_ALIGN_EPI true
#endif
namespace pg8 {
constexpr int BM = 256, BK = 64, HALF = 128, HTB = HALF * BK * 2, STAGE_BYTES = 8 * HTB, NXCD = 8, WGM = 8;
DI int lds_byte(int r, int c) { const int st = (r >> 4) * 2 + (c >> 5), rr = r & 15, cc = c & 31, ob = rr * 64 + cc * 2; return st * 1024 + (ob ^ (((ob >> 9) & 1) << 5)); }
DI void stage_rc(int b, int& R, int& C) { const int st = b / 1024, sb = b % 1024, swz = sb ^ (((sb >> 9) & 1) << 5); R = (st >> 1) * 16 + swz / 64; C = (st & 1) * 32 + (swz % 64) / 2; }
DI int perm32(int rho) { const int n = rho >> 4, i = rho & 15; return 8 * (i >> 2) + 4 * n + (i & 3); }

struct GU { const char* a; const char* b; int pm, pn, e, aux; };

template <class Epi, class Sched>
DI void gemm_phase(LAS unsigned char* lds, const Sched& S, const Epi& E) {
    const int tid = threadIdx.x, wid = __builtin_amdgcn_readfirstlane(tid >> 6), lane = tid & 63, wr = wid >> 2, wc = wid & 3, fr = lane & 15, fq = lane >> 4;
    const int K = S.K, nt = K / BK;
    int RR[2], CC[2];
    unsigned voffA[2], voffB[2];
#pragma unroll
    for (int i = 0; i < 2; ++i) { int R, C; stage_rc(tid * 16 + i * 8192, R, C); RR[i] = R; CC[i] = C; const int Rb = Epi::PERM ? ((R & ~31) + perm32(R & 31)) : R;
        voffA[i] = (unsigned)(R * (int)S.lda + C * 2); voffB[i] = (unsigned)(Rb * (int)S.ldb + C * 2); }
    const size_t kstep = (size_t)(BK * 2);
    const size_t ahs = S.a_h, bhs = S.b_h;
    const unsigned ldsw = (unsigned)wid * 1024u;
    const int aoff = lds_byte(wr * 64 + fr, fq * 8), boff = lds_byte(wc * 32 + fr, fq * 8);
#define PG8_SA(b, h) (((b) * 2 + (h)) * HTB)
#define PG8_SB(b, h) ((4 + (b) * 2 + (h)) * HTB)
#define PG8_STAGE(bufoff, gbase, voff) do { _Pragma("unroll") for (int _i = 0; _i < 2; ++_i) \
        __builtin_amdgcn_global_load_lds((const unsigned*)((const char*)(gbase) + (voff)[_i]), (LAS unsigned*)(lds + (bufoff) + ldsw + _i * 8192), 16, 0, 0); } while (0)
#define PG8_STAGE_A(bufoff, gbase, h, VG) do { if constexpr (Sched::GATHER) { PG8_STAGE(bufoff, gbase, VG[h]); } else { PG8_STAGE(bufoff, (gbase) + (h) * ahs, voffA); } } while (0)
#define PG8_STAGE_B(bufoff, gbase, h) PG8_STAGE(bufoff, (gbase) + (h) * bhs, voffB)
#define PG8_LDA(dst, b, h) do { _Pragma("unroll") for (int m = 0; m < 4; ++m) _Pragma("unroll") for (int k = 0; k < 2; ++k) dst[m][k] = *(const LAS bf16x8*)(lds + PG8_SA(b, h) + aoff + m * 2048 + k * 1024); } while (0)
#define PG8_LDB(dst, b, h) do { _Pragma("unroll") for (int n = 0; n < 2; ++n) _Pragma("unroll") for (int k = 0; k < 2; ++k) dst[n][k] = *(const LAS bf16x8*)(lds + PG8_SB(b, h) + boff + n * 2048 + k * 1024); } while (0)
#define PG8_MMA(ai, bj, At, Bt) do { __builtin_amdgcn_s_setprio(1); _Pragma("unroll") for (int m = 0; m < 4; ++m) _Pragma("unroll") for (int n = 0; n < 2; ++n) _Pragma("unroll") for (int k = 0; k < 2; ++k) \
        acc[ai][bj][m][n] = __builtin_amdgcn_mfma_f32_16x16x32_bf16(Bt[n][k], At[m][k], acc[ai][bj][m][n], 0, 0, 0); __builtin_amdgcn_s_setprio(0); } while (0)
#define PG8_WAIT_V(n) asm volatile("s_waitcnt vmcnt(" #n ")" ::: "memory")
#define PG8_WAIT_L(n) asm volatile("s_waitcnt lgkmcnt(" #n ")" ::: "memory")
#define PG8_BAR __builtin_amdgcn_s_barrier()
#define PG8_SCHED __builtin_amdgcn_sched_barrier(0)
    GU cur, nxt; int ui = 0;
    if (!S.next(0, cur)) return;
    f32x4 acc[2][2][4][2];
#pragma unroll
    for (int a = 0; a < 2; ++a)
#pragma unroll
        for (int b = 0; b < 2; ++b)
#pragma unroll
            for (int m = 0; m < 4; ++m)
#pragma unroll
                for (int n = 0; n < 2; ++n) acc[a][b][m][n] = (f32x4){0.f, 0.f, 0.f, 0.f};
    bf16x8 At[4][2], B0[2][2], B1[2][2];
    unsigned vc[2][2], vn[2][2];
    if constexpr (Sched::GATHER) {
#pragma unroll
        for (int h = 0; h < 2; ++h)
#pragma unroll
            for (int i = 0; i < 2; ++i) { vc[h][i] = S.rowoff(cur, RR[i] + 128 * h) + (unsigned)(CC[i] * 2); vn[h][i] = vc[h][i]; }
    } else {
#pragma unroll
        for (int h = 0; h < 2; ++h)
#pragma unroll
            for (int i = 0; i < 2; ++i) { vc[h][i] = 0u; vn[h][i] = 0u; }
    }
    const char* cA = cur.a; const char* cB = cur.b;
    if constexpr (PG8_SP2) {
        PG8_STAGE_B(PG8_SB(0, 0), cB, 0); PG8_STAGE_B(PG8_SB(0, 1), cB, 1); PG8_STAGE_A(PG8_SA(0, 0), cA, 0, vc); PG8_STAGE_A(PG8_SA(0, 1), cA, 1, vc);
        if (wr == 1) PG8_BAR;
        PG8_WAIT_V(2); PG8_BAR;
        PG8_STAGE_B(PG8_SB(1, 0), cB + kstep, 0); PG8_STAGE_A(PG8_SA(1, 0), cA + kstep, 0, vc); PG8_STAGE_B(PG8_SB(1, 1), cB + kstep, 1);
        PG8_WAIT_V(6); PG8_BAR;
    } else {
        PG8_STAGE_B(PG8_SB(0, 0), cB, 0); PG8_STAGE_A(PG8_SA(0, 0), cA, 0, vc); PG8_STAGE_B(PG8_SB(0, 1), cB, 1); PG8_STAGE_A(PG8_SA(0, 1), cA, 1, vc);
        if (wr == 1) PG8_BAR;
        PG8_WAIT_V(4); PG8_BAR;
        PG8_STAGE_B(PG8_SB(1, 0), cB + kstep, 0); PG8_STAGE_A(PG8_SA(1, 0), cA + kstep, 0, vc); PG8_STAGE_B(PG8_SB(1, 1), cB + kstep, 1);
        PG8_WAIT_V(6); PG8_BAR;
    }
    for (;;) {
        const bool has_next = S.next(ui + 1, nxt);
        const char* nA = has_next ? nxt.a : cA; const char* nB = has_next ? nxt.b : cB;
        if constexpr (Sched::GATHER) {
            if (has_next) {
#pragma unroll
                for (int h = 0; h < 2; ++h)
#pragma unroll
                    for (int i = 0; i < 2; ++i) vn[h][i] = S.rowoff(nxt, RR[i] + 128 * h) + (unsigned)(CC[i] * 2);
            } else {
#pragma unroll
                for (int h = 0; h < 2; ++h)
#pragma unroll
                    for (int i = 0; i < 2; ++i) vn[h][i] = vc[h][i];
            }
        }
        for (int t = 0; t < nt; t += 2) {
            const bool last = (t == nt - 2);
            const char* a1 = cA + (size_t)(t + 1) * kstep;
            const char* a2 = last ? nA : cA + (size_t)(t + 2) * kstep; const char* b2 = last ? nB : cB + (size_t)(t + 2) * kstep;
            const char* a3 = a2 + kstep; const char* b3 = b2 + kstep;
            unsigned v2[2][2];
#pragma unroll
            for (int h = 0; h < 2; ++h)
#pragma unroll
                for (int i = 0; i < 2; ++i) v2[h][i] = last ? vn[h][i] : vc[h][i];
            if constexpr (PG8_SP2) {
            PG8_LDB(B0, 0, 0); PG8_LDB(B1, 0, 1); PG8_SCHED; PG8_LDA(At, 0, 0); PG8_STAGE_A(PG8_SA(1, 1), a1, 1, vc);
            PG8_WAIT_V(8); PG8_WAIT_L(0); PG8_BAR; PG8_MMA(0, 0, At, B0); PG8_MMA(0, 1, At, B1); PG8_BAR; PG8_SCHED;
            PG8_LDA(At, 0, 1); PG8_STAGE_B(PG8_SB(0, 0), b2, 0); PG8_STAGE_B(PG8_SB(0, 1), b2, 1); PG8_STAGE_A(PG8_SA(0, 0), a2, 0, v2);
            PG8_WAIT_V(8); PG8_WAIT_L(0); PG8_BAR; PG8_MMA(1, 0, At, B0); PG8_MMA(1, 1, At, B1); PG8_BAR; PG8_SCHED;
            PG8_LDB(B0, 1, 0); PG8_LDB(B1, 1, 1); PG8_SCHED; PG8_LDA(At, 1, 0); PG8_STAGE_A(PG8_SA(0, 1), a2, 1, v2);
            PG8_WAIT_V(8); PG8_WAIT_L(0); PG8_BAR; PG8_MMA(0, 0, At, B0); PG8_MMA(0, 1, At, B1); PG8_BAR; PG8_SCHED;
            PG8_LDA(At, 1, 1); PG8_STAGE_B(PG8_SB(1, 0), b3, 0); PG8_STAGE_B(PG8_SB(1, 1), b3, 1); PG8_STAGE_A(PG8_SA(1, 0), a3, 0, v2);
            PG8_WAIT_V(8); PG8_WAIT_L(0); PG8_BAR; PG8_MMA(1, 0, At, B0); PG8_MMA(1, 1, At, B1); PG8_BAR; PG8_SCHED;
            } else {
            PG8_LDB(B0, 0, 0); PG8_SCHED; PG8_LDA(At, 0, 0); PG8_STAGE_A(PG8_SA(1, 1), a1, 1, vc);
            PG8_WAIT_L(8); PG8_BAR; PG8_WAIT_L(0); PG8_MMA(0, 0, At, B0); PG8_BAR; PG8_SCHED;
            PG8_LDB(B1, 0, 1); PG8_STAGE_B(PG8_SB(0, 0), b2, 0);
            PG8_BAR; PG8_WAIT_L(0); PG8_MMA(0, 1, At, B1); PG8_BAR;
            PG8_LDA(At, 0, 1); PG8_STAGE_A(PG8_SA(0, 0), a2, 0, v2);
            PG8_BAR; PG8_WAIT_L(0); PG8_MMA(1, 0, At, B0); PG8_BAR; PG8_SCHED;
            PG8_STAGE_B(PG8_SB(0, 1), b2, 1);
            PG8_WAIT_V(6); PG8_BAR; PG8_MMA(1, 1, At, B1); PG8_BAR;
            PG8_LDB(B0, 1, 0); PG8_SCHED; PG8_LDA(At, 1, 0); PG8_STAGE_A(PG8_SA(0, 1), a2, 1, v2);
            PG8_WAIT_L(8); PG8_BAR; PG8_WAIT_L(0); PG8_MMA(0, 0, At, B0); PG8_BAR; PG8_SCHED;
            PG8_LDB(B1, 1, 1); PG8_STAGE_B(PG8_SB(1, 0), b3, 0);
            PG8_BAR; PG8_WAIT_L(0); PG8_MMA(0, 1, At, B1); PG8_BAR;
            PG8_LDA(At, 1, 1); PG8_STAGE_A(PG8_SA(1, 0), a3, 0, v2);
            PG8_BAR; PG8_WAIT_L(0); PG8_MMA(1, 0, At, B0); PG8_BAR; PG8_SCHED;
            PG8_STAGE_B(PG8_SB(1, 1), b3, 1);
            PG8_WAIT_V(6); PG8_BAR; PG8_MMA(1, 1, At, B1); PG8_BAR;
            }
        }
        if constexpr (PG8_ALIGN_EPI) { if (wr == 0) PG8_BAR; }
        E(acc, cur, wr, wc, fr, fq);
        if (!has_next) break;
#pragma unroll
        for (int a = 0; a < 2; ++a)
#pragma unroll
            for (int b = 0; b < 2; ++b)
#pragma unroll
                for (int m = 0; m < 4; ++m)
#pragma unroll
                    for (int n = 0; n < 2; ++n) acc[a][b][m][n] = (f32x4){0.f, 0.f, 0.f, 0.f};
        cur = nxt; cA = nA; cB = nB; ++ui;
        if constexpr (Sched::GATHER) {
#pragma unroll
            for (int h = 0; h < 2; ++h)
#pragma unroll
                for (int i = 0; i < 2; ++i) vc[h][i] = vn[h][i];
        }
        if constexpr (PG8_ALIGN_EPI) { if (wr == 1) PG8_BAR; }
    }
    PG8_WAIT_V(0);
    if constexpr (!PG8_ALIGN_EPI) { if (wr == 0) PG8_BAR; }
    PG8_BAR;
#undef PG8_SA
#undef PG8_SB
#undef PG8_STAGE
#undef PG8_STAGE_A
#undef PG8_STAGE_B
#undef PG8_LDA
#undef PG8_LDB
#undef PG8_MMA
#undef PG8_WAIT_V
#undef PG8_WAIT_L
#undef PG8_BAR
#undef PG8_SCHED
}

struct TileOrder {
    int nM, nN, nwg, G, c;
    DI void init(int nM_, int nN_, int G_, int c_) { nM = nM_; nN = nN_; nwg = nM * nN; G = G_; c = c_; }
    DI bool tile(int i, int& pm, int& pn) const {
        const long L = (long)i * G + c; if (L >= nwg) return false;
        int wgid = (int)L; { const int q = nwg / NXCD, r = nwg % NXCD, xcd = wgid % NXCD, off = wgid / NXCD; wgid = (xcd < r ? xcd * (q + 1) : r * (q + 1) + (xcd - r) * q) + off; }
        const int nig = WGM * nN, gid = wgid / nig, fm = gid * WGM, gsz = (nM - fm) < WGM ? (nM - fm) : WGM;
        pm = fm + ((wgid % nig) % gsz); pn = (wgid % nig) / gsz; return true;
    }
};
}
constexpr size_t AL(size_t x) { return (x + 255) & ~(size_t)255; }
constexpr int MOE_CAP = NTOK;
constexpr int SLOT_ROWS = 2 * NTOK + NEXP * 256;
constexpr int NCHUNK = (CTX + SEQ) / 64;
constexpr size_t WS_CTL    = 0;
constexpr size_t CTL_BYTES = 65536;
constexpr size_t CW_BAR    = 0;
constexpr size_t CW_CNT    = 16384;
constexpr size_t WS_MOD    = AL(WS_CTL + CTL_BYTES);
constexpr size_t WS_ROPE0  = AL(WS_MOD + (size_t)2 * 5 * MODN * 4);
constexpr size_t WS_ROPE1  = AL(WS_ROPE0 + 64 * 16 * 8);
constexpr size_t WS_W0IN   = AL(WS_ROPE1 + 64 * 32 * 8);
constexpr size_t WS_WUQ    = AL(WS_W0IN + (size_t)L0INP * DM * 2);
constexpr size_t WS_WUKV   = AL(WS_WUQ + (size_t)1536 * 512 * 2);
constexpr size_t WS_W0OUT  = AL(WS_WUKV + (size_t)2048 * 256 * 2);
constexpr size_t WS_W1IN   = AL(WS_W0OUT + (size_t)DM * DM * 2);
constexpr size_t WS_W1OUT  = AL(WS_W1IN + (size_t)L1IN * DM * 2);
constexpr size_t EXPW      = (size_t)NEXP * EFF * DM * 2;
constexpr size_t WS_EG     = AL(WS_W1OUT + (size_t)DM * DM * 2);
constexpr size_t WS_EU     = AL(WS_EG + 2 * EXPW);
constexpr size_t WS_ED     = AL(WS_EU + 2 * EXPW);
constexpr size_t WS_GW     = AL(WS_ED + 2 * EXPW);
constexpr size_t WS_XA     = AL(WS_GW + (size_t)2 * 16 * 128 * 128 * 2);
constexpr size_t WS_XB     = AL(WS_XA + (size_t)NTOK * DM * 4);
constexpr size_t WS_H      = AL(WS_XB + (size_t)NTOK * DM * 4);
constexpr size_t WS_Z      = AL(WS_H + (size_t)NTOK * DM * 2);
constexpr size_t WS_CQN    = AL(WS_Z + (size_t)NTOK * L1IN * 2);
constexpr size_t WS_CKVN   = AL(WS_CQN + (size_t)NTOK * 512 * 2);
constexpr size_t WS_KR     = AL(WS_CKVN + (size_t)NTOK * 256 * 2);
constexpr size_t WS_Q0     = AL(WS_KR + (size_t)NTOK * 64 * 2);
constexpr size_t WS_KV0    = AL(WS_Q0 + (size_t)NTOK * 1536 * 2);
constexpr size_t WS_Y      = AL(WS_KV0 + (size_t)NTOK * 2048 * 2);
constexpr size_t WS_SUMM   = AL(WS_Y + (size_t)NTOK * DM * 2);
constexpr size_t WS_CARRY  = AL(WS_SUMM + (size_t)2 * NB * NCHUNK * 1024 * 8);
constexpr size_t WS_LIST   = AL(WS_CARRY + (size_t)2 * NB * NCHUNK * 1024 * 4);
constexpr size_t WS_TOK    = AL(WS_LIST + (size_t)NEXP * MOE_CAP * 4);
constexpr size_t WS_ACT    = AL(WS_TOK + (size_t)NTOK * 32);
constexpr size_t WS_OUT2   = AL(WS_ACT + (size_t)SLOT_ROWS * EFF * 2);
constexpr size_t WS_D      = AL(WS_OUT2 + (size_t)SLOT_ROWS * DM * 2);
constexpr size_t WS_ABG    = AL(WS_D + (size_t)NTOK * DM * 2);
constexpr size_t WS_END    = AL(WS_ABG + (size_t)NB * NCHUNK * 8 * 2 * 64 * 128 * 4);

struct TokInfo { int e0, p0, e1, p1; float w0, w1; int pad0, pad1; };

constexpr int LDS_STAGE = 0;
constexpr int LDS_MISC  = 139264;
constexpr int LDS_BYTES = 139264 + 4096;

struct Params { const float* in[38]; float* out; unsigned char* ws; int ph_lo, ph_hi, flags, pad; };

struct Frame {
    const float* const* in; float* out; unsigned char* ws; LAS unsigned char* lds;
    int tid, lane, wave, G, bid;
};
struct CvtJob { const float* src; bf16_t* dst; int K, N, ldo, perm, tiles_per_b, tile0; size_t sstride, dstride; };

DI int l1_permrow(int n) {
    if (n >= 1280) return n;
    const int hb = n & ~127, d = n & 127, a = d >> 6, part = (d >> 5) & 1, i = d & 31;
    return hb + 64 * a + 32 * (i >> 4) + 16 * part + (i & 15);
}

DI void set_job(LAS CvtJob* J, int j, const float* src, bf16_t* dst, int K, int N, int ldo, int perm, int nb, size_t ss, size_t ds, int& t0) {
    J[j].src = src; J[j].dst = dst; J[j].K = K; J[j].N = N; J[j].ldo = ldo; J[j].perm = perm; J[j].tiles_per_b = (K / 64) * ((N + 255) / 256); J[j].tile0 = t0;
    J[j].sstride = ss; J[j].dstride = ds; t0 += nb * J[j].tiles_per_b;
}

struct CvtTile { const float* src; bf16_t* dst; int N, ldo, k0, n0, nw, perm; };
DI void cvt_decode(LAS CvtJob* J, int nj, int gt, CvtTile& t) {
    int j = 0;
#pragma unroll 1
    for (int q = 1; q < nj; ++q) if (gt >= J[q].tile0) j = q;
    const int rem = gt - J[j].tile0, tpb = J[j].tiles_per_b, b = rem / tpb, r2 = rem % tpb;
    t.N = J[j].N; t.ldo = J[j].ldo; const int nst = (t.N + 255) / 256, kt = r2 / nst, st = r2 % nst; t.perm = J[j].perm;
    t.src = J[j].src + (size_t)b * J[j].sstride; t.dst = J[j].dst + (size_t)b * J[j].dstride;
    t.k0 = kt * 64; t.n0 = st * 256; t.nw = min(256, t.N - t.n0);
}
constexpr int MOE_CVT_TILES = 3 * NEXP * 64;
#ifndef BG_L0_P2
#define BG_L0_P2 960
#endif
#ifndef BG_L0_P6
#define BG_L0_P6 3960
#endif
#define BG_L1_DOWN0 4096
#ifndef BG_L0_P7
#define BG_L0_P7 (BG_L0_P6 + 768)
#endif
#ifndef BG_L1_P8
#define BG_L1_P8 2400
#endif
#ifndef BG_L1_P11
#define BG_L1_P11 4096
#endif
DI void cvt_group(const Params& p, LAS unsigned char* lds, int group, int t_lo, int t_hi, int r, int I) {
    const int tid = threadIdx.x;
    unsigned char* ws = p.ws;
    __syncthreads();
    LAS CvtJob* J = (LAS CvtJob*)(lds + 72 * 1024);
    LAS float* tile = (LAS float*)lds;
    if (tid == 0) {
        int t0 = 0, nj = 0;
        if (group == 0) {
            set_job(J, 0, p.in[11], (bf16_t*)(ws + WS_W0IN), DM, L0IN, DM, 0, 1, 0, 0, t0);
            set_job(J, 1, p.in[13], (bf16_t*)(ws + WS_WUQ), 512, 1536, 512, 0, 1, 0, 0, t0);
            set_job(J, 2, p.in[15], (bf16_t*)(ws + WS_WUKV), 256, 2048, 256, 0, 1, 0, 0, t0);
            set_job(J, 3, p.in[23], (bf16_t*)(ws + WS_W0OUT), DM, DM, DM, 0, 1, 0, 0, t0);
            set_job(J, 4, p.in[31], (bf16_t*)(ws + WS_W1IN), DM, L1IN, DM, 1, 1, 0, 0, t0);
            set_job(J, 5, p.in[34], (bf16_t*)(ws + WS_W1OUT), DM, DM, DM, 0, 1, 0, 0, t0);
            set_job(J, 6, p.in[18], (bf16_t*)(ws + WS_GW), 128, 128, 128, 0, 16, 128 * 128, 128 * 128, t0);
            set_job(J, 7, p.in[20], (bf16_t*)(ws + WS_GW + (size_t)16 * 128 * 128 * 2), 128, 128, 128, 0, 16, 128 * 128, 128 * 128, t0);
            nj = 8;
        } else if (group == 1) {
            set_job(J, 0, p.in[24], (bf16_t*)(ws + WS_EG), DM, EFF, DM, 0, NEXP, (size_t)DM * EFF, (size_t)EFF * DM, t0);
            set_job(J, 1, p.in[25], (bf16_t*)(ws + WS_EU), DM, EFF, DM, 0, NEXP, (size_t)DM * EFF, (size_t)EFF * DM, t0);
            set_job(J, 2, p.in[26], (bf16_t*)(ws + WS_ED), EFF, DM, EFF, 0, NEXP, (size_t)DM * EFF, (size_t)EFF * DM, t0);
            nj = 3;
        } else {
            set_job(J, 0, p.in[35], (bf16_t*)(ws + WS_EG + EXPW), DM, EFF, DM, 0, NEXP, (size_t)DM * EFF, (size_t)EFF * DM, t0);
            set_job(J, 1, p.in[36], (bf16_t*)(ws + WS_EU + EXPW), DM, EFF, DM, 0, NEXP, (size_t)DM * EFF, (size_t)EFF * DM, t0);
            set_job(J, 2, p.in[37], (bf16_t*)(ws + WS_ED + EXPW), EFF, DM, EFF, 0, NEXP, (size_t)DM * EFF, (size_t)EFF * DM, t0);
            nj = 3;
        }
        J[nj].tile0 = t0; J[15].tile0 = nj;
    }
    __syncthreads();
    const int nj = J[15].tile0, total = J[nj].tile0;
    const int hi = min(t_hi, total);
    const int row = tid >> 6, c4 = (tid & 63) * 4;
    for (int gt = t_lo + r; gt < hi; gt += I) {
        CvtTile cur; cvt_decode(J, nj, gt, cur);
        if (c4 < cur.nw) {
            f32x4 v[8];
#pragma unroll
            for (int i = 0; i < 8; ++i) v[i] = *(const f32x4*)(cur.src + (size_t)(cur.k0 + row + 8 * i) * cur.N + cur.n0 + c4);
#pragma unroll
            for (int i = 0; i < 8; ++i) *(LAS f32x4*)(tile + (row + 8 * i) * 260 + c4) = v[i];
        }
        __syncthreads();
        { const int n = tid & 255, kh = tid >> 8;
          if (n < cur.nw) {
              const int orow = cur.perm ? l1_permrow(cur.n0 + n) : (cur.n0 + n);
#pragma unroll
              for (int q8 = 0; q8 < 4; ++q8) {
                  float w8[8];
#pragma unroll
                  for (int q = 0; q < 8; ++q) w8[q] = tile[(32 * kh + 8 * q8 + q) * 260 + n];
                  u32x4 w; w.x = pk_bf16(w8[0], w8[1]); w.y = pk_bf16(w8[2], w8[3]); w.z = pk_bf16(w8[4], w8[5]); w.w = pk_bf16(w8[6], w8[7]);
                  *(u32x4*)(cur.dst + (size_t)orow * cur.ldo + cur.k0 + 32 * kh + 8 * q8) = w;
              }
          } }
        __syncthreads();
    }
}
DI void bg_range(const Params& p, LAS unsigned char* lds, int group, int t_lo, int t_hi, int nunits, int G, int bid) {
    const int rem = nunits % G;
    if (rem == 0) cvt_group(p, lds, group, t_lo, t_hi, bid, G);
    else if (bid >= rem) cvt_group(p, lds, group, t_lo, t_hi, bid - rem, G - rem);
}
DI int bg_end(int t_lo, int nunits, int per_wg, int G) { const int rem = nunits % G; if (rem == 0) return t_lo; return min(t_lo + (G - rem) * per_wg, MOE_CVT_TILES); }
DI int bg_convert(const Params& p, LAS unsigned char* lds, int group, int t_lo, int nunits, int per_wg, int G, int bid) {
    const int rem = nunits % G;
    if (rem == 0) return t_lo;
    const int idle = G - rem, t_hi = min(t_lo + idle * per_wg, MOE_CVT_TILES);
    if (bid >= rem && t_hi > t_lo) cvt_group(p, lds, group, t_lo, t_hi, bid - rem, idle);
    return t_hi;
}

DI void phase_prologue(const Params& p, LAS unsigned char* lds, int G, int bid) {
    const int tid = threadIdx.x;
    unsigned char* ws = p.ws;
    {
        LAS float* s = (LAS float*)lds;
        LAS float* part = (LAS float*)(lds + 40960);
        for (int i = tid; i < 5 * DM; i += NTHREADS) { const int r = i / DM, k = i % DM; const float c = r < 4 ? p.in[1][r * DM + k] : p.in[3][k]; s[i] = c / (1.0f + __expf(-c)); }
        __syncthreads();
        float* MOD = (float*)(ws + WS_MOD);
        for (int chunk = bid; chunk < 256; chunk += G) {
            const int layer = chunk >> 7, n0 = (chunk & 127) * 96;
            const float* W = layer ? p.in[27] : p.in[7]; const float* bias = layer ? p.in[28] : p.in[8];
            const int cg = tid % 24, ks = tid / 24;
            if (ks < 16) {
                f32x4 acc[5];
#pragma unroll
                for (int r = 0; r < 5; ++r) acc[r] = (f32x4){0.f, 0.f, 0.f, 0.f};
                const float* wp = W + (size_t)(ks * 128) * MODN + n0 + 4 * cg;
                for (int k = 0; k < 128; k += 8) {
                    f32x4 w[8];
#pragma unroll
                    for (int j = 0; j < 8; ++j) w[j] = *(const f32x4*)(wp + (size_t)(k + j) * MODN);
#pragma unroll
                    for (int j = 0; j < 8; ++j)
#pragma unroll
                        for (int r = 0; r < 5; ++r) acc[r] += s[r * DM + ks * 128 + k + j] * w[j];
                }
#pragma unroll
                for (int r = 0; r < 5; ++r)
#pragma unroll
                    for (int j = 0; j < 4; ++j) part[(ks * 5 + r) * 96 + cg * 4 + j] = acc[r][j];
            }
            __syncthreads();
            if (tid < 480) {
                const int r = tid / 96, col = tid % 96; float a = bias[n0 + col];
#pragma unroll
                for (int k2 = 0; k2 < 16; ++k2) a += part[(k2 * 5 + r) * 96 + col];
                MOD[((size_t)layer * 5 + r) * MODN + n0 + col] = a;
            }
            __syncthreads();
        }
    }
    {
        f32x2* R0 = (f32x2*)(ws + WS_ROPE0); f32x2* R1 = (f32x2*)(ws + WS_ROPE1);
        for (int i = bid * NTHREADS + tid; i < 64 * 16 + 64 * 32; i += G * NTHREADS) {
            if (i < 64 * 16) { const int pos = i >> 4, k = i & 15; const float ang = (float)pos * exp2f(-(float)k * (13.287712379549449f / 16.0f)); R0[i] = (f32x2){cosf(ang), sinf(ang)}; }
            else { const int j = i - 64 * 16, pos = j >> 5, k = j & 31; const float ang = (float)pos * exp2f(-(float)k * (13.287712379549449f / 32.0f)); R1[j] = (f32x2){cosf(ang), sinf(ang)}; }
        }
        u32x4* z = (u32x4*)(ws + WS_W0IN + (size_t)L0IN * DM * 2);
        for (int i = bid * NTHREADS + tid; i < (L0INP - L0IN) * DM * 2 / 16; i += G * NTHREADS) z[i] = (u32x4){0u, 0u, 0u, 0u};
    }
    cvt_group(p, lds, 0, 0, 1 << 30, bid, G);
    cvt_group(p, lds, 1, BG_L0_P7, MOE_CVT_TILES, bid, G);
    cvt_group(p, lds, 2, BG_L1_P11, BG_L1_DOWN0, bid, G);
}

DI void norm_mod_store(const f32x4 (&v)[8], const float* gain, const float* shift, const float* scale, bf16_t* hrow, int lane) {
    float ss = 0.f;
#pragma unroll
    for (int i = 0; i < 8; ++i) ss += v[i][0] * v[i][0] + v[i][1] * v[i][1] + v[i][2] * v[i][2] + v[i][3] * v[i][3];
    ss = wave_sum(ss);
    const float r = rsqrtf(ss * (1.0f / DM) + EPS);
#pragma unroll
    for (int i = 0; i < 8; ++i) {
        const int col = 4 * lane + 256 * i;
        const f32x4 g = *(const f32x4*)(gain + col), sh = *(const f32x4*)(shift + col), sc = *(const f32x4*)(scale + col);
        const f32x4 h = (v[i] * r * g) * (1.0f + sc) + sh;
        u32x2 w; w.x = pk_bf16(h[0], h[1]); w.y = pk_bf16(h[2], h[3]);
        *(u32x2*)(hrow + col) = w;
    }
}

DI void phase_norm0(const Params& p, int G, int bid) {
    const int lane = threadIdx.x & 63, wave = threadIdx.x >> 6;
    const float* MOD = (const float*)(p.ws + WS_MOD);
    bf16_t* H = (bf16_t*)(p.ws + WS_H);
    for (int row = bid * 8 + wave; row < NTOK; row += G * 8) {
        const float* xr = row < NCTX ? p.in[2] + (size_t)row * DM : p.in[0] + (size_t)(row - NCTX) * DM;
        f32x4 v[8];
#pragma unroll
        for (int i = 0; i < 8; ++i) v[i] = *(const f32x4*)(xr + 4 * lane + 256 * i);
        const float* md = MOD + (size_t)row_mod(row) * MODN;
        norm_mod_store(v, p.in[9], md, md + DM, H + (size_t)row * DM, lane);
    }
}
DI void phase_l0_rows(const Params& p, int G, int bid) {
    const int lane = threadIdx.x & 63, wave = threadIdx.x >> 6;
    const bf16_t* Z = (const bf16_t*)(p.ws + WS_Z);
    bf16_t* CQN = (bf16_t*)(p.ws + WS_CQN); bf16_t* CKVN = (bf16_t*)(p.ws + WS_CKVN); bf16_t* KR = (bf16_t*)(p.ws + WS_KR);
    const f32x2* R0 = (const f32x2*)(p.ws + WS_ROPE0);
    for (int row = bid * 8 + wave; row < NTOK; row += G * 8) {
        const bf16_t* z = Z + (size_t)row * L0INP;
        {
            const u32x4 w = *(const u32x4*)(z + 8 * lane);
            float v[8] = {bflo(w.x), bfhi(w.x), bflo(w.y), bfhi(w.y), bflo(w.z), bfhi(w.z), bflo(w.w), bfhi(w.w)};
            float ss = 0.f;
#pragma unroll
            for (int j = 0; j < 8; ++j) ss += v[j] * v[j];
            ss = wave_sum(ss);
            const float r = rsqrtf(ss * (1.0f / 512.0f) + EPS);
            const f32x4 g0 = *(const f32x4*)(p.in[12] + 8 * lane), g1 = *(const f32x4*)(p.in[12] + 8 * lane + 4);
            u32x4 o; o.x = pk_bf16(v[0] * r * g0[0], v[1] * r * g0[1]); o.y = pk_bf16(v[2] * r * g0[2], v[3] * r * g0[3]);
            o.z = pk_bf16(v[4] * r * g1[0], v[5] * r * g1[1]); o.w = pk_bf16(v[6] * r * g1[2], v[7] * r * g1[3]);
            *(u32x4*)(CQN + (size_t)row * 512 + 8 * lane) = o;
        }
        {
            const u32x2 w = *(const u32x2*)(z + 512 + 4 * lane);
            float v[4] = {bflo(w.x), bfhi(w.x), bflo(w.y), bfhi(w.y)};
            float ss = v[0] * v[0] + v[1] * v[1] + v[2] * v[2] + v[3] * v[3];
            ss = wave_sum(ss);
            const float r = rsqrtf(ss * (1.0f / 256.0f) + EPS);
            const f32x4 g = *(const f32x4*)(p.in[14] + 4 * lane);
            u32x2 o; o.x = pk_bf16(v[0] * r * g[0], v[1] * r * g[1]); o.y = pk_bf16(v[2] * r * g[2], v[3] * r * g[3]);
            *(u32x2*)(CKVN + (size_t)row * 256 + 4 * lane) = o;
        }
        {
            const float x = bf2f(z[768 + lane]);
            const float xp = __shfl_xor(x, 16);
            float o = x;
            if (row >= NCTX) {
                const int t = (row - NCTX) & (SEQ - 1), axis = lane >> 5, part = (lane >> 4) & 1, i = lane & 15;
                const int pos = axis ? (t & 63) : (t >> 6);
                const f32x2 cs = R0[pos * 16 + i];
                o = part ? (x * cs[0] + xp * cs[1]) : (x * cs[0] - xp * cs[1]);
            }
            KR[(size_t)row * 64 + lane] = f2bf(o);
        }
    }
}

DI float gelu_tanh(float x) { const float u = 0.7978845608028654f * (x + 0.044715f * x * x * x); const float e = __expf(2.0f * u); const float th = 1.0f - 2.0f / (e + 1.0f); return 0.5f * x * (1.0f + th); }

template <int PASS>
DI void lru_units(const Params& p, LAS unsigned char* lds, int G, int bid) {
    const int tid = threadIdx.x, lane = tid & 63, wave = tid >> 6;
    const bf16_t* Z = (const bf16_t*)(p.ws + WS_Z);
    const bf16_t* GWA = (const bf16_t*)(p.ws + WS_GW); const bf16_t* GWX = GWA + 16 * 128 * 128;
    f32x2* SUMM = (f32x2*)(p.ws + WS_SUMM); const float* CARRY = (const float*)(p.ws + WS_CARRY);
    bf16_t* Y = (bf16_t*)(p.ws + WS_Y);
    unsigned* ABG = (unsigned*)(p.ws + WS_ABG);
    LAS float* U32 = (LAS float*)lds;
    LAS unsigned char* UBF = lds + 32768;
    LAS f32x2* AB = (LAS f32x2*)lds;
    const bool by_n = (G % 8) == 0;
    const int n_fix = bid & 7, nW = by_n ? G / 8 : G, q0 = by_n ? bid >> 3 : bid, nunits = by_n ? NCHUNK * NB : NCHUNK * NB * 8;
    const int d = wave >> 2, nt = wave & 3, jl = lane & 31, h = lane >> 5, ch = 32 * nt + jl;
    bf16x8 wa[8], wx[8];
    if (by_n) {
        const bf16_t* pa = GWA + ((size_t)(d * 8 + n_fix) * 128 + ch) * 128 + 8 * h;
        const bf16_t* px = GWX + ((size_t)(d * 8 + n_fix) * 128 + ch) * 128 + 8 * h;
#pragma unroll
        for (int ks = 0; ks < 8; ++ks) { wa[ks] = *(const bf16x8*)(pa + 16 * ks); wx[ks] = *(const bf16x8*)(px + 16 * ks); }
    }
    for (int v = q0; v < nunits; v += nW) {
        const int n = by_n ? n_fix : (v & 7), bc = by_n ? v : (v >> 3), b = bc & 3, ci = bc >> 2;
        const int seg_len = ci < 4 ? CTX : SEQ, t0 = ci < 4 ? 64 * ci : 64 * (ci - 4);
        const int row0 = ci < 4 ? b * CTX + t0 : NCTX + b * SEQ + t0;
        const int chg = 128 * n + ch;
        if (!by_n) {
            const bf16_t* pa = GWA + ((size_t)(d * 8 + n) * 128 + ch) * 128 + 8 * h;
            const bf16_t* px = GWX + ((size_t)(d * 8 + n) * 128 + ch) * 128 + 8 * h;
#pragma unroll
            for (int ks = 0; ks < 8; ++ks) { wa[ks] = *(const bf16x8*)(pa + 16 * ks); wx[ks] = *(const bf16x8*)(px + 16 * ks); }
        }
        u32x2 grw[4];
        {
            const int c4 = (tid & 31) * 4, tb = 4 * (tid >> 5), cg = 128 * n + c4;
            f32x4 xv[7];
#pragma unroll
            for (int q = 0; q < 7; ++q) { const int tt = t0 + tb + q - 2; u32x2 w = (u32x2){0u, 0u};
                if (tt >= 0 && tt < seg_len) w = *(const u32x2*)(Z + (size_t)(row0 + tb + q - 2) * L0INP + 832 + cg);
                xv[q] = (f32x4){bflo(w.x), bfhi(w.x), bflo(w.y), bfhi(w.y)}; }
            if (PASS == 2) {
#pragma unroll
                for (int j = 0; j < 4; ++j) grw[j] = *(const u32x2*)(Z + (size_t)(row0 + tb + j) * L0INP + 1856 + cg);
            }
            const f32x4 cb = *(const f32x4*)(p.in[17] + cg);
            f32x4 cw[4];
#pragma unroll
            for (int tap = 0; tap < 4; ++tap) cw[tap] = *(const f32x4*)(p.in[16] + tap * 1024 + cg);
#pragma unroll
            for (int j = 0; j < 4; ++j) {
                const f32x4 acc = cb + xv[j] * cw[0] + xv[j + 1] * cw[1] + xv[j + 2] * cw[2] + xv[j + 3] * cw[3];
                *(LAS f32x4*)(U32 + (tb + j) * 128 + c4) = acc;
                u32x2 o; o.x = pk_bf16(acc[0], acc[1]); o.y = pk_bf16(acc[2], acc[3]);
                *(LAS u32x2*)(UBF + (tb + j) * 272 + c4 * 2) = o;
            }
        }
        __syncthreads();
        f32x16 acc[2][2];
#pragma unroll
        for (int g = 0; g < 2; ++g)
#pragma unroll
            for (int mt = 0; mt < 2; ++mt)
#pragma unroll
                for (int i = 0; i < 16; ++i) acc[g][mt][i] = 0.f;
#pragma unroll
        for (int ks = 0; ks < 8; ++ks) {
            const bf16x8 a0 = *(const LAS bf16x8*)(UBF + jl * 272 + (16 * ks + 8 * h) * 2);
            const bf16x8 a1 = *(const LAS bf16x8*)(UBF + (32 + jl) * 272 + (16 * ks + 8 * h) * 2);
            acc[0][0] = __builtin_amdgcn_mfma_f32_32x32x16_bf16(a0, wa[ks], acc[0][0], 0, 0, 0);
            acc[0][1] = __builtin_amdgcn_mfma_f32_32x32x16_bf16(a1, wa[ks], acc[0][1], 0, 0, 0);
            acc[1][0] = __builtin_amdgcn_mfma_f32_32x32x16_bf16(a0, wx[ks], acc[1][0], 0, 0, 0);
            acc[1][1] = __builtin_amdgcn_mfma_f32_32x32x16_bf16(a1, wx[ks], acc[1][1], 0, 0, 0);
        }
        {
            const float ga_b = p.in[19][d * 1024 + chg], gx_b = p.in[21][d * 1024 + chg], lam = p.in[22][d * 1024 + chg];
            const float sp8l2 = 8.0f * LOG2E * log1pf(expf(-lam));
#pragma unroll
            for (int mt = 0; mt < 2; ++mt)
#pragma unroll
                for (int i = 0; i < 16; ++i) {
                    const int t = 32 * mt + (i & 3) + 8 * (i >> 2) + 4 * h;
                    const float r = __builtin_amdgcn_rcpf(1.0f + __builtin_amdgcn_exp2f(-LOG2E * (acc[0][mt][i] + ga_b)));
                    const float ig = __builtin_amdgcn_rcpf(1.0f + __builtin_amdgcn_exp2f(-LOG2E * (acc[1][mt][i] + gx_b)));
                    const float a = __builtin_amdgcn_exp2f(-sp8l2 * r);
                    const float bb = __builtin_amdgcn_sqrtf((1.0f - a) * (1.0f + a)) * (ig * U32[t * 128 + ch]);
                    acc[0][mt][i] = a; acc[1][mt][i] = bb;
                }
        }
        __syncthreads();
#pragma unroll
        for (int mt = 0; mt < 2; ++mt)
#pragma unroll
            for (int i = 0; i < 16; ++i) { const int t = 32 * mt + (i & 3) + 8 * (i >> 2) + 4 * h; AB[(d * 64 + t) * 128 + ch] = (f32x2){acc[0][mt][i], acc[1][mt][i]};
                if (PASS == 1) ABG[((((size_t)(b * NCHUNK + ci) * 8 + n) * 2 + d) * 64 + t) * 128 + ch] = pk_bf16(1.0f - acc[0][mt][i], acc[1][mt][i]); }
        __syncthreads();
        if (tid < 256) {
            const int sd = tid >> 7, sc = tid & 127;
            const size_t sidx = ((size_t)(sd * NB + b) * NCHUNK + ci) * 1024 + 128 * n + sc;
            if (PASS == 1) {
                float hh = 0.f, ap = 1.f;
#pragma unroll 16
                for (int s2 = 0; s2 < 64; ++s2) { const int t = sd ? 63 - s2 : s2; const f32x2 ab = AB[(sd * 64 + t) * 128 + sc]; hh = ab[0] * hh + ab[1]; ap *= ab[0]; }
                SUMM[sidx] = (f32x2){ap, hh};
            } else {
                float hh = CARRY[sidx];
#pragma unroll 16
                for (int s2 = 0; s2 < 64; ++s2) { const int t = sd ? 63 - s2 : s2; const f32x2 ab = AB[(sd * 64 + t) * 128 + sc]; hh = ab[0] * hh + ab[1]; AB[(sd * 64 + t) * 128 + sc] = (f32x2){ab[0], hh}; }
            }
        }
        __syncthreads();
        if (PASS == 2) {
            const int c4 = (tid & 31) * 4, tb = 4 * (tid >> 5);
#pragma unroll
            for (int j = 0; j < 4; ++j) {
                const int t = tb + j; const size_t row = (size_t)(row0 + t);
                const float gr[4] = {bflo(grw[j].x), bfhi(grw[j].x), bflo(grw[j].y), bfhi(grw[j].y)};
                float y[4];
#pragma unroll
                for (int k = 0; k < 4; ++k) y[k] = (AB[(t) * 128 + c4 + k][1] + AB[(64 + t) * 128 + c4 + k][1]) * gelu_tanh(gr[k]);
                u32x2 o; o.x = pk_bf16(y[0], y[1]); o.y = pk_bf16(y[2], y[3]);
                *(u32x2*)(Y + row * DM + 1024 + 128 * n + c4) = o;
            }
            __syncthreads();
        }
    }
}

DI void lru_pass2(const Params& p, LAS unsigned char* lds, int G, int bid) {
    const int tid = threadIdx.x;
    const bf16_t* Z = (const bf16_t*)(p.ws + WS_Z);
    const unsigned* ABG = (const unsigned*)(p.ws + WS_ABG); const float* CARRY = (const float*)(p.ws + WS_CARRY);
    bf16_t* Y = (bf16_t*)(p.ws + WS_Y);
    LAS float* HB = (LAS float*)lds;
    for (int u = bid; u < NCHUNK * NB * 8; u += G) {
        const int n = u & 7, bc = u >> 3, b = bc & 3, ci = bc >> 2;
        const int t0 = ci < 4 ? 64 * ci : 64 * (ci - 4);
        const int row0 = ci < 4 ? b * CTX + t0 : NCTX + b * SEQ + t0;
        const int c4 = (tid & 31) * 4, tb = 4 * (tid >> 5), cg = 128 * n + c4;
        u32x2 grw[4];
#pragma unroll
        for (int j = 0; j < 4; ++j) grw[j] = *(const u32x2*)(Z + (size_t)(row0 + tb + j) * L0INP + 1856 + cg);
        if (tid < 256) {
            const int sd = tid >> 7, sc = tid & 127;
            const unsigned* ab = ABG + ((((size_t)(b * NCHUNK + ci) * 8 + n) * 2 + sd) * 64) * 128 + sc;
            unsigned w[64];
#pragma unroll
            for (int t = 0; t < 64; ++t) w[t] = ab[t * 128];
            float hh = CARRY[((size_t)(sd * NB + b) * NCHUNK + ci) * 1024 + 128 * n + sc];
            if (sd == 0) {
#pragma unroll
                for (int t = 0; t < 64; ++t) { hh = fmaf(1.0f - bflo(w[t]), hh, bfhi(w[t])); HB[t * 128 + sc] = hh; }
            } else {
#pragma unroll
                for (int t = 63; t >= 0; --t) { hh = fmaf(1.0f - bflo(w[t]), hh, bfhi(w[t])); HB[(64 + t) * 128 + sc] = hh; }
            }
        }
        __syncthreads();
#pragma unroll
        for (int j = 0; j < 4; ++j) {
            const int t = tb + j; const size_t row = (size_t)(row0 + t);
            const float gr[4] = {bflo(grw[j].x), bfhi(grw[j].x), bflo(grw[j].y), bfhi(grw[j].y)};
            const f32x4 hf = *(const LAS f32x4*)(HB + t * 128 + c4), hb = *(const LAS f32x4*)(HB + (64 + t) * 128 + c4);
            float y[4];
#pragma unroll
            for (int k = 0; k < 4; ++k) y[k] = (hf[k] + hb[k]) * gelu_tanh(gr[k]);
            u32x2 o; o.x = pk_bf16(y[0], y[1]); o.y = pk_bf16(y[2], y[3]);
            *(u32x2*)(Y + row * DM + 1024 + 128 * n + c4) = o;
        }
        __syncthreads();
    }
}

DI void lru_carry(const Params& p, int G, int bid) {
    const f32x2* SUMM = (const f32x2*)(p.ws + WS_SUMM); float* CARRY = (float*)(p.ws + WS_CARRY);
    for (int gid = bid * NTHREADS + threadIdx.x; gid < 2 * NB * 1024; gid += G * NTHREADS) {
        const int d = gid >> 12, b = (gid >> 10) & 3, ch = gid & 1023;
        const size_t base = ((size_t)(d * NB + b) * NCHUNK) * 1024 + ch;
        float hh = 0.f;
#pragma unroll
        for (int pos = 0; pos < NCHUNK; ++pos) {
            const int ci = d == 0 ? pos : (pos < 4 ? 3 - pos : 39 - pos);
            CARRY[base + (size_t)ci * 1024] = hh;
            const f32x2 s = SUMM[base + (size_t)ci * 1024];
            hh = s[0] * hh + s[1];
        }
    }
}
#define MFMA32(a, b, c) __builtin_amdgcn_mfma_f32_32x32x16_bf16((a), (b), (c), 0, 0, 0)
constexpr int AT_KSLOT = 24576, AT_VSLOT = 16384, AT_K0 = 0, AT_V0 = 2 * AT_KSLOT, AT_XOFF = AT_V0 + 2 * AT_VSLOT;

#ifndef AT_PIPE_MLA
#define AT_PIPE_MLA false
#endif
#ifndef AT_PIPE_WIN
#define AT_PIPE_WIN false
#endif
#ifndef AT_PIPE_NA
#define AT_PIPE_NA false
#endif
#ifndef AT_SKEW_MLA
#define AT_SKEW_MLA 0
#endif
#ifndef AT_SKEW_WIN
#define AT_SKEW_WIN 0
#endif
#ifndef AT_SKEW_NA
#define AT_SKEW_NA 0
#endif
constexpr float AT_M0 = -30.0f;
struct NoBias { DI float operator()(int, float nm) const { return nm; } };

struct AtRd { int kbase, kbase1, ko[4], vbase, vo[4]; };
template <int DQ> DI int at_kf(int r) { return DQ == 128 ? (r & 15) : ((r >> 1) & 7); }
template <int DQ>
DI AtRd at_rd_init(int lane) {
    AtRd r; const int kr = lane & 31, h = lane >> 5, i16 = lane & 15, q = i16 >> 2, pp = i16 & 3, blk = (lane >> 4) & 1;
    const int f = at_kf<DQ>(kr);
    r.kbase = kr * (DQ * 2) + ((f >> 3) << 7); r.kbase1 = kr * (DQ * 2) + (((f >> 3) ^ 1) << 7);
#pragma unroll
    for (int i = 0; i < 4; ++i) r.ko[i] = ((2 * i + h) ^ (f & 7)) << 4;
    r.vbase = (4 * h + q) * 256 + 8 * pp;
#pragma unroll
    for (int t = 0; t < 4; ++t) r.vo[t] = ((2 * t + blk) ^ ((4 * h + q) & 7)) << 5;
    return r;
}
template <int DQ>
DI void at_qk(const LAS unsigned char* ks, const AtRd& rd, const bf16x8 (&qf)[DQ / 16], f32x16& s0, f32x16& s1) {
#pragma unroll
    for (int i = 0; i < 16; ++i) { s0[i] = 0.f; s1[i] = 0.f; }
    const LAS unsigned char* kp0 = ks + rd.kbase; const LAS unsigned char* kp1 = ks + rd.kbase1;
#pragma unroll
    for (int s = 0; s < DQ / 16; ++s) {
        const LAS unsigned char* kp = (DQ == 128) ? ((s >> 2) ? kp1 : kp0) : kp0 + ((s >> 2) << 7);
        const bf16x8 a0 = *(const LAS bf16x8*)(kp + rd.ko[s & 3]);
        const bf16x8 a1 = *(const LAS bf16x8*)(kp + 32 * (DQ * 2) + rd.ko[s & 3]);
        s0 = MFMA32(a0, qf[s], s0); s1 = MFMA32(a1, qf[s], s1);
    }
}
template <class BiasFn>
DI void at_sm(f32x16& s0, f32x16& s1, f32x16 (&o)[4], float& m, float& l, const float c2, const BiasFn& bias, const int lane, bf16x8 (&pf)[4]) {
    const int h = lane >> 5;
    const float nm = -m;
    float mx = -INFINITY;
#pragma unroll
    for (int i = 0; i < 16; ++i) {
        const int key = (i & 3) + 8 * (i >> 2) + 4 * h;
        s0[i] = fmaf(s0[i], c2, bias(key, nm)); s1[i] = fmaf(s1[i], c2, bias(32 + key, nm));
        mx = fmaxf(mx, fmaxf(s0[i], s1[i]));
    }
    { const auto sw = __builtin_amdgcn_permlane32_swap(__float_as_uint(mx), __float_as_uint(mx), false, false); mx = fmaxf(__uint_as_float(sw[0]), __uint_as_float(sw[1])); }
    if (__any(mx > 8.0f)) {
        const float d = fmaxf(mx, 0.f), alpha = __builtin_amdgcn_exp2f(-d);
        m += d; l *= alpha;
#pragma unroll
        for (int t = 0; t < 4; ++t)
#pragma unroll
            for (int i = 0; i < 16; ++i) o[t][i] *= alpha;
#pragma unroll
        for (int i = 0; i < 16; ++i) { s0[i] -= d; s1[i] -= d; }
    }
    float rs = 0.f;
#pragma unroll
    for (int i = 0; i < 16; ++i) { s0[i] = __builtin_amdgcn_exp2f(s0[i]); s1[i] = __builtin_amdgcn_exp2f(s1[i]); rs += s0[i] + s1[i]; }
    l += rs;
    u32x4 w;
    w.x = pk_bf16(s0[0], s0[1]); w.y = pk_bf16(s0[2], s0[3]); w.z = pk_bf16(s0[4], s0[5]); w.w = pk_bf16(s0[6], s0[7]); pf[0] = __builtin_bit_cast(bf16x8, w);
    w.x = pk_bf16(s0[8], s0[9]); w.y = pk_bf16(s0[10], s0[11]); w.z = pk_bf16(s0[12], s0[13]); w.w = pk_bf16(s0[14], s0[15]); pf[1] = __builtin_bit_cast(bf16x8, w);
    w.x = pk_bf16(s1[0], s1[1]); w.y = pk_bf16(s1[2], s1[3]); w.z = pk_bf16(s1[4], s1[5]); w.w = pk_bf16(s1[6], s1[7]); pf[2] = __builtin_bit_cast(bf16x8, w);
    w.x = pk_bf16(s1[8], s1[9]); w.y = pk_bf16(s1[10], s1[11]); w.z = pk_bf16(s1[12], s1[13]); w.w = pk_bf16(s1[14], s1[15]); pf[3] = __builtin_bit_cast(bf16x8, w);
}
DI void at_pv(const LAS unsigned char* vs, const AtRd& rd, const bf16x8 (&pf)[4], f32x16 (&o)[4]) {
    const LAS unsigned char* vb = vs + rd.vbase;
#pragma unroll
    for (int ks = 0; ks < 4; ++ks)
#pragma unroll
        for (int t = 0; t < 4; ++t) {
            const s16x4 lo = __builtin_amdgcn_ds_read_tr16_b64_v4i16((LAS s16x4*)(vb + (16 * ks) * 256 + rd.vo[t]));
            const s16x4 hi = __builtin_amdgcn_ds_read_tr16_b64_v4i16((LAS s16x4*)(vb + (16 * ks + 8) * 256 + rd.vo[t]));
            const bf16x8 vf = __builtin_shufflevector(lo, hi, 0, 1, 2, 3, 4, 5, 6, 7);
            o[t] = MFMA32(vf, pf[ks], o[t]);
        }
}
template <class BiasFn>
DI void at_sm_pv(const LAS unsigned char* vs, const AtRd& rd, f32x16& s0, f32x16& s1, f32x16 (&o)[4], float& m, float& l, const float c2, const BiasFn& bias, const int lane) {
    bf16x8 pf[4];
    at_sm(s0, s1, o, m, l, c2, bias, lane, pf);
    at_pv(vs, rd, pf, o);
}

struct AtDma { unsigned ko[3], vo[2]; unsigned rope; };
template <int DQ>
DI AtDma at_dma_init(int ld_bytes, int wave, int lane) {
    AtDma d; d.rope = 0u;
    constexpr int PPR = DQ / 8;
#pragma unroll
    for (int k = 0; k < DQ / 64; ++k) { const int L = (wave + 8 * k) * 64 + lane, r = L / PPR, pc = (L % PPR) ^ at_kf<DQ>(r);
        if (DQ == 192 && pc >= 16) { d.ko[k] = (unsigned)(r * 128 + (pc - 16) * 16); d.rope |= 1u << k; } else d.ko[k] = (unsigned)(r * ld_bytes + pc * 16); }
    if (DQ == 128) d.ko[2] = 0u;
#pragma unroll
    for (int k = 0; k < 2; ++k) { const int L = (wave + 8 * k) * 64 + lane, r = L >> 4, pc = (L & 15) ^ (2 * (r & 7)); d.vo[k] = (unsigned)(r * ld_bytes + pc * 16); }
    return d;
}
template <int DQ>
DI void at_dma_k(LAS unsigned char* kslot, const char* kb, const char* rb, const AtDma& d, int wave) {
#pragma unroll
    for (int k = 0; k < DQ / 64; ++k) {
        const char* src = (DQ == 192 && ((d.rope >> k) & 1u)) ? rb + d.ko[k] : kb + d.ko[k];
        __builtin_amdgcn_global_load_lds((const unsigned*)src, (LAS unsigned*)(kslot + (wave + 8 * k) * 1024), 16, 0, 0);
    }
}
DI void at_dma_v(LAS unsigned char* vslot, const char* vb, const AtDma& d, int wave) {
#pragma unroll
    for (int k = 0; k < 2; ++k) __builtin_amdgcn_global_load_lds((const unsigned*)(vb + d.vo[k]), (LAS unsigned*)(vslot + (wave + 8 * k) * 1024), 16, 0, 0);
}
#define AT_DRAIN_SYNC() do { asm volatile("s_waitcnt vmcnt(0)" ::: "memory"); __syncthreads(); } while (0)

template <int DQ, bool PIPE, class Drv>
DI void at_run(LAS unsigned char* lds, const Drv& D, const int n, const AtRd& rd, const AtDma& dm, const bf16x8 (&qf)[DQ / 16], f32x16 (&o)[4], float& m, float& l, const float c2, const int lane, const int wave) {
    f32x16 a0, a1;
    __syncthreads();
    at_dma_k<DQ>(lds + AT_K0, D.kb(0), D.rb(0), dm, wave); at_dma_v(lds + AT_V0, D.vb(0), dm, wave);
    if constexpr (PIPE) {
        f32x16 b0, b1;
        if (n > 1) at_dma_k<DQ>(lds + AT_K0 + AT_KSLOT, D.kb(1), D.rb(1), dm, wave);
        AT_DRAIN_SYNC();
        if (D.act(0)) at_qk<DQ>(lds + AT_K0, rd, qf, a0, a1);
#define AT_STEP(J, PAR, C0, C1, N0, N1) do { const int j_ = (J); \
        if (j_ + 2 < n) at_dma_k<DQ>(lds + AT_K0 + (PAR) * AT_KSLOT, D.kb(j_ + 2), D.rb(j_ + 2), dm, wave); \
        if (j_ + 1 < n) at_dma_v(lds + AT_V0 + (1 - (PAR)) * AT_VSLOT, D.vb(j_ + 1), dm, wave); \
        if (j_ + 1 < n && D.act(j_ + 1)) at_qk<DQ>(lds + AT_K0 + (1 - (PAR)) * AT_KSLOT, rd, qf, N0, N1); \
        if (D.act(j_)) at_sm_pv(lds + AT_V0 + (PAR) * AT_VSLOT, rd, C0, C1, o, m, l, c2, D.bias(j_), lane); \
        AT_DRAIN_SYNC(); } while (0)
        for (int j = 0; j < n; j += 2) {
            AT_STEP(j, 0, a0, a1, b0, b1);
            if (j + 1 < n) AT_STEP(j + 1, 1, b0, b1, a0, a1);
        }
#undef AT_STEP
    } else {
        AT_DRAIN_SYNC();
        for (int j = 0; j < n; ++j) {
            const int par = j & 1;
            if (j + 1 < n) { at_dma_k<DQ>(lds + AT_K0 + (1 - par) * AT_KSLOT, D.kb(j + 1), D.rb(j + 1), dm, wave); at_dma_v(lds + AT_V0 + (1 - par) * AT_VSLOT, D.vb(j + 1), dm, wave); }
            if (D.act(j)) { at_qk<DQ>(lds + AT_K0 + par * AT_KSLOT, rd, qf, a0, a1); at_sm_pv(lds + AT_V0 + par * AT_VSLOT, rd, a0, a1, o, m, l, c2, D.bias(j), lane); }
            AT_DRAIN_SYNC();
        }
    }
}

constexpr int AT3_V0 = 2 * AT_KSLOT, AT3_XOFF = AT3_V0 + 3 * AT_VSLOT;
template <int DQ, class Drv>
DI void at_run_skew(LAS unsigned char* lds, const Drv& D, const int n, const AtRd& rd, const AtDma& dm, const bf16x8 (&qf)[DQ / 16], f32x16 (&o)[4], float& m, float& l, const float c2, const int lane, const int wave) {
    const bool late = wave >= 4;
    bf16x8 pf[4];
    __syncthreads();
    at_dma_k<DQ>(lds + AT_K0, D.kb(0), D.rb(0), dm, wave); at_dma_v(lds + AT3_V0, D.vb(0), dm, wave);
    AT_DRAIN_SYNC();
    int vcur = 0;
    for (int j = 0; j < n; ++j) {
        const int vnext = vcur == 2 ? 0 : vcur + 1, vprev = vcur == 0 ? 2 : vcur - 1;
        if (j + 1 < n) { at_dma_k<DQ>(lds + AT_K0 + ((j + 1) & 1) * AT_KSLOT, D.kb(j + 1), D.rb(j + 1), dm, wave); at_dma_v(lds + AT3_V0 + vnext * AT_VSLOT, D.vb(j + 1), dm, wave); }
        if (late && j > 0 && D.act(j - 1)) at_pv(lds + AT3_V0 + vprev * AT_VSLOT, rd, pf, o);
        if (D.act(j)) {
            f32x16 a0, a1;
            at_qk<DQ>(lds + AT_K0 + (j & 1) * AT_KSLOT, rd, qf, a0, a1);
            at_sm(a0, a1, o, m, l, c2, D.bias(j), lane, pf);
            if (!late) at_pv(lds + AT3_V0 + vcur * AT_VSLOT, rd, pf, o);
        }
        AT_DRAIN_SYNC();
        vcur = vnext;
    }
    if (late && D.act(n - 1)) at_pv(lds + AT3_V0 + (vcur == 0 ? 2 : vcur - 1) * AT_VSLOT, rd, pf, o);
}

constexpr int AT4_SLOT = AT_KSLOT + AT_VSLOT, AT4_XOFF = 3 * AT4_SLOT;
template <int DQ, class Drv>
DI void at_run3(LAS unsigned char* lds, const Drv& D, const int n, const AtRd& rd, const AtDma& dm, const bf16x8 (&qf)[DQ / 16], f32x16 (&o)[4], float& m, float& l, const float c2, const int lane, const int wave) {
    __syncthreads();
    at_dma_k<DQ>(lds, D.kb(0), D.rb(0), dm, wave); at_dma_v(lds + AT_KSLOT, D.vb(0), dm, wave);
    if (n > 1) { at_dma_k<DQ>(lds + AT4_SLOT, D.kb(1), D.rb(1), dm, wave); at_dma_v(lds + AT4_SLOT + AT_KSLOT, D.vb(1), dm, wave);
        if (DQ == 192) asm volatile("s_waitcnt vmcnt(5)" ::: "memory"); else asm volatile("s_waitcnt vmcnt(4)" ::: "memory"); }
    else asm volatile("s_waitcnt vmcnt(0)" ::: "memory");
    __syncthreads();
    int cur = 0;
    for (int j = 0; j < n; ++j) {
        const int nx2 = cur == 0 ? 2 : cur - 1;
        if (j + 2 < n) { at_dma_k<DQ>(lds + nx2 * AT4_SLOT, D.kb(j + 2), D.rb(j + 2), dm, wave); at_dma_v(lds + nx2 * AT4_SLOT + AT_KSLOT, D.vb(j + 2), dm, wave); }
        if (D.act(j)) {
            f32x16 a0, a1;
            at_qk<DQ>(lds + cur * AT4_SLOT, rd, qf, a0, a1);
            at_sm_pv(lds + cur * AT4_SLOT + AT_KSLOT, rd, a0, a1, o, m, l, c2, D.bias(j), lane);
        }
        if (j + 2 < n) { if (DQ == 192) asm volatile("s_waitcnt vmcnt(5)" ::: "memory"); else asm volatile("s_waitcnt vmcnt(4)" ::: "memory"); }
        else asm volatile("s_waitcnt vmcnt(0)" ::: "memory");
        __syncthreads();
        cur = cur == 2 ? 0 : cur + 1;
    }
}

DI void attn_store(const f32x16 (&o)[4], float l, float extra, bf16_t* orow, int lane) {
    const int h = lane >> 5;
    const float lt = l + __shfl_xor(l, 32) + extra;
    const float inv = 1.0f / lt;
#pragma unroll
    for (int t = 0; t < 4; ++t)
#pragma unroll
        for (int g4 = 0; g4 < 4; ++g4) {
            u32x2 w; w.x = pk_bf16(o[t][4 * g4] * inv, o[t][4 * g4 + 1] * inv); w.y = pk_bf16(o[t][4 * g4 + 2] * inv, o[t][4 * g4 + 3] * inv);
            *(u32x2*)(orow + 32 * t + 8 * g4 + 4 * h) = w;
        }
}

struct MlaDrv {
    const char* KV; const char* KR; int b, head;
    DI int keyrow0(int j) const { return j < 4 ? b * CTX + 64 * j : NCTX + b * SEQ + 64 * (j - 4); }
    DI const char* kb(int j) const { return KV + (size_t)keyrow0(j) * 4096 + head * 512; }
    DI const char* vb(int j) const { return KV + (size_t)keyrow0(j) * 4096 + head * 512 + 256; }
    DI const char* rb(int j) const { return KR + (size_t)keyrow0(j) * 128; }
    DI bool act(int) const { return true; }
    DI NoBias bias(int) const { return NoBias(); }
};

DI void phase_attn0(const Params& p, LAS unsigned char* lds, int G, int bid) {
    const int tid = threadIdx.x, lane = tid & 63, wave = __builtin_amdgcn_readfirstlane(tid >> 6), h = lane >> 5;
    const bf16_t* Q0 = (const bf16_t*)(p.ws + WS_Q0);
    bf16_t* Y = (bf16_t*)(p.ws + WS_Y);
    const float c2 = 0.07216878364870322f * LOG2E;
    const AtRd rd = at_rd_init<192>(lane);
    const AtDma dm = at_dma_init<192>(4096, wave, lane);
    for (int it = 0; it < 2; ++it)
    for (int u = it == 0 ? bid : 256 + (bid + G - G / 2) % G; u < (it == 0 ? 256 : 256 + 32); u += G) {
        MlaDrv T; T.KV = (const char*)(p.ws + WS_KV0); T.KR = (const char*)(p.ws + WS_KR);
        int qrow, nt;
        if (u < 256) { T.b = u >> 6; T.head = (u >> 3) & 7; nt = 36; qrow = NCTX + T.b * SEQ + (u & 7) * 256 + wave * 32 + (lane & 31); }
        else { const int v = u - 256; T.b = v >> 3; T.head = v & 7; nt = 4; qrow = T.b * CTX + wave * 32 + (lane & 31); }
        bf16x8 qf[12];
#pragma unroll
        for (int s = 0; s < 12; ++s) qf[s] = *(const bf16x8*)(Q0 + (size_t)qrow * 1536 + T.head * 192 + 16 * s + 8 * h);
        f32x16 o[4];
#pragma unroll
        for (int t = 0; t < 4; ++t)
#pragma unroll
            for (int i = 0; i < 16; ++i) o[t][i] = 0.f;
        float m = AT_M0, l = 0.f;
        if (AT_SKEW_MLA == 2) at_run3<192>(lds, T, nt, rd, dm, qf, o, m, l, c2, lane, wave); else if (AT_SKEW_MLA) at_run_skew<192>(lds, T, nt, rd, dm, qf, o, m, l, c2, lane, wave); else at_run<192, AT_PIPE_MLA>(lds, T, nt, rd, dm, qf, o, m, l, c2, lane, wave);
        attn_store(o, l, 0.f, Y + (size_t)qrow * DM + T.head * 128, lane);
    }
}

struct WinBias { int base; DI float operator()(int key, float nm) const { return ((unsigned)(base - key) <= 256u) ? nm : -1e30f; } };
struct WinDrv {
    const char* Z; int b, kvh, k0base, jlo, qpos;
    DI int tid_(int q) const { return q < 4 ? q : jlo + q - 4; }
    DI int keyrow0(int q) const { const int j = tid_(q); return j < 4 ? b * CTX + 64 * j : NCTX + b * SEQ + k0base + 64 * (j - 4); }
    DI const char* kb(int q) const { return Z + (size_t)keyrow0(q) * (L1IN * 2) + (1024 + kvh * 128) * 2; }
    DI const char* vb(int q) const { return Z + (size_t)keyrow0(q) * (L1IN * 2) + (1280 + kvh * 128) * 2; }
    DI const char* rb(int) const { return nullptr; }
    DI bool act(int) const { return true; }
    DI WinBias bias(int q) const { const int j = tid_(q); WinBias B; B.base = j < 4 ? 100 : qpos - (k0base + 64 * (j - 4)) + 128; return B; }
};

DI void phase_attn_win(const Params& p, LAS unsigned char* lds, int G, int bid) {
    const int tid = threadIdx.x, lane = tid & 63, wave = __builtin_amdgcn_readfirstlane(tid >> 6), h = lane >> 5;
    const bf16_t* Z = (const bf16_t*)(p.ws + WS_Z);
    bf16_t* Y = (bf16_t*)(p.ws + WS_Y);
    const float c2 = 0.08838834764831845f * LOG2E;
    const AtRd rd = at_rd_init<128>(lane);
    const AtDma dm = at_dma_init<128>(L1IN * 2, wave, lane);
    for (int u = bid; u < 256; u += G) {
        WinDrv T; T.Z = (const char*)Z; T.b = u >> 6; T.kvh = (u >> 5) & 1; const int blk = u & 31; T.k0base = 64 * blk - 128;
        const int head = T.kvh * 4 + (wave >> 1), qpos = 64 * blk + 32 * (wave & 1) + (lane & 31), qrow = NCTX + T.b * SEQ + qpos;
        T.qpos = qpos;
        bf16x8 qf[8];
#pragma unroll
        for (int s = 0; s < 8; ++s) qf[s] = *(const bf16x8*)(Z + (size_t)qrow * L1IN + head * 128 + 16 * s + 8 * h);
        f32x16 o[4];
#pragma unroll
        for (int t = 0; t < 4; ++t)
#pragma unroll
            for (int i = 0; i < 16; ++i) o[t][i] = 0.f;
        float m = AT_M0, l = 0.f;
        T.jlo = (T.k0base < 0) ? 4 + ((-T.k0base) >> 6) : 4;
        const int jhi = (T.k0base + 320 > SEQ) ? 9 - ((T.k0base + 320 - SEQ) >> 6) : 9;
        if (AT_SKEW_WIN == 2) at_run3<128>(lds, T, 4 + (jhi - T.jlo), rd, dm, qf, o, m, l, c2, lane, wave); else if (AT_SKEW_WIN) at_run_skew<128>(lds, T, 4 + (jhi - T.jlo), rd, dm, qf, o, m, l, c2, lane, wave); else at_run<128, AT_PIPE_WIN>(lds, T, 4 + (jhi - T.jlo), rd, dm, qf, o, m, l, c2, lane, wave);
        const float sink = p.in[32][head];
        attn_store(o, l, __builtin_amdgcn_exp2f(sink * LOG2E - m), Y + (size_t)qrow * DM + head * 128, lane);
    }
}

struct NaBias { const LAS float* rp; int c0; bool all; DI float operator()(int key, float nm) const { return all ? nm : ((key >= c0 && key < c0 + 16) ? fmaf(rp[key], LOG2E, nm) : -1e30f); } };
struct NaDrv {
    const char* Z; const LAS float* RPB; int b, head, rlo, r, c, r0, c0;
    DI int keyrow0(int j) const { return j < 4 ? b * CTX + 64 * j : NCTX + b * SEQ + 64 * (rlo + j - 4); }
    DI const char* kb(int j) const { return Z + (size_t)keyrow0(j) * (L1IN * 2) + (2560 + head * 128) * 2; }
    DI const char* vb(int j) const { return Z + (size_t)keyrow0(j) * (L1IN * 2) + (3584 + head * 128) * 2; }
    DI const char* rb(int) const { return nullptr; }
    DI bool act(int j) const { const int rr = rlo + j - 4; return j < 4 || (rr >= r0 && rr <= r0 + 7); }
    DI NaBias bias(int j) const { const int rr = rlo + j - 4; NaBias B; B.rp = RPB + (j < 4 ? 0 : (rr - r + 7) * 31 + (15 - c)); B.c0 = c0; B.all = j < 4; return B; }
};

DI void phase_attn_na(const Params& p, LAS unsigned char* lds, int G, int bid) {
    const int tid = threadIdx.x, lane = tid & 63, wave = __builtin_amdgcn_readfirstlane(tid >> 6), h = lane >> 5;
    const bf16_t* Z = (const bf16_t*)(p.ws + WS_Z);
    bf16_t* Y = (bf16_t*)(p.ws + WS_Y);
    LAS float* RPB = (LAS float*)(lds + AT4_XOFF);
    const float c2 = 0.08838834764831845f * LOG2E;
    const AtRd rd = at_rd_init<128>(lane);
    const AtDma dm = at_dma_init<128>(L1IN * 2, wave, lane);
    for (int u = bid; u < 256; u += G) {
        NaDrv T; T.Z = (const char*)Z; T.RPB = RPB; T.b = u >> 6; T.head = (u >> 3) & 7; const int R = u & 7;
        T.r = 4 * R + (wave >> 1); T.c = 32 * (wave & 1) + (lane & 31); const int qrow = NCTX + T.b * SEQ + 64 * T.r + T.c;
        T.r0 = min(max(T.r - 4, 0), 24); T.c0 = min(max(T.c - 8, 0), 48);
        T.rlo = min(max(4 * R - 4, 0), 24);
        const int rhi = min(max(4 * R + 3 - 4, 0), 24) + 7;
        const int ntl = 4 + (rhi - T.rlo + 1);
        __syncthreads();
        for (int i = tid; i < 15 * 31; i += NTHREADS) RPB[i] = p.in[33][T.head * 465 + i];
        bf16x8 qf[8];
#pragma unroll
        for (int s = 0; s < 8; ++s) qf[s] = *(const bf16x8*)(Z + (size_t)qrow * L1IN + 1536 + T.head * 128 + 16 * s + 8 * h);
        f32x16 o[4];
#pragma unroll
        for (int t = 0; t < 4; ++t)
#pragma unroll
            for (int i = 0; i < 16; ++i) o[t][i] = 0.f;
        float m = AT_M0, l = 0.f;
        if (AT_SKEW_NA == 2) at_run3<128>(lds, T, ntl, rd, dm, qf, o, m, l, c2, lane, wave); else if (AT_SKEW_NA) at_run_skew<128>(lds, T, ntl, rd, dm, qf, o, m, l, c2, lane, wave); else at_run<128, AT_PIPE_NA>(lds, T, ntl, rd, dm, qf, o, m, l, c2, lane, wave);
        attn_store(o, l, 0.f, Y + (size_t)qrow * DM + 1024 + T.head * 128, lane);
    }
}
constexpr int RT_HS = 2052;
typedef float f32x4r __attribute__((ext_vector_type(4)));
DI void phase_router(const Params& p, LAS unsigned char* lds, int G, int bid, const int layer, const float* xin_ctx, const float* xin_lat, const int row_lo, const int row_hi) {
    const int tid = threadIdx.x, lane = tid & 63, wave = tid >> 6;
    const float* MOD = (const float*)(p.ws + WS_MOD) + (size_t)layer * 5 * MODN;
    const float* gain = layer ? p.in[30] : p.in[10];
    const float* rw = p.in[4]; const float* rb = p.in[5];
    bf16_t* H = (bf16_t*)(p.ws + WS_H);
    int* cnt = (int*)(p.ws + WS_CTL + CW_CNT) + layer * NEXP;
    int* LIST = (int*)(p.ws + WS_LIST); TokInfo* TOK = (TokInfo*)(p.ws + WS_TOK);
    LAS float* hs = (LAS float*)lds;
    LAS float* sc = (LAS float*)(lds + 16 * RT_HS * 4);
    const int nb = (row_hi - row_lo) / 16;
    float wb0[64], wb1[64];
    {
        const float* bp = rw + (size_t)(256 * wave + (lane >> 4)) * 32 + (lane & 15);
#pragma unroll
        for (int s2 = 0; s2 < 64; ++s2) { wb0[s2] = bp[4 * s2 * 32]; wb1[s2] = bp[4 * s2 * 32 + 16]; }
    }
    int lb = 0;
    for (int bt = bid; bt < nb; bt += G, ++lb) {
        __syncthreads();
#pragma unroll 1
        for (int rr = 0; rr < 2; ++rr) {
            const int lr = 2 * wave + rr, row = row_lo + bt * 16 + lr;
            const float* xr = row < NCTX ? xin_ctx + (size_t)row * DM : xin_lat + (size_t)(row - NCTX) * DM;
            const bf16_t* dr = (const bf16_t*)(p.ws + WS_D) + (size_t)row * DM;
            const float* md = MOD + (size_t)row_mod(row) * MODN;
            f32x4 v[8]; float ss = 0.f;
#pragma unroll
            for (int i = 0; i < 8; ++i) {
                const int col = 4 * lane + 256 * i;
                const u32x2 dw = *(const u32x2*)(dr + col);
                v[i] = *(const f32x4*)(xr + col) + *(const f32x4*)(md + 2 * DM + col) * (f32x4){bflo(dw.x), bfhi(dw.x), bflo(dw.y), bfhi(dw.y)};
                ss += v[i][0] * v[i][0] + v[i][1] * v[i][1] + v[i][2] * v[i][2] + v[i][3] * v[i][3];
            }
            ss = wave_sum(ss);
            const float r = rsqrtf(ss * (1.0f / DM) + EPS);
#pragma unroll
            for (int i = 0; i < 8; ++i) {
                const int col = 4 * lane + 256 * i;
                const f32x4 g = *(const f32x4*)(gain + col), sh = *(const f32x4*)(md + 3 * DM + col), scl = *(const f32x4*)(md + 4 * DM + col);
                const f32x4 hv = (v[i] * r * g) * (1.0f + scl) + sh;
                u32x2 w; w.x = pk_bf16(hv[0], hv[1]); w.y = pk_bf16(hv[2], hv[3]);
                *(u32x2*)(H + (size_t)row * DM + col) = w;
                *(LAS f32x4*)(hs + lr * RT_HS + col) = hv;
            }
        }
        __syncthreads();
        f32x4r c0 = {0.f, 0.f, 0.f, 0.f}, c1 = {0.f, 0.f, 0.f, 0.f};
        {
            const int ar = lane & 15, kq = lane >> 4;
            const LAS float* ap = hs + ar * RT_HS + 256 * wave + kq;
            if (!(p.flags & 8))
#pragma unroll
            for (int s2 = 0; s2 < 64; ++s2) {
                const float a = ap[4 * s2];
                c0 = __builtin_amdgcn_mfma_f32_16x16x4f32(a, wb0[s2], c0, 0, 0, 0);
                c1 = __builtin_amdgcn_mfma_f32_16x16x4f32(a, wb1[s2], c1, 0, 0, 0);
            }
        }
        __syncthreads();
        {
            LAS float* part = hs;
            const int e = lane & 15, r4 = 4 * (lane >> 4);
#pragma unroll
            for (int j = 0; j < 4; ++j) { part[(wave * 16 + r4 + j) * 32 + e] = c0[j]; part[(wave * 16 + r4 + j) * 32 + 16 + e] = c1[j]; }
        }
        __syncthreads();
        {
            const int r = tid >> 5, e = tid & 31; float a = 0.f;
#pragma unroll
            for (int w2 = 0; w2 < 8; ++w2) a += hs[(w2 * 16 + r) * 32 + e];
            sc[(lb * 16 + r) * 32 + e] = 1.0f / (1.0f + expf(-a));
        }
    }
    __syncthreads();
    {
        LAS int* lcnt = (LAS int*)(lds + LDS_MISC + 1024);
        if (tid < 64) lcnt[tid] = 0;
        __syncthreads();
        int e0 = 0, e1 = 0, li0 = 0, li1 = 0, trow = 0; float w0 = 0.f, w1 = 0.f;
        const bool has = tid < lb * 16;
        if (has) {
            const LAS float* s = sc + tid * 32;
            int bg = 0; float bgs = -INFINITY;
#pragma unroll
            for (int g = 0; g < 8; ++g) {
                const float v0 = s[4 * g] + rb[4 * g], v1 = s[4 * g + 1] + rb[4 * g + 1], v2 = s[4 * g + 2] + rb[4 * g + 2], v3 = s[4 * g + 3] + rb[4 * g + 3];
                const float hi01 = fmaxf(v0, v1), lo01 = fminf(v0, v1), hi23 = fmaxf(v2, v3), lo23 = fminf(v2, v3);
                const float m1 = fmaxf(hi01, hi23), m2 = fmaxf(fminf(hi01, hi23), fmaxf(lo01, lo23));
                const float gs = m1 + m2;
                if (gs > bgs) { bgs = gs; bg = g; }
            }
            float bv[4];
#pragma unroll
            for (int j = 0; j < 4; ++j) bv[j] = s[4 * bg + j] + rb[4 * bg + j];
            int i0 = 0; float b0 = bv[0];
#pragma unroll
            for (int j = 1; j < 4; ++j) if (bv[j] > b0) { b0 = bv[j]; i0 = j; }
            int i1 = -1; float b1 = -INFINITY;
#pragma unroll
            for (int j = 0; j < 4; ++j) if (j != i0 && bv[j] > b1) { b1 = bv[j]; i1 = j; }
            e0 = 4 * bg + i0; e1 = 4 * bg + i1;
            const float s0 = s[e0], s1 = s[e1], ws = s0 + s1; w0 = s0 / ws; w1 = s1 / ws;
            trow = row_lo + (bid + (tid >> 4) * G) * 16 + (tid & 15);
            li0 = atomicAdd((int*)(lcnt + e0), 1); li1 = atomicAdd((int*)(lcnt + e1), 1);
        }
        __syncthreads();
        if (tid < 32) { const int c = lcnt[tid]; lcnt[32 + tid] = c > 0 ? atomicAdd(cnt + tid, c) : 0; }
        __syncthreads();
        if (has) {
            const int p0 = lcnt[32 + e0] + li0, p1 = lcnt[32 + e1] + li1;
            LIST[(size_t)e0 * MOE_CAP + p0] = trow; LIST[(size_t)e1 * MOE_CAP + p1] = trow;
            TokInfo ti; ti.e0 = e0; ti.p0 = p0; ti.e1 = e1; ti.p1 = p1; ti.w0 = w0; ti.w1 = w1; ti.pad0 = 0; ti.pad1 = 0;
            TOK[trow] = ti;
        }
    }
}

DI void moe_tables(const Params& p, LAS int* MT, int layer) {
    const int tid = threadIdx.x;
    __syncthreads();
    if (tid < NEXP) MT[128 + tid] = ((const int*)(p.ws + WS_CTL + CW_CNT))[layer * NEXP + tid];
    __syncthreads();
    if (tid == 0) {
        int seg = 0, tp = 0;
        for (int e = 0; e < NEXP; ++e) { const int t = (MT[128 + e] + 255) >> 8; MT[e] = seg; MT[64 + e] = tp; seg += t * 256; tp += t; }
        MT[32] = seg; MT[64 + 32] = tp;
    }
    __syncthreads();
}

struct MoeSchedUp {
    static constexpr bool GATHER = true;
    const char* Hb; const char* EG; const int* LIST; const LAS int* MT; int K; size_t lda, ldb, a_h, b_h; int G, c;
    DI bool next(int i, pg8::GU& u) const {
        const int L = i * G + c, T = MT[64 + 32]; if (L >= T * 4) return false;
        const int rt = L >> 2, ct = L & 3; int e = 0;
#pragma unroll 1
        for (int q = 1; q < NEXP; ++q) if (rt >= MT[64 + q]) e = q;
        const int lt = rt - MT[64 + e];
        u.e = e; u.pm = lt; u.pn = ct; u.aux = MT[e] + 256 * lt; u.a = Hb; u.b = EG + (size_t)e * (EFF * DM * 2) + (size_t)ct * 128 * ldb; return true;
    }
    DI unsigned rowoff(const pg8::GU& u, int r) const { const int gr = 256 * u.pm + r; const int tok = gr < MT[128 + u.e] ? LIST[(size_t)u.e * MOE_CAP + gr] : 0; return (unsigned)tok * (unsigned)lda; }
};
struct MoeSchedDown {
    static constexpr bool GATHER = false;
    const char* ACT; const char* ED; const LAS int* MT; int K; size_t lda, ldb, a_h, b_h; int G, c;
    DI bool next(int i, pg8::GU& u) const {
        const int L = i * G + c, T = MT[64 + 32]; if (L >= T * 8) return false;
        const int rt = L >> 3, ct = L & 7; int e = 0;
#pragma unroll 1
        for (int q = 1; q < NEXP; ++q) if (rt >= MT[64 + q]) e = q;
        const int lt = rt - MT[64 + e];
        u.e = e; u.pm = lt; u.pn = ct; u.aux = MT[e] + 256 * lt; u.a = ACT + (size_t)u.aux * lda; u.b = ED + (size_t)e * (DM * EFF * 2) + (size_t)ct * 256 * ldb; return true;
    }
    DI unsigned rowoff(const pg8::GU&, int) const { return 0u; }
};
struct EpiSwiGLU {
    static constexpr bool PERM = true;
    bf16_t* ACT;
    DI void operator()(const f32x4 (&acc)[2][2][4][2], const pg8::GU& u, int wr, int wc, int fr, int fq) const {
        const int row0 = u.aux + wr * 64 + fr, col0 = u.pn * 128 + wc * 32 + 8 * fq;
#pragma unroll
        for (int ai = 0; ai < 2; ++ai)
#pragma unroll
            for (int m = 0; m < 4; ++m) {
                float a[8];
#pragma unroll
                for (int n = 0; n < 2; ++n)
#pragma unroll
                    for (int j = 0; j < 4; ++j) { const float g = acc[ai][0][m][n][j], up = acc[ai][1][m][n][j]; a[4 * n + j] = g / (1.0f + __expf(-g)) * up; }
                u32x4 w; w.x = pk_bf16(a[0], a[1]); w.y = pk_bf16(a[2], a[3]); w.z = pk_bf16(a[4], a[5]); w.w = pk_bf16(a[6], a[7]);
                *(u32x4*)(ACT + (size_t)(row0 + ai * 128 + m * 16) * EFF + col0) = w;
            }
    }
};
struct EpiBf16Rows {
    static constexpr bool PERM = true;
    bf16_t* O; int ldc; int use_aux; int skip = 0;
    DI void operator()(const f32x4 (&acc)[2][2][4][2], const pg8::GU& u, int wr, int wc, int fr, int fq) const {
        if (skip) return;
        const int row0 = (use_aux ? u.aux : u.pm * 256) + wr * 64 + fr, col0 = u.pn * 256 + wc * 32 + 8 * fq;
#pragma unroll
        for (int ai = 0; ai < 2; ++ai)
#pragma unroll
            for (int m = 0; m < 4; ++m) {
                bf16_t* rowp = O + (size_t)(row0 + ai * 128 + m * 16) * ldc + col0;
#pragma unroll
                for (int bj = 0; bj < 2; ++bj) {
                    const f32x4 v0 = acc[ai][bj][m][0], v1 = acc[ai][bj][m][1];
                    u32x4 w; w.x = pk_bf16(v0[0], v0[1]); w.y = pk_bf16(v0[2], v0[3]); w.z = pk_bf16(v1[0], v1[1]); w.w = pk_bf16(v1[2], v1[3]);
                    *(u32x4*)(rowp + bj * 128) = w;
                }
            }
    }
};

template <bool FINAL>
DI void phase_combine(const Params& p, LAS unsigned char* lds, int G, int bid, const int layer, const float* xin_ctx, const float* xin_lat, const int row_lo, const int row_hi) {
    const int lane = threadIdx.x & 63, wave = threadIdx.x >> 6;
    LAS int* MT = (LAS int*)(lds + LDS_MISC + 64);
    moe_tables(p, MT, layer);
    const float* MOD = (const float*)(p.ws + WS_MOD);
    const bf16_t* OUT2 = (const bf16_t*)(p.ws + WS_OUT2);
    const TokInfo* TOK = (const TokInfo*)(p.ws + WS_TOK);
    float* XB = (float*)(p.ws + WS_XB); bf16_t* H = (bf16_t*)(p.ws + WS_H);
    for (int row = row_lo + bid * 8 + wave; row < row_hi; row += G * 8) {
        const TokInfo ti = TOK[row];
        const bf16_t* o0 = OUT2 + (size_t)(MT[ti.e0] + ti.p0) * DM; const bf16_t* o1 = OUT2 + (size_t)(MT[ti.e1] + ti.p1) * DM;
        const float* xr = row < NCTX ? xin_ctx + (size_t)row * DM : xin_lat + (size_t)(row - NCTX) * DM;
        const bf16_t* dr = (const bf16_t*)(p.ws + WS_D) + (size_t)row * DM;
        const int mi = row_mod(row);
        const float* g1 = MOD + ((size_t)layer * 5 + mi) * MODN + 2 * DM;
        const float* g2 = MOD + ((size_t)layer * 5 + mi) * MODN + 5 * DM;
        f32x4 v[8];
#pragma unroll
        for (int i = 0; i < 8; ++i) {
            const int col = 4 * lane + 256 * i;
            const u32x2 dw = *(const u32x2*)(dr + col);
            const f32x4 x = *(const f32x4*)(xr + col) + *(const f32x4*)(g1 + col) * (f32x4){bflo(dw.x), bfhi(dw.x), bflo(dw.y), bfhi(dw.y)}, g = *(const f32x4*)(g2 + col);
            const u32x2 a = *(const u32x2*)(o0 + col), b = *(const u32x2*)(o1 + col);
            const f32x4 fa = {bflo(a.x), bfhi(a.x), bflo(a.y), bfhi(a.y)}, fb = {bflo(b.x), bfhi(b.x), bflo(b.y), bfhi(b.y)};
            v[i] = x + g * (fa * ti.w0 + fb * ti.w1);
        }
        if (!FINAL) {
#pragma unroll
            for (int i = 0; i < 8; ++i) *(f32x4*)(XB + (size_t)row * DM + 4 * lane + 256 * i) = v[i];
            const float* md = MOD + ((size_t)5 + mi) * MODN;
            norm_mod_store(v, p.in[29], md, md + DM, H + (size_t)row * DM, lane);
        } else {
            float ss = 0.f;
#pragma unroll
            for (int i = 0; i < 8; ++i) ss += v[i][0] * v[i][0] + v[i][1] * v[i][1] + v[i][2] * v[i][2] + v[i][3] * v[i][3];
            ss = wave_sum(ss);
            const float r = rsqrtf(ss * (1.0f / DM) + EPS);
#pragma unroll
            for (int i = 0; i < 8; ++i) { const int col = 4 * lane + 256 * i; const f32x4 g = *(const f32x4*)(p.in[6] + col); *(f32x4*)(p.out + (size_t)(row - NCTX) * DM + col) = v[i] * r * g; }
        }
    }
}
struct PlainSched {
    static constexpr bool GATHER = false;
    const char* A; const char* Bt; int K; size_t lda, ldb, a_h, b_h; pg8::TileOrder T;
    DI void init(const void* A_, const void* Bt_, int M, int N, int K_, int lda_e, int ldb_e, int G, int c) {
        A = (const char*)A_; Bt = (const char*)Bt_; K = K_; lda = (size_t)lda_e * 2; ldb = (size_t)ldb_e * 2; a_h = 128 * lda; b_h = 128 * ldb; T.init(M / 256, N / 256, G, c); }
    DI bool next(int i, pg8::GU& u) const { int pm, pn; if (!T.tile(i, pm, pn)) return false; u.pm = pm; u.pn = pn; u.e = 0; u.aux = 0; u.a = A + (size_t)pm * 256 * lda; u.b = Bt + (size_t)pn * 256 * ldb; return true; }
    DI unsigned rowoff(const pg8::GU&, int) const { return 0u; }
};

template <int MODE>
struct EpiRope {
    static constexpr bool PERM = false;
    bf16_t* O; int ldc; const f32x2* R;
    DI void operator()(const f32x4 (&acc)[2][2][4][2], const pg8::GU& u, int wr, int wc, int fr, int fq) const {
        const int row0 = u.pm * 256 + wr * 64 + fr;
#pragma unroll
        for (int bj = 0; bj < 2; ++bj) {
            const int g32 = 8 * u.pn + 4 * bj + wc;
            int axis, ibase; bool rot;
            if (MODE == 0) { const int hg = g32 % 6; rot = hg >= 4; axis = hg - 4; ibase = 4 * fq; }
            else { rot = u.pn < 5; axis = (g32 & 3) >> 1; ibase = 16 * (g32 & 1) + 4 * fq; }
            const int col0 = 32 * g32 + 4 * fq;
#pragma unroll
            for (int ai = 0; ai < 2; ++ai)
#pragma unroll
                for (int m = 0; m < 4; ++m) {
                    const int row = row0 + ai * 128 + m * 16;
                    f32x4 x1 = acc[ai][bj][m][0], x2 = acc[ai][bj][m][1];
                    if (rot && row >= NCTX) {
                        const int t = (row - NCTX) & (SEQ - 1), pos = axis ? (t & 63) : (t >> 6);
                        const f32x2* cs = R + pos * (MODE == 0 ? 16 : 32) + ibase;
                        f32x4 o1, o2;
#pragma unroll
                        for (int j = 0; j < 4; ++j) { const f32x2 c = cs[j]; o1[j] = x1[j] * c[0] - x2[j] * c[1]; o2[j] = x2[j] * c[0] + x1[j] * c[1]; }
                        x1 = o1; x2 = o2;
                    }
                    bf16_t* rowp = O + (size_t)row * ldc + col0;
                    u32x2 w1, w2; w1.x = pk_bf16(x1[0], x1[1]); w1.y = pk_bf16(x1[2], x1[3]); w2.x = pk_bf16(x2[0], x2[1]); w2.y = pk_bf16(x2[2], x2[3]);
                    *(u32x2*)(rowp) = w1; *(u32x2*)(rowp + 16) = w2;
                }
        }
    }
};

struct EpiResid {
    static constexpr bool PERM = true;
    const float* xin_ctx; const float* xin_lat; float* XO; const float* MODL; int rowbase;
    DI void operator()(const f32x4 (&acc)[2][2][4][2], const pg8::GU& u, int wr, int wc, int fr, int fq) const {
        const int row0 = rowbase + u.pm * 256 + wr * 64 + fr, col0 = u.pn * 256 + wc * 32 + 8 * fq;
        const float* g1 = MODL + (size_t)row_mod(rowbase + u.pm * 256) * MODN + 2 * DM;
        f32x4 gv[2][2];
#pragma unroll
        for (int bj = 0; bj < 2; ++bj)
#pragma unroll
            for (int n = 0; n < 2; ++n) gv[bj][n] = *(const f32x4*)(g1 + col0 + bj * 128 + n * 4);
#pragma unroll
        for (int ai = 0; ai < 2; ++ai)
#pragma unroll
            for (int m = 0; m < 4; ++m) {
                const int row = row0 + ai * 128 + m * 16;
                const float* xr = (row < NCTX ? xin_ctx + (size_t)row * DM : xin_lat + (size_t)(row - NCTX) * DM) + col0;
                float* xo = XO + (size_t)row * DM + col0;
#pragma unroll
                for (int bj = 0; bj < 2; ++bj)
#pragma unroll
                    for (int n = 0; n < 2; ++n) *(f32x4*)(xo + bj * 128 + n * 4) = *(const f32x4*)(xr + bj * 128 + n * 4) + gv[bj][n] * acc[ai][bj][m][n];
            }
    }
};

constexpr int NPHASE = 18;
constexpr int BG_U2 = (NTOK / 256) * (L0INP / 256), BG_U6 = (NTOK / 256) * (DM / 256), BG_U11 = (NTOK / 256) * (L1IN / 256);
#ifndef BG_Q2
#define BG_Q2 12
#endif
#ifndef BG_Q6
#define BG_Q6 10
#endif
#ifndef BG_Q8
#define BG_Q8 12
#endif
#ifndef BG_Q11
#define BG_Q11 12
#endif
__global__ void __launch_bounds__(NTHREADS, 2) fwd_kernel(Params p) {
    extern __shared__ __attribute__((aligned(16))) unsigned char lds_raw[];
    LAS unsigned char* lds = (LAS unsigned char*)lds_raw;
    const int tid = threadIdx.x, G = gridDim.x, bid = blockIdx.x;
    unsigned char* ws = p.ws;
    if (tid < 64) ((LAS unsigned*)(lds + LDS_MISC))[tid] = 0u;
    __syncthreads();
    const int lo = p.ph_lo, hi = p.ph_hi;
    const bool use_bar = (hi - lo) > 1;
    XcdBarrier bar; bar.bar = (unsigned*)(ws + WS_CTL + CW_BAR); bar.x = 0; bar.st = (volatile LAS unsigned*)(lds + LDS_MISC);
    if (use_bar) bar = xcd_barrier_post((unsigned*)(ws + WS_CTL + CW_BAR), (volatile LAS unsigned*)(lds + LDS_MISC));
#ifndef PH_MASK
#define PH_MASK 0x3ffff
#endif
#define IN(k) (((PH_MASK >> (k)) & 1) && lo <= (k) && (k) < hi)
#ifndef REPEAT_MASK
#define REPEAT_MASK 0
#endif
#define REP(k) 0
#define SEAM(k) do { if (rep_ == REP(k) && IN((k) + 1)) xcd_barrier(bar); } while (0)
    const float* MOD = (const float*)(ws + WS_MOD);
    LAS int* MT = (LAS int*)(lds + LDS_MISC + 64);
    const int vc = (G % 8 == 0) ? (bid % 8) * (G / 8) + bid / 8 : bid;
    (void)vc;

    if (IN(0)) for (int rep_ = 0; rep_ <= REP(0); ++rep_) { if (rep_) __syncthreads(); phase_prologue(p, lds, G, bid); SEAM(0); }
    if (IN(1)) for (int rep_ = 0; rep_ <= REP(1); ++rep_) { if (rep_) __syncthreads(); phase_norm0(p, G, bid); SEAM(1); }
    if (IN(2)) for (int rep_ = 0; rep_ <= REP(2); ++rep_) { if (rep_) __syncthreads();
        PlainSched S; S.init(ws + WS_H, ws + WS_W0IN, NTOK, L0INP, DM, DM, DM, G, bid);
        EpiBf16Rows E{(bf16_t*)(ws + WS_Z), L0INP, 0, p.flags & 1};
        pg8::gemm_phase(lds, S, E);
        bg_range(p, lds, 1, 0, BG_L0_P2, BG_U2, G, bid);
        SEAM(2);
    }
    if (IN(3)) for (int rep_ = 0; rep_ <= REP(3); ++rep_) { if (rep_) __syncthreads(); phase_l0_rows(p, G, bid); __syncthreads(); lru_units<1>(p, lds, G, bid); SEAM(3); }
    if (IN(4)) for (int rep_ = 0; rep_ <= REP(4); ++rep_) { if (rep_) __syncthreads();
        { PlainSched S; S.init(ws + WS_CQN, ws + WS_WUQ, NTOK, 1536, 512, 512, 512, G, bid);
          EpiRope<0> E{(bf16_t*)(ws + WS_Q0), 1536, (const f32x2*)(ws + WS_ROPE0)};
          pg8::gemm_phase(lds, S, E); }
        { PlainSched S; S.init(ws + WS_CKVN, ws + WS_WUKV, NTOK, 2048, 256, 256, 256, G, bid);
          EpiBf16Rows E{(bf16_t*)(ws + WS_KV0), 2048, 0};
          pg8::gemm_phase(lds, S, E); }
        lru_carry(p, G, bid);
        SEAM(4);
    }
    if (IN(5)) for (int rep_ = 0; rep_ <= REP(5); ++rep_) { if (rep_) __syncthreads(); if (!(p.flags & 2)) phase_attn0(p, lds, G, bid); __syncthreads(); if (!(p.flags & 4)) lru_pass2(p, lds, G, bid); SEAM(5); }
    if (IN(6)) for (int rep_ = 0; rep_ <= REP(6); ++rep_) { if (rep_) __syncthreads();
        PlainSched S; S.init(ws + WS_Y, ws + WS_W0OUT, NTOK, DM, DM, DM, DM, G, bid);
        EpiBf16Rows E{(bf16_t*)(ws + WS_D), DM, 0};
        pg8::gemm_phase(lds, S, E);
        bg_range(p, lds, 1, BG_L0_P2, BG_L0_P6, BG_U6, G, bid);
        SEAM(6);
    }
    if (IN(7)) for (int rep_ = 0; rep_ <= REP(7); ++rep_) { if (rep_) __syncthreads(); phase_router(p, lds, G, bid, 0, p.in[2], p.in[0], 0, NTOK);
        bg_range(p, lds, 1, BG_L0_P6, BG_L0_P7, NTOK / 16, G, bid); SEAM(7); }
    if (IN(8)) for (int rep_ = 0; rep_ <= REP(8); ++rep_) { if (rep_) __syncthreads();
        moe_tables(p, MT, 0);
        MoeSchedUp S; S.Hb = (const char*)(ws + WS_H); S.EG = (const char*)(ws + WS_EG); S.LIST = (const int*)(ws + WS_LIST); S.MT = MT; S.K = DM;
        S.lda = DM * 2; S.ldb = DM * 2; S.a_h = 0; S.b_h = WS_EU - WS_EG; S.G = G; S.c = bid;
        EpiSwiGLU E{(bf16_t*)(ws + WS_ACT)};
        pg8::gemm_phase(lds, S, E);
        bg_range(p, lds, 2, 0, BG_L1_P8, 4 * MT[64 + 32], G, bid);
        SEAM(8);
    }
    if (IN(9)) for (int rep_ = 0; rep_ <= REP(9); ++rep_) { if (rep_) __syncthreads();
        moe_tables(p, MT, 0);
        MoeSchedDown S; S.ACT = (const char*)(ws + WS_ACT); S.ED = (const char*)(ws + WS_ED); S.MT = MT; S.K = EFF;
        S.lda = EFF * 2; S.ldb = EFF * 2; S.a_h = 128 * EFF * 2; S.b_h = 128 * EFF * 2; S.G = G; S.c = bid;
        EpiBf16Rows E{(bf16_t*)(ws + WS_OUT2), DM, 1};
        pg8::gemm_phase(lds, S, E); SEAM(9);
    }
    if (IN(10)) for (int rep_ = 0; rep_ <= REP(10); ++rep_) { if (rep_) __syncthreads(); phase_combine<false>(p, lds, G, bid, 0, p.in[2], p.in[0], 0, NTOK); SEAM(10); }
    if (IN(11)) for (int rep_ = 0; rep_ <= REP(11); ++rep_) { if (rep_) __syncthreads();
        PlainSched S; S.init(ws + WS_H, ws + WS_W1IN, NTOK, L1IN, DM, DM, DM, G, bid);
        EpiRope<1> E{(bf16_t*)(ws + WS_Z), L1IN, (const f32x2*)(ws + WS_ROPE1)};
        pg8::gemm_phase(lds, S, E);
        bg_range(p, lds, 2, BG_L1_P8, BG_L1_P11, BG_U11, G, bid);
        SEAM(11);
    }
    if (IN(12)) for (int rep_ = 0; rep_ <= REP(12); ++rep_) { if (rep_) __syncthreads(); if (!(p.flags & 2)) phase_attn_win(p, lds, G, bid); __syncthreads(); if (!(p.flags & 4)) phase_attn_na(p, lds, G, bid); SEAM(12); }
    if (IN(13)) for (int rep_ = 0; rep_ <= REP(13); ++rep_) { if (rep_) __syncthreads();
        PlainSched S; S.init(ws + WS_Y + (size_t)NCTX * DM * 2, ws + WS_W1OUT, NLAT, DM, DM, DM, DM, G, bid);
        EpiBf16Rows E{(bf16_t*)(ws + WS_D) + (size_t)NCTX * DM, DM, 0};
        pg8::gemm_phase(lds, S, E); SEAM(13);
    }
    if (IN(14)) for (int rep_ = 0; rep_ <= REP(14); ++rep_) { if (rep_) __syncthreads(); phase_router(p, lds, G, bid, 1, (const float*)(ws + WS_XB), (const float*)(ws + WS_XB) + (size_t)NCTX * DM, NCTX, NTOK); SEAM(14); }
    if (IN(15)) for (int rep_ = 0; rep_ <= REP(15); ++rep_) { if (rep_) __syncthreads();
        moe_tables(p, MT, 1);
        MoeSchedUp S; S.Hb = (const char*)(ws + WS_H); S.EG = (const char*)(ws + WS_EG + EXPW); S.LIST = (const int*)(ws + WS_LIST); S.MT = MT; S.K = DM;
        S.lda = DM * 2; S.ldb = DM * 2; S.a_h = 0; S.b_h = WS_EU - WS_EG; S.G = G; S.c = bid;
        EpiSwiGLU E{(bf16_t*)(ws + WS_ACT)};
        pg8::gemm_phase(lds, S, E);
        bg_range(p, lds, 2, BG_L1_DOWN0, MOE_CVT_TILES, 4 * MT[64 + 32], G, bid);
        SEAM(15);
    }
    if (IN(16)) for (int rep_ = 0; rep_ <= REP(16); ++rep_) { if (rep_) __syncthreads();
        moe_tables(p, MT, 1);
        MoeSchedDown S; S.ACT = (const char*)(ws + WS_ACT); S.ED = (const char*)(ws + WS_ED + EXPW); S.MT = MT; S.K = EFF;
        S.lda = EFF * 2; S.ldb = EFF * 2; S.a_h = 128 * EFF * 2; S.b_h = 128 * EFF * 2; S.G = G; S.c = bid;
        EpiBf16Rows E{(bf16_t*)(ws + WS_OUT2), DM, 1};
        pg8::gemm_phase(lds, S, E); SEAM(16);
    }
    if (IN(17)) for (int rep_ = 0; rep_ <= REP(17); ++rep_) { if (rep_) __syncthreads(); phase_combine<true>(p, lds, G, bid, 1, (const float*)(ws + WS_XB), (const float*)(ws + WS_XB) + (size_t)NCTX * DM, NCTX, NTOK); }
#undef IN
#undef SEAM
}

#ifndef REPEAT_FLAGS
#define REPEAT_FLAGS 0
#endif
#ifndef N_LAUNCH_MODE
#define N_LAUNCH_MODE 0
#endif
extern "C" void kernel_launch(void* const* d_in, const int* in_sizes, int n_in, void* d_out, int out_size, void* d_ws, size_t ws_size, hipStream_t stream) {
    static int grid = 0;
    if (grid == 0) {
        if (n_in != 38 || out_size != NLAT * DM || ws_size < WS_END) { fprintf(stderr, "kernel_launch: unexpected problem shape (n_in %d out %d ws %zu need %zu)\n", n_in, out_size, ws_size, (size_t)WS_END); grid = -1; return; }
        int dev = 0, cus = 0, per_cu = 0;
        if (hipGetDevice(&dev) != hipSuccess || hipDeviceGetAttribute(&cus, hipDeviceAttributeMultiprocessorCount, dev) != hipSuccess) { grid = -1; return; }
        if (hipFuncSetAttribute((const void*)fwd_kernel, hipFuncAttributeMaxDynamicSharedMemorySize, LDS_BYTES) != hipSuccess) { fprintf(stderr, "kernel_launch: hipFuncSetAttribute failed\n"); grid = -1; return; }
        if (hipOccupancyMaxActiveBlocksPerMultiprocessor(&per_cu, (const void*)fwd_kernel, NTHREADS, LDS_BYTES) != hipSuccess || per_cu < 1) { fprintf(stderr, "kernel_launch: occupancy query reports %d\n", per_cu); (void)hipGetLastError(); }
        if (cus * 48 < NTOK) { fprintf(stderr, "kernel_launch: built for >= 192 CUs (router score table), got %d\n", cus); grid = -1; return; }
        grid = cus;
    }
    if (grid < 0) return;
    (void)hipMemsetAsync((char*)d_ws + WS_CTL, 0, CTL_BYTES, stream);
    Params prm{};
    for (int i = 0; i < 38; ++i) prm.in[i] = (const float*)d_in[i];
    prm.out = (float*)d_out; prm.ws = (unsigned char*)d_ws; prm.flags = 0; prm.pad = 0;
#if N_LAUNCH_MODE == 0
    prm.ph_lo = 0; prm.ph_hi = NPHASE;
    hipLaunchKernelGGL(fwd_kernel, dim3(grid), dim3(NTHREADS), LDS_BYTES, stream, prm);
#else
    for (int k = 0; k < NPHASE; ++k) { prm.ph_lo = k; prm.ph_hi = k + 1; const int reps = 1 + ((REPEAT_MASK >> k) & 1);
        for (int r = 0; r < reps; ++r) { prm.flags = (reps > 1 && r == 0) ? (REPEAT_FLAGS) : 0; if (r && (k == 7 || k == 14)) (void)hipMemsetAsync((char*)d_ws + WS_CTL + CW_CNT + (k == 14 ? NEXP * 4 : 0), 0, NEXP * 4, stream);
            hipLaunchKernelGGL(fwd_kernel, dim3(grid), dim3(NTHREADS), LDS_BYTES, stream, prm); } }
#endif
}
```

```cpp
#define N_LAUNCH_MODE 0
#include <hip/hip_runtime.h>
#include <stdint.h>
#include <stdio.h>

#define LAS __attribute__((address_space(3)))
#define DI __device__ __forceinline__
typedef unsigned short bf16_t;
typedef short bf16x8 __attribute__((ext_vector_type(8)));
typedef short s16x4 __attribute__((ext_vector_type(4)));
typedef float f32x2 __attribute__((ext_vector_type(2)));
typedef float f32x4 __attribute__((ext_vector_type(4)));
typedef float f32x16 __attribute__((ext_vector_type(16)));
typedef unsigned u32x2 __attribute__((ext_vector_type(2)));
typedef unsigned u32x4 __attribute__((ext_vector_type(4)));
typedef __bf16 hbf16x2 __attribute__((ext_vector_type(2)));

constexpr int DM = 2048, NB = 4, SEQ = 2048, CTX = 256, GRIDW = 64;
constexpr int NCTX = NB * CTX;
constexpr int NLAT = NB * SEQ;
constexpr int NTOK = NCTX + NLAT;
constexpr float EPS = 1e-6f;
constexpr int NEXP = 32, EFF = 512;
constexpr int L0IN = 2880, L0INP = 3072, L1IN = 4608;
constexpr int MODN = 6 * DM;
constexpr int NTHREADS = 512;
constexpr float LOG2E = 1.4426950408889634f;

DI unsigned pk_bf16(float lo, float hi) { f32x2 v = {lo, hi}; hbf16x2 r = __builtin_convertvector(v, hbf16x2); return __builtin_bit_cast(unsigned, r); }
DI float bflo(unsigned w) { return __uint_as_float(w << 16); }
DI float bfhi(unsigned w) { return __uint_as_float(w & 0xffff0000u); }
DI float bf2f(bf16_t b) { return __uint_as_float(((unsigned)b) << 16); }
DI bf16_t f2bf(float f) { return (bf16_t)(pk_bf16(f, 0.f) & 0xffffu); }
DI float wave_sum(float v) {
#pragma unroll
    for (int o = 32; o > 0; o >>= 1) v += __shfl_xor(v, o);
    return v;
}
DI float sigmoidf_(float x) { return 1.0f / (1.0f + __expf(-x)); }
DI int row_mod(int row) { return row < NCTX ? 4 : ((row - NCTX) >> 11); }
#define XB_TMO      128
#define XB_XCNT(j)  (256  + 64 * (j))
#define XB_XSUB(j)  (1280 + 64 * (j))
#define XB_XGEN(j)  (2304 + 64 * (j))
#define XB_TOP      3328
#define XB_TOPGEN   3392
#define XCD_BAR_WORDS 3456
#define XB_SPIN_CAP (1u << 18)

__device__ __forceinline__ unsigned xb_ld(unsigned* p)              { return __hip_atomic_load(p, __ATOMIC_RELAXED, __HIP_MEMORY_SCOPE_AGENT); }
__device__ __forceinline__ unsigned xb_add(unsigned* p, unsigned v) { return __hip_atomic_fetch_add(p, v, __ATOMIC_RELAXED, __HIP_MEMORY_SCOPE_AGENT); }
__device__ __forceinline__ unsigned xb_xcc_id() { return (unsigned)__builtin_amdgcn_s_getreg((3 << 11) | 20) & 0xFu; }
#define XB_SPIN(cond, bar) do { unsigned _sp = 0; while (cond) { __builtin_amdgcn_s_sleep(1); \
    if ((++_sp & 255u) == 0u) { if (xb_ld(&(bar)[XB_TMO])) break; if (_sp > XB_SPIN_CAP) { atomicAdd(&(bar)[XB_TMO], 1u); break; } } } } while (0)

struct XcdBarrier {
    unsigned* bar; unsigned x;
    volatile LAS unsigned* st;
};

__device__ __forceinline__ XcdBarrier xcd_barrier_post(unsigned* bar, volatile LAS unsigned* st) {
    XcdBarrier b; b.bar = bar; b.x = xb_xcc_id(); b.st = st;
    if (threadIdx.x == 0) (void)xb_add(&bar[XB_XCNT(b.x)], 1u);
    return b;
}
__device__ __forceinline__ void xcd_barrier_complete(unsigned* bar, unsigned x, unsigned& nloc, unsigned& nx) {
    const unsigned G = gridDim.x * gridDim.y * gridDim.z;
    unsigned sum, cnt, mine, sp = 0u;
    for (;;) {
        sum = 0u; cnt = 0u; mine = 0u;
#pragma unroll
        for (unsigned j = 0; j < 16; ++j) { const unsigned c = xb_ld(&bar[XB_XCNT(j)]); sum += c; cnt += (c > 0u) ? 1u : 0u; mine = (j == x) ? c : mine; }
        if (sum == G) break;
        __builtin_amdgcn_s_sleep(1);
        if ((++sp & 255u) == 0u) { if (xb_ld(&bar[XB_TMO])) break; if (sp > XB_SPIN_CAP) { atomicAdd(&bar[XB_TMO], 1u); break; } }
    }
    nloc = mine > 0u ? mine : 1u; nx = cnt > 0u ? cnt : 1u;
}

__device__ __forceinline__ void xcd_barrier(const XcdBarrier& b) {
    asm volatile("s_waitcnt vmcnt(0)" ::: "memory");
    __syncthreads();
    if (threadIdx.x == 0) {
        unsigned* bar = b.bar;
        __builtin_amdgcn_s_waitcnt(0);
        unsigned nloc = b.st[0], nx = b.st[1];
        if (nloc == 0u) { xcd_barrier_complete(bar, b.x, nloc, nx); b.st[0] = nloc; b.st[1] = nx; }
        const unsigned old = xb_add(&bar[XB_XSUB(b.x)], 1u);
        const unsigned gen = old / nloc;
        if (old + 1u == (gen + 1u) * nloc) {
            __builtin_amdgcn_fence(__ATOMIC_RELEASE, "agent");
            asm volatile("s_waitcnt vmcnt(0)" ::: "memory");
            const unsigned og = xb_add(&bar[XB_TOP], 1u);
            const unsigned tg = og / nx;
            if (og + 1u == (tg + 1u) * nx) xb_add(&bar[XB_TOPGEN], 1u);
            else XB_SPIN(xb_ld(&bar[XB_TOPGEN]) == tg, bar);
            __builtin_amdgcn_fence(__ATOMIC_ACQUIRE, "agent");
            xb_add(&bar[XB_XGEN(b.x)], 1u);
            asm volatile("s_waitcnt vmcnt(0)" ::: "memory");
        } else {
            XB_SPIN(xb_ld(&bar[XB_XGEN(b.x)]) == gen, bar);
            __builtin_amdgcn_fence(__ATOMIC_ACQUIRE, "agent");
            asm volatile("s_waitcnt vmcnt(0)" ::: "memory");
        }
    }
    __syncthreads();
}

#ifndef PG8_SP2
#define PG8_SP2 true
#endif
#ifndef PG8_ALIGN_EPI
#define PG8_ALIGN_EPI true
#endif
namespace pg8 {
constexpr int BM = 256, BK = 64, HALF = 128, HTB = HALF * BK * 2, STAGE_BYTES = 8 * HTB, NXCD = 8, WGM = 8;
DI int lds_byte(int r, int c) { const int st = (r >> 4) * 2 + (c >> 5), rr = r & 15, cc = c & 31, ob = rr * 64 + cc * 2; return st * 1024 + (ob ^ (((ob >> 9) & 1) << 5)); }
DI void stage_rc(int b, int& R, int& C) { const int st = b / 1024, sb = b % 1024, swz = sb ^ (((sb >> 9) & 1) << 5); R = (st >> 1) * 16 + swz / 64; C = (st & 1) * 32 + (swz % 64) / 2; }
DI int perm32(int rho) { const int n = rho >> 4, i = rho & 15; return 8 * (i >> 2) + 4 * n + (i & 3); }

struct GU { const char* a; const char* b; int pm, pn, e, aux; };

template <class Epi, class Sched>
DI void gemm_phase(LAS unsigned char* lds, const Sched& S, const Epi& E) {
    const int tid = threadIdx.x, wid = __builtin_amdgcn_readfirstlane(tid >> 6), lane = tid & 63, wr = wid >> 2, wc = wid & 3, fr = lane & 15, fq = lane >> 4;
    const int K = S.K, nt = K / BK;
    int RR[2], CC[2];
    unsigned voffA[2], voffB[2];
#pragma unroll
    for (int i = 0; i < 2; ++i) { int R, C; stage_rc(tid * 16 + i * 8192, R, C); RR[i] = R; CC[i] = C; const int Rb = Epi::PERM ? ((R & ~31) + perm32(R & 31)) : R;
        voffA[i] = (unsigned)(R * (int)S.lda + C * 2); voffB[i] = (unsigned)(Rb * (int)S.ldb + C * 2); }
    const size_t kstep = (size_t)(BK * 2);
    const size_t ahs = S.a_h, bhs = S.b_h;
    const unsigned ldsw = (unsigned)wid * 1024u;
    const int aoff = lds_byte(wr * 64 + fr, fq * 8), boff = lds_byte(wc * 32 + fr, fq * 8);
#define PG8_SA(b, h) (((b) * 2 + (h)) * HTB)
#define PG8_SB(b, h) ((4 + (b) * 2 + (h)) * HTB)
#define PG8_STAGE(bufoff, gbase, voff) do { _Pragma("unroll") for (int _i = 0; _i < 2; ++_i) \
        __builtin_amdgcn_global_load_lds((const unsigned*)((const char*)(gbase) + (voff)[_i]), (LAS unsigned*)(lds + (bufoff) + ldsw + _i * 8192), 16, 0, 0); } while (0)
#define PG8_STAGE_A(bufoff, gbase, h, VG) do { if constexpr (Sched::GATHER) { PG8_STAGE(bufoff, gbase, VG[h]); } else { PG8_STAGE(bufoff, (gbase) + (h) * ahs, voffA); } } while (0)
#define PG8_STAGE_B(bufoff, gbase, h) PG8_STAGE(bufoff, (gbase) + (h) * bhs, voffB)
#define PG8_LDA(dst, b, h) do { _Pragma("unroll") for (int m = 0; m < 4; ++m) _Pragma("unroll") for (int k = 0; k < 2; ++k) dst[m][k] = *(const LAS bf16x8*)(lds + PG8_SA(b, h) + aoff + m * 2048 + k * 1024); } while (0)
#define PG8_LDB(dst, b, h) do { _Pragma("unroll") for (int n = 0; n < 2; ++n) _Pragma("unroll") for (int k = 0; k < 2; ++k) dst[n][k] = *(const LAS bf16x8*)(lds + PG8_SB(b, h) + boff + n * 2048 + k * 1024); } while (0)
#define PG8_MMA(ai, bj, At, Bt) do { __builtin_amdgcn_s_setprio(1); _Pragma("unroll") for (int m = 0; m < 4; ++m) _Pragma("unroll") for (int n = 0; n < 2; ++n) _Pragma("unroll") for (int k = 0; k < 2; ++k) \
        acc[ai][bj][m][n] = __builtin_amdgcn_mfma_f32_16x16x32_bf16(Bt[n][k], At[m][k], acc[ai][bj][m][n], 0, 0, 0); __builtin_amdgcn_s_setprio(0); } while (0)
#define PG8_WAIT_V(n) asm volatile("s_waitcnt vmcnt(" #n ")" ::: "memory")
#define PG8_WAIT_L(n) asm volatile("s_waitcnt lgkmcnt(" #n ")" ::: "memory")
#define PG8_BAR __builtin_amdgcn_s_barrier()
#define PG8_SCHED __builtin_amdgcn_sched_barrier(0)
    GU cur, nxt; int ui = 0;
    if (!S.next(0, cur)) return;
    f32x4 acc[2][2][4][2];
#pragma unroll
    for (int a = 0; a < 2; ++a)
#pragma unroll
        for (int b = 0; b < 2; ++b)
#pragma unroll
            for (int m = 0; m < 4; ++m)
#pragma unroll
                for (int n = 0; n < 2; ++n) acc[a][b][m][n] = (f32x4){0.f, 0.f, 0.f, 0.f};
    bf16x8 At[4][2], B0[2][2], B1[2][2];
    unsigned vc[2][2], vn[2][2];
    if constexpr (Sched::GATHER) {
#pragma unroll
        for (int h = 0; h < 2; ++h)
#pragma unroll
            for (int i = 0; i < 2; ++i) { vc[h][i] = S.rowoff(cur, RR[i] + 128 * h) + (unsigned)(CC[i] * 2); vn[h][i] = vc[h][i]; }
    } else {
#pragma unroll
        for (int h = 0; h < 2; ++h)
#pragma unroll
            for (int i = 0; i < 2; ++i) { vc[h][i] = 0u; vn[h][i] = 0u; }
    }
    const char* cA = cur.a; const char* cB = cur.b;
    if constexpr (PG8_SP2) {
        PG8_STAGE_B(PG8_SB(0, 0), cB, 0); PG8_STAGE_B(PG8_SB(0, 1), cB, 1); PG8_STAGE_A(PG8_SA(0, 0), cA, 0, vc); PG8_STAGE_A(PG8_SA(0, 1), cA, 1, vc);
        if (wr == 1) PG8_BAR;
        PG8_WAIT_V(2); PG8_BAR;
        PG8_STAGE_B(PG8_SB(1, 0), cB + kstep, 0); PG8_STAGE_A(PG8_SA(1, 0), cA + kstep, 0, vc); PG8_STAGE_B(PG8_SB(1, 1), cB + kstep, 1);
        PG8_WAIT_V(6); PG8_BAR;
    } else {
        PG8_STAGE_B(PG8_SB(0, 0), cB, 0); PG8_STAGE_A(PG8_SA(0, 0), cA, 0, vc); PG8_STAGE_B(PG8_SB(0, 1), cB, 1); PG8_STAGE_A(PG8_SA(0, 1), cA, 1, vc);
        if (wr == 1) PG8_BAR;
        PG8_WAIT_V(4); PG8_BAR;
        PG8_STAGE_B(PG8_SB(1, 0), cB + kstep, 0); PG8_STAGE_A(PG8_SA(1, 0), cA + kstep, 0, vc); PG8_STAGE_B(PG8_SB(1, 1), cB + kstep, 1);
        PG8_WAIT_V(6); PG8_BAR;
    }
    for (;;) {
        const bool has_next = S.next(ui + 1, nxt);
        const char* nA = has_next ? nxt.a : cA; const char* nB = has_next ? nxt.b : cB;
        if constexpr (Sched::GATHER) {
            if (has_next) {
#pragma unroll
                for (int h = 0; h < 2; ++h)
#pragma unroll
                    for (int i = 0; i < 2; ++i) vn[h][i] = S.rowoff(nxt, RR[i] + 128 * h) + (unsigned)(CC[i] * 2);
            } else {
#pragma unroll
                for (int h = 0; h < 2; ++h)
#pragma unroll
                    for (int i = 0; i < 2; ++i) vn[h][i] = vc[h][i];
            }
        }
        for (int t = 0; t < nt; t += 2) {
            const bool last = (t == nt - 2);
            const char* a1 = cA + (size_t)(t + 1) * kstep;
            const char* a2 = last ? nA : cA + (size_t)(t + 2) * kstep; const char* b2 = last ? nB : cB + (size_t)(t + 2) * kstep;
            const char* a3 = a2 + kstep; const char* b3 = b2 + kstep;
            unsigned v2[2][2];
#pragma unroll
            for (int h = 0; h < 2; ++h)
#pragma unroll
                for (int i = 0; i < 2; ++i) v2[h][i] = last ? vn[h][i] : vc[h][i];
            if constexpr (PG8_SP2) {
            PG8_LDB(B0, 0, 0); PG8_LDB(B1, 0, 1); PG8_SCHED; PG8_LDA(At, 0, 0); PG8_STAGE_A(PG8_SA(1, 1), a1, 1, vc);
            PG8_WAIT_V(8); PG8_WAIT_L(0); PG8_BAR; PG8_MMA(0, 0, At, B0); PG8_MMA(0, 1, At, B1); PG8_BAR; PG8_SCHED;
            PG8_LDA(At, 0, 1); PG8_STAGE_B(PG8_SB(0, 0), b2, 0); PG8_STAGE_B(PG8_SB(0, 1), b2, 1); PG8_STAGE_A(PG8_SA(0, 0), a2, 0, v2);
            PG8_WAIT_V(8); PG8_WAIT_L(0); PG8_BAR; PG8_MMA(1, 0, At, B0); PG8_MMA(1, 1, At, B1); PG8_BAR; PG8_SCHED;
            PG8_LDB(B0, 1, 0); PG8_LDB(B1, 1, 1); PG8_SCHED; PG8_LDA(At, 1, 0); PG8_STAGE_A(PG8_SA(0, 1), a2, 1, v2);
            PG8_WAIT_V(8); PG8_WAIT_L(0); PG8_BAR; PG8_MMA(0, 0, At, B0); PG8_MMA(0, 1, At, B1); PG8_BAR; PG8_SCHED;
            PG8_LDA(At, 1, 1); PG8_STAGE_B(PG8_SB(1, 0), b3, 0); PG8_STAGE_B(PG8_SB(1, 1), b3, 1); PG8_STAGE_A(PG8_SA(1, 0), a3, 0, v2);
            PG8_WAIT_V(8); PG8_WAIT_L(0); PG8_BAR; PG8_MMA(1, 0, At, B0); PG8_MMA(1, 1, At, B1); PG8_BAR; PG8_SCHED;
            } else {
            PG8_LDB(B0, 0, 0); PG8_SCHED; PG8_LDA(At, 0, 0); PG8_STAGE_A(PG8_SA(1, 1), a1, 1, vc);
            PG8_WAIT_L(8); PG8_BAR; PG8_WAIT_L(0); PG8_MMA(0, 0, At, B0); PG8_BAR; PG8_SCHED;
            PG8_LDB(B1, 0, 1); PG8_STAGE_B(PG8_SB(0, 0), b2, 0);
            PG8_BAR; PG8_WAIT_L(0); PG8_MMA(0, 1, At, B1); PG8_BAR;
            PG8_LDA(At, 0, 1); PG8_STAGE_A(PG8_SA(0, 0), a2, 0, v2);
            PG8_BAR; PG8_WAIT_L(0); PG8_MMA(1, 0, At, B0); PG8_BAR; PG8_SCHED;
            PG8_STAGE_B(PG8_SB(0, 1), b2, 1);
            PG8_WAIT_V(6); PG8_BAR; PG8_MMA(1, 1, At, B1); PG8_BAR;
            PG8_LDB(B0, 1, 0); PG8_SCHED; PG8_LDA(At, 1, 0); PG8_STAGE_A(PG8_SA(0, 1), a2, 1, v2);
            PG8_WAIT_L(8); PG8_BAR; PG8_WAIT_L(0); PG8_MMA(0, 0, At, B0); PG8_BAR; PG8_SCHED;
            PG8_LDB(B1, 1, 1); PG8_STAGE_B(PG8_SB(1, 0), b3, 0);
            PG8_BAR; PG8_WAIT_L(0); PG8_MMA(0, 1, At, B1); PG8_BAR;
            PG8_LDA(At, 1, 1); PG8_STAGE_A(PG8_SA(1, 0), a3, 0, v2);
            PG8_BAR; PG8_WAIT_L(0); PG8_MMA(1, 0, At, B0); PG8_BAR; PG8_SCHED;
            PG8_STAGE_B(PG8_SB(1, 1), b3, 1);
            PG8_WAIT_V(6); PG8_BAR; PG8_MMA(1, 1, At, B1); PG8_BAR;
            }
        }
        if constexpr (PG8_ALIGN_EPI) { if (wr == 0) PG8_BAR; }
        E(acc, cur, wr, wc, fr, fq);
        if (!has_next) break;
#pragma unroll
        for (int a = 0; a < 2; ++a)
#pragma unroll
            for (int b = 0; b < 2; ++b)
#pragma unroll
                for (int m = 0; m < 4; ++m)
#pragma unroll
                    for (int n = 0; n < 2; ++n) acc[a][b][m][n] = (f32x4){0.f, 0.f, 0.f, 0.f};
        cur = nxt; cA = nA; cB = nB; ++ui;
        if constexpr (Sched::GATHER) {
#pragma unroll
            for (int h = 0; h < 2; ++h)
#pragma unroll
                for (int i = 0; i < 2; ++i) vc[h][i] = vn[h][i];
        }
        if constexpr (PG8_ALIGN_EPI) { if (wr == 1) PG8_BAR; }
    }
    PG8_WAIT_V(0);
    if constexpr (!PG8_ALIGN_EPI) { if (wr == 0) PG8_BAR; }
    PG8_BAR;
#undef PG8_SA
#undef PG8_SB
#undef PG8_STAGE
#undef PG8_STAGE_A
#undef PG8_STAGE_B
#undef PG8_LDA
#undef PG8_LDB
#undef PG8_MMA
#undef PG8_WAIT_V
#undef PG8_WAIT_L
#undef PG8_BAR
#undef PG8_SCHED
}

struct TileOrder {
    int nM, nN, nwg, G, c;
    DI void init(int nM_, int nN_, int G_, int c_) { nM = nM_; nN = nN_; nwg = nM * nN; G = G_; c = c_; }
    DI bool tile(int i, int& pm, int& pn) const {
        const long L = (long)i * G + c; if (L >= nwg) return false;
        int wgid = (int)L; { const int q = nwg / NXCD, r = nwg % NXCD, xcd = wgid % NXCD, off = wgid / NXCD; wgid = (xcd < r ? xcd * (q + 1) : r * (q + 1) + (xcd - r) * q) + off; }
        const int nig = WGM * nN, gid = wgid / nig, fm = gid * WGM, gsz = (nM - fm) < WGM ? (nM - fm) : WGM;
        pm = fm + ((wgid % nig) % gsz); pn = (wgid % nig) / gsz; return true;
    }
};
}
constexpr size_t AL(size_t x) { return (x + 255) & ~(size_t)255; }
constexpr int MOE_CAP = NTOK;
constexpr int SLOT_ROWS = 2 * NTOK + NEXP * 256;
constexpr int NCHUNK = (CTX + SEQ) / 64;
constexpr size_t WS_CTL    = 0;
constexpr size_t CTL_BYTES = 65536;
constexpr size_t CW_BAR    = 0;
constexpr size_t CW_CNT    = 16384;
constexpr size_t WS_MOD    = AL(WS_CTL + CTL_BYTES);
constexpr size_t WS_ROPE0  = AL(WS_MOD + (size_t)2 * 5 * MODN * 4);
constexpr size_t WS_ROPE1  = AL(WS_ROPE0 + 64 * 16 * 8);
constexpr size_t WS_W0IN   = AL(WS_ROPE1 + 64 * 32 * 8);
constexpr size_t WS_WUQ    = AL(WS_W0IN + (size_t)L0INP * DM * 2);
constexpr size_t WS_WUKV   = AL(WS_WUQ + (size_t)1536 * 512 * 2);
constexpr size_t WS_W0OUT  = AL(WS_WUKV + (size_t)2048 * 256 * 2);
constexpr size_t WS_W1IN   = AL(WS_W0OUT + (size_t)DM * DM * 2);
constexpr size_t WS_W1OUT  = AL(WS_W1IN + (size_t)L1IN * DM * 2);
constexpr size_t EXPW      = (size_t)NEXP * EFF * DM * 2;
constexpr size_t WS_EG     = AL(WS_W1OUT + (size_t)DM * DM * 2);
constexpr size_t WS_EU     = AL(WS_EG + 2 * EXPW);
constexpr size_t WS_ED     = AL(WS_EU + 2 * EXPW);
constexpr size_t WS_GW     = AL(WS_ED + 2 * EXPW);
constexpr size_t WS_XA     = AL(WS_GW + (size_t)2 * 16 * 128 * 128 * 2);
constexpr size_t WS_XB     = AL(WS_XA + (size_t)NTOK * DM * 4);
constexpr size_t WS_H      = AL(WS_XB + (size_t)NTOK * DM * 4);
constexpr size_t WS_Z      = AL(WS_H + (size_t)NTOK * DM * 2);
constexpr size_t WS_CQN    = AL(WS_Z + (size_t)NTOK * L1IN * 2);
constexpr size_t WS_CKVN   = AL(WS_CQN + (size_t)NTOK * 512 * 2);
constexpr size_t WS_KR     = AL(WS_CKVN + (size_t)NTOK * 256 * 2);
constexpr size_t WS_Q0     = AL(WS_KR + (size_t)NTOK * 64 * 2);
constexpr size_t WS_KV0    = AL(WS_Q0 + (size_t)NTOK * 1536 * 2);
constexpr size_t WS_Y      = AL(WS_KV0 + (size_t)NTOK * 2048 * 2);
constexpr size_t WS_SUMM   = AL(WS_Y + (size_t)NTOK * DM * 2);
constexpr size_t WS_CARRY  = AL(WS_SUMM + (size_t)2 * NB * NCHUNK * 1024 * 8);
constexpr size_t WS_LIST   = AL(WS_CARRY + (size_t)2 * NB * NCHUNK * 1024 * 4);
constexpr size_t WS_TOK    = AL(WS_LIST + (size_t)NEXP * MOE_CAP * 4);
constexpr size_t WS_ACT    = AL(WS_TOK + (size_t)NTOK * 32);
constexpr size_t WS_OUT2   = AL(WS_ACT + (size_t)SLOT_ROWS * EFF * 2);
constexpr size_t WS_D      = AL(WS_OUT2 + (size_t)SLOT_ROWS * DM * 2);
constexpr size_t WS_ABG    = AL(WS_D + (size_t)NTOK * DM * 2);
constexpr size_t WS_END    = AL(WS_ABG + (size_t)NB * NCHUNK * 8 * 2 * 64 * 128 * 4);

struct TokInfo { int e0, p0, e1, p1; float w0, w1; int pad0, pad1; };

constexpr int LDS_STAGE = 0;
constexpr int LDS_MISC  = 139264;
constexpr int LDS_BYTES = 139264 + 4096;

struct Params { const float* in[38]; float* out; unsigned char* ws; int ph_lo, ph_hi, flags, pad; };

struct Frame {
    const float* const* in; float* out; unsigned char* ws; LAS unsigned char* lds;
    int tid, lane, wave, G, bid;
};
struct CvtJob { const float* src; bf16_t* dst; int K, N, ldo, perm, tiles_per_b, tile0; size_t sstride, dstride; };

DI int l1_permrow(int n) {
    if (n >= 1280) return n;
    const int hb = n & ~127, d = n & 127, a = d >> 6, part = (d >> 5) & 1, i = d & 31;
    return hb + 64 * a + 32 * (i >> 4) + 16 * part + (i & 15);
}

DI void set_job(LAS CvtJob* J, int j, const float* src, bf16_t* dst, int K, int N, int ldo, int perm, int nb, size_t ss, size_t ds, int& t0) {
    J[j].src = src; J[j].dst = dst; J[j].K = K; J[j].N = N; J[j].ldo = ldo; J[j].perm = perm; J[j].tiles_per_b = (K / 64) * ((N + 255) / 256); J[j].tile0 = t0;
    J[j].sstride = ss; J[j].dstride = ds; t0 += nb * J[j].tiles_per_b;
}

struct CvtTile { const float* src; bf16_t* dst; int N, ldo, k0, n0, nw, perm; };
DI void cvt_decode(LAS CvtJob* J, int nj, int gt, CvtTile& t) {
    int j = 0;
#pragma unroll 1
    for (int q = 1; q < nj; ++q) if (gt >= J[q].tile0) j = q;
    const int rem = gt - J[j].tile0, tpb = J[j].tiles_per_b, b = rem / tpb, r2 = rem % tpb;
    t.N = J[j].N; t.ldo = J[j].ldo; const int nst = (t.N + 255) / 256, kt = r2 / nst, st = r2 % nst; t.perm = J[j].perm;
    t.src = J[j].src + (size_t)b * J[j].sstride; t.dst = J[j].dst + (size_t)b * J[j].dstride;
    t.k0 = kt * 64; t.n0 = st * 256; t.nw = min(256, t.N - t.n0);
}
constexpr int MOE_CVT_TILES = 3 * NEXP * 64;
#ifndef BG_L0_P2
#define BG_L0_P2 960
#endif
#ifndef BG_L0_P6
#define BG_L0_P6 3960
#endif
#define BG_L1_DOWN0 4096
#ifndef BG_L0_P7
#define BG_L0_P7 (BG_L0_P6 + 768)
#endif
#ifndef BG_L1_P8
#define BG_L1_P8 2400
#endif
#ifndef BG_L1_P11
#define BG_L1_P11 4096
#endif
DI void cvt_group(const Params& p, LAS unsigned char* lds, int group, int t_lo, int t_hi, int r, int I) {
    const int tid = threadIdx.x;
    unsigned char* ws = p.ws;
    __syncthreads();
    LAS CvtJob* J = (LAS CvtJob*)(lds + 72 * 1024);
    LAS float* tile = (LAS float*)lds;
    if (tid == 0) {
        int t0 = 0, nj = 0;
        if (group == 0) {
            set_job(J, 0, p.in[11], (bf16_t*)(ws + WS_W0IN), DM, L0IN, DM, 0, 1, 0, 0, t0);
            set_job(J, 1, p.in[13], (bf16_t*)(ws + WS_WUQ), 512, 1536, 512, 0, 1, 0, 0, t0);
            set_job(J, 2, p.in[15], (bf16_t*)(ws + WS_WUKV), 256, 2048, 256, 0, 1, 0, 0, t0);
            set_job(J, 3, p.in[23], (bf16_t*)(ws + WS_W0OUT), DM, DM, DM, 0, 1, 0, 0, t0);
            set_job(J, 4, p.in[31], (bf16_t*)(ws + WS_W1IN), DM, L1IN, DM, 1, 1, 0, 0, t0);
            set_job(J, 5, p.in[34], (bf16_t*)(ws + WS_W1OUT), DM, DM, DM, 0, 1, 0, 0, t0);
            set_job(J, 6, p.in[18], (bf16_t*)(ws + WS_GW), 128, 128, 128, 0, 16, 128 * 128, 128 * 128, t0);
            set_job(J, 7, p.in[20], (bf16_t*)(ws + WS_GW + (size_t)16 * 128 * 128 * 2), 128, 128, 128, 0, 16, 128 * 128, 128 * 128, t0);
            nj = 8;
        } else if (group == 1) {
            set_job(J, 0, p.in[24], (bf16_t*)(ws + WS_EG), DM, EFF, DM, 0, NEXP, (size_t)DM * EFF, (size_t)EFF * DM, t0);
            set_job(J, 1, p.in[25], (bf16_t*)(ws + WS_EU), DM, EFF, DM, 0, NEXP, (size_t)DM * EFF, (size_t)EFF * DM, t0);
            set_job(J, 2, p.in[26], (bf16_t*)(ws + WS_ED), EFF, DM, EFF, 0, NEXP, (size_t)DM * EFF, (size_t)EFF * DM, t0);
            nj = 3;
        } else {
            set_job(J, 0, p.in[35], (bf16_t*)(ws + WS_EG + EXPW), DM, EFF, DM, 0, NEXP, (size_t)DM * EFF, (size_t)EFF * DM, t0);
            set_job(J, 1, p.in[36], (bf16_t*)(ws + WS_EU + EXPW), DM, EFF, DM, 0, NEXP, (size_t)DM * EFF, (size_t)EFF * DM, t0);
            set_job(J, 2, p.in[37], (bf16_t*)(ws + WS_ED + EXPW), EFF, DM, EFF, 0, NEXP, (size_t)DM * EFF, (size_t)EFF * DM, t0);
            nj = 3;
        }
        J[nj].tile0 = t0; J[15].tile0 = nj;
    }
    __syncthreads();
    const int nj = J[15].tile0, total = J[nj].tile0;
    const int hi = min(t_hi, total);
    const int row = tid >> 6, c4 = (tid & 63) * 4;
    for (int gt = t_lo + r; gt < hi; gt += I) {
        CvtTile cur; cvt_decode(J, nj, gt, cur);
        if (c4 < cur.nw) {
            f32x4 v[8];
#pragma unroll
            for (int i = 0; i < 8; ++i) v[i] = *(const f32x4*)(cur.src + (size_t)(cur.k0 + row + 8 * i) * cur.N + cur.n0 + c4);
#pragma unroll
            for (int i = 0; i < 8; ++i) *(LAS f32x4*)(tile + (row + 8 * i) * 260 + c4) = v[i];
        }
        __syncthreads();
        { const int n = tid & 255, kh = tid >> 8;
          if (n < cur.nw) {
              const int orow = cur.perm ? l1_permrow(cur.n0 + n) : (cur.n0 + n);
#pragma unroll
              for (int q8 = 0; q8 < 4; ++q8) {
                  float w8[8];
#pragma unroll
                  for (int q = 0; q < 8; ++q) w8[q] = tile[(32 * kh + 8 * q8 + q) * 260 + n];
                  u32x4 w; w.x = pk_bf16(w8[0], w8[1]); w.y = pk_bf16(w8[2], w8[3]); w.z = pk_bf16(w8[4], w8[5]); w.w = pk_bf16(w8[6], w8[7]);
                  *(u32x4*)(cur.dst + (size_t)orow * cur.ldo + cur.k0 + 32 * kh + 8 * q8) = w;
              }
          } }
        __syncthreads();
    }
}
DI void bg_range(const Params& p, LAS unsigned char* lds, int group, int t_lo, int t_hi, int nunits, int G, int bid) {
    const int rem = nunits % G;
    if (rem == 0) cvt_group(p, lds, group, t_lo, t_hi, bid, G);
    else if (bid >= rem) cvt_group(p, lds, group, t_lo, t_hi, bid - rem, G - rem);
}
DI int bg_end(int t_lo, int nunits, int per_wg, int G) { const int rem = nunits % G; if (rem == 0) return t_lo; return min(t_lo + (G - rem) * per_wg, MOE_CVT_TILES); }
DI int bg_convert(const Params& p, LAS unsigned char* lds, int group, int t_lo, int nunits, int per_wg, int G, int bid) {
    const int rem = nunits % G;
    if (rem == 0) return t_lo;
    const int idle = G - rem, t_hi = min(t_lo + idle * per_wg, MOE_CVT_TILES);
    if (bid >= rem && t_hi > t_lo) cvt_group(p, lds, group, t_lo, t_hi, bid - rem, idle);
    return t_hi;
}

DI void phase_prologue(const Params& p, LAS unsigned char* lds, int G, int bid) {
    const int tid = threadIdx.x;
    unsigned char* ws = p.ws;
    {
        LAS float* s = (LAS float*)lds;
        LAS float* part = (LAS float*)(lds + 40960);
        for (int i = tid; i < 5 * DM; i += NTHREADS) { const int r = i / DM, k = i % DM; const float c = r < 4 ? p.in[1][r * DM + k] : p.in[3][k]; s[i] = c / (1.0f + __expf(-c)); }
        __syncthreads();
        float* MOD = (float*)(ws + WS_MOD);
        for (int chunk = bid; chunk < 256; chunk += G) {
            const int layer = chunk >> 7, n0 = (chunk & 127) * 96;
            const float* W = layer ? p.in[27] : p.in[7]; const float* bias = layer ? p.in[28] : p.in[8];
            const int cg = tid % 24, ks = tid / 24;
            if (ks < 16) {
                f32x4 acc[5];
#pragma unroll
                for (int r = 0; r < 5; ++r) acc[r] = (f32x4){0.f, 0.f, 0.f, 0.f};
                const float* wp = W + (size_t)(ks * 128) * MODN + n0 + 4 * cg;
                for (int k = 0; k < 128; k += 8) {
                    f32x4 w[8];
#pragma unroll
                    for (int j = 0; j < 8; ++j) w[j] = *(const f32x4*)(wp + (size_t)(k + j) * MODN);
#pragma unroll
                    for (int j = 0; j < 8; ++j)
#pragma unroll
                        for (int r = 0; r < 5; ++r) acc[r] += s[r * DM + ks * 128 + k + j] * w[j];
                }
#pragma unroll
                for (int r = 0; r < 5; ++r)
#pragma unroll
                    for (int j = 0; j < 4; ++j) part[(ks * 5 + r) * 96 + cg * 4 + j] = acc[r][j];
            }
            __syncthreads();
            if (tid < 480) {
                const int r = tid / 96, col = tid % 96; float a = bias[n0 + col];
#pragma unroll
                for (int k2 = 0; k2 < 16; ++k2) a += part[(k2 * 5 + r) * 96 + col];
                MOD[((size_t)layer * 5 + r) * MODN + n0 + col] = a;
            }
            __syncthreads();
        }
    }
    {
        f32x2* R0 = (f32x2*)(ws + WS_ROPE0); f32x2* R1 = (f32x2*)(ws + WS_ROPE1);
        for (int i = bid * NTHREADS + tid; i < 64 * 16 + 64 * 32; i += G * NTHREADS) {
            if (i < 64 * 16) { const int pos = i >> 4, k = i & 15; const float ang = (float)pos * exp2f(-(float)k * (13.287712379549449f / 16.0f)); R0[i] = (f32x2){cosf(ang), sinf(ang)}; }
            else { const int j = i - 64 * 16, pos = j >> 5, k = j & 31; const float ang = (float)pos * exp2f(-(float)k * (13.287712379549449f / 32.0f)); R1[j] = (f32x2){cosf(ang), sinf(ang)}; }
        }
        u32x4* z = (u32x4*)(ws + WS_W0IN + (size_t)L0IN * DM * 2);
        for (int i = bid * NTHREADS + tid; i < (L0INP - L0IN) * DM * 2 / 16; i += G * NTHREADS) z[i] = (u32x4){0u, 0u, 0u, 0u};
    }
    cvt_group(p, lds, 0, 0, 1 << 30, bid, G);
    cvt_group(p, lds, 1, BG_L0_P7, MOE_CVT_TILES, bid, G);
    cvt_group(p, lds, 2, BG_L1_P11, BG_L1_DOWN0, bid, G);
}

DI void norm_mod_store(const f32x4 (&v)[8], const float* gain, const float* shift, const float* scale, bf16_t* hrow, int lane) {
    float ss = 0.f;
#pragma unroll
    for (int i = 0; i < 8; ++i) ss += v[i][0] * v[i][0] + v[i][1] * v[i][1] + v[i][2] * v[i][2] + v[i][3] * v[i][3];
    ss = wave_sum(ss);
    const float r = rsqrtf(ss * (1.0f / DM) + EPS);
#pragma unroll
    for (int i = 0; i < 8; ++i) {
        const int col = 4 * lane + 256 * i;
        const f32x4 g = *(const f32x4*)(gain + col), sh = *(const f32x4*)(shift + col), sc = *(const f32x4*)(scale + col);
        const f32x4 h = (v[i] * r * g) * (1.0f + sc) + sh;
        u32x2 w; w.x = pk_bf16(h[0], h[1]); w.y = pk_bf16(h[2], h[3]);
        *(u32x2*)(hrow + col) = w;
    }
}

DI void phase_norm0(const Params& p, int G, int bid) {
    const int lane = threadIdx.x & 63, wave = threadIdx.x >> 6;
    const float* MOD = (const float*)(p.ws + WS_MOD);
    bf16_t* H = (bf16_t*)(p.ws + WS_H);
    for (int row = bid * 8 + wave; row < NTOK; row += G * 8) {
        const float* xr = row < NCTX ? p.in[2] + (size_t)row * DM : p.in[0] + (size_t)(row - NCTX) * DM;
        f32x4 v[8];
#pragma unroll
        for (int i = 0; i < 8; ++i) v[i] = *(const f32x4*)(xr + 4 * lane + 256 * i);
        const float* md = MOD + (size_t)row_mod(row) * MODN;
        norm_mod_store(v, p.in[9], md, md + DM, H + (size_t)row * DM, lane);
    }
}
DI void phase_l0_rows(const Params& p, int G, int bid) {
    const int lane = threadIdx.x & 63, wave = threadIdx.x >> 6;
    const bf16_t* Z = (const bf16_t*)(p.ws + WS_Z);
    bf16_t* CQN = (bf16_t*)(p.ws + WS_CQN); bf16_t* CKVN = (bf16_t*)(p.ws + WS_CKVN); bf16_t* KR = (bf16_t*)(p.ws + WS_KR);
    const f32x2* R0 = (const f32x2*)(p.ws + WS_ROPE0);
    const bool wdeal = (G == 256);
    const int nslot = NTOK / 8;
    const int s_first = !wdeal ? bid : (bid < 128 ? bid : 128 + (bid - 128) * 4), s_cnt = !wdeal ? 1 : (bid < 128 ? 1 : 4), s_step = !wdeal ? G : 640;
    for (int sb = s_first; sb < nslot; sb += s_step)
    for (int sj = 0; sj < s_cnt && sb + sj < nslot; ++sj) {
        const int row = (sb + sj) * 8 + wave;
        const bf16_t* z = Z + (size_t)row * L0INP;
        {
            const u32x4 w = *(const u32x4*)(z + 8 * lane);
            float v[8] = {bflo(w.x), bfhi(w.x), bflo(w.y), bfhi(w.y), bflo(w.z), bfhi(w.z), bflo(w.w), bfhi(w.w)};
            float ss = 0.f;
#pragma unroll
            for (int j = 0; j < 8; ++j) ss += v[j] * v[j];
            ss = wave_sum(ss);
            const float r = rsqrtf(ss * (1.0f / 512.0f) + EPS);
            const f32x4 g0 = *(const f32x4*)(p.in[12] + 8 * lane), g1 = *(const f32x4*)(p.in[12] + 8 * lane + 4);
            u32x4 o; o.x = pk_bf16(v[0] * r * g0[0], v[1] * r * g0[1]); o.y = pk_bf16(v[2] * r * g0[2], v[3] * r * g0[3]);
            o.z = pk_bf16(v[4] * r * g1[0], v[5] * r * g1[1]); o.w = pk_bf16(v[6] * r * g1[2], v[7] * r * g1[3]);
            *(u32x4*)(CQN + (size_t)row * 512 + 8 * lane) = o;
        }
        {
            const u32x2 w = *(const u32x2*)(z + 512 + 4 * lane);
            float v[4] = {bflo(w.x), bfhi(w.x), bflo(w.y), bfhi(w.y)};
            float ss = v[0] * v[0] + v[1] * v[1] + v[2] * v[2] + v[3] * v[3];
            ss = wave_sum(ss);
            const float r = rsqrtf(ss * (1.0f / 256.0f) + EPS);
            const f32x4 g = *(const f32x4*)(p.in[14] + 4 * lane);
            u32x2 o; o.x = pk_bf16(v[0] * r * g[0], v[1] * r * g[1]); o.y = pk_bf16(v[2] * r * g[2], v[3] * r * g[3]);
            *(u32x2*)(CKVN + (size_t)row * 256 + 4 * lane) = o;
        }
        {
            const float x = bf2f(z[768 + lane]);
            const float xp = __shfl_xor(x, 16);
            float o = x;
            if (row >= NCTX) {
                const int t = (row - NCTX) & (SEQ - 1), axis = lane >> 5, part = (lane >> 4) & 1, i = lane & 15;
                const int pos = axis ? (t & 63) : (t >> 6);
                const f32x2 cs = R0[pos * 16 + i];
                o = part ? (x * cs[0] + xp * cs[1]) : (x * cs[0] - xp * cs[1]);
            }
            KR[(size_t)row * 64 + lane] = f2bf(o);
        }
    }
}

DI float gelu_tanh(float x) { const float u = 0.7978845608028654f * (x + 0.044715f * x * x * x); const float e = __expf(2.0f * u); const float th = 1.0f - 2.0f / (e + 1.0f); return 0.5f * x * (1.0f + th); }

template <int PASS>
DI void lru_units(const Params& p, LAS unsigned char* lds, int G, int bid) {
    const int tid = threadIdx.x, lane = tid & 63, wave = tid >> 6;
    const bf16_t* Z = (const bf16_t*)(p.ws + WS_Z);
    const bf16_t* GWA = (const bf16_t*)(p.ws + WS_GW); const bf16_t* GWX = GWA + 16 * 128 * 128;
    f32x2* SUMM = (f32x2*)(p.ws + WS_SUMM); const float* CARRY = (const float*)(p.ws + WS_CARRY);
    bf16_t* Y = (bf16_t*)(p.ws + WS_Y);
    unsigned* ABG = (unsigned*)(p.ws + WS_ABG);
    LAS float* U32 = (LAS float*)lds;
    LAS unsigned char* UBF = lds + 32768;
    LAS f32x2* AB = (LAS f32x2*)lds;
    const bool by_n = (G % 8) == 0;
    const int n_fix = bid & 7, nW = by_n ? G / 8 : G, q0 = by_n ? bid >> 3 : bid, nunits = by_n ? NCHUNK * NB : NCHUNK * NB * 8;
    const int d = wave >> 2, nt = wave & 3, jl = lane & 31, h = lane >> 5, ch = 32 * nt + jl;
    bf16x8 wa[8], wx[8];
    if (by_n) {
        const bf16_t* pa = GWA + ((size_t)(d * 8 + n_fix) * 128 + ch) * 128 + 8 * h;
        const bf16_t* px = GWX + ((size_t)(d * 8 + n_fix) * 128 + ch) * 128 + 8 * h;
#pragma unroll
        for (int ks = 0; ks < 8; ++ks) { wa[ks] = *(const bf16x8*)(pa + 16 * ks); wx[ks] = *(const bf16x8*)(px + 16 * ks); }
    }
    for (int v = q0; v < nunits; v += nW) {
        const int n = by_n ? n_fix : (v & 7), bc = by_n ? v : (v >> 3), b = bc & 3, ci = bc >> 2;
        const int seg_len = ci < 4 ? CTX : SEQ, t0 = ci < 4 ? 64 * ci : 64 * (ci - 4);
        const int row0 = ci < 4 ? b * CTX + t0 : NCTX + b * SEQ + t0;
        const int chg = 128 * n + ch;
        if (!by_n) {
            const bf16_t* pa = GWA + ((size_t)(d * 8 + n) * 128 + ch) * 128 + 8 * h;
            const bf16_t* px = GWX + ((size_t)(d * 8 + n) * 128 + ch) * 128 + 8 * h;
#pragma unroll
            for (int ks = 0; ks < 8; ++ks) { wa[ks] = *(const bf16x8*)(pa + 16 * ks); wx[ks] = *(const bf16x8*)(px + 16 * ks); }
        }
        u32x2 grw[4];
        {
            const int c4 = (tid & 31) * 4, tb = 4 * (tid >> 5), cg = 128 * n + c4;
            f32x4 xv[7];
#pragma unroll
            for (int q = 0; q < 7; ++q) { const int tt = t0 + tb + q - 2; u32x2 w = (u32x2){0u, 0u};
                if (tt >= 0 && tt < seg_len) w = *(const u32x2*)(Z + (size_t)(row0 + tb + q - 2) * L0INP + 832 + cg);
                xv[q] = (f32x4){bflo(w.x), bfhi(w.x), bflo(w.y), bfhi(w.y)}; }
            if (PASS == 2) {
#pragma unroll
                for (int j = 0; j < 4; ++j) grw[j] = *(const u32x2*)(Z + (size_t)(row0 + tb + j) * L0INP + 1856 + cg);
            }
            const f32x4 cb = *(const f32x4*)(p.in[17] + cg);
            f32x4 cw[4];
#pragma unroll
            for (int tap = 0; tap < 4; ++tap) cw[tap] = *(const f32x4*)(p.in[16] + tap * 1024 + cg);
#pragma unroll
            for (int j = 0; j < 4; ++j) {
                const f32x4 acc = cb + xv[j] * cw[0] + xv[j + 1] * cw[1] + xv[j + 2] * cw[2] + xv[j + 3] * cw[3];
                *(LAS f32x4*)(U32 + (tb + j) * 128 + c4) = acc;
                u32x2 o; o.x = pk_bf16(acc[0], acc[1]); o.y = pk_bf16(acc[2], acc[3]);
                *(LAS u32x2*)(UBF + (tb + j) * 272 + c4 * 2) = o;
            }
        }
        __syncthreads();
        f32x16 acc[2][2];
#pragma unroll
        for (int g = 0; g < 2; ++g)
#pragma unroll
            for (int mt = 0; mt < 2; ++mt)
#pragma unroll
                for (int i = 0; i < 16; ++i) acc[g][mt][i] = 0.f;
#pragma unroll
        for (int ks = 0; ks < 8; ++ks) {
            const bf16x8 a0 = *(const LAS bf16x8*)(UBF + jl * 272 + (16 * ks + 8 * h) * 2);
            const bf16x8 a1 = *(const LAS bf16x8*)(UBF + (32 + jl) * 272 + (16 * ks + 8 * h) * 2);
            acc[0][0] = __builtin_amdgcn_mfma_f32_32x32x16_bf16(a0, wa[ks], acc[0][0], 0, 0, 0);
            acc[0][1] = __builtin_amdgcn_mfma_f32_32x32x16_bf16(a1, wa[ks], acc[0][1], 0, 0, 0);
            acc[1][0] = __builtin_amdgcn_mfma_f32_32x32x16_bf16(a0, wx[ks], acc[1][0], 0, 0, 0);
            acc[1][1] = __builtin_amdgcn_mfma_f32_32x32x16_bf16(a1, wx[ks], acc[1][1], 0, 0, 0);
        }
        {
            const float ga_b = p.in[19][d * 1024 + chg], gx_b = p.in[21][d * 1024 + chg], lam = p.in[22][d * 1024 + chg];
            const float sp8l2 = 8.0f * LOG2E * log1pf(expf(-lam));
#pragma unroll
            for (int mt = 0; mt < 2; ++mt)
#pragma unroll
                for (int i = 0; i < 16; ++i) {
                    const int t = 32 * mt + (i & 3) + 8 * (i >> 2) + 4 * h;
                    const float r = __builtin_amdgcn_rcpf(1.0f + __builtin_amdgcn_exp2f(-LOG2E * (acc[0][mt][i] + ga_b)));
                    const float ig = __builtin_amdgcn_rcpf(1.0f + __builtin_amdgcn_exp2f(-LOG2E * (acc[1][mt][i] + gx_b)));
                    const float a = __builtin_amdgcn_exp2f(-sp8l2 * r);
                    const float bb = __builtin_amdgcn_sqrtf((1.0f - a) * (1.0f + a)) * (ig * U32[t * 128 + ch]);
                    acc[0][mt][i] = a; acc[1][mt][i] = bb;
                }
        }
        __syncthreads();
#pragma unroll
        for (int mt = 0; mt < 2; ++mt)
#pragma unroll
            for (int i = 0; i < 16; ++i) { const int t = 32 * mt + (i & 3) + 8 * (i >> 2) + 4 * h; AB[(d * 64 + t) * 128 + ch] = (f32x2){acc[0][mt][i], acc[1][mt][i]};
                if (PASS == 1) ABG[((((size_t)(b * NCHUNK + ci) * 8 + n) * 2 + d) * 64 + t) * 128 + ch] = pk_bf16(1.0f - acc[0][mt][i], acc[1][mt][i]); }
        __syncthreads();
        if (tid < 256) {
            const int sd = tid >> 7, sc = tid & 127;
            const size_t sidx = ((size_t)(sd * NB + b) * NCHUNK + ci) * 1024 + 128 * n + sc;
            if (PASS == 1) {
                float hh = 0.f, ap = 1.f;
#pragma unroll 16
                for (int s2 = 0; s2 < 64; ++s2) { const int t = sd ? 63 - s2 : s2; const f32x2 ab = AB[(sd * 64 + t) * 128 + sc]; hh = ab[0] * hh + ab[1]; ap *= ab[0]; }
                SUMM[sidx] = (f32x2){ap, hh};
            } else {
                float hh = CARRY[sidx];
#pragma unroll 16
                for (int s2 = 0; s2 < 64; ++s2) { const int t = sd ? 63 - s2 : s2; const f32x2 ab = AB[(sd * 64 + t) * 128 + sc]; hh = ab[0] * hh + ab[1]; AB[(sd * 64 + t) * 128 + sc] = (f32x2){ab[0], hh}; }
            }
        }
        __syncthreads();
        if (PASS == 2) {
            const int c4 = (tid & 31) * 4, tb = 4 * (tid >> 5);
#pragma unroll
            for (int j = 0; j < 4; ++j) {
                const int t = tb + j; const size_t row = (size_t)(row0 + t);
                const float gr[4] = {bflo(grw[j].x), bfhi(grw[j].x), bflo(grw[j].y), bfhi(grw[j].y)};
                float y[4];
#pragma unroll
                for (int k = 0; k < 4; ++k) y[k] = (AB[(t) * 128 + c4 + k][1] + AB[(64 + t) * 128 + c4 + k][1]) * gelu_tanh(gr[k]);
                u32x2 o; o.x = pk_bf16(y[0], y[1]); o.y = pk_bf16(y[2], y[3]);
                *(u32x2*)(Y + row * DM + 1024 + 128 * n + c4) = o;
            }
            __syncthreads();
        }
    }
}

DI void lru_pass2(const Params& p, LAS unsigned char* lds, int G, int bid) {
    const int tid = threadIdx.x;
    const bf16_t* Z = (const bf16_t*)(p.ws + WS_Z);
    const unsigned* ABG = (const unsigned*)(p.ws + WS_ABG); const float* CARRY = (const float*)(p.ws + WS_CARRY);
    bf16_t* Y = (bf16_t*)(p.ws + WS_Y);
    LAS float* HB = (LAS float*)lds;
    const int NU = NCHUNK * NB * 8;
    const bool special = (G == 256);
    const bool ctxwg = special && bid >= 128 && bid < 160;
    const int ustart = !special ? bid : (ctxwg ? (NU - 32) + (bid - 128) : (bid < 128 ? bid : bid - 32));
    const int ustep = !special ? G : (ctxwg ? NU : 224), uend = !special ? NU : (ctxwg ? NU : NU - 32);
    for (int u = ustart; u < uend; u += ustep) {
        const int n = u & 7, bc = u >> 3, b = bc & 3, ci = bc >> 2;
        const int t0 = ci < 4 ? 64 * ci : 64 * (ci - 4);
        const int row0 = ci < 4 ? b * CTX + t0 : NCTX + b * SEQ + t0;
        const int c4 = (tid & 31) * 4, tb = 4 * (tid >> 5), cg = 128 * n + c4;
        u32x2 grw[4];
#pragma unroll
        for (int j = 0; j < 4; ++j) grw[j] = *(const u32x2*)(Z + (size_t)(row0 + tb + j) * L0INP + 1856 + cg);
        if (tid < 256) {
            const int sd = tid >> 7, sc = tid & 127;
            const unsigned* ab = ABG + ((((size_t)(b * NCHUNK + ci) * 8 + n) * 2 + sd) * 64) * 128 + sc;
            unsigned w[64];
#pragma unroll
            for (int t = 0; t < 64; ++t) w[t] = ab[t * 128];
            float hh = CARRY[((size_t)(sd * NB + b) * NCHUNK + ci) * 1024 + 128 * n + sc];
            if (sd == 0) {
#pragma unroll
                for (int t = 0; t < 64; ++t) { hh = fmaf(1.0f - bflo(w[t]), hh, bfhi(w[t])); HB[t * 128 + sc] = hh; }
            } else {
#pragma unroll
                for (int t = 63; t >= 0; --t) { hh = fmaf(1.0f - bflo(w[t]), hh, bfhi(w[t])); HB[(64 + t) * 128 + sc] = hh; }
            }
        }
        __syncthreads();
#pragma unroll
        for (int j = 0; j < 4; ++j) {
            const int t = tb + j; const size_t row = (size_t)(row0 + t);
            const float gr[4] = {bflo(grw[j].x), bfhi(grw[j].x), bflo(grw[j].y), bfhi(grw[j].y)};
            const f32x4 hf = *(const LAS f32x4*)(HB + t * 128 + c4), hb = *(const LAS f32x4*)(HB + (64 + t) * 128 + c4);
            float y[4];
#pragma unroll
            for (int k = 0; k < 4; ++k) y[k] = (hf[k] + hb[k]) * gelu_tanh(gr[k]);
            u32x2 o; o.x = pk_bf16(y[0], y[1]); o.y = pk_bf16(y[2], y[3]);
            *(u32x2*)(Y + row * DM + 1024 + 128 * n + c4) = o;
        }
        __syncthreads();
    }
}

DI void lru_carry(const Params& p, int G, int bid) {
    const f32x2* SUMM = (const f32x2*)(p.ws + WS_SUMM); float* CARRY = (float*)(p.ws + WS_CARRY);
    for (int gid = bid * NTHREADS + threadIdx.x; gid < 2 * NB * 1024; gid += G * NTHREADS) {
        const int d = gid >> 12, b = (gid >> 10) & 3, ch = gid & 1023;
        const size_t base = ((size_t)(d * NB + b) * NCHUNK) * 1024 + ch;
        float hh = 0.f;
#pragma unroll
        for (int pos = 0; pos < NCHUNK; ++pos) {
            const int ci = d == 0 ? pos : (pos < 4 ? 3 - pos : 39 - pos);
            CARRY[base + (size_t)ci * 1024] = hh;
            const f32x2 s = SUMM[base + (size_t)ci * 1024];
            hh = s[0] * hh + s[1];
        }
    }
}
#define MFMA32(a, b, c) __builtin_amdgcn_mfma_f32_32x32x16_bf16((a), (b), (c), 0, 0, 0)
constexpr int AT_KSLOT = 24576, AT_VSLOT = 16384, AT_K0 = 0, AT_V0 = 2 * AT_KSLOT, AT_XOFF = AT_V0 + 2 * AT_VSLOT;

#ifndef AT_PIPE_MLA
#define AT_PIPE_MLA false
#endif
#ifndef AT_PIPE_WIN
#define AT_PIPE_WIN false
#endif
#ifndef AT_PIPE_NA
#define AT_PIPE_NA false
#endif
#ifndef AT_SKEW_MLA
#define AT_SKEW_MLA 0
#endif
#ifndef AT_SKEW_WIN
#define AT_SKEW_WIN 0
#endif
#ifndef AT_SKEW_NA
#define AT_SKEW_NA 0
#endif
constexpr float AT_M0 = -30.0f;
struct NoBias { DI float operator()(int, float nm) const { return nm; } };

struct AtRd { int kbase, kbase1, ko[4], vbase, vo[4]; };
template <int DQ> DI int at_kf(int r) { return DQ == 128 ? (r & 15) : ((r >> 1) & 7); }
template <int DQ>
DI AtRd at_rd_init(int lane) {
    AtRd r; const int kr = lane & 31, h = lane >> 5, i16 = lane & 15, q = i16 >> 2, pp = i16 & 3, blk = (lane >> 4) & 1;
    const int f = at_kf<DQ>(kr);
    r.kbase = kr * (DQ * 2) + ((f >> 3) << 7); r.kbase1 = kr * (DQ * 2) + (((f >> 3) ^ 1) << 7);
#pragma unroll
    for (int i = 0; i < 4; ++i) r.ko[i] = ((2 * i + h) ^ (f & 7)) << 4;
    r.vbase = (4 * h + q) * 256 + 8 * pp;
#pragma unroll
    for (int t = 0; t < 4; ++t) r.vo[t] = ((2 * t + blk) ^ ((4 * h + q) & 7)) << 5;
    return r;
}
template <int DQ>
DI void at_qk(const LAS unsigned char* ks, const AtRd& rd, const bf16x8 (&qf)[DQ / 16], f32x16& s0, f32x16& s1) {
#pragma unroll
    for (int i = 0; i < 16; ++i) { s0[i] = 0.f; s1[i] = 0.f; }
    const LAS unsigned char* kp0 = ks + rd.kbase; const LAS unsigned char* kp1 = ks + rd.kbase1;
#pragma unroll
    for (int s = 0; s < DQ / 16; ++s) {
        const LAS unsigned char* kp = (DQ == 128) ? ((s >> 2) ? kp1 : kp0) : kp0 + ((s >> 2) << 7);
        const bf16x8 a0 = *(const LAS bf16x8*)(kp + rd.ko[s & 3]);
        const bf16x8 a1 = *(const LAS bf16x8*)(kp + 32 * (DQ * 2) + rd.ko[s & 3]);
        s0 = MFMA32(a0, qf[s], s0); s1 = MFMA32(a1, qf[s], s1);
    }
}
template <class BiasFn>
DI void at_sm(f32x16& s0, f32x16& s1, f32x16 (&o)[4], float& m, float& l, const float c2, const BiasFn& bias, const int lane, bf16x8 (&pf)[4]) {
    const int h = lane >> 5;
    const float nm = -m;
    float mx = -INFINITY;
#pragma unroll
    for (int i = 0; i < 16; ++i) {
        const int key = (i & 3) + 8 * (i >> 2) + 4 * h;
        s0[i] = fmaf(s0[i], c2, bias(key, nm)); s1[i] = fmaf(s1[i], c2, bias(32 + key, nm));
        mx = fmaxf(mx, fmaxf(s0[i], s1[i]));
    }
    { const auto sw = __builtin_amdgcn_permlane32_swap(__float_as_uint(mx), __float_as_uint(mx), false, false); mx = fmaxf(__uint_as_float(sw[0]), __uint_as_float(sw[1])); }
    if (__any(mx > 8.0f)) {
        const float d = fmaxf(mx, 0.f), alpha = __builtin_amdgcn_exp2f(-d);
        m += d; l *= alpha;
#pragma unroll
        for (int t = 0; t < 4; ++t)
#pragma unroll
            for (int i = 0; i < 16; ++i) o[t][i] *= alpha;
#pragma unroll
        for (int i = 0; i < 16; ++i) { s0[i] -= d; s1[i] -= d; }
    }
    float rs = 0.f;
#pragma unroll
    for (int i = 0; i < 16; ++i) { s0[i] = __builtin_amdgcn_exp2f(s0[i]); s1[i] = __builtin_amdgcn_exp2f(s1[i]); rs += s0[i] + s1[i]; }
    l += rs;
    u32x4 w;
    w.x = pk_bf16(s0[0], s0[1]); w.y = pk_bf16(s0[2], s0[3]); w.z = pk_bf16(s0[4], s0[5]); w.w = pk_bf16(s0[6], s0[7]); pf[0] = __builtin_bit_cast(bf16x8, w);
    w.x = pk_bf16(s0[8], s0[9]); w.y = pk_bf16(s0[10], s0[11]); w.z = pk_bf16(s0[12], s0[13]); w.w = pk_bf16(s0[14], s0[15]); pf[1] = __builtin_bit_cast(bf16x8, w);
    w.x = pk_bf16(s1[0], s1[1]); w.y = pk_bf16(s1[2], s1[3]); w.z = pk_bf16(s1[4], s1[5]); w.w = pk_bf16(s1[6], s1[7]); pf[2] = __builtin_bit_cast(bf16x8, w);
    w.x = pk_bf16(s1[8], s1[9]); w.y = pk_bf16(s1[10], s1[11]); w.z = pk_bf16(s1[12], s1[13]); w.w = pk_bf16(s1[14], s1[15]); pf[3] = __builtin_bit_cast(bf16x8, w);
}
DI void at_pv(const LAS unsigned char* vs, const AtRd& rd, const bf16x8 (&pf)[4], f32x16 (&o)[4]) {
    const LAS unsigned char* vb = vs + rd.vbase;
#pragma unroll
    for (int ks = 0; ks < 4; ++ks)
#pragma unroll
        for (int t = 0; t < 4; ++t) {
            const s16x4 lo = __builtin_amdgcn_ds_read_tr16_b64_v4i16((LAS s16x4*)(vb + (16 * ks) * 256 + rd.vo[t]));
            const s16x4 hi = __builtin_amdgcn_ds_read_tr16_b64_v4i16((LAS s16x4*)(vb + (16 * ks + 8) * 256 + rd.vo[t]));
            const bf16x8 vf = __builtin_shufflevector(lo, hi, 0, 1, 2, 3, 4, 5, 6, 7);
            o[t] = MFMA32(vf, pf[ks], o[t]);
        }
}
template <class BiasFn>
DI void at_sm_pv(const LAS unsigned char* vs, const AtRd& rd, f32x16& s0, f32x16& s1, f32x16 (&o)[4], float& m, float& l, const float c2, const BiasFn& bias, const int lane) {
    bf16x8 pf[4];
    at_sm(s0, s1, o, m, l, c2, bias, lane, pf);
    at_pv(vs, rd, pf, o);
}

struct AtDma { unsigned ko[3], vo[2]; unsigned rope; };
template <int DQ>
DI AtDma at_dma_init(int ld_bytes, int wave, int lane) {
    AtDma d; d.rope = 0u;
    constexpr int PPR = DQ / 8;
#pragma unroll
    for (int k = 0; k < DQ / 64; ++k) { const int L = (wave + 8 * k) * 64 + lane, r = L / PPR, pc = (L % PPR) ^ at_kf<DQ>(r);
        if (DQ == 192 && pc >= 16) { d.ko[k] = (unsigned)(r * 128 + (pc - 16) * 16); d.rope |= 1u << k; } else d.ko[k] = (unsigned)(r * ld_bytes + pc * 16); }
    if (DQ == 128) d.ko[2] = 0u;
#pragma unroll
    for (int k = 0; k < 2; ++k) { const int L = (wave + 8 * k) * 64 + lane, r = L >> 4, pc = (L & 15) ^ (2 * (r & 7)); d.vo[k] = (unsigned)(r * ld_bytes + pc * 16); }
    return d;
}
template <int DQ>
DI void at_dma_k(LAS unsigned char* kslot, const char* kb, const char* rb, const AtDma& d, int wave) {
#pragma unroll
    for (int k = 0; k < DQ / 64; ++k) {
        const char* src = (DQ == 192 && ((d.rope >> k) & 1u)) ? rb + d.ko[k] : kb + d.ko[k];
        __builtin_amdgcn_global_load_lds((const unsigned*)src, (LAS unsigned*)(kslot + (wave + 8 * k) * 1024), 16, 0, 0);
    }
}
DI void at_dma_v(LAS unsigned char* vslot, const char* vb, const AtDma& d, int wave) {
#pragma unroll
    for (int k = 0; k < 2; ++k) __builtin_amdgcn_global_load_lds((const unsigned*)(vb + d.vo[k]), (LAS unsigned*)(vslot + (wave + 8 * k) * 1024), 16, 0, 0);
}
#define AT_DRAIN_SYNC() do { asm volatile("s_waitcnt vmcnt(0)" ::: "memory"); __syncthreads(); } while (0)

template <int DQ, bool PIPE, class Drv>
DI void at_run(LAS unsigned char* lds, const Drv& D, const int n, const AtRd& rd, const AtDma& dm, const bf16x8 (&qf)[DQ / 16], f32x16 (&o)[4], float& m, float& l, const float c2, const int lane, const int wave) {
    f32x16 a0, a1;
    __syncthreads();
    at_dma_k<DQ>(lds + AT_K0, D.kb(0), D.rb(0), dm, wave); at_dma_v(lds + AT_V0, D.vb(0), dm, wave);
    if constexpr (PIPE) {
        f32x16 b0, b1;
        if (n > 1) at_dma_k<DQ>(lds + AT_K0 + AT_KSLOT, D.kb(1), D.rb(1), dm, wave);
        AT_DRAIN_SYNC();
        if (D.act(0)) at_qk<DQ>(lds + AT_K0, rd, qf, a0, a1);
#define AT_STEP(J, PAR, C0, C1, N0, N1) do { const int j_ = (J); \
        if (j_ + 2 < n) at_dma_k<DQ>(lds + AT_K0 + (PAR) * AT_KSLOT, D.kb(j_ + 2), D.rb(j_ + 2), dm, wave); \
        if (j_ + 1 < n) at_dma_v(lds + AT_V0 + (1 - (PAR)) * AT_VSLOT, D.vb(j_ + 1), dm, wave); \
        if (j_ + 1 < n && D.act(j_ + 1)) at_qk<DQ>(lds + AT_K0 + (1 - (PAR)) * AT_KSLOT, rd, qf, N0, N1); \
        if (D.act(j_)) at_sm_pv(lds + AT_V0 + (PAR) * AT_VSLOT, rd, C0, C1, o, m, l, c2, D.bias(j_), lane); \
        AT_DRAIN_SYNC(); } while (0)
        for (int j = 0; j < n; j += 2) {
            AT_STEP(j, 0, a0, a1, b0, b1);
            if (j + 1 < n) AT_STEP(j + 1, 1, b0, b1, a0, a1);
        }
#undef AT_STEP
    } else {
        AT_DRAIN_SYNC();
        for (int j = 0; j < n; ++j) {
            const int par = j & 1;
            if (j + 1 < n) { at_dma_k<DQ>(lds + AT_K0 + (1 - par) * AT_KSLOT, D.kb(j + 1), D.rb(j + 1), dm, wave); at_dma_v(lds + AT_V0 + (1 - par) * AT_VSLOT, D.vb(j + 1), dm, wave); }
            if (D.act(j)) { at_qk<DQ>(lds + AT_K0 + par * AT_KSLOT, rd, qf, a0, a1); at_sm_pv(lds + AT_V0 + par * AT_VSLOT, rd, a0, a1, o, m, l, c2, D.bias(j), lane); }
            AT_DRAIN_SYNC();
        }
    }
}

constexpr int AT3_V0 = 2 * AT_KSLOT, AT3_XOFF = AT3_V0 + 3 * AT_VSLOT;
template <int DQ, class Drv>
DI void at_run_skew(LAS unsigned char* lds, const Drv& D, const int n, const AtRd& rd, const AtDma& dm, const bf16x8 (&qf)[DQ / 16], f32x16 (&o)[4], float& m, float& l, const float c2, const int lane, const int wave) {
    const bool late = wave >= 4;
    bf16x8 pf[4];
    __syncthreads();
    at_dma_k<DQ>(lds + AT_K0, D.kb(0), D.rb(0), dm, wave); at_dma_v(lds + AT3_V0, D.vb(0), dm, wave);
    AT_DRAIN_SYNC();
    int vcur = 0;
    for (int j = 0; j < n; ++j) {
        const int vnext = vcur == 2 ? 0 : vcur + 1, vprev = vcur == 0 ? 2 : vcur - 1;
        if (j + 1 < n) { at_dma_k<DQ>(lds + AT_K0 + ((j + 1) & 1) * AT_KSLOT, D.kb(j + 1), D.rb(j + 1), dm, wave); at_dma_v(lds + AT3_V0 + vnext * AT_VSLOT, D.vb(j + 1), dm, wave); }
        if (late && j > 0 && D.act(j - 1)) at_pv(lds + AT3_V0 + vprev * AT_VSLOT, rd, pf, o);
        if (D.act(j)) {
            f32x16 a0, a1;
            at_qk<DQ>(lds + AT_K0 + (j & 1) * AT_KSLOT, rd, qf, a0, a1);
            at_sm(a0, a1, o, m, l, c2, D.bias(j), lane, pf);
            if (!late) at_pv(lds + AT3_V0 + vcur * AT_VSLOT, rd, pf, o);
        }
        AT_DRAIN_SYNC();
        vcur = vnext;
    }
    if (late && D.act(n - 1)) at_pv(lds + AT3_V0 + (vcur == 0 ? 2 : vcur - 1) * AT_VSLOT, rd, pf, o);
}

constexpr int AT4_SLOT = AT_KSLOT + AT_VSLOT, AT4_XOFF = 3 * AT4_SLOT;
template <int DQ, class Drv>
DI void at_run3(LAS unsigned char* lds, const Drv& D, const int n, const AtRd& rd, const AtDma& dm, const bf16x8 (&qf)[DQ / 16], f32x16 (&o)[4], float& m, float& l, const float c2, const int lane, const int wave) {
    __syncthreads();
    at_dma_k<DQ>(lds, D.kb(0), D.rb(0), dm, wave); at_dma_v(lds + AT_KSLOT, D.vb(0), dm, wave);
    if (n > 1) { at_dma_k<DQ>(lds + AT4_SLOT, D.kb(1), D.rb(1), dm, wave); at_dma_v(lds + AT4_SLOT + AT_KSLOT, D.vb(1), dm, wave);
        if (DQ == 192) asm volatile("s_waitcnt vmcnt(5)" ::: "memory"); else asm volatile("s_waitcnt vmcnt(4)" ::: "memory"); }
    else asm volatile("s_waitcnt vmcnt(0)" ::: "memory");
    __syncthreads();
    int cur = 0;
    for (int j = 0; j < n; ++j) {
        const int nx2 = cur == 0 ? 2 : cur - 1;
        if (j + 2 < n) { at_dma_k<DQ>(lds + nx2 * AT4_SLOT, D.kb(j + 2), D.rb(j + 2), dm, wave); at_dma_v(lds + nx2 * AT4_SLOT + AT_KSLOT, D.vb(j + 2), dm, wave); }
        if (D.act(j)) {
            f32x16 a0, a1;
            at_qk<DQ>(lds + cur * AT4_SLOT, rd, qf, a0, a1);
            at_sm_pv(lds + cur * AT4_SLOT + AT_KSLOT, rd, a0, a1, o, m, l, c2, D.bias(j), lane);
        }
        if (j + 2 < n) { if (DQ == 192) asm volatile("s_waitcnt vmcnt(5)" ::: "memory"); else asm volatile("s_waitcnt vmcnt(4)" ::: "memory"); }
        else asm volatile("s_waitcnt vmcnt(0)" ::: "memory");
        __syncthreads();
        cur = cur == 2 ? 0 : cur + 1;
    }
}

DI void attn_store(const f32x16 (&o)[4], float l, float extra, bf16_t* orow, int lane) {
    const int h = lane >> 5;
    const float lt = l + __shfl_xor(l, 32) + extra;
    const float inv = 1.0f / lt;
#pragma unroll
    for (int t = 0; t < 4; ++t)
#pragma unroll
        for (int g4 = 0; g4 < 4; ++g4) {
            u32x2 w; w.x = pk_bf16(o[t][4 * g4] * inv, o[t][4 * g4 + 1] * inv); w.y = pk_bf16(o[t][4 * g4 + 2] * inv, o[t][4 * g4 + 3] * inv);
            *(u32x2*)(orow + 32 * t + 8 * g4 + 4 * h) = w;
        }
}

struct MlaDrv {
    const char* KV; const char* KR; int b, head;
    DI int keyrow0(int j) const { return j < 4 ? b * CTX + 64 * j : NCTX + b * SEQ + 64 * (j - 4); }
    DI const char* kb(int j) const { return KV + (size_t)keyrow0(j) * 4096 + head * 512; }
    DI const char* vb(int j) const { return KV + (size_t)keyrow0(j) * 4096 + head * 512 + 256; }
    DI const char* rb(int j) const { return KR + (size_t)keyrow0(j) * 128; }
    DI bool act(int) const { return true; }
    DI NoBias bias(int) const { return NoBias(); }
};

DI void phase_attn0(const Params& p, LAS unsigned char* lds, int G, int bid) {
    const int tid = threadIdx.x, lane = tid & 63, wave = __builtin_amdgcn_readfirstlane(tid >> 6), h = lane >> 5;
    const bf16_t* Q0 = (const bf16_t*)(p.ws + WS_Q0);
    bf16_t* Y = (bf16_t*)(p.ws + WS_Y);
    const float c2 = 0.07216878364870322f * LOG2E;
    const AtRd rd = at_rd_init<192>(lane);
    const AtDma dm = at_dma_init<192>(4096, wave, lane);
    for (int it = 0; it < 2; ++it)
    for (int u = it == 0 ? bid : 256 + (bid + G - G / 2) % G; u < (it == 0 ? 256 : 256 + 32); u += G) {
        MlaDrv T; T.KV = (const char*)(p.ws + WS_KV0); T.KR = (const char*)(p.ws + WS_KR);
        int qrow, nt;
        if (u < 256) { T.b = u >> 6; T.head = (u >> 3) & 7; nt = 36; qrow = NCTX + T.b * SEQ + (u & 7) * 256 + wave * 32 + (lane & 31); }
        else { const int v = u - 256; T.b = v >> 3; T.head = v & 7; nt = 4; qrow = T.b * CTX + wave * 32 + (lane & 31); }
        bf16x8 qf[12];
#pragma unroll
        for (int s = 0; s < 12; ++s) qf[s] = *(const bf16x8*)(Q0 + (size_t)qrow * 1536 + T.head * 192 + 16 * s + 8 * h);
        f32x16 o[4];
#pragma unroll
        for (int t = 0; t < 4; ++t)
#pragma unroll
            for (int i = 0; i < 16; ++i) o[t][i] = 0.f;
        float m = AT_M0, l = 0.f;
        if (AT_SKEW_MLA == 2) at_run3<192>(lds, T, nt, rd, dm, qf, o, m, l, c2, lane, wave); else if (AT_SKEW_MLA) at_run_skew<192>(lds, T, nt, rd, dm, qf, o, m, l, c2, lane, wave); else at_run<192, AT_PIPE_MLA>(lds, T, nt, rd, dm, qf, o, m, l, c2, lane, wave);
        attn_store(o, l, 0.f, Y + (size_t)qrow * DM + T.head * 128, lane);
    }
}

struct WinBias { int base; DI float operator()(int key, float nm) const { return ((unsigned)(base - key) <= 256u) ? nm : -1e30f; } };
struct WinDrv {
    const char* Z; int b, kvh, k0base, jlo, qpos;
    DI int tid_(int q) const { return q < 4 ? q : jlo + q - 4; }
    DI int keyrow0(int q) const { const int j = tid_(q); return j < 4 ? b * CTX + 64 * j : NCTX + b * SEQ + k0base + 64 * (j - 4); }
    DI const char* kb(int q) const { return Z + (size_t)keyrow0(q) * (L1IN * 2) + (1024 + kvh * 128) * 2; }
    DI const char* vb(int q) const { return Z + (size_t)keyrow0(q) * (L1IN * 2) + (1280 + kvh * 128) * 2; }
    DI const char* rb(int) const { return nullptr; }
    DI bool act(int) const { return true; }
    DI WinBias bias(int q) const { const int j = tid_(q); WinBias B; B.base = j < 4 ? 100 : qpos - (k0base + 64 * (j - 4)) + 128; return B; }
};

DI void phase_attn_win(const Params& p, LAS unsigned char* lds, int G, int bid) {
    const int tid = threadIdx.x, lane = tid & 63, wave = __builtin_amdgcn_readfirstlane(tid >> 6), h = lane >> 5;
    const bf16_t* Z = (const bf16_t*)(p.ws + WS_Z);
    bf16_t* Y = (bf16_t*)(p.ws + WS_Y);
    const float c2 = 0.08838834764831845f * LOG2E;
    const AtRd rd = at_rd_init<128>(lane);
    const AtDma dm = at_dma_init<128>(L1IN * 2, wave, lane);
    for (int u = bid; u < 256; u += G) {
        WinDrv T; T.Z = (const char*)Z; T.b = u >> 6; T.kvh = (u >> 5) & 1; const int blk = u & 31; T.k0base = 64 * blk - 128;
        const int head = T.kvh * 4 + (wave >> 1), qpos = 64 * blk + 32 * (wave & 1) + (lane & 31), qrow = NCTX + T.b * SEQ + qpos;
        T.qpos = qpos;
        bf16x8 qf[8];
#pragma unroll
        for (int s = 0; s < 8; ++s) qf[s] = *(const bf16x8*)(Z + (size_t)qrow * L1IN + head * 128 + 16 * s + 8 * h);
        f32x16 o[4];
#pragma unroll
        for (int t = 0; t < 4; ++t)
#pragma unroll
            for (int i = 0; i < 16; ++i) o[t][i] = 0.f;
        float m = AT_M0, l = 0.f;
        T.jlo = (T.k0base < 0) ? 4 + ((-T.k0base) >> 6) : 4;
        const int jhi = (T.k0base + 320 > SEQ) ? 9 - ((T.k0base + 320 - SEQ) >> 6) : 9;
        if (AT_SKEW_WIN == 2) at_run3<128>(lds, T, 4 + (jhi - T.jlo), rd, dm, qf, o, m, l, c2, lane, wave); else if (AT_SKEW_WIN) at_run_skew<128>(lds, T, 4 + (jhi - T.jlo), rd, dm, qf, o, m, l, c2, lane, wave); else at_run<128, AT_PIPE_WIN>(lds, T, 4 + (jhi - T.jlo), rd, dm, qf, o, m, l, c2, lane, wave);
        const float sink = p.in[32][head];
        attn_store(o, l, __builtin_amdgcn_exp2f(sink * LOG2E - m), Y + (size_t)qrow * DM + head * 128, lane);
    }
}

struct NaBias { const LAS float* rp; int c0; bool all; DI float operator()(int key, float nm) const { return all ? nm : ((key >= c0 && key < c0 + 16) ? fmaf(rp[key], LOG2E, nm) : -1e30f); } };
struct NaDrv {
    const char* Z; const LAS float* RPB; int b, head, rlo, r, c, r0, c0;
    DI int keyrow0(int j) const { return j < 4 ? b * CTX + 64 * j : NCTX + b * SEQ + 64 * (rlo + j - 4); }
    DI const char* kb(int j) const { return Z + (size_t)keyrow0(j) * (L1IN * 2) + (2560 + head * 128) * 2; }
    DI const char* vb(int j) const { return Z + (size_t)keyrow0(j) * (L1IN * 2) + (3584 + head * 128) * 2; }
    DI const char* rb(int) const { return nullptr; }
    DI bool act(int j) const { const int rr = rlo + j - 4; return j < 4 || (rr >= r0 && rr <= r0 + 7); }
    DI NaBias bias(int j) const { const int rr = rlo + j - 4; NaBias B; B.rp = RPB + (j < 4 ? 0 : (rr - r + 7) * 31 + (15 - c)); B.c0 = c0; B.all = j < 4; return B; }
};

DI void phase_attn_na(const Params& p, LAS unsigned char* lds, int G, int bid) {
    const int tid = threadIdx.x, lane = tid & 63, wave = __builtin_amdgcn_readfirstlane(tid >> 6), h = lane >> 5;
    const bf16_t* Z = (const bf16_t*)(p.ws + WS_Z);
    bf16_t* Y = (bf16_t*)(p.ws + WS_Y);
    LAS float* RPB = (LAS float*)(lds + AT4_XOFF);
    const float c2 = 0.08838834764831845f * LOG2E;
    const AtRd rd = at_rd_init<128>(lane);
    const AtDma dm = at_dma_init<128>(L1IN * 2, wave, lane);
    for (int u = bid; u < 256; u += G) {
        NaDrv T; T.Z = (const char*)Z; T.RPB = RPB; T.b = u >> 6; T.head = (u >> 3) & 7; const int R = u & 7;
        T.r = 4 * R + (wave >> 1); T.c = 32 * (wave & 1) + (lane & 31); const int qrow = NCTX + T.b * SEQ + 64 * T.r + T.c;
        T.r0 = min(max(T.r - 4, 0), 24); T.c0 = min(max(T.c - 8, 0), 48);
        T.rlo = min(max(4 * R - 4, 0), 24);
        const int rhi = min(max(4 * R + 3 - 4, 0), 24) + 7;
        const int ntl = 4 + (rhi - T.rlo + 1);
        __syncthreads();
        for (int i = tid; i < 15 * 31; i += NTHREADS) RPB[i] = p.in[33][T.head * 465 + i];
        bf16x8 qf[8];
#pragma unroll
        for (int s = 0; s < 8; ++s) qf[s] = *(const bf16x8*)(Z + (size_t)qrow * L1IN + 1536 + T.head * 128 + 16 * s + 8 * h);
        f32x16 o[4];
#pragma unroll
        for (int t = 0; t < 4; ++t)
#pragma unroll
            for (int i = 0; i < 16; ++i) o[t][i] = 0.f;
        float m = AT_M0, l = 0.f;
        if (AT_SKEW_NA == 2) at_run3<128>(lds, T, ntl, rd, dm, qf, o, m, l, c2, lane, wave); else if (AT_SKEW_NA) at_run_skew<128>(lds, T, ntl, rd, dm, qf, o, m, l, c2, lane, wave); else at_run<128, AT_PIPE_NA>(lds, T, ntl, rd, dm, qf, o, m, l, c2, lane, wave);
        attn_store(o, l, 0.f, Y + (size_t)qrow * DM + 1024 + T.head * 128, lane);
    }
}
constexpr int RT_HS = 2052;
typedef float f32x4r __attribute__((ext_vector_type(4)));
DI void phase_router(const Params& p, LAS unsigned char* lds, int G, int bid, const int layer, const float* xin_ctx, const float* xin_lat, const int row_lo, const int row_hi) {
    const int tid = threadIdx.x, lane = tid & 63, wave = tid >> 6;
    const float* MOD = (const float*)(p.ws + WS_MOD) + (size_t)layer * 5 * MODN;
    const float* gain = layer ? p.in[30] : p.in[10];
    const float* rw = p.in[4]; const float* rb = p.in[5];
    bf16_t* H = (bf16_t*)(p.ws + WS_H);
    int* cnt = (int*)(p.ws + WS_CTL + CW_CNT) + layer * NEXP;
    int* LIST = (int*)(p.ws + WS_LIST); TokInfo* TOK = (TokInfo*)(p.ws + WS_TOK);
    LAS float* hs = (LAS float*)lds;
    LAS float* sc = (LAS float*)(lds + 16 * RT_HS * 4);
    const int nb = (row_hi - row_lo) / 16;
    float wb0[64], wb1[64];
    {
        const float* bp = rw + (size_t)(256 * wave + (lane >> 4)) * 32 + (lane & 15);
#pragma unroll
        for (int s2 = 0; s2 < 64; ++s2) { wb0[s2] = bp[4 * s2 * 32]; wb1[s2] = bp[4 * s2 * 32 + 16]; }
    }
    int lb = 0;
    for (int bt = bid; bt < nb; bt += G, ++lb) {
        __syncthreads();
#pragma unroll 1
        for (int rr = 0; rr < 2; ++rr) {
            const int lr = 2 * wave + rr, row = row_lo + bt * 16 + lr;
            const float* xr = row < NCTX ? xin_ctx + (size_t)row * DM : xin_lat + (size_t)(row - NCTX) * DM;
            const bf16_t* dr = (const bf16_t*)(p.ws + WS_D) + (size_t)row * DM;
            const float* md = MOD + (size_t)row_mod(row) * MODN;
            f32x4 v[8]; float ss = 0.f;
#pragma unroll
            for (int i = 0; i < 8; ++i) {
                const int col = 4 * lane + 256 * i;
                const u32x2 dw = *(const u32x2*)(dr + col);
                v[i] = *(const f32x4*)(xr + col) + *(const f32x4*)(md + 2 * DM + col) * (f32x4){bflo(dw.x), bfhi(dw.x), bflo(dw.y), bfhi(dw.y)};
                ss += v[i][0] * v[i][0] + v[i][1] * v[i][1] + v[i][2] * v[i][2] + v[i][3] * v[i][3];
            }
            ss = wave_sum(ss);
            const float r = rsqrtf(ss * (1.0f / DM) + EPS);
#pragma unroll
            for (int i = 0; i < 8; ++i) {
                const int col = 4 * lane + 256 * i;
                const f32x4 g = *(const f32x4*)(gain + col), sh = *(const f32x4*)(md + 3 * DM + col), scl = *(const f32x4*)(md + 4 * DM + col);
                const f32x4 hv = (v[i] * r * g) * (1.0f + scl) + sh;
                u32x2 w; w.x = pk_bf16(hv[0], hv[1]); w.y = pk_bf16(hv[2], hv[3]);
                *(u32x2*)(H + (size_t)row * DM + col) = w;
                *(LAS f32x4*)(hs + lr * RT_HS + col) = hv;
            }
        }
        __syncthreads();
        f32x4r c0 = {0.f, 0.f, 0.f, 0.f}, c1 = {0.f, 0.f, 0.f, 0.f};
        {
            const int ar = lane & 15, kq = lane >> 4;
            const LAS float* ap = hs + ar * RT_HS + 256 * wave + kq;
            if (!(p.flags & 8))
#pragma unroll
            for (int s2 = 0; s2 < 64; ++s2) {
                const float a = ap[4 * s2];
                c0 = __builtin_amdgcn_mfma_f32_16x16x4f32(a, wb0[s2], c0, 0, 0, 0);
                c1 = __builtin_amdgcn_mfma_f32_16x16x4f32(a, wb1[s2], c1, 0, 0, 0);
            }
        }
        __syncthreads();
        {
            LAS float* part = hs;
            const int e = lane & 15, r4 = 4 * (lane >> 4);
#pragma unroll
            for (int j = 0; j < 4; ++j) { part[(wave * 16 + r4 + j) * 32 + e] = c0[j]; part[(wave * 16 + r4 + j) * 32 + 16 + e] = c1[j]; }
        }
        __syncthreads();
        {
            const int r = tid >> 5, e = tid & 31; float a = 0.f;
#pragma unroll
            for (int w2 = 0; w2 < 8; ++w2) a += hs[(w2 * 16 + r) * 32 + e];
            sc[(lb * 16 + r) * 32 + e] = 1.0f / (1.0f + expf(-a));
        }
    }
    __syncthreads();
    {
        LAS int* lcnt = (LAS int*)(lds + LDS_MISC + 1024);
        if (tid < 64) lcnt[tid] = 0;
        __syncthreads();
        int e0 = 0, e1 = 0, li0 = 0, li1 = 0, trow = 0; float w0 = 0.f, w1 = 0.f;
        const bool has = tid < lb * 16;
        if (has) {
            const LAS float* s = sc + tid * 32;
            int bg = 0; float bgs = -INFINITY;
#pragma unroll
            for (int g = 0; g < 8; ++g) {
                const float v0 = s[4 * g] + rb[4 * g], v1 = s[4 * g + 1] + rb[4 * g + 1], v2 = s[4 * g + 2] + rb[4 * g + 2], v3 = s[4 * g + 3] + rb[4 * g + 3];
                const float hi01 = fmaxf(v0, v1), lo01 = fminf(v0, v1), hi23 = fmaxf(v2, v3), lo23 = fminf(v2, v3);
                const float m1 = fmaxf(hi01, hi23), m2 = fmaxf(fminf(hi01, hi23), fmaxf(lo01, lo23));
                const float gs = m1 + m2;
                if (gs > bgs) { bgs = gs; bg = g; }
            }
            float bv[4];
#pragma unroll
            for (int j = 0; j < 4; ++j) bv[j] = s[4 * bg + j] + rb[4 * bg + j];
            int i0 = 0; float b0 = bv[0];
#pragma unroll
            for (int j = 1; j < 4; ++j) if (bv[j] > b0) { b0 = bv[j]; i0 = j; }
            int i1 = -1; float b1 = -INFINITY;
#pragma unroll
            for (int j = 0; j < 4; ++j) if (j != i0 && bv[j] > b1) { b1 = bv[j]; i1 = j; }
            e0 = 4 * bg + i0; e1 = 4 * bg + i1;
            const float s0 = s[e0], s1 = s[e1], ws = s0 + s1; w0 = s0 / ws; w1 = s1 / ws;
            trow = row_lo + (bid + (tid >> 4) * G) * 16 + (tid & 15);
            li0 = atomicAdd((int*)(lcnt + e0), 1); li1 = atomicAdd((int*)(lcnt + e1), 1);
        }
        __syncthreads();
        if (tid < 32) { const int c = lcnt[tid]; lcnt[32 + tid] = c > 0 ? atomicAdd(cnt + tid, c) : 0; }
        __syncthreads();
        if (has) {
            const int p0 = lcnt[32 + e0] + li0, p1 = lcnt[32 + e1] + li1;
            LIST[(size_t)e0 * MOE_CAP + p0] = trow; LIST[(size_t)e1 * MOE_CAP + p1] = trow;
            TokInfo ti; ti.e0 = e0; ti.p0 = p0; ti.e1 = e1; ti.p1 = p1; ti.w0 = w0; ti.w1 = w1; ti.pad0 = 0; ti.pad1 = 0;
            TOK[trow] = ti;
        }
    }
}

DI void moe_tables(const Params& p, LAS int* MT, int layer) {
    const int tid = threadIdx.x;
    __syncthreads();
    if (tid < NEXP) MT[128 + tid] = ((const int*)(p.ws + WS_CTL + CW_CNT))[layer * NEXP + tid];
    __syncthreads();
    if (tid == 0) {
        int seg = 0, tp = 0;
        for (int e = 0; e < NEXP; ++e) { const int t = (MT[128 + e] + 255) >> 8; MT[e] = seg; MT[64 + e] = tp; seg += t * 256; tp += t; }
        MT[32] = seg; MT[64 + 32] = tp;
    }
    __syncthreads();
}

struct MoeSchedUp {
    static constexpr bool GATHER = true;
    const char* Hb; const char* EG; const int* LIST; const LAS int* MT; int K; size_t lda, ldb, a_h, b_h; int G, c;
    DI bool next(int i, pg8::GU& u) const {
        const int L = i * G + c, T = MT[64 + 32]; if (L >= T * 4) return false;
        const int rt = L >> 2, ct = L & 3; int e = 0;
#pragma unroll 1
        for (int q = 1; q < NEXP; ++q) if (rt >= MT[64 + q]) e = q;
        const int lt = rt - MT[64 + e];
        u.e = e; u.pm = lt; u.pn = ct; u.aux = MT[e] + 256 * lt; u.a = Hb; u.b = EG + (size_t)e * (EFF * DM * 2) + (size_t)ct * 128 * ldb; return true;
    }
    DI unsigned rowoff(const pg8::GU& u, int r) const { const int gr = 256 * u.pm + r; const int tok = gr < MT[128 + u.e] ? LIST[(size_t)u.e * MOE_CAP + gr] : 0; return (unsigned)tok * (unsigned)lda; }
};
struct MoeSchedDown {
    static constexpr bool GATHER = false;
    const char* ACT; const char* ED; const LAS int* MT; int K; size_t lda, ldb, a_h, b_h; int G, c;
    DI bool next(int i, pg8::GU& u) const {
        const int L = i * G + c, T = MT[64 + 32]; if (L >= T * 8) return false;
        const int rt = L >> 3, ct = L & 7; int e = 0;
#pragma unroll 1
        for (int q = 1; q < NEXP; ++q) if (rt >= MT[64 + q]) e = q;
        const int lt = rt - MT[64 + e];
        u.e = e; u.pm = lt; u.pn = ct; u.aux = MT[e] + 256 * lt; u.a = ACT + (size_t)u.aux * lda; u.b = ED + (size_t)e * (DM * EFF * 2) + (size_t)ct * 256 * ldb; return true;
    }
    DI unsigned rowoff(const pg8::GU&, int) const { return 0u; }
};
struct EpiSwiGLU {
    static constexpr bool PERM = true;
    bf16_t* ACT;
    DI void operator()(const f32x4 (&acc)[2][2][4][2], const pg8::GU& u, int wr, int wc, int fr, int fq) const {
        const int row0 = u.aux + wr * 64 + fr, col0 = u.pn * 128 + wc * 32 + 8 * fq;
#pragma unroll
        for (int ai = 0; ai < 2; ++ai)
#pragma unroll
            for (int m = 0; m < 4; ++m) {
                float a[8];
#pragma unroll
                for (int n = 0; n < 2; ++n)
#pragma unroll
                    for (int j = 0; j < 4; ++j) { const float g = acc[ai][0][m][n][j], up = acc[ai][1][m][n][j]; a[4 * n + j] = g / (1.0f + __expf(-g)) * up; }
                u32x4 w; w.x = pk_bf16(a[0], a[1]); w.y = pk_bf16(a[2], a[3]); w.z = pk_bf16(a[4], a[5]); w.w = pk_bf16(a[6], a[7]);
                *(u32x4*)(ACT + (size_t)(row0 + ai * 128 + m * 16) * EFF + col0) = w;
            }
    }
};
struct EpiBf16Rows {
    static constexpr bool PERM = true;
    bf16_t* O; int ldc; int use_aux; int skip = 0;
    DI void operator()(const f32x4 (&acc)[2][2][4][2], const pg8::GU& u, int wr, int wc, int fr, int fq) const {
        if (skip) return;
        const int row0 = (use_aux ? u.aux : u.pm * 256) + wr * 64 + fr, col0 = u.pn * 256 + wc * 32 + 8 * fq;
#pragma unroll
        for (int ai = 0; ai < 2; ++ai)
#pragma unroll
            for (int m = 0; m < 4; ++m) {
                bf16_t* rowp = O + (size_t)(row0 + ai * 128 + m * 16) * ldc + col0;
#pragma unroll
                for (int bj = 0; bj < 2; ++bj) {
                    const f32x4 v0 = acc[ai][bj][m][0], v1 = acc[ai][bj][m][1];
                    u32x4 w; w.x = pk_bf16(v0[0], v0[1]); w.y = pk_bf16(v0[2], v0[3]); w.z = pk_bf16(v1[0], v1[1]); w.w = pk_bf16(v1[2], v1[3]);
                    *(u32x4*)(rowp + bj * 128) = w;
                }
            }
    }
};

template <bool FINAL>
DI void phase_combine(const Params& p, LAS unsigned char* lds, int G, int bid, const int layer, const float* xin_ctx, const float* xin_lat, const int row_lo, const int row_hi) {
    const int lane = threadIdx.x & 63, wave = threadIdx.x >> 6;
    LAS int* MT = (LAS int*)(lds + LDS_MISC + 64);
    moe_tables(p, MT, layer);
    const float* MOD = (const float*)(p.ws + WS_MOD);
    const bf16_t* OUT2 = (const bf16_t*)(p.ws + WS_OUT2);
    const TokInfo* TOK = (const TokInfo*)(p.ws + WS_TOK);
    float* XB = (float*)(p.ws + WS_XB); bf16_t* H = (bf16_t*)(p.ws + WS_H);
    for (int row = row_lo + bid * 8 + wave; row < row_hi; row += G * 8) {
        const TokInfo ti = TOK[row];
        const bf16_t* o0 = OUT2 + (size_t)(MT[ti.e0] + ti.p0) * DM; const bf16_t* o1 = OUT2 + (size_t)(MT[ti.e1] + ti.p1) * DM;
        const float* xr = row < NCTX ? xin_ctx + (size_t)row * DM : xin_lat + (size_t)(row - NCTX) * DM;
        const bf16_t* dr = (const bf16_t*)(p.ws + WS_D) + (size_t)row * DM;
        const int mi = row_mod(row);
        const float* g1 = MOD + ((size_t)layer * 5 + mi) * MODN + 2 * DM;
        const float* g2 = MOD + ((size_t)layer * 5 + mi) * MODN + 5 * DM;
        f32x4 v[8];
#pragma unroll
        for (int i = 0; i < 8; ++i) {
            const int col = 4 * lane + 256 * i;
            const u32x2 dw = *(const u32x2*)(dr + col);
            const f32x4 x = *(const f32x4*)(xr + col) + *(const f32x4*)(g1 + col) * (f32x4){bflo(dw.x), bfhi(dw.x), bflo(dw.y), bfhi(dw.y)}, g = *(const f32x4*)(g2 + col);
            const u32x2 a = *(const u32x2*)(o0 + col), b = *(const u32x2*)(o1 + col);
            const f32x4 fa = {bflo(a.x), bfhi(a.x), bflo(a.y), bfhi(a.y)}, fb = {bflo(b.x), bfhi(b.x), bflo(b.y), bfhi(b.y)};
            v[i] = x + g * (fa * ti.w0 + fb * ti.w1);
        }
        if (!FINAL) {
#pragma unroll
            for (int i = 0; i < 8; ++i) *(f32x4*)(XB + (size_t)row * DM + 4 * lane + 256 * i) = v[i];
            const float* md = MOD + ((size_t)5 + mi) * MODN;
            norm_mod_store(v, p.in[29], md, md + DM, H + (size_t)row * DM, lane);
        } else {
            float ss = 0.f;
#pragma unroll
            for (int i = 0; i < 8; ++i) ss += v[i][0] * v[i][0] + v[i][1] * v[i][1] + v[i][2] * v[i][2] + v[i][3] * v[i][3];
            ss = wave_sum(ss);
            const float r = rsqrtf(ss * (1.0f / DM) + EPS);
#pragma unroll
            for (int i = 0; i < 8; ++i) { const int col = 4 * lane + 256 * i; const f32x4 g = *(const f32x4*)(p.in[6] + col); *(f32x4*)(p.out + (size_t)(row - NCTX) * DM + col) = v[i] * r * g; }
        }
    }
}
struct PlainSched {
    static constexpr bool GATHER = false;
    const char* A; const char* Bt; int K; size_t lda, ldb, a_h, b_h; pg8::TileOrder T;
    DI void init(const void* A_, const void* Bt_, int M, int N, int K_, int lda_e, int ldb_e, int G, int c) {
        A = (const char*)A_; Bt = (const char*)Bt_; K = K_; lda = (size_t)lda_e * 2; ldb = (size_t)ldb_e * 2; a_h = 128 * lda; b_h = 128 * ldb; T.init(M / 256, N / 256, G, c); }
    DI bool next(int i, pg8::GU& u) const { int pm, pn; if (!T.tile(i, pm, pn)) return false; u.pm = pm; u.pn = pn; u.e = 0; u.aux = 0; u.a = A + (size_t)pm * 256 * lda; u.b = Bt + (size_t)pn * 256 * ldb; return true; }
    DI unsigned rowoff(const pg8::GU&, int) const { return 0u; }
};

template <int MODE>
struct EpiRope {
    static constexpr bool PERM = false;
    bf16_t* O; int ldc; const f32x2* R;
    DI void operator()(const f32x4 (&acc)[2][2][4][2], const pg8::GU& u, int wr, int wc, int fr, int fq) const {
        const int row0 = u.pm * 256 + wr * 64 + fr;
#pragma unroll
        for (int bj = 0; bj < 2; ++bj) {
            const int g32 = 8 * u.pn + 4 * bj + wc;
            int axis, ibase; bool rot;
            if (MODE == 0) { const int hg = g32 % 6; rot = hg >= 4; axis = hg - 4; ibase = 4 * fq; }
            else { rot = u.pn < 5; axis = (g32 & 3) >> 1; ibase = 16 * (g32 & 1) + 4 * fq; }
            const int col0 = 32 * g32 + 4 * fq;
#pragma unroll
            for (int ai = 0; ai < 2; ++ai)
#pragma unroll
                for (int m = 0; m < 4; ++m) {
                    const int row = row0 + ai * 128 + m * 16;
                    f32x4 x1 = acc[ai][bj][m][0], x2 = acc[ai][bj][m][1];
                    if (rot && row >= NCTX) {
                        const int t = (row - NCTX) & (SEQ - 1), pos = axis ? (t & 63) : (t >> 6);
                        const f32x2* cs = R + pos * (MODE == 0 ? 16 : 32) + ibase;
                        f32x4 o1, o2;
#pragma unroll
                        for (int j = 0; j < 4; ++j) { const f32x2 c = cs[j]; o1[j] = x1[j] * c[0] - x2[j] * c[1]; o2[j] = x2[j] * c[0] + x1[j] * c[1]; }
                        x1 = o1; x2 = o2;
                    }
                    bf16_t* rowp = O + (size_t)row * ldc + col0;
                    u32x2 w1, w2; w1.x = pk_bf16(x1[0], x1[1]); w1.y = pk_bf16(x1[2], x1[3]); w2.x = pk_bf16(x2[0], x2[1]); w2.y = pk_bf16(x2[2], x2[3]);
                    *(u32x2*)(rowp) = w1; *(u32x2*)(rowp + 16) = w2;
                }
        }
    }
};

struct EpiResid {
    static constexpr bool PERM = true;
    const float* xin_ctx; const float* xin_lat; float* XO; const float* MODL; int rowbase;
    DI void operator()(const f32x4 (&acc)[2][2][4][2], const pg8::GU& u, int wr, int wc, int fr, int fq) const {
        const int row0 = rowbase + u.pm * 256 + wr * 64 + fr, col0 = u.pn * 256 + wc * 32 + 8 * fq;
        const float* g1 = MODL + (size_t)row_mod(rowbase + u.pm * 256) * MODN + 2 * DM;
        f32x4 gv[2][2];
#pragma unroll
        for (int bj = 0; bj < 2; ++bj)
#pragma unroll
            for (int n = 0; n < 2; ++n) gv[bj][n] = *(const f32x4*)(g1 + col0 + bj * 128 + n * 4);
#pragma unroll
        for (int ai = 0; ai < 2; ++ai)
#pragma unroll
            for (int m = 0; m < 4; ++m) {
                const int row = row0 + ai * 128 + m * 16;
                const float* xr = (row < NCTX ? xin_ctx + (size_t)row * DM : xin_lat + (size_t)(row - NCTX) * DM) + col0;
                float* xo = XO + (size_t)row * DM + col0;
#pragma unroll
                for (int bj = 0; bj < 2; ++bj)
#pragma unroll
                    for (int n = 0; n < 2; ++n) *(f32x4*)(xo + bj * 128 + n * 4) = *(const f32x4*)(xr + bj * 128 + n * 4) + gv[bj][n] * acc[ai][bj][m][n];
            }
    }
};

constexpr int NPHASE = 18;
constexpr int BG_U2 = (NTOK / 256) * (L0INP / 256), BG_U6 = (NTOK / 256) * (DM / 256), BG_U11 = (NTOK / 256) * (L1IN / 256);
#ifndef BG_Q2
#define BG_Q2 12
#endif
#ifndef BG_Q6
#define BG_Q6 10
#endif
#ifndef BG_Q8
#define BG_Q8 12
#endif
#ifndef BG_Q11
#define BG_Q11 12
#endif
__global__ void __launch_bounds__(NTHREADS, 2) fwd_kernel(Params p) {
    extern __shared__ __attribute__((aligned(16))) unsigned char lds_raw[];
    LAS unsigned char* lds = (LAS unsigned char*)lds_raw;
    const int tid = threadIdx.x, G = gridDim.x, bid = blockIdx.x;
    unsigned char* ws = p.ws;
    if (tid < 64) ((LAS unsigned*)(lds + LDS_MISC))[tid] = 0u;
    __syncthreads();
    const int lo = p.ph_lo, hi = p.ph_hi;
    const bool use_bar = (hi - lo) > 1;
    XcdBarrier bar; bar.bar = (unsigned*)(ws + WS_CTL + CW_BAR); bar.x = 0; bar.st = (volatile LAS unsigned*)(lds + LDS_MISC);
    if (use_bar) bar = xcd_barrier_post((unsigned*)(ws + WS_CTL + CW_BAR), (volatile LAS unsigned*)(lds + LDS_MISC));
#ifndef PH_MASK
#define PH_MASK 0x3ffff
#endif
#define IN(k) (((PH_MASK >> (k)) & 1) && lo <= (k) && (k) < hi)
#ifndef REPEAT_MASK
#define REPEAT_MASK 0
#endif
#define REP(k) 0
#define SEAM(k) do { if (rep_ == REP(k) && IN((k) + 1)) xcd_barrier(bar); } while (0)
    const float* MOD = (const float*)(ws + WS_MOD);
    LAS int* MT = (LAS int*)(lds + LDS_MISC + 64);
    const int vc = (G % 8 == 0) ? (bid % 8) * (G / 8) + bid / 8 : bid;
    (void)vc;

    if (IN(0)) for (int rep_ = 0; rep_ <= REP(0); ++rep_) { if (rep_) __syncthreads(); phase_prologue(p, lds, G, bid); SEAM(0); }
    if (IN(1)) for (int rep_ = 0; rep_ <= REP(1); ++rep_) { if (rep_) __syncthreads(); phase_norm0(p, G, bid); SEAM(1); }
    if (IN(2)) for (int rep_ = 0; rep_ <= REP(2); ++rep_) { if (rep_) __syncthreads();
        PlainSched S; S.init(ws + WS_H, ws + WS_W0IN, NTOK, L0INP, DM, DM, DM, G, bid);
        EpiBf16Rows E{(bf16_t*)(ws + WS_Z), L0INP, 0, p.flags & 1};
        pg8::gemm_phase(lds, S, E);
        bg_range(p, lds, 1, 0, BG_L0_P2, BG_U2, G, bid);
        SEAM(2);
    }
    if (IN(3)) for (int rep_ = 0; rep_ <= REP(3); ++rep_) { if (rep_) __syncthreads(); phase_l0_rows(p, G, bid); __syncthreads(); lru_units<1>(p, lds, G, bid); SEAM(3); }
    if (IN(4)) for (int rep_ = 0; rep_ <= REP(4); ++rep_) { if (rep_) __syncthreads();
        { PlainSched S; S.init(ws + WS_CQN, ws + WS_WUQ, NTOK, 1536, 512, 512, 512, G, bid);
          EpiRope<0> E{(bf16_t*)(ws + WS_Q0), 1536, (const f32x2*)(ws + WS_ROPE0)};
          pg8::gemm_phase(lds, S, E); }
        { PlainSched S; S.init(ws + WS_CKVN, ws + WS_WUKV, NTOK, 2048, 256, 256, 256, G, (bid + G - ((NTOK / 256) * 6) % G) % G);
          EpiBf16Rows E{(bf16_t*)(ws + WS_KV0), 2048, 0};
          pg8::gemm_phase(lds, S, E); }
        lru_carry(p, G, bid);
        SEAM(4);
    }
    if (IN(5)) for (int rep_ = 0; rep_ <= REP(5); ++rep_) { if (rep_) __syncthreads(); if (!(p.flags & 2)) phase_attn0(p, lds, G, bid); __syncthreads(); if (!(p.flags & 4)) lru_pass2(p, lds, G, bid); SEAM(5); }
    if (IN(6)) for (int rep_ = 0; rep_ <= REP(6); ++rep_) { if (rep_) __syncthreads();
        PlainSched S; S.init(ws + WS_Y, ws + WS_W0OUT, NTOK, DM, DM, DM, DM, G, bid);
        EpiBf16Rows E{(bf16_t*)(ws + WS_D), DM, 0};
        pg8::gemm_phase(lds, S, E);
        bg_range(p, lds, 1, BG_L0_P2, BG_L0_P6, BG_U6, G, bid);
        SEAM(6);
    }
    if (IN(7)) for (int rep_ = 0; rep_ <= REP(7); ++rep_) { if (rep_) __syncthreads(); phase_router(p, lds, G, bid, 0, p.in[2], p.in[0], 0, NTOK);
        bg_range(p, lds, 1, BG_L0_P6, BG_L0_P7, NTOK / 16, G, bid); SEAM(7); }
    if (IN(8)) for (int rep_ = 0; rep_ <= REP(8); ++rep_) { if (rep_) __syncthreads();
        moe_tables(p, MT, 0);
        MoeSchedUp S; S.Hb = (const char*)(ws + WS_H); S.EG = (const char*)(ws + WS_EG); S.LIST = (const int*)(ws + WS_LIST); S.MT = MT; S.K = DM;
        S.lda = DM * 2; S.ldb = DM * 2; S.a_h = 0; S.b_h = WS_EU - WS_EG; S.G = G; S.c = bid;
        EpiSwiGLU E{(bf16_t*)(ws + WS_ACT)};
        pg8::gemm_phase(lds, S, E);
        bg_range(p, lds, 2, 0, BG_L1_P8, 4 * MT[64 + 32], G, bid);
        SEAM(8);
    }
    if (IN(9)) for (int rep_ = 0; rep_ <= REP(9); ++rep_) { if (rep_) __syncthreads();
        moe_tables(p, MT, 0);
        MoeSchedDown S; S.ACT = (const char*)(ws + WS_ACT); S.ED = (const char*)(ws + WS_ED); S.MT = MT; S.K = EFF;
        S.lda = EFF * 2; S.ldb = EFF * 2; S.a_h = 128 * EFF * 2; S.b_h = 128 * EFF * 2; S.G = G; S.c = bid;
        EpiBf16Rows E{(bf16_t*)(ws + WS_OUT2), DM, 1};
        pg8::gemm_phase(lds, S, E); SEAM(9);
    }
    if (IN(10)) for (int rep_ = 0; rep_ <= REP(10); ++rep_) { if (rep_) __syncthreads(); phase_combine<false>(p, lds, G, bid, 0, p.in[2], p.in[0], 0, NTOK); SEAM(10); }
    if (IN(11)) for (int rep_ = 0; rep_ <= REP(11); ++rep_) { if (rep_) __syncthreads();
        PlainSched S; S.init(ws + WS_H, ws + WS_W1IN, NTOK, L1IN, DM, DM, DM, G, bid);
        EpiRope<1> E{(bf16_t*)(ws + WS_Z), L1IN, (const f32x2*)(ws + WS_ROPE1)};
        pg8::gemm_phase(lds, S, E);
        bg_range(p, lds, 2, BG_L1_P8, BG_L1_P11, BG_U11, G, bid);
        SEAM(11);
    }
    if (IN(12)) for (int rep_ = 0; rep_ <= REP(12); ++rep_) { if (rep_) __syncthreads(); if (!(p.flags & 2)) phase_attn_win(p, lds, G, bid); __syncthreads(); if (!(p.flags & 4)) phase_attn_na(p, lds, G, bid); SEAM(12); }
    if (IN(13)) for (int rep_ = 0; rep_ <= REP(13); ++rep_) { if (rep_) __syncthreads();
        PlainSched S; S.init(ws + WS_Y + (size_t)NCTX * DM * 2, ws + WS_W1OUT, NLAT, DM, DM, DM, DM, G, bid);
        EpiBf16Rows E{(bf16_t*)(ws + WS_D) + (size_t)NCTX * DM, DM, 0};
        pg8::gemm_phase(lds, S, E); SEAM(13);
    }
    if (IN(14)) for (int rep_ = 0; rep_ <= REP(14); ++rep_) { if (rep_) __syncthreads(); phase_router(p, lds, G, bid, 1, (const float*)(ws + WS_XB), (const float*)(ws + WS_XB) + (size_t)NCTX * DM, NCTX, NTOK); SEAM(14); }
    if (IN(15)) for (int rep_ = 0; rep_ <= REP(15); ++rep_) { if (rep_) __syncthreads();
        moe_tables(p, MT, 1);
        MoeSchedUp S; S.Hb = (const char*)(ws + WS_H); S.EG = (const char*)(ws + WS_EG + EXPW); S.LIST = (const int*)(ws + WS_LIST); S.MT = MT; S.K = DM;
        S.lda = DM * 2; S.ldb = DM * 2; S.a_h = 0; S.b_h = WS_EU - WS_EG; S.G = G; S.c = bid;
        EpiSwiGLU E{(bf16_t*)(ws + WS_ACT)};
        pg8::gemm_phase(lds, S, E);
        bg_range(p, lds, 2, BG_L1_DOWN0, MOE_CVT_TILES, 4 * MT[64 + 32], G, bid);
        SEAM(15);
    }
    if (IN(16)) for (int rep_ = 0; rep_ <= REP(16); ++rep_) { if (rep_) __syncthreads();
        moe_tables(p, MT, 1);
        MoeSchedDown S; S.ACT = (const char*)(ws + WS_ACT); S.ED = (const char*)(ws + WS_ED + EXPW); S.MT = MT; S.K = EFF;
        S.lda = EFF * 2; S.ldb = EFF * 2; S.a_h = 128 * EFF * 2; S.b_h = 128 * EFF * 2; S.G = G; S.c = bid;
        EpiBf16Rows E{(bf16_t*)(ws + WS_OUT2), DM, 1};
        pg8::gemm_phase(lds, S, E); SEAM(16);
    }
    if (IN(17)) for (int rep_ = 0; rep_ <= REP(17); ++rep_) { if (rep_) __syncthreads(); phase_combine<true>(p, lds, G, bid, 1, (const float*)(ws + WS_XB), (const float*)(ws + WS_XB) + (size_t)NCTX * DM, NCTX, NTOK); }
#undef IN
#undef SEAM
}

#ifndef REPEAT_FLAGS
#define REPEAT_FLAGS 0
#endif
#ifndef N_LAUNCH_MODE
#define N_LAUNCH_MODE 0
#endif
extern "C" void kernel_launch(void* const* d_in, const int* in_sizes, int n_in, void* d_out, int out_size, void* d_ws, size_t ws_size, hipStream_t stream) {
    static int grid = 0;
    if (grid == 0) {
        if (n_in != 38 || out_size != NLAT * DM || ws_size < WS_END) { fprintf(stderr, "kernel_launch: unexpected problem shape (n_in %d out %d ws %zu need %zu)\n", n_in, out_size, ws_size, (size_t)WS_END); grid = -1; return; }
        int dev = 0, cus = 0, per_cu = 0;
        if (hipGetDevice(&dev) != hipSuccess || hipDeviceGetAttribute(&cus, hipDeviceAttributeMultiprocessorCount, dev) != hipSuccess) { grid = -1; return; }
        if (hipFuncSetAttribute((const void*)fwd_kernel, hipFuncAttributeMaxDynamicSharedMemorySize, LDS_BYTES) != hipSuccess) { fprintf(stderr, "kernel_launch: hipFuncSetAttribute failed\n"); grid = -1; return; }
        if (hipOccupancyMaxActiveBlocksPerMultiprocessor(&per_cu, (const void*)fwd_kernel, NTHREADS, LDS_BYTES) != hipSuccess || per_cu < 1) { fprintf(stderr, "kernel_launch: occupancy query reports %d\n", per_cu); (void)hipGetLastError(); }
        if (cus * 48 < NTOK) { fprintf(stderr, "kernel_launch: built for >= 192 CUs (router score table), got %d\n", cus); grid = -1; return; }
        grid = cus;
    }
    if (grid < 0) return;
    (void)hipMemsetAsync((char*)d_ws + WS_CTL, 0, CTL_BYTES, stream);
    Params prm{};
    for (int i = 0; i < 38; ++i) prm.in[i] = (const float*)d_in[i];
    prm.out = (float*)d_out; prm.ws = (unsigned char*)d_ws; prm.flags = 0; prm.pad = 0;
#if N_LAUNCH_MODE == 0
    prm.ph_lo = 0; prm.ph_hi = NPHASE;
    hipLaunchKernelGGL(fwd_kernel, dim3(grid), dim3(NTHREADS), LDS_BYTES, stream, prm);
#else
    for (int k = 0; k < NPHASE; ++k) { prm.ph_lo = k; prm.ph_hi = k + 1; const int reps = 1 + ((REPEAT_MASK >> k) & 1);
        for (int r = 0; r < reps; ++r) { prm.flags = (reps > 1 && r == 0) ? (REPEAT_FLAGS) : 0; if (r && (k == 7 || k == 14)) (void)hipMemsetAsync((char*)d_ws + WS_CTL + CW_CNT + (k == 14 ? NEXP * 4 : 0), 0, NEXP * 4, stream);
            hipLaunchKernelGGL(fwd_kernel, dim3(grid), dim3(NTHREADS), LDS_BYTES, stream, prm); } }
#endif
}
```

```cpp
#define N_LAUNCH_MODE 0
#include <hip/hip_runtime.h>
#include <stdint.h>
#include <stdio.h>

#define LAS __attribute__((address_space(3)))
#define DI __device__ __forceinline__
typedef unsigned short bf16_t;
typedef short bf16x8 __attribute__((ext_vector_type(8)));
typedef short s16x4 __attribute__((ext_vector_type(4)));
typedef float f32x2 __attribute__((ext_vector_type(2)));
typedef float f32x4 __attribute__((ext_vector_type(4)));
typedef float f32x16 __attribute__((ext_vector_type(16)));
typedef unsigned u32x2 __attribute__((ext_vector_type(2)));
typedef unsigned u32x4 __attribute__((ext_vector_type(4)));
typedef __bf16 hbf16x2 __attribute__((ext_vector_type(2)));

constexpr int DM = 2048, NB = 4, SEQ = 2048, CTX = 256, GRIDW = 64;
constexpr int NCTX = NB * CTX;
constexpr int NLAT = NB * SEQ;
constexpr int NTOK = NCTX + NLAT;
constexpr float EPS = 1e-6f;
constexpr int NEXP = 32, EFF = 512;
constexpr int L0IN = 2880, L0INP = 3072, L1IN = 4608;
constexpr int MODN = 6 * DM;
constexpr int NTHREADS = 512;
constexpr float LOG2E = 1.4426950408889634f;

DI unsigned pk_bf16(float lo, float hi) { f32x2 v = {lo, hi}; hbf16x2 r = __builtin_convertvector(v, hbf16x2); return __builtin_bit_cast(unsigned, r); }
DI float bflo(unsigned w) { return __uint_as_float(w << 16); }
DI float bfhi(unsigned w) { return __uint_as_float(w & 0xffff0000u); }
DI float bf2f(bf16_t b) { return __uint_as_float(((unsigned)b) << 16); }
DI bf16_t f2bf(float f) { return (bf16_t)(pk_bf16(f, 0.f) & 0xffffu); }
DI float wave_sum(float v) {
#pragma unroll
    for (int o = 32; o > 0; o >>= 1) v += __shfl_xor(v, o);
    return v;
}
DI float sigmoidf_(float x) { return 1.0f / (1.0f + __expf(-x)); }
DI int row_mod(int row) { return row < NCTX ? 4 : ((row - NCTX) >> 11); }

DI unsigned pk_fp8x4(float a, float b, float c, float d) {
    a = fminf(fmaxf(a, -448.f), 448.f); b = fminf(fmaxf(b, -448.f), 448.f); c = fminf(fmaxf(c, -448.f), 448.f); d = fminf(fmaxf(d, -448.f), 448.f);
    int w = __builtin_amdgcn_cvt_pk_fp8_f32(a, b, 0, false); w = __builtin_amdgcn_cvt_pk_fp8_f32(c, d, w, true); return (unsigned)w; }
#define XB_TMO      128
#define XB_XCNT(j)  (256  + 64 * (j))
#define XB_XSUB(j)  (1280 + 64 * (j))
#define XB_XGEN(j)  (2304 + 64 * (j))
#define XB_TOP      3328
#define XB_TOPGEN   3392
#define XCD_BAR_WORDS 3456
#define XB_SPIN_CAP (1u << 18)

__device__ __forceinline__ unsigned xb_ld(unsigned* p)              { return __hip_atomic_load(p, __ATOMIC_RELAXED, __HIP_MEMORY_SCOPE_AGENT); }
__device__ __forceinline__ unsigned xb_add(unsigned* p, unsigned v) { return __hip_atomic_fetch_add(p, v, __ATOMIC_RELAXED, __HIP_MEMORY_SCOPE_AGENT); }
__device__ __forceinline__ unsigned xb_xcc_id() { return (unsigned)__builtin_amdgcn_s_getreg((3 << 11) | 20) & 0xFu; }
#define XB_SPIN(cond, bar) do { unsigned _sp = 0; while (cond) { __builtin_amdgcn_s_sleep(1); \
    if ((++_sp & 255u) == 0u) { if (xb_ld(&(bar)[XB_TMO])) break; if (_sp > XB_SPIN_CAP) { atomicAdd(&(bar)[XB_TMO], 1u); break; } } } } while (0)

struct XcdBarrier {
    unsigned* bar; unsigned x;
    volatile LAS unsigned* st;
};

__device__ __forceinline__ XcdBarrier xcd_barrier_post(unsigned* bar, volatile LAS unsigned* st) {
    XcdBarrier b; b.bar = bar; b.x = xb_xcc_id(); b.st = st;
    if (threadIdx.x == 0) (void)xb_add(&bar[XB_XCNT(b.x)], 1u);
    return b;
}
__device__ __forceinline__ void xcd_barrier_complete(unsigned* bar, unsigned x, unsigned& nloc, unsigned& nx) {
    const unsigned G = gridDim.x * gridDim.y * gridDim.z;
    unsigned sum, cnt, mine, sp = 0u;
    for (;;) {
        sum = 0u; cnt = 0u; mine = 0u;
#pragma unroll
        for (unsigned j = 0; j < 16; ++j) { const unsigned c = xb_ld(&bar[XB_XCNT(j)]); sum += c; cnt += (c > 0u) ? 1u : 0u; mine = (j == x) ? c : mine; }
        if (sum == G) break;
        __builtin_amdgcn_s_sleep(1);
        if ((++sp & 255u) == 0u) { if (xb_ld(&bar[XB_TMO])) break; if (sp > XB_SPIN_CAP) { atomicAdd(&bar[XB_TMO], 1u); break; } }
    }
    nloc = mine > 0u ? mine : 1u; nx = cnt > 0u ? cnt : 1u;
}

__device__ __forceinline__ void xcd_barrier(const XcdBarrier& b) {
    asm volatile("s_waitcnt vmcnt(0)" ::: "memory");
    __syncthreads();
    if (threadIdx.x == 0) {
        unsigned* bar = b.bar;
        __builtin_amdgcn_s_waitcnt(0);
        unsigned nloc = b.st[0], nx = b.st[1];
        if (nloc == 0u) { xcd_barrier_complete(bar, b.x, nloc, nx); b.st[0] = nloc; b.st[1] = nx; }
        const unsigned old = xb_add(&bar[XB_XSUB(b.x)], 1u);
        const unsigned gen = old / nloc;
        if (old + 1u == (gen + 1u) * nloc) {
            __builtin_amdgcn_fence(__ATOMIC_RELEASE, "agent");
            asm volatile("s_waitcnt vmcnt(0)" ::: "memory");
            const unsigned og = xb_add(&bar[XB_TOP], 1u);
            const unsigned tg = og / nx;
            if (og + 1u == (tg + 1u) * nx) xb_add(&bar[XB_TOPGEN], 1u);
            else XB_SPIN(xb_ld(&bar[XB_TOPGEN]) == tg, bar);
            __builtin_amdgcn_fence(__ATOMIC_ACQUIRE, "agent");
            xb_add(&bar[XB_XGEN(b.x)], 1u);
            asm volatile("s_waitcnt vmcnt(0)" ::: "memory");
        } else {
            XB_SPIN(xb_ld(&bar[XB_XGEN(b.x)]) == gen, bar);
            __builtin_amdgcn_fence(__ATOMIC_ACQUIRE, "agent");
            asm volatile("s_waitcnt vmcnt(0)" ::: "memory");
        }
    }
    __syncthreads();
}

#ifndef PG8_SP2
#define PG8_SP2 true
#endif
#ifndef PG8_ALIGN_EPI
#define PG8_ALIGN_EPI true
#endif
namespace pg8 {
constexpr int BM = 256, BK = 64, HALF = 128, HTB = HALF * BK * 2, STAGE_BYTES = 8 * HTB, NXCD = 8, WGM = 8;
DI int lds_byte(int r, int c) { const int st = (r >> 4) * 2 + (c >> 5), rr = r & 15, cc = c & 31, ob = rr * 64 + cc * 2; return st * 1024 + (ob ^ (((ob >> 9) & 1) << 5)); }
DI void stage_rc(int b, int& R, int& C) { const int st = b / 1024, sb = b % 1024, swz = sb ^ (((sb >> 9) & 1) << 5); R = (st >> 1) * 16 + swz / 64; C = (st & 1) * 32 + (swz % 64) / 2; }
DI int perm32(int rho) { const int n = rho >> 4, i = rho & 15; return 8 * (i >> 2) + 4 * n + (i & 3); }

typedef int v4i32_t __attribute__((ext_vector_type(4)));
typedef int v8i32_t __attribute__((ext_vector_type(8)));
struct GU { const char* a; const char* b; int pm, pn, e, aux, h1; };

template <class Epi, class Sched>
DI void gemm_phase(LAS unsigned char* lds, const Sched& S, const Epi& E) {
    const int tid = threadIdx.x, wid = __builtin_amdgcn_readfirstlane(tid >> 6), lane = tid & 63, wr = wid >> 2, wc = wid & 3, fr = lane & 15, fq = lane >> 4;
    const int K = S.K, nt = K / BK;
    int RR[2], CC[2];
    unsigned voffA[2], voffB[2];
#pragma unroll
    for (int i = 0; i < 2; ++i) { int R, C; stage_rc(tid * 16 + i * 8192, R, C); RR[i] = R; CC[i] = C; const int Rb = Epi::PERM ? ((R & ~31) + perm32(R & 31)) : R;
        voffA[i] = (unsigned)(R * (int)S.lda + C * 2); voffB[i] = (unsigned)(Rb * (int)S.ldb + C * 2); }
    const size_t kstep = (size_t)(BK * 2);
    const size_t ahs = S.a_h, bhs = S.b_h;
    const unsigned ldsw = (unsigned)wid * 1024u;
    const int aoff = lds_byte(wr * 64 + fr, fq * 8), boff = lds_byte(wc * 32 + fr, fq * 8);
#define PG8_SA(b, h) (((b) * 2 + (h)) * HTB)
#define PG8_SB(b, h) ((4 + (b) * 2 + (h)) * HTB)
#define PG8_STAGE(bufoff, gbase, voff) do { _Pragma("unroll") for (int _i = 0; _i < 2; ++_i) \
        __builtin_amdgcn_global_load_lds((const unsigned*)((const char*)(gbase) + (voff)[_i]), (LAS unsigned*)(lds + (bufoff) + ldsw + _i * 8192), 16, 0, 0); } while (0)
#define PG8_STAGE_A(bufoff, gbase, h, VG) do { if constexpr (Sched::GATHER) { PG8_STAGE(bufoff, gbase, VG[h]); } else { PG8_STAGE(bufoff, (gbase) + (h) * ahs, voffA); } } while (0)
#define PG8_STAGE_B(bufoff, gbase, h) PG8_STAGE(bufoff, (gbase) + (h) * bhs, voffB)
#define PG8_LDA(dst, b, h) do { if constexpr (Sched::FP8) { _Pragma("unroll") for (int m = 0; m < 4; ++m) { \
            const v4i32_t lo_ = *(const LAS v4i32_t*)(lds + PG8_SA(b, h) + aoff + m * 2048), hi_ = *(const LAS v4i32_t*)(lds + PG8_SA(b, h) + aoff + m * 2048 + 1024); \
            dst##8[m] = __builtin_shufflevector(lo_, hi_, 0, 1, 2, 3, 4, 5, 6, 7); } } \
        else { _Pragma("unroll") for (int m = 0; m < 4; ++m) _Pragma("unroll") for (int k = 0; k < 2; ++k) dst[m][k] = *(const LAS bf16x8*)(lds + PG8_SA(b, h) + aoff + m * 2048 + k * 1024); } } while (0)
#define PG8_LDB(dst, b, h) do { if constexpr (Sched::FP8) { _Pragma("unroll") for (int n = 0; n < 2; ++n) { \
            const v4i32_t lo_ = *(const LAS v4i32_t*)(lds + PG8_SB(b, h) + boff + n * 2048), hi_ = *(const LAS v4i32_t*)(lds + PG8_SB(b, h) + boff + n * 2048 + 1024); \
            dst##8[n] = __builtin_shufflevector(lo_, hi_, 0, 1, 2, 3, 4, 5, 6, 7); } } \
        else { _Pragma("unroll") for (int n = 0; n < 2; ++n) _Pragma("unroll") for (int k = 0; k < 2; ++k) dst[n][k] = *(const LAS bf16x8*)(lds + PG8_SB(b, h) + boff + n * 2048 + k * 1024); } } while (0)
#define PG8_MMA(ai, bj, At, Bt) do { __builtin_amdgcn_s_setprio(1); _Pragma("unroll") for (int m = 0; m < 4; ++m) _Pragma("unroll") for (int n = 0; n < 2; ++n) { \
        if constexpr (Sched::FP8) {   \
              \
              \
            asm volatile("v_mfma_scale_f32_16x16x128_f8f6f4 %0, %1, %2, %0, %3, %4 op_sel_hi:[0,0,0]" : "+v"(acc[ai][bj][m][n]) : "v"(Bt##8[n]), "v"(At##8[m]), "v"(wsc_), "v"(one_)); \
        } else { _Pragma("unroll") for (int k = 0; k < 2; ++k) acc[ai][bj][m][n] = __builtin_amdgcn_mfma_f32_16x16x32_bf16(Bt[n][k], At[m][k], acc[ai][bj][m][n], 0, 0, 0); } } \
        __builtin_amdgcn_s_setprio(0); } while (0)
#define PG8_WAIT_V(n) asm volatile("s_waitcnt vmcnt(" #n ")" ::: "memory")
#define PG8_WAIT_L(n) asm volatile("s_waitcnt lgkmcnt(" #n ")" ::: "memory")
#define PG8_BAR __builtin_amdgcn_s_barrier()
#define PG8_SCHED __builtin_amdgcn_sched_barrier(0)
    GU cur, nxt; int ui = 0;
    if (!S.next(0, cur)) return;
    f32x4 acc[2][2][4][2];
#pragma unroll
    for (int a = 0; a < 2; ++a)
#pragma unroll
        for (int b = 0; b < 2; ++b)
#pragma unroll
            for (int m = 0; m < 4; ++m)
#pragma unroll
                for (int n = 0; n < 2; ++n) acc[a][b][m][n] = (f32x4){0.f, 0.f, 0.f, 0.f};
    bf16x8 At[4][2], B0[2][2], B1[2][2];
    v8i32_t At8[4], B08[2], B18[2];
    const int wsc_ = Sched::WSCALE, one_ = 127;
    unsigned vc[2][2], vn[2][2];
    if constexpr (Sched::GATHER) {
#pragma unroll
        for (int h = 0; h < 2; ++h)
#pragma unroll
            for (int i = 0; i < 2; ++i) { vc[h][i] = S.rowoff(cur, RR[i] + 128 * h) + (unsigned)(CC[i] * 2); vn[h][i] = vc[h][i]; }
    } else {
#pragma unroll
        for (int h = 0; h < 2; ++h)
#pragma unroll
            for (int i = 0; i < 2; ++i) { vc[h][i] = 0u; vn[h][i] = 0u; }
    }
    const char* cA = cur.a; const char* cB = cur.b;
    if constexpr (PG8_SP2) {
        PG8_STAGE_B(PG8_SB(0, 0), cB, 0); PG8_STAGE_B(PG8_SB(0, 1), cB, 1); PG8_STAGE_A(PG8_SA(0, 0), cA, 0, vc); PG8_STAGE_A(PG8_SA(0, 1), cA, 1, vc);
        if (wr == 1) PG8_BAR;
        PG8_WAIT_V(2); PG8_BAR;
        PG8_STAGE_B(PG8_SB(1, 0), cB + kstep, 0); PG8_STAGE_A(PG8_SA(1, 0), cA + kstep, 0, vc); PG8_STAGE_B(PG8_SB(1, 1), cB + kstep, 1);
        PG8_WAIT_V(6); PG8_BAR;
    } else {
        PG8_STAGE_B(PG8_SB(0, 0), cB, 0); PG8_STAGE_A(PG8_SA(0, 0), cA, 0, vc); PG8_STAGE_B(PG8_SB(0, 1), cB, 1); PG8_STAGE_A(PG8_SA(0, 1), cA, 1, vc);
        if (wr == 1) PG8_BAR;
        PG8_WAIT_V(4); PG8_BAR;
        PG8_STAGE_B(PG8_SB(1, 0), cB + kstep, 0); PG8_STAGE_A(PG8_SA(1, 0), cA + kstep, 0, vc); PG8_STAGE_B(PG8_SB(1, 1), cB + kstep, 1);
        PG8_WAIT_V(6); PG8_BAR;
    }
    for (;;) {
        const bool has_next = S.next(ui + 1, nxt);
        const char* nA = has_next ? nxt.a : cA; const char* nB = has_next ? nxt.b : cB;
        if constexpr (Sched::GATHER) {
            if (has_next) {
#pragma unroll
                for (int h = 0; h < 2; ++h)
#pragma unroll
                    for (int i = 0; i < 2; ++i) vn[h][i] = S.rowoff(nxt, RR[i] + 128 * h) + (unsigned)(CC[i] * 2);
            } else {
#pragma unroll
                for (int h = 0; h < 2; ++h)
#pragma unroll
                    for (int i = 0; i < 2; ++i) vn[h][i] = vc[h][i];
            }
        }
        const bool skip1 = Sched::GATHER_OR_PAD && cur.h1 != 0;
        for (int t = 0; t < nt; t += 2) {
            const bool last = (t == nt - 2);
            const char* a1 = cA + (size_t)(t + 1) * kstep;
            const char* a2 = last ? nA : cA + (size_t)(t + 2) * kstep; const char* b2 = last ? nB : cB + (size_t)(t + 2) * kstep;
            const char* a3 = a2 + kstep; const char* b3 = b2 + kstep;
            unsigned v2[2][2];
#pragma unroll
            for (int h = 0; h < 2; ++h)
#pragma unroll
                for (int i = 0; i < 2; ++i) v2[h][i] = last ? vn[h][i] : vc[h][i];
            if constexpr (PG8_SP2) {
            PG8_LDB(B0, 0, 0); PG8_LDB(B1, 0, 1); PG8_SCHED; PG8_LDA(At, 0, 0); PG8_STAGE_A(PG8_SA(1, 1), a1, 1, vc);
            PG8_WAIT_V(8); PG8_WAIT_L(0); PG8_BAR; PG8_MMA(0, 0, At, B0); PG8_MMA(0, 1, At, B1); PG8_BAR; PG8_SCHED;
            if (!skip1) PG8_LDA(At, 0, 1); PG8_STAGE_B(PG8_SB(0, 0), b2, 0); PG8_STAGE_B(PG8_SB(0, 1), b2, 1); PG8_STAGE_A(PG8_SA(0, 0), a2, 0, v2);
            PG8_WAIT_V(8); PG8_WAIT_L(0); PG8_BAR; if (!skip1) { PG8_MMA(1, 0, At, B0); PG8_MMA(1, 1, At, B1); } PG8_BAR; PG8_SCHED;
            PG8_LDB(B0, 1, 0); PG8_LDB(B1, 1, 1); PG8_SCHED; PG8_LDA(At, 1, 0); PG8_STAGE_A(PG8_SA(0, 1), a2, 1, v2);
            PG8_WAIT_V(8); PG8_WAIT_L(0); PG8_BAR; PG8_MMA(0, 0, At, B0); PG8_MMA(0, 1, At, B1); PG8_BAR; PG8_SCHED;
            if (!skip1) PG8_LDA(At, 1, 1); PG8_STAGE_B(PG8_SB(1, 0), b3, 0); PG8_STAGE_B(PG8_SB(1, 1), b3, 1); PG8_STAGE_A(PG8_SA(1, 0), a3, 0, v2);
            PG8_WAIT_V(8); PG8_WAIT_L(0); PG8_BAR; if (!skip1) { PG8_MMA(1, 0, At, B0); PG8_MMA(1, 1, At, B1); } PG8_BAR; PG8_SCHED;
            } else {
            PG8_LDB(B0, 0, 0); PG8_SCHED; PG8_LDA(At, 0, 0); PG8_STAGE_A(PG8_SA(1, 1), a1, 1, vc);
            PG8_WAIT_L(8); PG8_BAR; PG8_WAIT_L(0); PG8_MMA(0, 0, At, B0); PG8_BAR; PG8_SCHED;
            PG8_LDB(B1, 0, 1); PG8_STAGE_B(PG8_SB(0, 0), b2, 0);
            PG8_BAR; PG8_WAIT_L(0); PG8_MMA(0, 1, At, B1); PG8_BAR;
            PG8_LDA(At, 0, 1); PG8_STAGE_A(PG8_SA(0, 0), a2, 0, v2);
            PG8_BAR; PG8_WAIT_L(0); PG8_MMA(1, 0, At, B0); PG8_BAR; PG8_SCHED;
            PG8_STAGE_B(PG8_SB(0, 1), b2, 1);
            PG8_WAIT_V(6); PG8_BAR; PG8_MMA(1, 1, At, B1); PG8_BAR;
            PG8_LDB(B0, 1, 0); PG8_SCHED; PG8_LDA(At, 1, 0); PG8_STAGE_A(PG8_SA(0, 1), a2, 1, v2);
            PG8_WAIT_L(8); PG8_BAR; PG8_WAIT_L(0); PG8_MMA(0, 0, At, B0); PG8_BAR; PG8_SCHED;
            PG8_LDB(B1, 1, 1); PG8_STAGE_B(PG8_SB(1, 0), b3, 0);
            PG8_BAR; PG8_WAIT_L(0); PG8_MMA(0, 1, At, B1); PG8_BAR;
            PG8_LDA(At, 1, 1); PG8_STAGE_A(PG8_SA(1, 0), a3, 0, v2);
            PG8_BAR; PG8_WAIT_L(0); PG8_MMA(1, 0, At, B0); PG8_BAR; PG8_SCHED;
            PG8_STAGE_B(PG8_SB(1, 1), b3, 1);
            PG8_WAIT_V(6); PG8_BAR; PG8_MMA(1, 1, At, B1); PG8_BAR;
            }
        }
        if constexpr (PG8_ALIGN_EPI) { if (wr == 0) PG8_BAR; }
        if constexpr (Sched::FP8) asm volatile("s_nop 15\n\ts_nop 15" ::: "memory");
        E(acc, cur, wr, wc, fr, fq);
        if (!has_next) break;
#pragma unroll
        for (int a = 0; a < 2; ++a)
#pragma unroll
            for (int b = 0; b < 2; ++b)
#pragma unroll
                for (int m = 0; m < 4; ++m)
#pragma unroll
                    for (int n = 0; n < 2; ++n) acc[a][b][m][n] = (f32x4){0.f, 0.f, 0.f, 0.f};
        cur = nxt; cA = nA; cB = nB; ++ui;
        if constexpr (Sched::GATHER) {
#pragma unroll
            for (int h = 0; h < 2; ++h)
#pragma unroll
                for (int i = 0; i < 2; ++i) vc[h][i] = vn[h][i];
        }
        if constexpr (PG8_ALIGN_EPI) { if (wr == 1) PG8_BAR; }
    }
    PG8_WAIT_V(0);
    if constexpr (!PG8_ALIGN_EPI) { if (wr == 0) PG8_BAR; }
    PG8_BAR;
#undef PG8_SA
#undef PG8_SB
#undef PG8_STAGE
#undef PG8_STAGE_A
#undef PG8_STAGE_B
#undef PG8_LDA
#undef PG8_LDB
#undef PG8_MMA
#undef PG8_WAIT_V
#undef PG8_WAIT_L
#undef PG8_BAR
#undef PG8_SCHED
}

struct TileOrder {
    int nM, nN, nwg, G, c;
    DI void init(int nM_, int nN_, int G_, int c_) { nM = nM_; nN = nN_; nwg = nM * nN; G = G_; c = c_; }
    DI bool tile(int i, int& pm, int& pn) const {
        const long L = (long)i * G + c; if (L >= nwg) return false;
        int wgid = (int)L; { const int q = nwg / NXCD, r = nwg % NXCD, xcd = wgid % NXCD, off = wgid / NXCD; wgid = (xcd < r ? xcd * (q + 1) : r * (q + 1) + (xcd - r) * q) + off; }
        const int nig = WGM * nN, gid = wgid / nig, fm = gid * WGM, gsz = (nM - fm) < WGM ? (nM - fm) : WGM;
        pm = fm + ((wgid % nig) % gsz); pn = (wgid % nig) / gsz; return true;
    }
};
}
constexpr size_t AL(size_t x) { return (x + 255) & ~(size_t)255; }
constexpr int MOE_CAP = NTOK;
constexpr int SLOT_ROWS = 2 * NTOK + NEXP * 256;
constexpr int NCHUNK = (CTX + SEQ) / 64;
constexpr size_t WS_CTL    = 0;
constexpr size_t CTL_BYTES = 65536;
constexpr size_t CW_BAR    = 0;
constexpr size_t CW_CNT    = 16384;
constexpr size_t WS_MOD    = AL(WS_CTL + CTL_BYTES);
constexpr size_t WS_ROPE0  = AL(WS_MOD + (size_t)2 * 5 * MODN * 4);
constexpr size_t WS_ROPE1  = AL(WS_ROPE0 + 64 * 16 * 8);
constexpr size_t WS_W0IN   = AL(WS_ROPE1 + 64 * 32 * 8);
constexpr size_t WS_WUQ    = AL(WS_W0IN + (size_t)L0INP * DM * 2);
constexpr size_t WS_WUKV   = AL(WS_WUQ + (size_t)1536 * 512 * 2);
constexpr size_t WS_W0OUT  = AL(WS_WUKV + (size_t)2048 * 256 * 2);
constexpr size_t WS_W1IN   = AL(WS_W0OUT + (size_t)DM * DM * 2);
constexpr size_t WS_W1OUT  = AL(WS_W1IN + (size_t)L1IN * DM * 2);
constexpr size_t EXPW      = (size_t)NEXP * EFF * DM * 2;
constexpr size_t WS_EG     = AL(WS_W1OUT + (size_t)DM * DM * 2);
constexpr size_t WS_EU     = AL(WS_EG + 2 * EXPW);
constexpr size_t WS_ED     = AL(WS_EU + 2 * EXPW);
constexpr size_t WS_GW     = AL(WS_ED + 2 * EXPW);
constexpr size_t WS_XA     = AL(WS_GW + (size_t)2 * 16 * 128 * 128 * 2);
constexpr size_t WS_XB     = AL(WS_XA + (size_t)NTOK * DM * 4);
constexpr size_t WS_H      = AL(WS_XB + (size_t)NTOK * DM * 4);
constexpr size_t WS_Z      = AL(WS_H + (size_t)NTOK * DM * 2);
constexpr size_t WS_CQN    = AL(WS_Z + (size_t)NTOK * L1IN * 2);
constexpr size_t WS_CKVN   = AL(WS_CQN + (size_t)NTOK * 512 * 2);
constexpr size_t WS_KR     = AL(WS_CKVN + (size_t)NTOK * 256 * 2);
constexpr size_t WS_Q0     = AL(WS_KR + (size_t)NTOK * 64 * 2);
constexpr size_t WS_KV0    = AL(WS_Q0 + (size_t)NTOK * 1536 * 2);
constexpr size_t WS_Y      = AL(WS_KV0 + (size_t)NTOK * 2048 * 2);
constexpr size_t WS_SUMM   = AL(WS_Y + (size_t)NTOK * DM * 2);
constexpr size_t WS_CARRY  = AL(WS_SUMM + (size_t)2 * NB * NCHUNK * 1024 * 8);
constexpr size_t WS_LIST   = AL(WS_CARRY + (size_t)2 * NB * NCHUNK * 1024 * 4);
constexpr size_t WS_TOK    = AL(WS_LIST + (size_t)NEXP * MOE_CAP * 4);
constexpr size_t WS_ACT    = AL(WS_TOK + (size_t)NTOK * 32);
constexpr size_t WS_OUT2   = AL(WS_ACT + (size_t)SLOT_ROWS * EFF * 2);
constexpr size_t WS_D      = AL(WS_OUT2 + (size_t)SLOT_ROWS * DM * 2);
constexpr size_t WS_ABG    = AL(WS_D + (size_t)NTOK * DM * 2);
constexpr size_t WS_H8     = AL(WS_ABG + (size_t)NB * NCHUNK * 8 * 2 * 64 * 128 * 4);
constexpr size_t WS_END    = AL(WS_H8 + (size_t)(NTOK + 1) * DM);

struct TokInfo { int e0, p0, e1, p1; float w0, w1; int pad0, pad1; };

constexpr int LDS_STAGE = 0;
constexpr int LDS_MISC  = 139264;
constexpr int LDS_BYTES = 139264 + 4096;

struct Params { const float* in[38]; float* out; unsigned char* ws; int ph_lo, ph_hi, flags, pad; };

struct Frame {
    const float* const* in; float* out; unsigned char* ws; LAS unsigned char* lds;
    int tid, lane, wave, G, bid;
};
struct CvtJob { const float* src; bf16_t* dst; int K, N, ldo, perm, tiles_per_b, tile0; size_t sstride, dstride; float f8scale; };

DI int l1_permrow(int n) {
    if (n >= 1280) return n;
    const int hb = n & ~127, d = n & 127, a = d >> 6, part = (d >> 5) & 1, i = d & 31;
    return hb + 64 * a + 32 * (i >> 4) + 16 * part + (i & 15);
}

DI void set_job(LAS CvtJob* J, int j, const float* src, bf16_t* dst, int K, int N, int ldo, int perm, int nb, size_t ss, size_t ds, int& t0) {
    J[j].src = src; J[j].dst = dst; J[j].K = K; J[j].N = N; J[j].ldo = ldo; J[j].perm = perm; J[j].tiles_per_b = (K / 64) * ((N + 255) / 256); J[j].tile0 = t0;
    J[j].sstride = ss; J[j].dstride = ds; J[j].f8scale = 0.f; t0 += nb * J[j].tiles_per_b;
}

struct CvtTile { const float* src; bf16_t* dst; int N, ldo, k0, n0, nw, perm; float f8scale; };
DI void cvt_decode(LAS CvtJob* J, int nj, int gt, CvtTile& t) {
    int j = 0;
#pragma unroll 1
    for (int q = 1; q < nj; ++q) if (gt >= J[q].tile0) j = q;
    const int rem = gt - J[j].tile0, tpb = J[j].tiles_per_b, b = rem / tpb, r2 = rem % tpb;
    t.N = J[j].N; t.ldo = J[j].ldo; const int nst = (t.N + 255) / 256, kt = r2 / nst, st = r2 % nst; t.perm = J[j].perm;
    t.f8scale = J[j].f8scale;
    t.src = J[j].src + (size_t)b * J[j].sstride; t.dst = (J[j].f8scale != 0.f) ? (bf16_t*)((unsigned char*)J[j].dst + (size_t)b * J[j].dstride) : J[j].dst + (size_t)b * J[j].dstride;
    t.k0 = kt * 64; t.n0 = st * 256; t.nw = min(256, t.N - t.n0);
}
#ifndef FP8_IN1
#define FP8_IN1 1
#endif
#ifndef FP8_OUT1
#define FP8_OUT1 1
#endif
#ifndef FP8_L0
#define FP8_L0 1
#endif
constexpr int MOE_CVT_TILES = 3 * NEXP * 64;
#ifndef BG_L0_P2
#define BG_L0_P2 960
#endif
#ifndef BG_L0_P6
#define BG_L0_P6 3960
#endif
#define BG_L1_DOWN0 4096
#ifndef BG_L0_P7
#define BG_L0_P7 (BG_L0_P6 + 768)
#endif
#ifndef BG_L1_P8
#define BG_L1_P8 2400
#endif
#ifndef BG_L1_P11
#define BG_L1_P11 4096
#endif
DI void cvt_group(const Params& p, LAS unsigned char* lds, int group, int t_lo, int t_hi, int r, int I) {
    const int tid = threadIdx.x;
    unsigned char* ws = p.ws;
    __syncthreads();
    LAS CvtJob* J = (LAS CvtJob*)(lds + 72 * 1024);
    LAS float* tile = (LAS float*)lds;
    if (tid == 0) {
        int t0 = 0, nj = 0;
        if (group == 0) {
            set_job(J, 0, p.in[11], (bf16_t*)(ws + WS_W0IN), DM, L0IN, DM, 0, 1, 0, 0, t0);
            set_job(J, 1, p.in[13], (bf16_t*)(ws + WS_WUQ), 512, 1536, 512, 0, 1, 0, 0, t0);
            set_job(J, 2, p.in[15], (bf16_t*)(ws + WS_WUKV), 256, 2048, 256, 0, 1, 0, 0, t0);
            set_job(J, 3, p.in[23], (bf16_t*)(ws + WS_W0OUT), DM, DM, DM, 0, 1, 0, 0, t0);
            set_job(J, 4, p.in[31], (bf16_t*)(ws + WS_W1IN), DM, L1IN, DM, 1, 1, 0, 0, t0); if (FP8_IN1) J[4].f8scale = 64.f;
            set_job(J, 5, p.in[34], (bf16_t*)(ws + WS_W1OUT), DM, DM, DM, 0, 1, 0, 0, t0); if (FP8_OUT1) J[5].f8scale = 64.f;
            set_job(J, 6, p.in[18], (bf16_t*)(ws + WS_GW), 128, 128, 128, 0, 16, 128 * 128, 128 * 128, t0);
            set_job(J, 7, p.in[20], (bf16_t*)(ws + WS_GW + (size_t)16 * 128 * 128 * 2), 128, 128, 128, 0, 16, 128 * 128, 128 * 128, t0);
            nj = 8;
        } else if (group == 1) {
            set_job(J, 0, p.in[24], (bf16_t*)(ws + WS_EG), DM, EFF, DM, 0, NEXP, (size_t)DM * EFF, (size_t)EFF * DM, t0);
            set_job(J, 1, p.in[25], (bf16_t*)(ws + WS_EU), DM, EFF, DM, 0, NEXP, (size_t)DM * EFF, (size_t)EFF * DM, t0);
            set_job(J, 2, p.in[26], (bf16_t*)(ws + WS_ED), EFF, DM, EFF, 0, NEXP, (size_t)DM * EFF, (size_t)EFF * DM, t0);
            if (FP8_L0) { J[0].f8scale = 64.f; J[1].f8scale = 64.f; J[2].f8scale = 32.f; }
            nj = 3;
        } else {
            set_job(J, 0, p.in[35], (bf16_t*)(ws + WS_EG + EXPW), DM, EFF, DM, 0, NEXP, (size_t)DM * EFF, (size_t)EFF * DM, t0); J[0].f8scale = 64.f;
            set_job(J, 1, p.in[36], (bf16_t*)(ws + WS_EU + EXPW), DM, EFF, DM, 0, NEXP, (size_t)DM * EFF, (size_t)EFF * DM, t0); J[1].f8scale = 64.f;
            set_job(J, 2, p.in[37], (bf16_t*)(ws + WS_ED + EXPW), EFF, DM, EFF, 0, NEXP, (size_t)DM * EFF, (size_t)EFF * DM, t0); J[2].f8scale = 32.f;
            nj = 3;
        }
        J[nj].tile0 = t0; J[15].tile0 = nj;
    }
    __syncthreads();
    const int nj = J[15].tile0, total = J[nj].tile0;
    const int hi = min(t_hi, total);
    const int row = tid >> 6, c4 = (tid & 63) * 4;
    for (int gt = t_lo + r; gt < hi; gt += I) {
        CvtTile cur; cvt_decode(J, nj, gt, cur);
        if (c4 < cur.nw) {
            f32x4 v[8];
#pragma unroll
            for (int i = 0; i < 8; ++i) v[i] = *(const f32x4*)(cur.src + (size_t)(cur.k0 + row + 8 * i) * cur.N + cur.n0 + c4);
#pragma unroll
            for (int i = 0; i < 8; ++i) *(LAS f32x4*)(tile + (row + 8 * i) * 260 + c4) = v[i];
        }
        __syncthreads();
        { const int n = tid & 255, kh = tid >> 8;
          if (n < cur.nw) {
              const int orow = cur.perm ? l1_permrow(cur.n0 + n) : (cur.n0 + n);
              if (cur.f8scale != 0.f) {
                  unsigned char* d8 = (unsigned char*)cur.dst + (size_t)orow * cur.ldo + cur.k0 + 32 * kh;
#pragma unroll
                  for (int q16 = 0; q16 < 2; ++q16) {
                      float w16[16];
#pragma unroll
                      for (int q = 0; q < 16; ++q) w16[q] = tile[(32 * kh + 16 * q16 + q) * 260 + n] * cur.f8scale;
                      u32x4 w; w.x = pk_fp8x4(w16[0], w16[1], w16[2], w16[3]); w.y = pk_fp8x4(w16[4], w16[5], w16[6], w16[7]);
                      w.z = pk_fp8x4(w16[8], w16[9], w16[10], w16[11]); w.w = pk_fp8x4(w16[12], w16[13], w16[14], w16[15]);
                      *(u32x4*)(d8 + 16 * q16) = w;
                  }
              } else {
#pragma unroll
              for (int q8 = 0; q8 < 4; ++q8) {
                  float w8[8];
#pragma unroll
                  for (int q = 0; q < 8; ++q) w8[q] = tile[(32 * kh + 8 * q8 + q) * 260 + n];
                  u32x4 w; w.x = pk_bf16(w8[0], w8[1]); w.y = pk_bf16(w8[2], w8[3]); w.z = pk_bf16(w8[4], w8[5]); w.w = pk_bf16(w8[6], w8[7]);
                  *(u32x4*)(cur.dst + (size_t)orow * cur.ldo + cur.k0 + 32 * kh + 8 * q8) = w;
              }
              }
          } }
        __syncthreads();
    }
}
DI void bg_range(const Params& p, LAS unsigned char* lds, int group, int t_lo, int t_hi, int nunits, int G, int bid) {
    const int rem = nunits % G;
    if (rem == 0) cvt_group(p, lds, group, t_lo, t_hi, bid, G);
    else if (bid >= rem) cvt_group(p, lds, group, t_lo, t_hi, bid - rem, G - rem);
}
DI int bg_end(int t_lo, int nunits, int per_wg, int G) { const int rem = nunits % G; if (rem == 0) return t_lo; return min(t_lo + (G - rem) * per_wg, MOE_CVT_TILES); }
DI int bg_convert(const Params& p, LAS unsigned char* lds, int group, int t_lo, int nunits, int per_wg, int G, int bid) {
    const int rem = nunits % G;
    if (rem == 0) return t_lo;
    const int idle = G - rem, t_hi = min(t_lo + idle * per_wg, MOE_CVT_TILES);
    if (bid >= rem && t_hi > t_lo) cvt_group(p, lds, group, t_lo, t_hi, bid - rem, idle);
    return t_hi;
}

DI void phase_prologue(const Params& p, LAS unsigned char* lds, int G, int bid) {
    const int tid = threadIdx.x;
    unsigned char* ws = p.ws;
    {
        LAS float* s = (LAS float*)lds;
        LAS float* part = (LAS float*)(lds + 40960);
        for (int i = tid; i < 5 * DM; i += NTHREADS) { const int r = i / DM, k = i % DM; const float c = r < 4 ? p.in[1][r * DM + k] : p.in[3][k]; s[i] = c / (1.0f + __expf(-c)); }
        __syncthreads();
        float* MOD = (float*)(ws + WS_MOD);
        for (int chunk = bid; chunk < 256; chunk += G) {
            const int layer = chunk >> 7, n0 = (chunk & 127) * 96;
            const float* W = layer ? p.in[27] : p.in[7]; const float* bias = layer ? p.in[28] : p.in[8];
            const int cg = tid % 24, ks = tid / 24;
            if (ks < 16) {
                f32x4 acc[5];
#pragma unroll
                for (int r = 0; r < 5; ++r) acc[r] = (f32x4){0.f, 0.f, 0.f, 0.f};
                const float* wp = W + (size_t)(ks * 128) * MODN + n0 + 4 * cg;
                for (int k = 0; k < 128; k += 8) {
                    f32x4 w[8];
#pragma unroll
                    for (int j = 0; j < 8; ++j) w[j] = *(const f32x4*)(wp + (size_t)(k + j) * MODN);
#pragma unroll
                    for (int j = 0; j < 8; ++j)
#pragma unroll
                        for (int r = 0; r < 5; ++r) acc[r] += s[r * DM + ks * 128 + k + j] * w[j];
                }
#pragma unroll
                for (int r = 0; r < 5; ++r)
#pragma unroll
                    for (int j = 0; j < 4; ++j) part[(ks * 5 + r) * 96 + cg * 4 + j] = acc[r][j];
            }
            __syncthreads();
            if (tid < 480) {
                const int r = tid / 96, col = tid % 96; float a = bias[n0 + col];
#pragma unroll
                for (int k2 = 0; k2 < 16; ++k2) a += part[(k2 * 5 + r) * 96 + col];
                MOD[((size_t)layer * 5 + r) * MODN + n0 + col] = a;
            }
            __syncthreads();
        }
    }
    {
        f32x2* R0 = (f32x2*)(ws + WS_ROPE0); f32x2* R1 = (f32x2*)(ws + WS_ROPE1);
        for (int i = bid * NTHREADS + tid; i < 64 * 16 + 64 * 32; i += G * NTHREADS) {
            if (i < 64 * 16) { const int pos = i >> 4, k = i & 15; const float ang = (float)pos * exp2f(-(float)k * (13.287712379549449f / 16.0f)); R0[i] = (f32x2){cosf(ang), sinf(ang)}; }
            else { const int j = i - 64 * 16, pos = j >> 5, k = j & 31; const float ang = (float)pos * exp2f(-(float)k * (13.287712379549449f / 32.0f)); R1[j] = (f32x2){cosf(ang), sinf(ang)}; }
        }
        u32x4* z = (u32x4*)(ws + WS_W0IN + (size_t)L0IN * DM * 2);
        for (int i = bid * NTHREADS + tid; i < (L0INP - L0IN) * DM * 2 / 16; i += G * NTHREADS) z[i] = (u32x4){0u, 0u, 0u, 0u};
        if (bid == 0 && tid < DM / 16) ((u32x4*)(ws + WS_H8 + (size_t)NTOK * DM))[tid] = (u32x4){0u, 0u, 0u, 0u};
    }
    cvt_group(p, lds, 0, 0, 1 << 30, bid, G);
    cvt_group(p, lds, 1, BG_L0_P7, MOE_CVT_TILES, bid, G);
    cvt_group(p, lds, 2, BG_L1_P11, BG_L1_DOWN0, bid, G);
}

DI void norm_mod_store(const f32x4 (&v)[8], const float* gain, const float* shift, const float* scale, bf16_t* hrow, int lane, unsigned char* h8row = nullptr) {
    float ss = 0.f;
#pragma unroll
    for (int i = 0; i < 8; ++i) ss += v[i][0] * v[i][0] + v[i][1] * v[i][1] + v[i][2] * v[i][2] + v[i][3] * v[i][3];
    ss = wave_sum(ss);
    const float r = rsqrtf(ss * (1.0f / DM) + EPS);
#pragma unroll
    for (int i = 0; i < 8; ++i) {
        const int col = 4 * lane + 256 * i;
        const f32x4 g = *(const f32x4*)(gain + col), sh = *(const f32x4*)(shift + col), sc = *(const f32x4*)(scale + col);
        const f32x4 h = (v[i] * r * g) * (1.0f + sc) + sh;
        if (h8row) *(unsigned*)(h8row + col) = pk_fp8x4(h[0], h[1], h[2], h[3]);
        else { u32x2 w; w.x = pk_bf16(h[0], h[1]); w.y = pk_bf16(h[2], h[3]); *(u32x2*)(hrow + col) = w; }
    }
}

DI void phase_norm0(const Params& p, int G, int bid) {
    const int lane = threadIdx.x & 63, wave = threadIdx.x >> 6;
    const float* MOD = (const float*)(p.ws + WS_MOD);
    bf16_t* H = (bf16_t*)(p.ws + WS_H);
    for (int row = bid * 8 + wave; row < NTOK; row += G * 8) {
        const float* xr = row < NCTX ? p.in[2] + (size_t)row * DM : p.in[0] + (size_t)(row - NCTX) * DM;
        f32x4 v[8];
#pragma unroll
        for (int i = 0; i < 8; ++i) v[i] = *(const f32x4*)(xr + 4 * lane + 256 * i);
        const float* md = MOD + (size_t)row_mod(row) * MODN;
        norm_mod_store(v, p.in[9], md, md + DM, H + (size_t)row * DM, lane);
    }
}
DI void phase_l0_rows(const Params& p, int G, int bid) {
    const int lane = threadIdx.x & 63, wave = threadIdx.x >> 6;
    const bf16_t* Z = (const bf16_t*)(p.ws + WS_Z);
    bf16_t* CQN = (bf16_t*)(p.ws + WS_CQN); bf16_t* CKVN = (bf16_t*)(p.ws + WS_CKVN); bf16_t* KR = (bf16_t*)(p.ws + WS_KR);
    const f32x2* R0 = (const f32x2*)(p.ws + WS_ROPE0);
    const bool wdeal = (G == 256);
    const int nslot = NTOK / 8;
    const int s_first = !wdeal ? bid : (bid < 128 ? bid : 128 + (bid - 128) * 4), s_cnt = !wdeal ? 1 : (bid < 128 ? 1 : 4), s_step = !wdeal ? G : 640;
    for (int sb = s_first; sb < nslot; sb += s_step)
    for (int sj = 0; sj < s_cnt && sb + sj < nslot; ++sj) {
        const int row = (sb + sj) * 8 + wave;
        const bf16_t* z = Z + (size_t)row * L0INP;
        {
            const u32x4 w = *(const u32x4*)(z + 8 * lane);
            float v[8] = {bflo(w.x), bfhi(w.x), bflo(w.y), bfhi(w.y), bflo(w.z), bfhi(w.z), bflo(w.w), bfhi(w.w)};
            float ss = 0.f;
#pragma unroll
            for (int j = 0; j < 8; ++j) ss += v[j] * v[j];
            ss = wave_sum(ss);
            const float r = rsqrtf(ss * (1.0f / 512.0f) + EPS);
            const f32x4 g0 = *(const f32x4*)(p.in[12] + 8 * lane), g1 = *(const f32x4*)(p.in[12] + 8 * lane + 4);
            u32x4 o; o.x = pk_bf16(v[0] * r * g0[0], v[1] * r * g0[1]); o.y = pk_bf16(v[2] * r * g0[2], v[3] * r * g0[3]);
            o.z = pk_bf16(v[4] * r * g1[0], v[5] * r * g1[1]); o.w = pk_bf16(v[6] * r * g1[2], v[7] * r * g1[3]);
            *(u32x4*)(CQN + (size_t)row * 512 + 8 * lane) = o;
        }
        {
            const u32x2 w = *(const u32x2*)(z + 512 + 4 * lane);
            float v[4] = {bflo(w.x), bfhi(w.x), bflo(w.y), bfhi(w.y)};
            float ss = v[0] * v[0] + v[1] * v[1] + v[2] * v[2] + v[3] * v[3];
            ss = wave_sum(ss);
            const float r = rsqrtf(ss * (1.0f / 256.0f) + EPS);
            const f32x4 g = *(const f32x4*)(p.in[14] + 4 * lane);
            u32x2 o; o.x = pk_bf16(v[0] * r * g[0], v[1] * r * g[1]); o.y = pk_bf16(v[2] * r * g[2], v[3] * r * g[3]);
            *(u32x2*)(CKVN + (size_t)row * 256 + 4 * lane) = o;
        }
        {
            const float x = bf2f(z[768 + lane]);
            const float xp = __shfl_xor(x, 16);
            float o = x;
            if (row >= NCTX) {
                const int t = (row - NCTX) & (SEQ - 1), axis = lane >> 5, part = (lane >> 4) & 1, i = lane & 15;
                const int pos = axis ? (t & 63) : (t >> 6);
                const f32x2 cs = R0[pos * 16 + i];
                o = part ? (x * cs[0] + xp * cs[1]) : (x * cs[0] - xp * cs[1]);
            }
            KR[(size_t)row * 64 + lane] = f2bf(o);
        }
    }
}

DI float gelu_tanh(float x) { const float u = 0.7978845608028654f * (x + 0.044715f * x * x * x); const float e = __expf(2.0f * u); const float th = 1.0f - 2.0f / (e + 1.0f); return 0.5f * x * (1.0f + th); }

template <int PASS>
DI void lru_units(const Params& p, LAS unsigned char* lds, int G, int bid) {
    const int tid = threadIdx.x, lane = tid & 63, wave = tid >> 6;
    const bf16_t* Z = (const bf16_t*)(p.ws + WS_Z);
    const bf16_t* GWA = (const bf16_t*)(p.ws + WS_GW); const bf16_t* GWX = GWA + 16 * 128 * 128;
    f32x2* SUMM = (f32x2*)(p.ws + WS_SUMM); const float* CARRY = (const float*)(p.ws + WS_CARRY);
    bf16_t* Y = (bf16_t*)(p.ws + WS_Y);
    unsigned* ABG = (unsigned*)(p.ws + WS_ABG);
    LAS float* U32 = (LAS float*)lds;
    LAS unsigned char* UBF = lds + 32768;
    LAS f32x2* AB = (LAS f32x2*)lds;
    const bool by_n = (G % 8) == 0;
    const int n_fix = bid & 7, nW = by_n ? G / 8 : G, q0 = by_n ? bid >> 3 : bid, nunits = by_n ? NCHUNK * NB : NCHUNK * NB * 8;
    const int d = wave >> 2, nt = wave & 3, jl = lane & 31, h = lane >> 5, ch = 32 * nt + jl;
    bf16x8 wa[8], wx[8];
    if (by_n) {
        const bf16_t* pa = GWA + ((size_t)(d * 8 + n_fix) * 128 + ch) * 128 + 8 * h;
        const bf16_t* px = GWX + ((size_t)(d * 8 + n_fix) * 128 + ch) * 128 + 8 * h;
#pragma unroll
        for (int ks = 0; ks < 8; ++ks) { wa[ks] = *(const bf16x8*)(pa + 16 * ks); wx[ks] = *(const bf16x8*)(px + 16 * ks); }
    }
    for (int v = q0; v < nunits; v += nW) {
        const int n = by_n ? n_fix : (v & 7), bc = by_n ? v : (v >> 3), b = bc & 3, ci = bc >> 2;
        const int seg_len = ci < 4 ? CTX : SEQ, t0 = ci < 4 ? 64 * ci : 64 * (ci - 4);
        const int row0 = ci < 4 ? b * CTX + t0 : NCTX + b * SEQ + t0;
        const int chg = 128 * n + ch;
        if (!by_n) {
            const bf16_t* pa = GWA + ((size_t)(d * 8 + n) * 128 + ch) * 128 + 8 * h;
            const bf16_t* px = GWX + ((size_t)(d * 8 + n) * 128 + ch) * 128 + 8 * h;
#pragma unroll
            for (int ks = 0; ks < 8; ++ks) { wa[ks] = *(const bf16x8*)(pa + 16 * ks); wx[ks] = *(const bf16x8*)(px + 16 * ks); }
        }
        u32x2 grw[4];
        {
            const int c4 = (tid & 31) * 4, tb = 4 * (tid >> 5), cg = 128 * n + c4;
            f32x4 xv[7];
#pragma unroll
            for (int q = 0; q < 7; ++q) { const int tt = t0 + tb + q - 2; u32x2 w = (u32x2){0u, 0u};
                if (tt >= 0 && tt < seg_len) w = *(const u32x2*)(Z + (size_t)(row0 + tb + q - 2) * L0INP + 832 + cg);
                xv[q] = (f32x4){bflo(w.x), bfhi(w.x), bflo(w.y), bfhi(w.y)}; }
            if (PASS == 2) {
#pragma unroll
                for (int j = 0; j < 4; ++j) grw[j] = *(const u32x2*)(Z + (size_t)(row0 + tb + j) * L0INP + 1856 + cg);
            }
            const f32x4 cb = *(const f32x4*)(p.in[17] + cg);
            f32x4 cw[4];
#pragma unroll
            for (int tap = 0; tap < 4; ++tap) cw[tap] = *(const f32x4*)(p.in[16] + tap * 1024 + cg);
#pragma unroll
            for (int j = 0; j < 4; ++j) {
                const f32x4 acc = cb + xv[j] * cw[0] + xv[j + 1] * cw[1] + xv[j + 2] * cw[2] + xv[j + 3] * cw[3];
                *(LAS f32x4*)(U32 + (tb + j) * 128 + c4) = acc;
                u32x2 o; o.x = pk_bf16(acc[0], acc[1]); o.y = pk_bf16(acc[2], acc[3]);
                *(LAS u32x2*)(UBF + (tb + j) * 272 + c4 * 2) = o;
            }
        }
        __syncthreads();
        f32x16 acc[2][2];
#pragma unroll
        for (int g = 0; g < 2; ++g)
#pragma unroll
            for (int mt = 0; mt < 2; ++mt)
#pragma unroll
                for (int i = 0; i < 16; ++i) acc[g][mt][i] = 0.f;
#pragma unroll
        for (int ks = 0; ks < 8; ++ks) {
            const bf16x8 a0 = *(const LAS bf16x8*)(UBF + jl * 272 + (16 * ks + 8 * h) * 2);
            const bf16x8 a1 = *(const LAS bf16x8*)(UBF + (32 + jl) * 272 + (16 * ks + 8 * h) * 2);
            acc[0][0] = __builtin_amdgcn_mfma_f32_32x32x16_bf16(a0, wa[ks], acc[0][0], 0, 0, 0);
            acc[0][1] = __builtin_amdgcn_mfma_f32_32x32x16_bf16(a1, wa[ks], acc[0][1], 0, 0, 0);
            acc[1][0] = __builtin_amdgcn_mfma_f32_32x32x16_bf16(a0, wx[ks], acc[1][0], 0, 0, 0);
            acc[1][1] = __builtin_amdgcn_mfma_f32_32x32x16_bf16(a1, wx[ks], acc[1][1], 0, 0, 0);
        }
        {
            const float ga_b = p.in[19][d * 1024 + chg], gx_b = p.in[21][d * 1024 + chg], lam = p.in[22][d * 1024 + chg];
            const float sp8l2 = 8.0f * LOG2E * log1pf(expf(-lam));
#pragma unroll
            for (int mt = 0; mt < 2; ++mt)
#pragma unroll
                for (int i = 0; i < 16; ++i) {
                    const int t = 32 * mt + (i & 3) + 8 * (i >> 2) + 4 * h;
                    const float r = __builtin_amdgcn_rcpf(1.0f + __builtin_amdgcn_exp2f(-LOG2E * (acc[0][mt][i] + ga_b)));
                    const float ig = __builtin_amdgcn_rcpf(1.0f + __builtin_amdgcn_exp2f(-LOG2E * (acc[1][mt][i] + gx_b)));
                    const float a = __builtin_amdgcn_exp2f(-sp8l2 * r);
                    const float bb = __builtin_amdgcn_sqrtf((1.0f - a) * (1.0f + a)) * (ig * U32[t * 128 + ch]);
                    acc[0][mt][i] = a; acc[1][mt][i] = bb;
                }
        }
        if (PASS == 1) {
#pragma unroll
            for (int mt = 0; mt < 2; ++mt)
#pragma unroll
                for (int i = 0; i < 16; ++i) { const int t = 32 * mt + (i & 3) + 8 * (i >> 2) + 4 * h;
                    ABG[((((size_t)(b * NCHUNK + ci) * 8 + n) * 2 + d) * 64 + t) * 128 + ch] = pk_bf16(1.0f - acc[0][mt][i], acc[1][mt][i]); }
#define LRU_STEP(A_, B_, a_, b_) do { const float nf_ = fmaf((a_), (B_), (b_)), nb_ = fmaf((A_), (b_), (B_)); (B_) = d ? nb_ : nf_; (A_) *= (a_); } while (0)
            float GA[8], GB[8];
#pragma unroll
            for (int k = 0; k < 8; ++k) {
                const int mt = k >> 2, g = k & 3; float A = 1.f, B = 0.f;
#pragma unroll
                for (int e = 0; e < 4; ++e) LRU_STEP(A, B, acc[0][mt][4 * g + e], acc[1][mt][4 * g + e]);
                GA[k] = A; GB[k] = B;
            }
            float TA = 1.f, TB = 0.f;
#pragma unroll
            for (int k = 0; k < 8; ++k) {
                const float pa = __shfl_xor(GA[k], 32), pb = __shfl_xor(GB[k], 32);
                const float la = h ? pa : GA[k], lb = h ? pb : GB[k], ha = h ? GA[k] : pa, hb = h ? GB[k] : pb;
                LRU_STEP(TA, TB, la, lb); LRU_STEP(TA, TB, ha, hb);
            }
#undef LRU_STEP
            if (h == 0) SUMM[((size_t)(d * NB + b) * NCHUNK + ci) * 1024 + chg] = (f32x2){TA, TB};
        } else {
        __syncthreads();
#pragma unroll
        for (int mt = 0; mt < 2; ++mt)
#pragma unroll
            for (int i = 0; i < 16; ++i) { const int t = 32 * mt + (i & 3) + 8 * (i >> 2) + 4 * h; AB[(d * 64 + t) * 128 + ch] = (f32x2){acc[0][mt][i], acc[1][mt][i]};
                if (PASS == 1) ABG[((((size_t)(b * NCHUNK + ci) * 8 + n) * 2 + d) * 64 + t) * 128 + ch] = pk_bf16(1.0f - acc[0][mt][i], acc[1][mt][i]); }
        __syncthreads();
        if (tid < 256) {
            const int sd = tid >> 7, sc = tid & 127;
            const size_t sidx = ((size_t)(sd * NB + b) * NCHUNK + ci) * 1024 + 128 * n + sc;
            if (PASS == 1) {
                float hh = 0.f, ap = 1.f;
#pragma unroll 16
                for (int s2 = 0; s2 < 64; ++s2) { const int t = sd ? 63 - s2 : s2; const f32x2 ab = AB[(sd * 64 + t) * 128 + sc]; hh = ab[0] * hh + ab[1]; ap *= ab[0]; }
                SUMM[sidx] = (f32x2){ap, hh};
            } else {
                float hh = CARRY[sidx];
#pragma unroll 16
                for (int s2 = 0; s2 < 64; ++s2) { const int t = sd ? 63 - s2 : s2; const f32x2 ab = AB[(sd * 64 + t) * 128 + sc]; hh = ab[0] * hh + ab[1]; AB[(sd * 64 + t) * 128 + sc] = (f32x2){ab[0], hh}; }
            }
        }
        }
        __syncthreads();
        if (PASS == 2) {
            const int c4 = (tid & 31) * 4, tb = 4 * (tid >> 5);
#pragma unroll
            for (int j = 0; j < 4; ++j) {
                const int t = tb + j; const size_t row = (size_t)(row0 + t);
                const float gr[4] = {bflo(grw[j].x), bfhi(grw[j].x), bflo(grw[j].y), bfhi(grw[j].y)};
                float y[4];
#pragma unroll
                for (int k = 0; k < 4; ++k) y[k] = (AB[(t) * 128 + c4 + k][1] + AB[(64 + t) * 128 + c4 + k][1]) * gelu_tanh(gr[k]);
                u32x2 o; o.x = pk_bf16(y[0], y[1]); o.y = pk_bf16(y[2], y[3]);
                *(u32x2*)(Y + row * DM + 1024 + 128 * n + c4) = o;
            }
            __syncthreads();
        }
    }
}

DI void lru_pass2(const Params& p, LAS unsigned char* lds, int G, int bid) {
    const int tid = threadIdx.x;
    const bf16_t* Z = (const bf16_t*)(p.ws + WS_Z);
    const unsigned* ABG = (const unsigned*)(p.ws + WS_ABG); const float* CARRY = (const float*)(p.ws + WS_CARRY);
    bf16_t* Y = (bf16_t*)(p.ws + WS_Y);
    LAS float* HB = (LAS float*)lds;
    const int NU = NCHUNK * NB * 8;
    const bool special = (G == 256);
    const bool ctxwg = special && bid >= 128 && bid < 160;
    const int ustart = !special ? bid : (ctxwg ? (NU - 32) + (bid - 128) : (bid < 128 ? bid : bid - 32));
    const int ustep = !special ? G : (ctxwg ? NU : 224), uend = !special ? NU : (ctxwg ? NU : NU - 32);
    for (int u = ustart; u < uend; u += ustep) {
        const int n = u & 7, bc = u >> 3, b = bc & 3, ci = bc >> 2;
        const int t0 = ci < 4 ? 64 * ci : 64 * (ci - 4);
        const int row0 = ci < 4 ? b * CTX + t0 : NCTX + b * SEQ + t0;
        const int c4 = (tid & 31) * 4, tb = 4 * (tid >> 5), cg = 128 * n + c4;
        u32x2 grw[4];
#pragma unroll
        for (int j = 0; j < 4; ++j) grw[j] = *(const u32x2*)(Z + (size_t)(row0 + tb + j) * L0INP + 1856 + cg);
        if (tid < 256) {
            const int sd = tid >> 7, sc = tid & 127;
            const unsigned* ab = ABG + ((((size_t)(b * NCHUNK + ci) * 8 + n) * 2 + sd) * 64) * 128 + sc;
            unsigned w[64];
#pragma unroll
            for (int t = 0; t < 64; ++t) w[t] = ab[t * 128];
            float hh = CARRY[((size_t)(sd * NB + b) * NCHUNK + ci) * 1024 + 128 * n + sc];
            if (sd == 0) {
#pragma unroll
                for (int t = 0; t < 64; ++t) { hh = fmaf(1.0f - bflo(w[t]), hh, bfhi(w[t])); HB[t * 128 + sc] = hh; }
            } else {
#pragma unroll
                for (int t = 63; t >= 0; --t) { hh = fmaf(1.0f - bflo(w[t]), hh, bfhi(w[t])); HB[(64 + t) * 128 + sc] = hh; }
            }
        }
        __syncthreads();
#pragma unroll
        for (int j = 0; j < 4; ++j) {
            const int t = tb + j; const size_t row = (size_t)(row0 + t);
            const float gr[4] = {bflo(grw[j].x), bfhi(grw[j].x), bflo(grw[j].y), bfhi(grw[j].y)};
            const f32x4 hf = *(const LAS f32x4*)(HB + t * 128 + c4), hb = *(const LAS f32x4*)(HB + (64 + t) * 128 + c4);
            float y[4];
#pragma unroll
            for (int k = 0; k < 4; ++k) y[k] = (hf[k] + hb[k]) * gelu_tanh(gr[k]);
            u32x2 o; o.x = pk_bf16(y[0], y[1]); o.y = pk_bf16(y[2], y[3]);
            *(u32x2*)(Y + row * DM + 1024 + 128 * n + c4) = o;
        }
        __syncthreads();
    }
}

DI void lru_carry(const Params& p, int G, int bid) {
    const f32x2* SUMM = (const f32x2*)(p.ws + WS_SUMM); float* CARRY = (float*)(p.ws + WS_CARRY);
    for (int gid = bid * NTHREADS + threadIdx.x; gid < 2 * NB * 1024; gid += G * NTHREADS) {
        const int d = gid >> 12, b = (gid >> 10) & 3, ch = gid & 1023;
        const size_t base = ((size_t)(d * NB + b) * NCHUNK) * 1024 + ch;
        f32x2 sm[NCHUNK];
#pragma unroll
        for (int pos = 0; pos < NCHUNK; ++pos) { const int ci = d == 0 ? pos : (pos < 4 ? 3 - pos : 39 - pos); sm[pos] = SUMM[base + (size_t)ci * 1024]; }
        float hh = 0.f;
#pragma unroll
        for (int pos = 0; pos < NCHUNK; ++pos) {
            const int ci = d == 0 ? pos : (pos < 4 ? 3 - pos : 39 - pos);
            CARRY[base + (size_t)ci * 1024] = hh;
            hh = sm[pos][0] * hh + sm[pos][1];
        }
    }
}
#define MFMA32(a, b, c) __builtin_amdgcn_mfma_f32_32x32x16_bf16((a), (b), (c), 0, 0, 0)
constexpr int AT_KSLOT = 24576, AT_VSLOT = 16384, AT_K0 = 0, AT_V0 = 2 * AT_KSLOT, AT_XOFF = AT_V0 + 2 * AT_VSLOT;

#ifndef AT_PIPE_MLA
#define AT_PIPE_MLA false
#endif
#ifndef AT_PIPE_WIN
#define AT_PIPE_WIN false
#endif
#ifndef AT_PIPE_NA
#define AT_PIPE_NA false
#endif
#ifndef AT_SKEW_MLA
#define AT_SKEW_MLA 0
#endif
#ifndef AT_SKEW_WIN
#define AT_SKEW_WIN 0
#endif
#ifndef AT_SKEW_NA
#define AT_SKEW_NA 0
#endif
constexpr float AT_M0 = -30.0f;
struct NoBias { DI float operator()(int, float nm) const { return nm; } };

struct AtRd { int kbase, kbase1, ko[4], vbase, vo[4]; };
template <int DQ> DI int at_kf(int r) { return DQ == 128 ? (r & 15) : ((r >> 1) & 7); }
template <int DQ>
DI AtRd at_rd_init(int lane) {
    AtRd r; const int kr = lane & 31, h = lane >> 5, i16 = lane & 15, q = i16 >> 2, pp = i16 & 3, blk = (lane >> 4) & 1;
    const int f = at_kf<DQ>(kr);
    r.kbase = kr * (DQ * 2) + ((f >> 3) << 7); r.kbase1 = kr * (DQ * 2) + (((f >> 3) ^ 1) << 7);
#pragma unroll
    for (int i = 0; i < 4; ++i) r.ko[i] = ((2 * i + h) ^ (f & 7)) << 4;
    r.vbase = (4 * h + q) * 256 + 8 * pp;
#pragma unroll
    for (int t = 0; t < 4; ++t) r.vo[t] = ((2 * t + blk) ^ ((4 * h + q) & 7)) << 5;
    return r;
}
template <int DQ>
DI void at_qk(const LAS unsigned char* ks, const AtRd& rd, const bf16x8 (&qf)[DQ / 16], f32x16& s0, f32x16& s1, const float init = 0.f) {
#pragma unroll
    for (int i = 0; i < 16; ++i) { s0[i] = init; s1[i] = init; }
    const LAS unsigned char* kp0 = ks + rd.kbase; const LAS unsigned char* kp1 = ks + rd.kbase1;
#pragma unroll
    for (int s = 0; s < DQ / 16; ++s) {
        const LAS unsigned char* kp = (DQ == 128) ? ((s >> 2) ? kp1 : kp0) : kp0 + ((s >> 2) << 7);
        const bf16x8 a0 = *(const LAS bf16x8*)(kp + rd.ko[s & 3]);
        const bf16x8 a1 = *(const LAS bf16x8*)(kp + 32 * (DQ * 2) + rd.ko[s & 3]);
        s0 = MFMA32(a0, qf[s], s0); s1 = MFMA32(a1, qf[s], s1);
    }
}
template <class BiasFn, bool PRE = false>
DI void at_sm(f32x16& s0, f32x16& s1, f32x16 (&o)[4], float& m, float& l, const float c2, const BiasFn& bias, const int lane, bf16x8 (&pf)[4]) {
    const int h = lane >> 5;
    const float nm = -m;
    int mi = (int)0x80000000;
#pragma unroll
    for (int i = 0; i < 16; ++i) {
        const int key = (i & 3) + 8 * (i >> 2) + 4 * h;
        if (!PRE) { s0[i] = fmaf(s0[i], c2, bias(key, nm)); s1[i] = fmaf(s1[i], c2, bias(32 + key, nm)); }
        mi = max(mi, max((int)__float_as_uint(s0[i]), (int)__float_as_uint(s1[i])));
    }
    { const auto sw = __builtin_amdgcn_permlane32_swap((unsigned)mi, (unsigned)mi, false, false); mi = max((int)sw[0], (int)sw[1]); }
    const float mx = __uint_as_float((unsigned)mi);
    if (__any(mx > 8.0f)) {
        const float d = fmaxf(mx, 0.f), alpha = __builtin_amdgcn_exp2f(-d);
        m += d; l *= alpha;
#pragma unroll
        for (int t = 0; t < 4; ++t)
#pragma unroll
            for (int i = 0; i < 16; ++i) o[t][i] *= alpha;
#pragma unroll
        for (int i = 0; i < 16; ++i) { s0[i] -= d; s1[i] -= d; }
    }
    float rs = 0.f;
#pragma unroll
    for (int i = 0; i < 16; ++i) { s0[i] = __builtin_amdgcn_exp2f(s0[i]); s1[i] = __builtin_amdgcn_exp2f(s1[i]); rs += s0[i] + s1[i]; }
    l += rs;
    u32x4 w;
    w.x = pk_bf16(s0[0], s0[1]); w.y = pk_bf16(s0[2], s0[3]); w.z = pk_bf16(s0[4], s0[5]); w.w = pk_bf16(s0[6], s0[7]); pf[0] = __builtin_bit_cast(bf16x8, w);
    w.x = pk_bf16(s0[8], s0[9]); w.y = pk_bf16(s0[10], s0[11]); w.z = pk_bf16(s0[12], s0[13]); w.w = pk_bf16(s0[14], s0[15]); pf[1] = __builtin_bit_cast(bf16x8, w);
    w.x = pk_bf16(s1[0], s1[1]); w.y = pk_bf16(s1[2], s1[3]); w.z = pk_bf16(s1[4], s1[5]); w.w = pk_bf16(s1[6], s1[7]); pf[2] = __builtin_bit_cast(bf16x8, w);
    w.x = pk_bf16(s1[8], s1[9]); w.y = pk_bf16(s1[10], s1[11]); w.z = pk_bf16(s1[12], s1[13]); w.w = pk_bf16(s1[14], s1[15]); pf[3] = __builtin_bit_cast(bf16x8, w);
}
DI void at_pv(const LAS unsigned char* vs, const AtRd& rd, const bf16x8 (&pf)[4], f32x16 (&o)[4]) {
    const LAS unsigned char* vb = vs + rd.vbase;
#pragma unroll
    for (int ks = 0; ks < 4; ++ks)
#pragma unroll
        for (int t = 0; t < 4; ++t) {
            const s16x4 lo = __builtin_amdgcn_ds_read_tr16_b64_v4i16((LAS s16x4*)(vb + (16 * ks) * 256 + rd.vo[t]));
            const s16x4 hi = __builtin_amdgcn_ds_read_tr16_b64_v4i16((LAS s16x4*)(vb + (16 * ks + 8) * 256 + rd.vo[t]));
            const bf16x8 vf = __builtin_shufflevector(lo, hi, 0, 1, 2, 3, 4, 5, 6, 7);
            o[t] = MFMA32(vf, pf[ks], o[t]);
        }
}
template <class BiasFn, bool PRE = false>
DI void at_sm_pv(const LAS unsigned char* vs, const AtRd& rd, f32x16& s0, f32x16& s1, f32x16 (&o)[4], float& m, float& l, const float c2, const BiasFn& bias, const int lane) {
    bf16x8 pf[4];
    at_sm<BiasFn, PRE>(s0, s1, o, m, l, c2, bias, lane, pf);
    at_pv(vs, rd, pf, o);
}
DI void at_qk1(const LAS unsigned char* ks, const AtRd& rd, const int off, const bf16x8 (&qf)[8], f32x16& s0) {
#pragma unroll
    for (int i = 0; i < 16; ++i) s0[i] = 0.f;
    const bool swp = (off & 8) != 0;
    const LAS unsigned char* kp0 = ks + off * 256 + (swp ? rd.kbase1 : rd.kbase); const LAS unsigned char* kp1 = ks + off * 256 + (swp ? rd.kbase : rd.kbase1);
#pragma unroll
    for (int s = 0; s < 8; ++s) {
        const LAS unsigned char* kp = (s >> 2) ? kp1 : kp0;
        const bf16x8 a0 = *(const LAS bf16x8*)(kp + rd.ko[s & 3]);
        s0 = MFMA32(a0, qf[s], s0);
    }
}
template <class BiasFn>
DI void at_sm1(f32x16& s0, f32x16 (&o)[4], float& m, float& l, const float c2, const BiasFn& bias, const int lane, const int koff, bf16x8 (&pf)[2]) {
    const int h = lane >> 5;
    const float nm = -m;
    float mx = -INFINITY;
#pragma unroll
    for (int i = 0; i < 16; ++i) {
        const int key = koff + (i & 3) + 8 * (i >> 2) + 4 * h;
        s0[i] = fmaf(s0[i], c2, bias(key, nm));
        mx = fmaxf(mx, s0[i]);
    }
    { const auto sw = __builtin_amdgcn_permlane32_swap(__float_as_uint(mx), __float_as_uint(mx), false, false); mx = fmaxf(__uint_as_float(sw[0]), __uint_as_float(sw[1])); }
    if (__any(mx > 8.0f)) {
        const float d = fmaxf(mx, 0.f), alpha = __builtin_amdgcn_exp2f(-d);
        m += d; l *= alpha;
#pragma unroll
        for (int t = 0; t < 4; ++t)
#pragma unroll
            for (int i = 0; i < 16; ++i) o[t][i] *= alpha;
#pragma unroll
        for (int i = 0; i < 16; ++i) s0[i] -= d;
    }
    float rs = 0.f;
#pragma unroll
    for (int i = 0; i < 16; ++i) { s0[i] = __builtin_amdgcn_exp2f(s0[i]); rs += s0[i]; }
    l += rs;
    u32x4 w;
    w.x = pk_bf16(s0[0], s0[1]); w.y = pk_bf16(s0[2], s0[3]); w.z = pk_bf16(s0[4], s0[5]); w.w = pk_bf16(s0[6], s0[7]); pf[0] = __builtin_bit_cast(bf16x8, w);
    w.x = pk_bf16(s0[8], s0[9]); w.y = pk_bf16(s0[10], s0[11]); w.z = pk_bf16(s0[12], s0[13]); w.w = pk_bf16(s0[14], s0[15]); pf[1] = __builtin_bit_cast(bf16x8, w);
}
DI void at_pv1(const LAS unsigned char* vs, const AtRd& rd, const int off, const bf16x8 (&pf)[2], f32x16 (&o)[4]) {
    const LAS unsigned char* vb = vs + rd.vbase + off * 256;
#pragma unroll
    for (int ks = 0; ks < 2; ++ks)
#pragma unroll
        for (int t = 0; t < 4; ++t) {
            const s16x4 lo = __builtin_amdgcn_ds_read_tr16_b64_v4i16((LAS s16x4*)(vb + (16 * ks) * 256 + rd.vo[t]));
            const s16x4 hi = __builtin_amdgcn_ds_read_tr16_b64_v4i16((LAS s16x4*)(vb + (16 * ks + 8) * 256 + rd.vo[t]));
            const bf16x8 vf = __builtin_shufflevector(lo, hi, 0, 1, 2, 3, 4, 5, 6, 7);
            o[t] = MFMA32(vf, pf[ks], o[t]);
        }
}
template <int DQ, class BiasFn>
DI void at_block1(const LAS unsigned char* ks, const LAS unsigned char* vs, const AtRd& rd, const int off_, const bf16x8 (&qf)[DQ / 16], f32x16 (&o)[4], float& m, float& l, const float c2, const BiasFn& bias, const int lane) {
    f32x16 a0; bf16x8 pf[2];
    int off = off_; asm volatile("" : "+s"(off));
    at_qk1(ks, rd, off, qf, a0);
    at_sm1(a0, o, m, l, c2, bias, lane, off, pf);
    at_pv1(vs, rd, off, pf, o);
}
template <int DQ, class Drv>
DI void at_tile(const LAS unsigned char* ks, const LAS unsigned char* vs, const Drv& D, const int j, const AtRd& rd, const bf16x8 (&qf)[DQ / 16], f32x16 (&o)[4], float& m, float& l, const float c2, const int lane) {
    if constexpr (Drv::HALF) {
        if (D.half(j)) at_block1<DQ>(ks, vs, rd, D.koff, qf, o, m, l, c2, D.bias(j), lane);
        else { at_block1<DQ>(ks, vs, rd, 0, qf, o, m, l, c2, NoBias(), lane); at_block1<DQ>(ks, vs, rd, 32, qf, o, m, l, c2, NoBias(), lane); }
    } else {
        f32x16 a0, a1;
        at_qk<DQ>(ks, rd, qf, a0, a1, Drv::PRE ? -m : 0.f);
        at_sm_pv<decltype(D.bias(j)), Drv::PRE>(vs, rd, a0, a1, o, m, l, c2, D.bias(j), lane);
    }
}

struct AtDma { unsigned ko[3], vo[2]; unsigned rope; };
template <int DQ>
DI AtDma at_dma_init(int ld_bytes, int wave, int lane) {
    AtDma d; d.rope = 0u;
    constexpr int PPR = DQ / 8;
#pragma unroll
    for (int k = 0; k < DQ / 64; ++k) { const int L = (wave + 8 * k) * 64 + lane, r = L / PPR, pc = (L % PPR) ^ at_kf<DQ>(r);
        if (DQ == 192 && pc >= 16) { d.ko[k] = (unsigned)(r * 128 + (pc - 16) * 16); d.rope |= 1u << k; } else d.ko[k] = (unsigned)(r * ld_bytes + pc * 16); }
    if (DQ == 128) d.ko[2] = 0u;
#pragma unroll
    for (int k = 0; k < 2; ++k) { const int L = (wave + 8 * k) * 64 + lane, r = L >> 4, pc = (L & 15) ^ (2 * (r & 7)); d.vo[k] = (unsigned)(r * ld_bytes + pc * 16); }
    return d;
}
template <int DQ>
DI void at_dma_k(LAS unsigned char* kslot, const char* kb, const char* rb, const AtDma& d, int wave) {
#pragma unroll
    for (int k = 0; k < DQ / 64; ++k) {
        const char* src = (DQ == 192 && ((d.rope >> k) & 1u)) ? rb + d.ko[k] : kb + d.ko[k];
        __builtin_amdgcn_global_load_lds((const unsigned*)src, (LAS unsigned*)(kslot + (wave + 8 * k) * 1024), 16, 0, 0);
    }
}
DI void at_dma_v(LAS unsigned char* vslot, const char* vb, const AtDma& d, int wave) {
#pragma unroll
    for (int k = 0; k < 2; ++k) __builtin_amdgcn_global_load_lds((const unsigned*)(vb + d.vo[k]), (LAS unsigned*)(vslot + (wave + 8 * k) * 1024), 16, 0, 0);
}
#define AT_DRAIN_SYNC() do { asm volatile("s_waitcnt vmcnt(0)" ::: "memory"); __syncthreads(); } while (0)

template <int DQ, bool PIPE, class Drv>
DI void at_run(LAS unsigned char* lds, const Drv& D, const int n, const AtRd& rd, const AtDma& dm, const bf16x8 (&qf)[DQ / 16], f32x16 (&o)[4], float& m, float& l, const float c2, const int lane, const int wave) {
    f32x16 a0, a1;
    __syncthreads();
    at_dma_k<DQ>(lds + AT_K0, D.kb(0), D.rb(0), dm, wave); at_dma_v(lds + AT_V0, D.vb(0), dm, wave);
    if constexpr (PIPE) {
        f32x16 b0, b1;
        if (n > 1) at_dma_k<DQ>(lds + AT_K0 + AT_KSLOT, D.kb(1), D.rb(1), dm, wave);
        AT_DRAIN_SYNC();
        if (D.act(0)) at_qk<DQ>(lds + AT_K0, rd, qf, a0, a1);
#define AT_STEP(J, PAR, C0, C1, N0, N1) do { const int j_ = (J); \
        if (j_ + 2 < n) at_dma_k<DQ>(lds + AT_K0 + (PAR) * AT_KSLOT, D.kb(j_ + 2), D.rb(j_ + 2), dm, wave); \
        if (j_ + 1 < n) at_dma_v(lds + AT_V0 + (1 - (PAR)) * AT_VSLOT, D.vb(j_ + 1), dm, wave); \
        if (j_ + 1 < n && D.act(j_ + 1)) at_qk<DQ>(lds + AT_K0 + (1 - (PAR)) * AT_KSLOT, rd, qf, N0, N1); \
        if (D.act(j_)) at_sm_pv(lds + AT_V0 + (PAR) * AT_VSLOT, rd, C0, C1, o, m, l, c2, D.bias(j_), lane); \
        AT_DRAIN_SYNC(); } while (0)
        for (int j = 0; j < n; j += 2) {
            AT_STEP(j, 0, a0, a1, b0, b1);
            if (j + 1 < n) AT_STEP(j + 1, 1, b0, b1, a0, a1);
        }
#undef AT_STEP
    } else {
        AT_DRAIN_SYNC();
        for (int j = 0; j < n; ++j) {
            const int par = j & 1;
            if (j + 1 < n) { at_dma_k<DQ>(lds + AT_K0 + (1 - par) * AT_KSLOT, D.kb(j + 1), D.rb(j + 1), dm, wave); at_dma_v(lds + AT_V0 + (1 - par) * AT_VSLOT, D.vb(j + 1), dm, wave); }
            if (D.act(j)) at_tile<DQ>(lds + AT_K0 + par * AT_KSLOT, lds + AT_V0 + par * AT_VSLOT, D, j, rd, qf, o, m, l, c2, lane);
            AT_DRAIN_SYNC();
        }
    }
}

constexpr int AT3_V0 = 2 * AT_KSLOT, AT3_XOFF = AT3_V0 + 3 * AT_VSLOT;
template <int DQ, class Drv>
DI void at_run_skew(LAS unsigned char* lds, const Drv& D, const int n, const AtRd& rd, const AtDma& dm, const bf16x8 (&qf)[DQ / 16], f32x16 (&o)[4], float& m, float& l, const float c2, const int lane, const int wave) {
    const bool late = wave >= 4;
    bf16x8 pf[4];
    __syncthreads();
    at_dma_k<DQ>(lds + AT_K0, D.kb(0), D.rb(0), dm, wave); at_dma_v(lds + AT3_V0, D.vb(0), dm, wave);
    AT_DRAIN_SYNC();
    int vcur = 0;
    for (int j = 0; j < n; ++j) {
        const int vnext = vcur == 2 ? 0 : vcur + 1, vprev = vcur == 0 ? 2 : vcur - 1;
        if (j + 1 < n) { at_dma_k<DQ>(lds + AT_K0 + ((j + 1) & 1) * AT_KSLOT, D.kb(j + 1), D.rb(j + 1), dm, wave); at_dma_v(lds + AT3_V0 + vnext * AT_VSLOT, D.vb(j + 1), dm, wave); }
        if (late && j > 0 && D.act(j - 1)) at_pv(lds + AT3_V0 + vprev * AT_VSLOT, rd, pf, o);
        if (D.act(j)) {
            f32x16 a0, a1;
            at_qk<DQ>(lds + AT_K0 + (j & 1) * AT_KSLOT, rd, qf, a0, a1);
            at_sm(a0, a1, o, m, l, c2, D.bias(j), lane, pf);
            if (!late) at_pv(lds + AT3_V0 + vcur * AT_VSLOT, rd, pf, o);
        }
        AT_DRAIN_SYNC();
        vcur = vnext;
    }
    if (late && D.act(n - 1)) at_pv(lds + AT3_V0 + (vcur == 0 ? 2 : vcur - 1) * AT_VSLOT, rd, pf, o);
}

constexpr int AT4_SLOT = AT_KSLOT + AT_VSLOT, AT4_XOFF = 3 * AT4_SLOT;
template <int DQ, class Drv>
DI void at_run3(LAS unsigned char* lds, const Drv& D, const int n, const AtRd& rd, const AtDma& dm, const bf16x8 (&qf)[DQ / 16], f32x16 (&o)[4], float& m, float& l, const float c2, const int lane, const int wave) {
    __syncthreads();
    at_dma_k<DQ>(lds, D.kb(0), D.rb(0), dm, wave); at_dma_v(lds + AT_KSLOT, D.vb(0), dm, wave);
    if (n > 1) { at_dma_k<DQ>(lds + AT4_SLOT, D.kb(1), D.rb(1), dm, wave); at_dma_v(lds + AT4_SLOT + AT_KSLOT, D.vb(1), dm, wave);
        if (DQ == 192) asm volatile("s_waitcnt vmcnt(5)" ::: "memory"); else asm volatile("s_waitcnt vmcnt(4)" ::: "memory"); }
    else asm volatile("s_waitcnt vmcnt(0)" ::: "memory");
    __syncthreads();
    int cur = 0;
    for (int j = 0; j < n; ++j) {
        const int nx2 = cur == 0 ? 2 : cur - 1;
        if (j + 2 < n) { at_dma_k<DQ>(lds + nx2 * AT4_SLOT, D.kb(j + 2), D.rb(j + 2), dm, wave); at_dma_v(lds + nx2 * AT4_SLOT + AT_KSLOT, D.vb(j + 2), dm, wave); }
        if (D.act(j)) {
            f32x16 a0, a1;
            at_qk<DQ>(lds + cur * AT4_SLOT, rd, qf, a0, a1);
            at_sm_pv(lds + cur * AT4_SLOT + AT_KSLOT, rd, a0, a1, o, m, l, c2, D.bias(j), lane);
        }
        if (j + 2 < n) { if (DQ == 192) asm volatile("s_waitcnt vmcnt(5)" ::: "memory"); else asm volatile("s_waitcnt vmcnt(4)" ::: "memory"); }
        else asm volatile("s_waitcnt vmcnt(0)" ::: "memory");
        __syncthreads();
        cur = cur == 2 ? 0 : cur + 1;
    }
}

DI unsigned at_swap_lo(unsigned a, unsigned b, unsigned& bo) { const auto r = __builtin_amdgcn_permlane32_swap(a, b, false, false); bo = r[1]; return r[0]; }
DI void attn_store(const f32x16 (&o)[4], float l, float extra, bf16_t* orow, int lane) {
    const int h = lane >> 5;
    const float lt = l + __shfl_xor(l, 32) + extra;
    const float inv = 1.0f / lt;
#pragma unroll
    for (int t = 0; t < 4; ++t)
#pragma unroll
        for (int pr = 0; pr < 2; ++pr) {
            const int ga = 8 * pr, gb = 8 * pr + 4;
            unsigned ax = pk_bf16(o[t][ga] * inv, o[t][ga + 1] * inv), ay = pk_bf16(o[t][ga + 2] * inv, o[t][ga + 3] * inv);
            unsigned bx = pk_bf16(o[t][gb] * inv, o[t][gb + 1] * inv), by = pk_bf16(o[t][gb + 2] * inv, o[t][gb + 3] * inv);
            u32x4 w; unsigned t0, t1;
            w.x = at_swap_lo(ax, bx, t0); w.y = at_swap_lo(ay, by, t1); w.z = t0; w.w = t1;
            *(u32x4*)(orow + 32 * t + 8 * (2 * pr + h)) = w;
        }
}

DI void attn_store8(const f32x16 (&o)[4], float l, float extra, unsigned char* orow8, int lane) {
    const int h = lane >> 5;
    const float lt = l + __shfl_xor(l, 32) + extra;
    const float inv = 1.0f / lt;
#pragma unroll
    for (int t = 0; t < 4; ++t)
#pragma unroll
        for (int pr = 0; pr < 2; ++pr) {
            const int ga = 8 * pr, gb = 8 * pr + 4;
            const unsigned a = pk_fp8x4(o[t][ga] * inv, o[t][ga + 1] * inv, o[t][ga + 2] * inv, o[t][ga + 3] * inv);
            const unsigned b2 = pk_fp8x4(o[t][gb] * inv, o[t][gb + 1] * inv, o[t][gb + 2] * inv, o[t][gb + 3] * inv);
            u32x2 w; unsigned t0;
            w.x = at_swap_lo(a, b2, t0); w.y = t0;
            *(u32x2*)(orow8 + 32 * t + 8 * (2 * pr + h)) = w;
        }
}

struct MlaDrv {
    static constexpr bool HALF = false, PRE = true;
    const char* KV; const char* KR; int b, head;
    DI int keyrow0(int j) const { return j < 4 ? b * CTX + 64 * j : NCTX + b * SEQ + 64 * (j - 4); }
    DI const char* kb(int j) const { return KV + (size_t)keyrow0(j) * 4096 + head * 512; }
    DI const char* vb(int j) const { return KV + (size_t)keyrow0(j) * 4096 + head * 512 + 256; }
    DI const char* rb(int j) const { return KR + (size_t)keyrow0(j) * 128; }
    DI bool act(int) const { return true; }
    DI NoBias bias(int) const { return NoBias(); }
};

DI void phase_attn0(const Params& p, LAS unsigned char* lds, int G, int bid) {
    const int tid = threadIdx.x, lane = tid & 63, wave = __builtin_amdgcn_readfirstlane(tid >> 6), h = lane >> 5;
    const bf16_t* Q0 = (const bf16_t*)(p.ws + WS_Q0);
    bf16_t* Y = (bf16_t*)(p.ws + WS_Y);
    const float c2 = 0.07216878364870322f * LOG2E;
    const AtRd rd = at_rd_init<192>(lane);
    const AtDma dm = at_dma_init<192>(4096, wave, lane);
    for (int it = 0; it < 2; ++it)
    for (int u = it == 0 ? bid : 256 + (bid + G - G / 2) % G; u < (it == 0 ? 256 : 256 + 32); u += G) {
        MlaDrv T; T.KV = (const char*)(p.ws + WS_KV0); T.KR = (const char*)(p.ws + WS_KR);
        int qrow, nt;
        if (u < 256) { T.b = u >> 6; T.head = (u >> 3) & 7; nt = 36; qrow = NCTX + T.b * SEQ + (u & 7) * 256 + wave * 32 + (lane & 31); }
        else { const int v = u - 256; T.b = v >> 3; T.head = v & 7; nt = 4; qrow = T.b * CTX + wave * 32 + (lane & 31); }
        bf16x8 qf[12];
#pragma unroll
        for (int s = 0; s < 12; ++s) qf[s] = *(const bf16x8*)(Q0 + (size_t)qrow * 1536 + T.head * 192 + 16 * s + 8 * h);
        f32x16 o[4];
#pragma unroll
        for (int t = 0; t < 4; ++t)
#pragma unroll
            for (int i = 0; i < 16; ++i) o[t][i] = 0.f;
        float m = AT_M0, l = 0.f;
        if (AT_SKEW_MLA == 2) at_run3<192>(lds, T, nt, rd, dm, qf, o, m, l, c2, lane, wave); else if (AT_SKEW_MLA) at_run_skew<192>(lds, T, nt, rd, dm, qf, o, m, l, c2, lane, wave); else at_run<192, AT_PIPE_MLA>(lds, T, nt, rd, dm, qf, o, m, l, c2, lane, wave);
        attn_store(o, l, 0.f, Y + (size_t)qrow * DM + T.head * 128, lane);
    }
}

struct WinBias { int base; DI float operator()(int key, float nm) const { return ((unsigned)(base - key) <= 256u) ? nm : -1e30f; } };
struct WinDrv {
    static constexpr bool HALF = false, PRE = false;
    const char* Z; int b, kvh, k0base, jlo, qpos;
    DI int tid_(int q) const { return q < 4 ? q : jlo + q - 4; }
    DI int keyrow0(int q) const { const int j = tid_(q); return j < 4 ? b * CTX + 64 * j : NCTX + b * SEQ + k0base + 64 * (j - 4); }
    DI const char* kb(int q) const { return Z + (size_t)keyrow0(q) * (L1IN * 2) + (1024 + kvh * 128) * 2; }
    DI const char* vb(int q) const { return Z + (size_t)keyrow0(q) * (L1IN * 2) + (1280 + kvh * 128) * 2; }
    DI const char* rb(int) const { return nullptr; }
    DI bool act(int) const { return true; }
    DI WinBias bias(int q) const { const int j = tid_(q); WinBias B; B.base = j < 4 ? 100 : qpos - (k0base + 64 * (j - 4)) + 128; return B; }
};

DI void phase_attn_win(const Params& p, LAS unsigned char* lds, int G, int bid) {
    const int tid = threadIdx.x, lane = tid & 63, wave = __builtin_amdgcn_readfirstlane(tid >> 6), h = lane >> 5;
    const bf16_t* Z = (const bf16_t*)(p.ws + WS_Z);
    bf16_t* Y = (bf16_t*)(p.ws + WS_Y);
    const float c2 = 0.08838834764831845f * LOG2E;
    const AtRd rd = at_rd_init<128>(lane);
    const AtDma dm = at_dma_init<128>(L1IN * 2, wave, lane);
    for (int u = bid; u < 256; u += G) {
        WinDrv T; T.Z = (const char*)Z; T.b = u >> 6; T.kvh = (u >> 5) & 1; const int blk = u & 31; T.k0base = 64 * blk - 128;
        const int head = T.kvh * 4 + (wave >> 1), qpos = 64 * blk + 32 * (wave & 1) + (lane & 31), qrow = NCTX + T.b * SEQ + qpos;
        T.qpos = qpos;
        bf16x8 qf[8];
#pragma unroll
        for (int s = 0; s < 8; ++s) qf[s] = *(const bf16x8*)(Z + (size_t)qrow * L1IN + head * 128 + 16 * s + 8 * h);
        f32x16 o[4];
#pragma unroll
        for (int t = 0; t < 4; ++t)
#pragma unroll
            for (int i = 0; i < 16; ++i) o[t][i] = 0.f;
        float m = AT_M0, l = 0.f;
        T.jlo = (T.k0base < 0) ? 4 + ((-T.k0base) >> 6) : 4;
        const int jhi = (T.k0base + 320 > SEQ) ? 9 - ((T.k0base + 320 - SEQ) >> 6) : 9;
        if (AT_SKEW_WIN == 2) at_run3<128>(lds, T, 4 + (jhi - T.jlo), rd, dm, qf, o, m, l, c2, lane, wave); else if (AT_SKEW_WIN) at_run_skew<128>(lds, T, 4 + (jhi - T.jlo), rd, dm, qf, o, m, l, c2, lane, wave); else at_run<128, AT_PIPE_WIN>(lds, T, 4 + (jhi - T.jlo), rd, dm, qf, o, m, l, c2, lane, wave);
        const float sink = p.in[32][head];
        if (FP8_OUT1) attn_store8(o, l, __builtin_amdgcn_exp2f(sink * LOG2E - m), (unsigned char*)Y + (size_t)qrow * DM + head * 128, lane);
        else attn_store(o, l, __builtin_amdgcn_exp2f(sink * LOG2E - m), Y + (size_t)qrow * DM + head * 128, lane);
    }
}

struct NaBias { const LAS float* rp; int lo, hi; float sc; DI float operator()(int key, float nm) const { const float v = fmaf(rp[key], sc, nm); return (key >= lo && key < hi) ? v : -1e30f; } };
struct NaDrv {
    static constexpr bool HALF = true, PRE = false;
    const char* Z; const LAS float* RPB; int b, head, rlo, r, c, r0, c0, koff, wr0, wr1;
    DI int keyrow0(int j) const { return j < 4 ? b * CTX + 64 * j : NCTX + b * SEQ + 64 * (rlo + j - 4); }
    DI const char* kb(int j) const { return Z + (size_t)keyrow0(j) * (L1IN * 2) + (2560 + head * 128) * 2; }
    DI const char* vb(int j) const { return Z + (size_t)keyrow0(j) * (L1IN * 2) + (3584 + head * 128) * 2; }
    DI const char* rb(int) const { return nullptr; }
    DI bool half(int j) const { return j >= 4; }
    DI bool act(int j) const { const int rr = rlo + j - 4; return j < 4 || (rr >= wr0 && rr <= wr1); }
    DI NaBias bias(int j) const {
        const int rr = rlo + j - 4; NaBias B; B.rp = RPB + (rr - r + 7) * 31 + (15 - c);
        const bool rowok = rr >= r0 && rr <= r0 + 7;
        B.lo = c0; B.hi = rowok ? c0 + 16 : c0; B.sc = LOG2E; return B; }
};

DI void phase_attn_na(const Params& p, LAS unsigned char* lds, int G, int bid) {
    const int tid = threadIdx.x, lane = tid & 63, wave = __builtin_amdgcn_readfirstlane(tid >> 6), h = lane >> 5;
    const bf16_t* Z = (const bf16_t*)(p.ws + WS_Z);
    bf16_t* Y = (bf16_t*)(p.ws + WS_Y);
    LAS float* RPB = (LAS float*)(lds + AT4_XOFF);
    const float c2 = 0.08838834764831845f * LOG2E;
    const AtRd rd = at_rd_init<128>(lane);
    const AtDma dm = at_dma_init<128>(L1IN * 2, wave, lane);
    for (int u = bid; u < 256; u += G) {
        NaDrv T; T.Z = (const char*)Z; T.RPB = RPB; T.b = u >> 6; T.head = (u >> 3) & 7; const int R = u & 7;
        const int ra = 4 * R + 2 * (wave >> 2), ca = wave & 3;
        T.r = ra + ((lane >> 4) & 1); T.c = 16 * ca + (lane & 15); const int qrow = NCTX + T.b * SEQ + 64 * T.r + T.c;
        T.r0 = min(max(T.r - 4, 0), 24); T.c0 = min(max(T.c - 8, 0), 48);
        T.koff = ca == 0 ? 0 : (ca == 1 ? 8 : (ca == 2 ? 24 : 32));
        T.wr0 = min(max(ra - 4, 0), 24); T.wr1 = min(max(ra + 1 - 4, 0), 24) + 7;
        T.rlo = min(max(4 * R - 4, 0), 24);
        const int rhi = min(max(4 * R + 3 - 4, 0), 24) + 7;
        const int ntl = 4 + (rhi - T.rlo + 1);
        __syncthreads();
        for (int i = tid; i < 15 * 31; i += NTHREADS) RPB[i] = p.in[33][T.head * 465 + i];
        bf16x8 qf[8];
#pragma unroll
        for (int s = 0; s < 8; ++s) qf[s] = *(const bf16x8*)(Z + (size_t)qrow * L1IN + 1536 + T.head * 128 + 16 * s + 8 * h);
        f32x16 o[4];
#pragma unroll
        for (int t = 0; t < 4; ++t)
#pragma unroll
            for (int i = 0; i < 16; ++i) o[t][i] = 0.f;
        float m = AT_M0, l = 0.f;
        if (AT_SKEW_NA == 2) at_run3<128>(lds, T, ntl, rd, dm, qf, o, m, l, c2, lane, wave); else if (AT_SKEW_NA) at_run_skew<128>(lds, T, ntl, rd, dm, qf, o, m, l, c2, lane, wave); else at_run<128, AT_PIPE_NA>(lds, T, ntl, rd, dm, qf, o, m, l, c2, lane, wave);
        if (FP8_OUT1) attn_store8(o, l, 0.f, (unsigned char*)Y + (size_t)qrow * DM + 1024 + T.head * 128, lane);
        else attn_store(o, l, 0.f, Y + (size_t)qrow * DM + 1024 + T.head * 128, lane);
    }
}
constexpr int RT_HS = 2052;
typedef float f32x4r __attribute__((ext_vector_type(4)));
DI void phase_router(const Params& p, LAS unsigned char* lds, int G, int bid, const int layer, const float* xin_ctx, const float* xin_lat, const int row_lo, const int row_hi) {
    const int tid = threadIdx.x, lane = tid & 63, wave = tid >> 6;
    const float* MOD = (const float*)(p.ws + WS_MOD) + (size_t)layer * 5 * MODN;
    const float* gain = layer ? p.in[30] : p.in[10];
    const float* rw = p.in[4]; const float* rb = p.in[5];
    bf16_t* H = (bf16_t*)(p.ws + WS_H);
    int* cnt = (int*)(p.ws + WS_CTL + CW_CNT) + layer * NEXP;
    int* LIST = (int*)(p.ws + WS_LIST); TokInfo* TOK = (TokInfo*)(p.ws + WS_TOK);
    LAS float* hs = (LAS float*)lds;
    LAS float* sc = (LAS float*)(lds + 16 * RT_HS * 4);
    const int nb = (row_hi - row_lo) / 16;
    float wb0[64], wb1[64];
    {
        const float* bp = rw + (size_t)(256 * wave + 64 * (lane >> 4)) * 32 + (lane & 15);
#pragma unroll
        for (int s2 = 0; s2 < 64; ++s2) { wb0[s2] = bp[s2 * 32]; wb1[s2] = bp[s2 * 32 + 16]; }
    }
    int lb = 0;
    for (int bt = bid; bt < nb; bt += G, ++lb) {
        __syncthreads();
#pragma unroll 1
        for (int rr = 0; rr < 2; ++rr) {
            const int lr = 2 * wave + rr, row = row_lo + bt * 16 + lr;
            const float* xr = row < NCTX ? xin_ctx + (size_t)row * DM : xin_lat + (size_t)(row - NCTX) * DM;
            const bf16_t* dr = (const bf16_t*)(p.ws + WS_D) + (size_t)row * DM;
            const float* md = MOD + (size_t)row_mod(row) * MODN;
            f32x4 v[8]; float ss = 0.f;
#pragma unroll
            for (int i = 0; i < 8; ++i) {
                const int col = 4 * lane + 256 * i;
                const u32x2 dw = *(const u32x2*)(dr + col);
                v[i] = *(const f32x4*)(xr + col) + *(const f32x4*)(md + 2 * DM + col) * (f32x4){bflo(dw.x), bfhi(dw.x), bflo(dw.y), bfhi(dw.y)};
                ss += v[i][0] * v[i][0] + v[i][1] * v[i][1] + v[i][2] * v[i][2] + v[i][3] * v[i][3];
            }
            ss = wave_sum(ss);
            const float r = rsqrtf(ss * (1.0f / DM) + EPS);
#pragma unroll
            for (int i = 0; i < 8; ++i) {
                const int col = 4 * lane + 256 * i;
                const f32x4 g = *(const f32x4*)(gain + col), sh = *(const f32x4*)(md + 3 * DM + col), scl = *(const f32x4*)(md + 4 * DM + col);
                const f32x4 hv = (v[i] * r * g) * (1.0f + scl) + sh;
                if (layer == 0 && !FP8_L0) { u32x2 w; w.x = pk_bf16(hv[0], hv[1]); w.y = pk_bf16(hv[2], hv[3]); *(u32x2*)(H + (size_t)row * DM + col) = w; }
                else *(unsigned*)(p.ws + WS_H8 + (size_t)row * DM + col) = pk_fp8x4(hv[0], hv[1], hv[2], hv[3]);
                *(LAS f32x4*)(hs + lr * RT_HS + col) = hv;
            }
        }
        __syncthreads();
        f32x4r c0 = {0.f, 0.f, 0.f, 0.f}, c1 = {0.f, 0.f, 0.f, 0.f};
        {
            const int ar = lane & 15, kq = lane >> 4;
            const LAS float* ap = hs + ar * RT_HS + 256 * wave + 64 * kq;
            if (!(p.flags & 8)) {
                f32x4 av[2][4];
#pragma unroll
                for (int i = 0; i < 4; ++i) av[0][i] = *(const LAS f32x4*)(ap + 4 * i);
#pragma unroll
                for (int g = 0; g < 4; ++g) {
                    if (g + 1 < 4) {
#pragma unroll
                        for (int i = 0; i < 4; ++i) av[(g + 1) & 1][i] = *(const LAS f32x4*)(ap + 16 * (g + 1) + 4 * i);
                    }
                    __builtin_amdgcn_sched_barrier(0);
#pragma unroll
                    for (int i = 0; i < 4; ++i)
#pragma unroll
                        for (int j = 0; j < 4; ++j) {
                            const float a = av[g & 1][i][j]; const int s2 = 16 * g + 4 * i + j;
                            c0 = __builtin_amdgcn_mfma_f32_16x16x4f32(a, wb0[s2], c0, 0, 0, 0);
                            c1 = __builtin_amdgcn_mfma_f32_16x16x4f32(a, wb1[s2], c1, 0, 0, 0);
                        }
                    __builtin_amdgcn_sched_barrier(0);
                }
            }
        }
        __syncthreads();
        {
            LAS float* part = hs;
            const int e = lane & 15, r4 = 4 * (lane >> 4);
#pragma unroll
            for (int j = 0; j < 4; ++j) { part[(wave * 16 + r4 + j) * 32 + e] = c0[j]; part[(wave * 16 + r4 + j) * 32 + 16 + e] = c1[j]; }
        }
        __syncthreads();
        {
            const int r = tid >> 5, e = tid & 31; float a = 0.f;
#pragma unroll
            for (int w2 = 0; w2 < 8; ++w2) a += hs[(w2 * 16 + r) * 32 + e];
            sc[(lb * 16 + r) * 32 + e] = 1.0f / (1.0f + expf(-a));
        }
    }
    __syncthreads();
    {
        LAS int* lcnt = (LAS int*)(lds + LDS_MISC + 1024);
        if (tid < 64) lcnt[tid] = 0;
        __syncthreads();
        int e0 = 0, e1 = 0, li0 = 0, li1 = 0, trow = 0; float w0 = 0.f, w1 = 0.f;
        const bool has = tid < lb * 16;
        if (has) {
            const LAS float* s = sc + tid * 32;
            int bg = 0; float bgs = -INFINITY;
#pragma unroll
            for (int g = 0; g < 8; ++g) {
                const float v0 = s[4 * g] + rb[4 * g], v1 = s[4 * g + 1] + rb[4 * g + 1], v2 = s[4 * g + 2] + rb[4 * g + 2], v3 = s[4 * g + 3] + rb[4 * g + 3];
                const float hi01 = fmaxf(v0, v1), lo01 = fminf(v0, v1), hi23 = fmaxf(v2, v3), lo23 = fminf(v2, v3);
                const float m1 = fmaxf(hi01, hi23), m2 = fmaxf(fminf(hi01, hi23), fmaxf(lo01, lo23));
                const float gs = m1 + m2;
                if (gs > bgs) { bgs = gs; bg = g; }
            }
            float bv[4];
#pragma unroll
            for (int j = 0; j < 4; ++j) bv[j] = s[4 * bg + j] + rb[4 * bg + j];
            int i0 = 0; float b0 = bv[0];
#pragma unroll
            for (int j = 1; j < 4; ++j) if (bv[j] > b0) { b0 = bv[j]; i0 = j; }
            int i1 = -1; float b1 = -INFINITY;
#pragma unroll
            for (int j = 0; j < 4; ++j) if (j != i0 && bv[j] > b1) { b1 = bv[j]; i1 = j; }
            e0 = 4 * bg + i0; e1 = 4 * bg + i1;
            const float s0 = s[e0], s1 = s[e1], ws = s0 + s1; w0 = s0 / ws; w1 = s1 / ws;
            trow = row_lo + (bid + (tid >> 4) * G) * 16 + (tid & 15);
            li0 = atomicAdd((int*)(lcnt + e0), 1); li1 = atomicAdd((int*)(lcnt + e1), 1);
        }
        __syncthreads();
        if (tid < 32) { const int c = lcnt[tid]; lcnt[32 + tid] = c > 0 ? atomicAdd(cnt + tid, c) : 0; }
        __syncthreads();
        if (has) {
            const int p0 = lcnt[32 + e0] + li0, p1 = lcnt[32 + e1] + li1;
            LIST[(size_t)e0 * MOE_CAP + p0] = trow; LIST[(size_t)e1 * MOE_CAP + p1] = trow;
            TokInfo ti; ti.e0 = e0; ti.p0 = p0; ti.e1 = e1; ti.p1 = p1; ti.w0 = w0; ti.w1 = w1; ti.pad0 = 0; ti.pad1 = 0;
            TOK[trow] = ti;
        }
    }
}

DI void moe_tables(const Params& p, LAS int* MT, int layer) {
    const int tid = threadIdx.x;
    __syncthreads();
    if (tid < 64) {
        const int e = tid & 31;
        const int c = ((const int*)(p.ws + WS_CTL + CW_CNT))[layer * NEXP + e];
        const int t = (c + 255) >> 8;
        int incl = t;
#pragma unroll
        for (int off = 1; off < 32; off <<= 1) { const int y = __shfl_up(incl, off, 32); if (e >= off) incl += y; }
        const int tp = incl - t;
        if (tid < 32) {
            MT[128 + e] = c; MT[e] = tp * 256; MT[64 + e] = tp;
            for (int k = 0; k < t; ++k) MT[192 + tp + k] = e;
            if (e == 31) { MT[32] = incl * 256; MT[64 + 32] = incl; }
        }
    }
    __syncthreads();
}

template <bool FP8_, int WS_ = 127>
struct MoeSchedUpT {
    static constexpr bool GATHER = true, FP8 = FP8_, GATHER_OR_PAD = true;
    static constexpr int WSCALE = WS_;
    const char* Hb; const char* EG; const int* LIST; const LAS int* MT; int K; size_t lda, ldb, a_h, b_h; int G, c; size_t estride; int wscale;
    DI bool next(int i, pg8::GU& u) const {
        const int L = i * G + c, T = MT[64 + 32]; if (L >= T * 4) return false;
        const int rt = L >> 2, ct = L & 3; const int e = MT[192 + rt];
        const int lt = rt - MT[64 + e];
        u.e = e; u.pm = lt; u.pn = ct; u.aux = MT[e] + 256 * lt; u.h1 = (MT[128 + e] - 256 * lt) <= 128; u.a = Hb; u.b = EG + (size_t)e * estride + (size_t)ct * 128 * ldb; return true;
    }
    DI unsigned rowoff(const pg8::GU& u, int r) const { const int gr = 256 * u.pm + r; const int tok = gr < MT[128 + u.e] ? LIST[(size_t)u.e * MOE_CAP + gr] : NTOK; return (unsigned)tok * (unsigned)lda; }
};
typedef MoeSchedUpT<false> MoeSchedUp;
template <bool FP8_, int WS_ = 127>
struct MoeSchedDownT {
    static constexpr bool GATHER = false, FP8 = FP8_, GATHER_OR_PAD = true;
    static constexpr int WSCALE = WS_;
    const char* ACT; const char* ED; const LAS int* MT; int K; size_t lda, ldb, a_h, b_h; int G, c; size_t estride; int wscale;
    DI bool next(int i, pg8::GU& u) const {
        const int L = i * G + c, T = MT[64 + 32]; if (L >= T * 8) return false;
        const int rt = L >> 3, ct = L & 7; const int e = MT[192 + rt];
        const int lt = rt - MT[64 + e];
        u.e = e; u.pm = lt; u.pn = ct; u.aux = MT[e] + 256 * lt; u.h1 = (MT[128 + e] - 256 * lt) <= 128; u.a = ACT + (size_t)u.aux * lda; u.b = ED + (size_t)e * estride + (size_t)ct * 256 * ldb; return true;
    }
    DI unsigned rowoff(const pg8::GU&, int) const { return 0u; }
};
typedef MoeSchedDownT<false> MoeSchedDown;
struct EpiSwiGLU {
    static constexpr bool PERM = true;
    bf16_t* ACT;
    DI void operator()(const f32x4 (&acc)[2][2][4][2], const pg8::GU& u, int wr, int wc, int fr, int fq) const {
        const int row0 = u.aux + wr * 64 + fr, col0 = u.pn * 128 + wc * 32 + 8 * fq;
#pragma unroll
        for (int ai = 0; ai < 2; ++ai)
#pragma unroll
            for (int m = 0; m < 4; ++m) {
                float a[8];
#pragma unroll
                for (int n = 0; n < 2; ++n)
#pragma unroll
                    for (int j = 0; j < 4; ++j) { const float g = acc[ai][0][m][n][j], up = acc[ai][1][m][n][j]; a[4 * n + j] = g / (1.0f + __expf(-g)) * up; }
                u32x4 w; w.x = pk_bf16(a[0], a[1]); w.y = pk_bf16(a[2], a[3]); w.z = pk_bf16(a[4], a[5]); w.w = pk_bf16(a[6], a[7]);
                *(u32x4*)(ACT + (size_t)(row0 + ai * 128 + m * 16) * EFF + col0) = w;
            }
    }
};
struct EpiSwiGLU8 {
    static constexpr bool PERM = true;
    unsigned char* ACT;
    DI void operator()(const f32x4 (&acc)[2][2][4][2], const pg8::GU& u, int wr, int wc, int fr, int fq) const {
        const int row0 = u.aux + wr * 64 + fr, col0 = u.pn * 128 + wc * 32 + 8 * fq;
#pragma unroll
        for (int ai = 0; ai < 2; ++ai) {
            if (ai == 1 && u.h1 != 0) break;
#pragma unroll
            for (int m = 0; m < 4; ++m) {
                float a[8];
#pragma unroll
                for (int n = 0; n < 2; ++n)
#pragma unroll
                    for (int j = 0; j < 4; ++j) { const float g = acc[ai][0][m][n][j], up = acc[ai][1][m][n][j]; a[4 * n + j] = g / (1.0f + __expf(-g)) * up; }
                u32x2 w; w.x = pk_fp8x4(a[0], a[1], a[2], a[3]); w.y = pk_fp8x4(a[4], a[5], a[6], a[7]);
                *(u32x2*)(ACT + (size_t)(row0 + ai * 128 + m * 16) * EFF + col0) = w;
            }
        }
    }
};
struct EpiBf16Rows {
    static constexpr bool PERM = true;
    bf16_t* O; int ldc; int use_aux; int skip = 0;
    DI void operator()(const f32x4 (&acc)[2][2][4][2], const pg8::GU& u, int wr, int wc, int fr, int fq) const {
        if (skip) return;
        const int row0 = (use_aux ? u.aux : u.pm * 256) + wr * 64 + fr, col0 = u.pn * 256 + wc * 32 + 8 * fq;
#pragma unroll
        for (int ai = 0; ai < 2; ++ai) {
            if (ai == 1 && u.h1 != 0) break;
#pragma unroll
            for (int m = 0; m < 4; ++m) {
                bf16_t* rowp = O + (size_t)(row0 + ai * 128 + m * 16) * ldc + col0;
#pragma unroll
                for (int bj = 0; bj < 2; ++bj) {
                    const f32x4 v0 = acc[ai][bj][m][0], v1 = acc[ai][bj][m][1];
                    u32x4 w; w.x = pk_bf16(v0[0], v0[1]); w.y = pk_bf16(v0[2], v0[3]); w.z = pk_bf16(v1[0], v1[1]); w.w = pk_bf16(v1[2], v1[3]);
                    *(u32x4*)(rowp + bj * 128) = w;
                }
            }
        }
    }
};

template <bool FINAL>
DI void phase_combine(const Params& p, LAS unsigned char* lds, int G, int bid, const int layer, const float* xin_ctx, const float* xin_lat, const int row_lo, const int row_hi) {
    const int lane = threadIdx.x & 63, wave = threadIdx.x >> 6;
    LAS int* MT = (LAS int*)(lds + LDS_MISC + 64);
    moe_tables(p, MT, layer);
    const float* MOD = (const float*)(p.ws + WS_MOD);
    const bf16_t* OUT2 = (const bf16_t*)(p.ws + WS_OUT2);
    const TokInfo* TOK = (const TokInfo*)(p.ws + WS_TOK);
    float* XB = (float*)(p.ws + WS_XB); bf16_t* H = (bf16_t*)(p.ws + WS_H);
    for (int row = row_lo + bid * 8 + wave; row < row_hi; row += G * 8) {
        const TokInfo ti = TOK[row];
        const bf16_t* o0 = OUT2 + (size_t)(MT[ti.e0] + ti.p0) * DM; const bf16_t* o1 = OUT2 + (size_t)(MT[ti.e1] + ti.p1) * DM;
        const float* xr = row < NCTX ? xin_ctx + (size_t)row * DM : xin_lat + (size_t)(row - NCTX) * DM;
        const bf16_t* dr = (const bf16_t*)(p.ws + WS_D) + (size_t)row * DM;
        const int mi = row_mod(row);
        const float* g1 = MOD + ((size_t)layer * 5 + mi) * MODN + 2 * DM;
        const float* g2 = MOD + ((size_t)layer * 5 + mi) * MODN + 5 * DM;
        f32x4 v[8];
#pragma unroll
        for (int i = 0; i < 8; ++i) {
            const int col = 4 * lane + 256 * i;
            const u32x2 dw = *(const u32x2*)(dr + col);
            const f32x4 x = *(const f32x4*)(xr + col) + *(const f32x4*)(g1 + col) * (f32x4){bflo(dw.x), bfhi(dw.x), bflo(dw.y), bfhi(dw.y)}, g = *(const f32x4*)(g2 + col);
            const u32x2 a = *(const u32x2*)(o0 + col), b = *(const u32x2*)(o1 + col);
            const f32x4 fa = {bflo(a.x), bfhi(a.x), bflo(a.y), bfhi(a.y)}, fb = {bflo(b.x), bfhi(b.x), bflo(b.y), bfhi(b.y)};
            v[i] = x + g * (fa * ti.w0 + fb * ti.w1);
        }
        if (!FINAL) {
            if (row >= NCTX)
#pragma unroll
            for (int i = 0; i < 8; ++i) *(f32x4*)(XB + (size_t)row * DM + 4 * lane + 256 * i) = v[i];
            const float* md = MOD + ((size_t)5 + mi) * MODN;
            norm_mod_store(v, p.in[29], md, md + DM, H + (size_t)row * DM, lane, FP8_IN1 ? (unsigned char*)(p.ws + WS_H8) + (size_t)row * DM : nullptr);
        } else {
            float ss = 0.f;
#pragma unroll
            for (int i = 0; i < 8; ++i) ss += v[i][0] * v[i][0] + v[i][1] * v[i][1] + v[i][2] * v[i][2] + v[i][3] * v[i][3];
            ss = wave_sum(ss);
            const float r = rsqrtf(ss * (1.0f / DM) + EPS);
#pragma unroll
            for (int i = 0; i < 8; ++i) { const int col = 4 * lane + 256 * i; const f32x4 g = *(const f32x4*)(p.in[6] + col); *(f32x4*)(p.out + (size_t)(row - NCTX) * DM + col) = v[i] * r * g; }
        }
    }
}
template <bool FP8_, int WS_>
struct PlainSchedT {
    static constexpr bool GATHER = false, FP8 = FP8_, GATHER_OR_PAD = false;
    static constexpr int WSCALE = WS_;
    const char* A; const char* Bt; int K; size_t lda, ldb, a_h, b_h; pg8::TileOrder T;
    DI void init(const void* A_, const void* Bt_, int M, int N, int K_, int lda_e, int ldb_e, int G, int c) {
        A = (const char*)A_; Bt = (const char*)Bt_; K = K_; lda = (size_t)lda_e * 2; ldb = (size_t)ldb_e * 2; a_h = 128 * lda; b_h = 128 * ldb; T.init(M / 256, N / 256, G, c); }
    DI bool next(int i, pg8::GU& u) const { int pm, pn; if (!T.tile(i, pm, pn)) return false; u.pm = pm; u.pn = pn; u.e = 0; u.aux = 0; u.h1 = 0; u.a = A + (size_t)pm * 256 * lda; u.b = Bt + (size_t)pn * 256 * ldb; return true; }
    DI unsigned rowoff(const pg8::GU&, int) const { return 0u; }
};
typedef PlainSchedT<false, 127> PlainSched;

struct L1InSched {
    static constexpr bool GATHER = false, FP8 = true, GATHER_OR_PAD = false;
    static constexpr int WSCALE = 127 - 6;
    static constexpr int NLAT_U = (NLAT / 256) * (L1IN / 256), NUNITS = NLAT_U + (NCTX / 256) * 10;
    const char* A; const char* Bt; int K; size_t lda, ldb, a_h, b_h; pg8::TileOrder T; int G, c;
    DI void init(const void* A_, const void* Bt_, int K_, int lda_e, int ldb_e, int G_, int c_) {
        A = (const char*)A_; Bt = (const char*)Bt_; K = K_; lda = (size_t)lda_e * 2; ldb = (size_t)ldb_e * 2; a_h = 128 * lda; b_h = 128 * ldb; G = G_; c = c_; T.init(NLAT / 256, L1IN / 256, G_, c_); }
    DI bool next(int i, pg8::GU& u) const {
        const int L = i * G + c; int pm, pn;
        if (L < NLAT_U) { T.tile(i, pm, pn); pm += NCTX / 256; }
        else if (L < NUNITS) { const int idx = L - NLAT_U, k = idx % 10; pm = idx / 10; pn = k < 2 ? 4 + k : 8 + k; }
        else return false;
        u.pm = pm; u.pn = pn; u.e = 0; u.aux = 0; u.h1 = 0; u.a = A + (size_t)pm * 256 * lda; u.b = Bt + (size_t)pn * 256 * ldb; return true; }
    DI unsigned rowoff(const pg8::GU&, int) const { return 0u; }
};

template <int MODE>
struct EpiRope {
    static constexpr bool PERM = false;
    bf16_t* O; int ldc; const f32x2* R;
    DI void operator()(const f32x4 (&acc)[2][2][4][2], const pg8::GU& u, int wr, int wc, int fr, int fq) const {
        const int row0 = u.pm * 256 + wr * 64 + fr;
#pragma unroll
        for (int bj = 0; bj < 2; ++bj) {
            const int g32 = 8 * u.pn + 4 * bj + wc;
            int axis, ibase; bool rot;
            if (MODE == 0) { const int hg = g32 % 6; rot = hg >= 4; axis = hg - 4; ibase = 4 * fq; }
            else { rot = u.pn < 5; axis = (g32 & 3) >> 1; ibase = 16 * (g32 & 1) + 4 * fq; }
            const int col0 = 32 * g32 + 4 * fq;
#pragma unroll
            for (int ai = 0; ai < 2; ++ai)
#pragma unroll
                for (int m = 0; m < 4; ++m) {
                    const int row = row0 + ai * 128 + m * 16;
                    f32x4 x1 = acc[ai][bj][m][0], x2 = acc[ai][bj][m][1];
                    if (MODE == 0) { x1 *= 0.07216878364870322f * LOG2E; x2 *= 0.07216878364870322f * LOG2E; }
                    if (rot && row >= NCTX) {
                        const int t = (row - NCTX) & (SEQ - 1), pos = axis ? (t & 63) : (t >> 6);
                        const f32x2* cs = R + pos * (MODE == 0 ? 16 : 32) + ibase;
                        f32x4 o1, o2;
#pragma unroll
                        for (int j = 0; j < 4; ++j) { const f32x2 c = cs[j]; o1[j] = x1[j] * c[0] - x2[j] * c[1]; o2[j] = x2[j] * c[0] + x1[j] * c[1]; }
                        x1 = o1; x2 = o2;
                    }
                    bf16_t* rowp = O + (size_t)row * ldc + col0;
                    u32x2 w1, w2; w1.x = pk_bf16(x1[0], x1[1]); w1.y = pk_bf16(x1[2], x1[3]); w2.x = pk_bf16(x2[0], x2[1]); w2.y = pk_bf16(x2[2], x2[3]);
                    *(u32x2*)(rowp) = w1; *(u32x2*)(rowp + 16) = w2;
                }
        }
    }
};

struct EpiResid {
    static constexpr bool PERM = true;
    const float* xin_ctx; const float* xin_lat; float* XO; const float* MODL; int rowbase;
    DI void operator()(const f32x4 (&acc)[2][2][4][2], const pg8::GU& u, int wr, int wc, int fr, int fq) const {
        const int row0 = rowbase + u.pm * 256 + wr * 64 + fr, col0 = u.pn * 256 + wc * 32 + 8 * fq;
        const float* g1 = MODL + (size_t)row_mod(rowbase + u.pm * 256) * MODN + 2 * DM;
        f32x4 gv[2][2];
#pragma unroll
        for (int bj = 0; bj < 2; ++bj)
#pragma unroll
            for (int n = 0; n < 2; ++n) gv[bj][n] = *(const f32x4*)(g1 + col0 + bj * 128 + n * 4);
#pragma unroll
        for (int ai = 0; ai < 2; ++ai)
#pragma unroll
            for (int m = 0; m < 4; ++m) {
                const int row = row0 + ai * 128 + m * 16;
                const float* xr = (row < NCTX ? xin_ctx + (size_t)row * DM : xin_lat + (size_t)(row - NCTX) * DM) + col0;
                float* xo = XO + (size_t)row * DM + col0;
#pragma unroll
                for (int bj = 0; bj < 2; ++bj)
#pragma unroll
                    for (int n = 0; n < 2; ++n) *(f32x4*)(xo + bj * 128 + n * 4) = *(const f32x4*)(xr + bj * 128 + n * 4) + gv[bj][n] * acc[ai][bj][m][n];
            }
    }
};

constexpr int NPHASE = 18;
constexpr int BG_U2 = (NTOK / 256) * (L0INP / 256), BG_U6 = (NTOK / 256) * (DM / 256), BG_U11 = FP8_IN1 ? (NLAT / 256) * (L1IN / 256) + (NCTX / 256) * 10 : (NTOK / 256) * (L1IN / 256);
#ifndef BG_Q2
#define BG_Q2 12
#endif
#ifndef BG_Q6
#define BG_Q6 10
#endif
#ifndef BG_Q8
#define BG_Q8 12
#endif
#ifndef BG_Q11
#define BG_Q11 12
#endif
__global__ void __launch_bounds__(NTHREADS, 2) fwd_kernel(Params p) {
    extern __shared__ __attribute__((aligned(16))) unsigned char lds_raw[];
    LAS unsigned char* lds = (LAS unsigned char*)lds_raw;
    const int tid = threadIdx.x, G = gridDim.x, bid = blockIdx.x;
    unsigned char* ws = p.ws;
    if (tid < 64) ((LAS unsigned*)(lds + LDS_MISC))[tid] = 0u;
    __syncthreads();
    const int lo = p.ph_lo, hi = p.ph_hi;
    const bool use_bar = (hi - lo) > 1;
    XcdBarrier bar; bar.bar = (unsigned*)(ws + WS_CTL + CW_BAR); bar.x = 0; bar.st = (volatile LAS unsigned*)(lds + LDS_MISC);
    if (use_bar) bar = xcd_barrier_post((unsigned*)(ws + WS_CTL + CW_BAR), (volatile LAS unsigned*)(lds + LDS_MISC));
#ifndef PH_MASK
#define PH_MASK 0x3ffff
#endif
#define IN(k) (((PH_MASK >> (k)) & 1) && lo <= (k) && (k) < hi)
#ifndef REPEAT_MASK
#define REPEAT_MASK 0
#endif
#define REP(k) 0
#define SEAM(k) do { if (rep_ == REP(k) && IN((k) + 1)) xcd_barrier(bar); } while (0)
    const float* MOD = (const float*)(ws + WS_MOD);
    LAS int* MT = (LAS int*)(lds + LDS_MISC + 64);
    const int vc = (G % 8 == 0) ? (bid % 8) * (G / 8) + bid / 8 : bid;
    (void)vc;

    if (IN(0)) for (int rep_ = 0; rep_ <= REP(0); ++rep_) { if (rep_) __syncthreads(); phase_prologue(p, lds, G, bid); SEAM(0); }
    if (IN(1)) for (int rep_ = 0; rep_ <= REP(1); ++rep_) { if (rep_) __syncthreads(); phase_norm0(p, G, bid); SEAM(1); }
    if (IN(2)) for (int rep_ = 0; rep_ <= REP(2); ++rep_) { if (rep_) __syncthreads();
        PlainSched S; S.init(ws + WS_H, ws + WS_W0IN, NTOK, L0INP, DM, DM, DM, G, bid);
        EpiBf16Rows E{(bf16_t*)(ws + WS_Z), L0INP, 0, p.flags & 1};
        pg8::gemm_phase(lds, S, E);
        bg_range(p, lds, 1, 0, BG_L0_P2, BG_U2, G, bid);
        SEAM(2);
    }
    if (IN(3)) for (int rep_ = 0; rep_ <= REP(3); ++rep_) { if (rep_) __syncthreads(); phase_l0_rows(p, G, bid); __syncthreads(); lru_units<1>(p, lds, G, bid); SEAM(3); }
    if (IN(4)) for (int rep_ = 0; rep_ <= REP(4); ++rep_) { if (rep_) __syncthreads();
        { PlainSched S; S.init(ws + WS_CQN, ws + WS_WUQ, NTOK, 1536, 512, 512, 512, G, bid);
          EpiRope<0> E{(bf16_t*)(ws + WS_Q0), 1536, (const f32x2*)(ws + WS_ROPE0)};
          pg8::gemm_phase(lds, S, E); }
        { PlainSched S; S.init(ws + WS_CKVN, ws + WS_WUKV, NTOK, 2048, 256, 256, 256, G, (bid + G - ((NTOK / 256) * 6) % G) % G);
          EpiBf16Rows E{(bf16_t*)(ws + WS_KV0), 2048, 0};
          pg8::gemm_phase(lds, S, E); }
        lru_carry(p, G, bid);
        SEAM(4);
    }
    if (IN(5)) for (int rep_ = 0; rep_ <= REP(5); ++rep_) { if (rep_) __syncthreads(); if (!(p.flags & 2)) phase_attn0(p, lds, G, bid); __syncthreads(); if (!(p.flags & 4)) lru_pass2(p, lds, G, bid); SEAM(5); }
    if (IN(6)) for (int rep_ = 0; rep_ <= REP(6); ++rep_) { if (rep_) __syncthreads();
        PlainSched S; S.init(ws + WS_Y, ws + WS_W0OUT, NTOK, DM, DM, DM, DM, G, bid);
        EpiBf16Rows E{(bf16_t*)(ws + WS_D), DM, 0};
        pg8::gemm_phase(lds, S, E);
        bg_range(p, lds, 1, BG_L0_P2, BG_L0_P6, BG_U6, G, bid);
        SEAM(6);
    }
    if (IN(7)) for (int rep_ = 0; rep_ <= REP(7); ++rep_) { if (rep_) __syncthreads(); phase_router(p, lds, G, bid, 0, p.in[2], p.in[0], 0, NTOK);
        bg_range(p, lds, 1, BG_L0_P6, BG_L0_P7, NTOK / 16, G, bid); SEAM(7); }
    if (IN(8)) for (int rep_ = 0; rep_ <= REP(8); ++rep_) { if (rep_) __syncthreads();
        moe_tables(p, MT, 0);
#if FP8_L0
        MoeSchedUpT<true, 127 - 6> S; S.Hb = (const char*)(ws + WS_H8); S.EG = (const char*)(ws + WS_EG); S.LIST = (const int*)(ws + WS_LIST); S.MT = MT; S.K = DM / 2;
        S.lda = DM; S.ldb = DM; S.a_h = 0; S.b_h = WS_EU - WS_EG; S.G = G; S.c = bid; S.estride = (size_t)EFF * DM; S.wscale = 127 - 6;
        EpiSwiGLU8 E{(unsigned char*)(ws + WS_ACT)};
        pg8::gemm_phase(lds, S, E);
#else
        MoeSchedUp S; S.Hb = (const char*)(ws + WS_H); S.EG = (const char*)(ws + WS_EG); S.LIST = (const int*)(ws + WS_LIST); S.MT = MT; S.K = DM;
        S.lda = DM * 2; S.ldb = DM * 2; S.a_h = 0; S.b_h = WS_EU - WS_EG; S.G = G; S.c = bid; S.estride = (size_t)EFF * DM * 2; S.wscale = 127;
        EpiSwiGLU E{(bf16_t*)(ws + WS_ACT)};
        pg8::gemm_phase(lds, S, E);
#endif
        bg_range(p, lds, 2, 0, BG_L1_P8, 4 * MT[64 + 32], G, bid);
        SEAM(8);
    }
    if (IN(9)) for (int rep_ = 0; rep_ <= REP(9); ++rep_) { if (rep_) __syncthreads();
        moe_tables(p, MT, 0);
#if FP8_L0
        MoeSchedDownT<true, 127 - 5> S; S.ACT = (const char*)(ws + WS_ACT); S.ED = (const char*)(ws + WS_ED); S.MT = MT; S.K = EFF / 2;
        S.lda = EFF; S.ldb = EFF; S.a_h = 128 * EFF; S.b_h = 128 * EFF; S.G = G; S.c = bid; S.estride = (size_t)DM * EFF; S.wscale = 127 - 5;
        EpiBf16Rows E{(bf16_t*)(ws + WS_OUT2), DM, 1};
#else
        MoeSchedDown S; S.ACT = (const char*)(ws + WS_ACT); S.ED = (const char*)(ws + WS_ED); S.MT = MT; S.K = EFF;
        S.lda = EFF * 2; S.ldb = EFF * 2; S.a_h = 128 * EFF * 2; S.b_h = 128 * EFF * 2; S.G = G; S.c = bid; S.estride = (size_t)DM * EFF * 2; S.wscale = 127;
        EpiBf16Rows E{(bf16_t*)(ws + WS_OUT2), DM, 1};
#endif
        pg8::gemm_phase(lds, S, E); SEAM(9);
    }
    if (IN(10)) for (int rep_ = 0; rep_ <= REP(10); ++rep_) { if (rep_) __syncthreads(); phase_combine<false>(p, lds, G, bid, 0, p.in[2], p.in[0], 0, NTOK); SEAM(10); }
    if (IN(11)) for (int rep_ = 0; rep_ <= REP(11); ++rep_) { if (rep_) __syncthreads();
#if FP8_IN1
        L1InSched S; S.init(ws + WS_H8, ws + WS_W1IN, DM / 2, DM / 2, DM / 2, G, bid);
#else
        PlainSched S; S.init(ws + WS_H, ws + WS_W1IN, NTOK, L1IN, DM, DM, DM, G, bid);
#endif
        EpiRope<1> E{(bf16_t*)(ws + WS_Z), L1IN, (const f32x2*)(ws + WS_ROPE1)};
        pg8::gemm_phase(lds, S, E);
        bg_range(p, lds, 2, BG_L1_P8, BG_L1_P11, BG_U11, G, bid);
        SEAM(11);
    }
    if (IN(12)) for (int rep_ = 0; rep_ <= REP(12); ++rep_) { if (rep_) __syncthreads(); if (!(p.flags & 2)) phase_attn_win(p, lds, G, bid); __syncthreads(); if (!(p.flags & 4)) phase_attn_na(p, lds, G, bid); SEAM(12); }
    if (IN(13)) for (int rep_ = 0; rep_ <= REP(13); ++rep_) { if (rep_) __syncthreads();
#if FP8_OUT1
        PlainSchedT<true, 127 - 6> S; S.init(ws + WS_Y + (size_t)NCTX * DM, ws + WS_W1OUT, NLAT, DM, DM / 2, DM / 2, DM / 2, G, bid);
#else
        PlainSched S; S.init(ws + WS_Y + (size_t)NCTX * DM * 2, ws + WS_W1OUT, NLAT, DM, DM, DM, DM, G, bid);
#endif
        EpiBf16Rows E{(bf16_t*)(ws + WS_D) + (size_t)NCTX * DM, DM, 0};
        pg8::gemm_phase(lds, S, E); SEAM(13);
    }
    if (IN(14)) for (int rep_ = 0; rep_ <= REP(14); ++rep_) { if (rep_) __syncthreads(); phase_router(p, lds, G, bid, 1, (const float*)(ws + WS_XB), (const float*)(ws + WS_XB) + (size_t)NCTX * DM, NCTX, NTOK); SEAM(14); }
    if (IN(15)) for (int rep_ = 0; rep_ <= REP(15); ++rep_) { if (rep_) __syncthreads();
        moe_tables(p, MT, 1);
        MoeSchedUpT<true, 127 - 6> S; S.Hb = (const char*)(ws + WS_H8); S.EG = (const char*)(ws + WS_EG + EXPW); S.LIST = (const int*)(ws + WS_LIST); S.MT = MT; S.K = DM / 2;
        S.lda = DM; S.ldb = DM; S.a_h = 0; S.b_h = WS_EU - WS_EG; S.G = G; S.c = bid; S.estride = (size_t)EFF * DM; S.wscale = 127 - 6;
        EpiSwiGLU8 E{(unsigned char*)(ws + WS_ACT)};
        pg8::gemm_phase(lds, S, E);
        bg_range(p, lds, 2, BG_L1_DOWN0, MOE_CVT_TILES, 4 * MT[64 + 32], G, bid);
        SEAM(15);
    }
    if (IN(16)) for (int rep_ = 0; rep_ <= REP(16); ++rep_) { if (rep_) __syncthreads();
        moe_tables(p, MT, 1);
        MoeSchedDownT<true, 127 - 5> S; S.ACT = (const char*)(ws + WS_ACT); S.ED = (const char*)(ws + WS_ED + EXPW); S.MT = MT; S.K = EFF / 2;
        S.lda = EFF; S.ldb = EFF; S.a_h = 128 * EFF; S.b_h = 128 * EFF; S.G = G; S.c = bid; S.estride = (size_t)DM * EFF; S.wscale = 127 - 5;
        EpiBf16Rows E{(bf16_t*)(ws + WS_OUT2), DM, 1};
        pg8::gemm_phase(lds, S, E); SEAM(16);
    }
    if (IN(17)) for (int rep_ = 0; rep_ <= REP(17); ++rep_) { if (rep_) __syncthreads(); phase_combine<true>(p, lds, G, bid, 1, (const float*)(ws + WS_XB), (const float*)(ws + WS_XB) + (size_t)NCTX * DM, NCTX, NTOK); }
#undef IN
#undef SEAM
}

#ifndef REPEAT_FLAGS
#define REPEAT_FLAGS 0
#endif
#ifndef N_LAUNCH_MODE
#define N_LAUNCH_MODE 0
#endif
extern "C" void kernel_launch(void* const* d_in, const int* in_sizes, int n_in, void* d_out, int out_size, void* d_ws, size_t ws_size, hipStream_t stream) {
    static int grid = 0;
    if (grid == 0) {
        if (n_in != 38 || out_size != NLAT * DM || ws_size < WS_END) { fprintf(stderr, "kernel_launch: unexpected problem shape (n_in %d out %d ws %zu need %zu)\n", n_in, out_size, ws_size, (size_t)WS_END); grid = -1; return; }
        int dev = 0, cus = 0, per_cu = 0;
        if (hipGetDevice(&dev) != hipSuccess || hipDeviceGetAttribute(&cus, hipDeviceAttributeMultiprocessorCount, dev) != hipSuccess) { grid = -1; return; }
        if (hipFuncSetAttribute((const void*)fwd_kernel, hipFuncAttributeMaxDynamicSharedMemorySize, LDS_BYTES) != hipSuccess) { fprintf(stderr, "kernel_launch: hipFuncSetAttribute failed\n"); grid = -1; return; }
        if (hipOccupancyMaxActiveBlocksPerMultiprocessor(&per_cu, (const void*)fwd_kernel, NTHREADS, LDS_BYTES) != hipSuccess || per_cu < 1) { fprintf(stderr, "kernel_launch: occupancy query reports %d\n", per_cu); (void)hipGetLastError(); }
        if (cus * 48 < NTOK) { fprintf(stderr, "kernel_launch: built for >= 192 CUs (router score table), got %d\n", cus); grid = -1; return; }
        grid = cus;
    }
    if (grid < 0) return;
    (void)hipMemsetAsync((char*)d_ws + WS_CTL, 0, CTL_BYTES, stream);
    Params prm{};
    for (int i = 0; i < 38; ++i) prm.in[i] = (const float*)d_in[i];
    prm.out = (float*)d_out; prm.ws = (unsigned char*)d_ws; prm.flags = 0; prm.pad = 0;
#if N_LAUNCH_MODE == 0
    prm.ph_lo = 0; prm.ph_hi = NPHASE;
    hipLaunchKernelGGL(fwd_kernel, dim3(grid), dim3(NTHREADS), LDS_BYTES, stream, prm);
#else
    for (int k = 0; k < NPHASE; ++k) { prm.ph_lo = k; prm.ph_hi = k + 1; const int reps = 1 + ((REPEAT_MASK >> k) & 1);
        for (int r = 0; r < reps; ++r) { prm.flags = (reps > 1 && r == 0) ? (REPEAT_FLAGS) : 0; if (r && (k == 7 || k == 14)) (void)hipMemsetAsync((char*)d_ws + WS_CTL + CW_CNT + (k == 14 ? NEXP * 4 : 0), 0, NEXP * 4, stream);
            hipLaunchKernelGGL(fwd_kernel, dim3(grid), dim3(NTHREADS), LDS_BYTES, stream, prm); } }
#endif
}
```
